# Optimizing an MI355X kernel written in HIP

```python
import jax, jax.numpy as jnp
from jax import lax
import numpy as np

D_MODEL = 1024
BATCH = 16
SEQ = 4096
DEPTH = 2

N_MIXERS = 2
N_META = 16
HEAD_DIM = 64
N_HEADS = 16
N_KV_HEADS = 2
GROUP = N_HEADS // N_KV_HEADS
Q_COLS = N_HEADS * HEAD_DIM
KV_COLS = N_KV_HEADS * HEAD_DIM
ROT_DIM = HEAD_DIM // 4
ROPE_THETA = 500000.0
ATTN_SCALE = HEAD_DIM ** -0.5
WINDOW = 128
BLOCK = 128
IDX_HEADS = 8
IDX_DIM = 64
IDX_ROT_DIM = IDX_DIM // 2
IDX_SCALE = IDX_DIM ** -0.5
IDX_W_SCALE = IDX_HEADS ** -0.5
TOPK_MAX = 256
IN_COLS_A = Q_COLS + 2 * KV_COLS
IN_COLS_B = Q_COLS + 2 * KV_COLS + IDX_HEADS * IDX_DIM + IDX_DIM + IDX_HEADS
N_EXPERTS = 32
TOP_K = 4
D_FF = 1024
SWIGLU_LIMIT = 7.0
SWIGLU_ALPHA = 1.702
MOE_BLOCK = 512
ALPHA = (2 * DEPTH) ** 0.25
BETA = (8 * DEPTH) ** -0.25
LN_EPS = 1e-5
NEG = -1e30
N_LAYERS_A = (DEPTH + 1) // 2
N_LAYERS_B = DEPTH // 2

kernel_name = 'hybrid_swa_sink_dsa_moe_deepnorm'


def layer_norm(x, g, b):
    xf = x.astype(jnp.float32)
    mu = jnp.mean(xf, -1, keepdims=True)
    var = jnp.mean(jnp.square(xf - mu), -1, keepdims=True)
    return ((xf - mu) * lax.rsqrt(var + LN_EPS) * g + b).astype(x.dtype)


def rope(x, pos, rot_dim):
    half = rot_dim // 2
    inv_freq = ROPE_THETA ** (-jnp.arange(half, dtype=jnp.float32) / half)
    ang = pos.astype(jnp.float32)[:, None] * inv_freq[None, :]
    cos = jnp.cos(ang)[:, None, :]
    sin = jnp.sin(ang)[:, None, :]
    x1 = x[..., :half].astype(jnp.float32)
    x2 = x[..., half:rot_dim].astype(jnp.float32)
    rot = jnp.concatenate([x1 * cos - x2 * sin, x2 * cos + x1 * sin], -1).astype(x.dtype)
    return jnp.concatenate([rot, x[..., rot_dim:]], -1)


def to_blocks(a):
    B, S = a.shape[:2]
    return jnp.moveaxis(a.reshape((B, S // BLOCK, BLOCK) + a.shape[2:]), 1, 0)


def from_blocks(a):
    a = jnp.moveaxis(a, 0, 1)
    return a.reshape((a.shape[0], a.shape[1] * a.shape[2]) + a.shape[3:])


def meta_causal_mask():
    i = jnp.arange(N_META)
    return i[None, :] <= i[:, None]


def split_heads(q, k, v, L):
    B = q.shape[0]
    pos = jnp.arange(L)
    q = rope(q.reshape(B, L, N_HEADS, HEAD_DIM), pos, ROT_DIM)
    q = q.reshape(B, L, N_KV_HEADS, GROUP, HEAD_DIM)
    k = rope(k.reshape(B, L, N_KV_HEADS, HEAD_DIM), pos, ROT_DIM)
    v = v.reshape(B, L, N_KV_HEADS, HEAD_DIM)
    return q, k, v


def swa_sink_mixer(h, w_in, b_in, sinks, w_out):
    B, L, _ = h.shape
    proj = jnp.einsum('bld,de->ble', h, w_in) + b_in
    q, k, v = jnp.split(proj, [Q_COLS, Q_COLS + KV_COLS], axis=-1)
    q, k, v = split_heads(q, k, v, L)
    sink = sinks.reshape(N_KV_HEADS, GROUP).astype(jnp.float32)[None, :, :, None, None]

    def probs_with_sink(logits):
        s = jnp.broadcast_to(sink, logits.shape[:-1] + (1,))
        p = jax.nn.softmax(jnp.concatenate([logits, s], -1), axis=-1)
        return p[..., :-1]

    qm, km, vm = q[:, :N_META], k[:, :N_META], v[:, :N_META]
    s_mm = jnp.einsum('bikgd,bjkd->bkgij', qm, km, preferred_element_type=jnp.float32) * ATTN_SCALE
    s_mm = jnp.where(meta_causal_mask(), s_mm, NEG)
    out_m = jnp.einsum('bkgij,bjkd->bikgd', probs_with_sink(s_mm).astype(v.dtype), vm)

    qb = to_blocks(q[:, N_META:])
    kb = to_blocks(k[:, N_META:])
    vb = to_blocks(v[:, N_META:])
    k_band = jnp.concatenate([jnp.concatenate([jnp.zeros_like(kb[:1]), kb[:-1]], 0), kb], 2)
    v_band = jnp.concatenate([jnp.concatenate([jnp.zeros_like(vb[:1]), vb[:-1]], 0), vb], 2)
    nb = qb.shape[0]
    ii = jnp.arange(BLOCK)[:, None]
    jj = jnp.arange(2 * BLOCK)[None, :]
    rel = BLOCK + ii - jj
    band_ok = (rel >= 0) & (rel < WINDOW)

    def block_fn(args):
        q_blk, k_blk, v_blk, n = args
        s_band = jnp.einsum('bikgd,bjkd->bkgij', q_blk, k_blk, preferred_element_type=jnp.float32) * ATTN_SCALE
        valid = band_ok & ((n > 0) | (jj >= BLOCK))
        s_band = jnp.where(valid, s_band, NEG)
        s_meta = jnp.einsum('bikgd,bmkd->bkgim', q_blk, km, preferred_element_type=jnp.float32) * ATTN_SCALE
        p = probs_with_sink(jnp.concatenate([s_meta, s_band], -1)).astype(v_blk.dtype)
        return (jnp.einsum('bkgim,bmkd->bikgd', p[..., :N_META], vm)
                + jnp.einsum('bkgij,bjkd->bikgd', p[..., N_META:], v_blk))

    out_r = lax.map(block_fn, (qb, k_band, v_band, jnp.arange(nb)))
    out = jnp.concatenate([out_m, from_blocks(out_r)], 1).reshape(B, L, Q_COLS)
    return jnp.einsum('ble,ed->bld', out, w_out)


def dsa_mixer(h, w_in, b_in, idx_k_g, idx_k_b, w_out):
    B, L, _ = h.shape
    S = L - N_META
    topk = min(TOPK_MAX, S // 4)
    proj = jnp.einsum('bld,de->ble', h, w_in) + b_in
    cuts = np.cumsum([Q_COLS, KV_COLS, KV_COLS, IDX_HEADS * IDX_DIM, IDX_DIM]).tolist()
    q, k, v, qi, ki, wi = jnp.split(proj, cuts, axis=-1)
    q, k, v = split_heads(q, k, v, L)
    pos = jnp.arange(L)
    qi = rope(qi.reshape(B, L, IDX_HEADS, IDX_DIM), pos, IDX_ROT_DIM)
    ki = rope(layer_norm(ki, idx_k_g, idx_k_b)[:, :, None, :], pos, IDX_ROT_DIM)[:, :, 0]
    wi = wi * IDX_W_SCALE

    qm, km, vm = q[:, :N_META], k[:, :N_META], v[:, :N_META]
    s_mm = jnp.einsum('bikgd,bjkd->bkgij', qm, km, preferred_element_type=jnp.float32) * ATTN_SCALE
    s_mm = jnp.where(meta_causal_mask(), s_mm, NEG)
    out_m = jnp.einsum('bkgij,bjkd->bikgd', jax.nn.softmax(s_mm, -1).astype(v.dtype), vm)

    kr, vr = k[:, N_META:], v[:, N_META:]
    kir = ki[:, N_META:]
    s_idx = jnp.arange(S)
    qb = to_blocks(q[:, N_META:])
    qib = to_blocks(qi[:, N_META:])
    wib = to_blocks(wi[:, N_META:])
    nb = qb.shape[0]
    gather_rows = jax.vmap(lambda arr, idx: arr[idx])

    def block_fn(args):
        q_blk, qi_blk, wi_blk, n = args
        t = n * BLOCK + jnp.arange(BLOCK)
        dots = jnp.einsum('bihd,bsd->bhis', qi_blk, kir, preferred_element_type=jnp.float32) * IDX_SCALE
        score = jnp.einsum('bhis,bih->bis', jax.nn.relu(dots), wi_blk.astype(jnp.float32))
        score = jnp.where(s_idx[None, :] <= t[:, None], score, NEG)
        _, sel = lax.top_k(score, topk)
        sel_ok = sel <= t[None, :, None]
        k_sel = gather_rows(kr, sel)
        v_sel = gather_rows(vr, sel)
        s_sel = jnp.einsum('bikgd,bijkd->bkgij', q_blk, k_sel, preferred_element_type=jnp.float32) * ATTN_SCALE
        s_sel = jnp.where(sel_ok[:, None, None], s_sel, NEG)
        s_meta = jnp.einsum('bikgd,bmkd->bkgim', q_blk, km, preferred_element_type=jnp.float32) * ATTN_SCALE
        p = jax.nn.softmax(jnp.concatenate([s_meta, s_sel], -1), -1).astype(v_sel.dtype)
        return (jnp.einsum('bkgim,bmkd->bikgd', p[..., :N_META], vm)
                + jnp.einsum('bkgij,bijkd->bikgd', p[..., N_META:], v_sel))

    out_r = lax.map(block_fn, (qb, qib, wib, jnp.arange(nb)))
    out = jnp.concatenate([out_m, from_blocks(out_r)], 1).reshape(B, L, Q_COLS)
    return jnp.einsum('ble,ed->bld', out, w_out)


def moe_ffn(h, w_router, b_router, w_gu, b_gu, w_down, b_down):
    B, L, D = h.shape
    x = h.reshape(-1, D)
    N = x.shape[0]
    logits = (jnp.einsum('nd,de->ne', x, w_router) + b_router).astype(jnp.float32)
    top_logit, top_e = lax.top_k(logits, TOP_K)
    gates = jax.nn.softmax(top_logit, -1)
    A = N * TOP_K
    flat_e = top_e.reshape(-1)
    flat_tok = jnp.repeat(jnp.arange(N, dtype=jnp.int32), TOP_K)
    flat_g = gates.reshape(-1)
    order = jnp.argsort(flat_e)
    e_s, tok_s, g_s = flat_e[order], flat_tok[order], flat_g[order]
    counts = jnp.bincount(flat_e, length=N_EXPERTS)
    padded = (counts + MOE_BLOCK - 1) // MOE_BLOCK * MOE_BLOCK
    start = jnp.cumsum(counts) - counts
    pend = jnp.cumsum(padded)
    pstart = pend - padded
    dest = pstart[e_s] + (jnp.arange(A) - start[e_s])
    P = (-(-A // MOE_BLOCK) + N_EXPERTS) * MOE_BLOCK
    nblk = P // MOE_BLOCK
    tok_pad = jnp.full((P,), N, jnp.int32).at[dest].set(tok_s)
    g_pad = jnp.zeros((P,), jnp.float32).at[dest].set(g_s)
    blk_e = jnp.minimum(jnp.searchsorted(pend, jnp.arange(nblk) * MOE_BLOCK, side='right'), N_EXPERTS - 1)
    x_pad = jnp.concatenate([x, jnp.zeros((1, D), x.dtype)], 0)

    def expert_block(args):
        tok, g, e = args
        xb = x_pad[tok]
        gu = xb @ w_gu[e] + b_gu[e]
        gate = jnp.minimum(gu[:, :D_FF], SWIGLU_LIMIT)
        up = jnp.clip(gu[:, D_FF:], -SWIGLU_LIMIT, SWIGLU_LIMIT)
        act = gate * jax.nn.sigmoid(SWIGLU_ALPHA * gate) * (up + 1)
        y = act @ w_down[e] + b_down[e]
        return y * g[:, None].astype(y.dtype)

    y = lax.map(expert_block, (tok_pad.reshape(nblk, MOE_BLOCK), g_pad.reshape(nblk, MOE_BLOCK), blk_e))
    out = jax.ops.segment_sum(y.reshape(P, D), tok_pad, num_segments=N + 1)[:N]
    return out.reshape(B, L, D)


def setup_inputs(seed: int = 0) -> dict:
    key = jax.random.key(seed)
    ks = jax.random.split(key, 24)
    nrm = lambda k, shape, s: jax.random.normal(k, shape, jnp.float32) * s
    D = D_MODEL
    return {
        'x': nrm(ks[0], (BATCH, SEQ, D), 1.0),
        'meta_tokens': nrm(ks[1], (N_META, D), 1.0),
        'w_in_a': nrm(ks[2], (N_LAYERS_A, D, IN_COLS_A), D ** -0.5),
        'b_in_a': nrm(ks[3], (N_LAYERS_A, IN_COLS_A), 0.02),
        'sinks_a': nrm(ks[4], (N_LAYERS_A, N_HEADS), 1.0),
        'w_out_a': nrm(ks[5], (N_LAYERS_A, Q_COLS, D), BETA * Q_COLS ** -0.5),
        'w_in_b': nrm(ks[6], (N_LAYERS_B, D, IN_COLS_B), D ** -0.5),
        'b_in_b': nrm(ks[7], (N_LAYERS_B, IN_COLS_B), 0.02),
        'idx_k_norm_g': 1.0 + nrm(ks[8], (N_LAYERS_B, IDX_DIM), 0.02),
        'idx_k_norm_b': nrm(ks[9], (N_LAYERS_B, IDX_DIM), 0.02),
        'w_out_b': nrm(ks[10], (N_LAYERS_B, Q_COLS, D), BETA * Q_COLS ** -0.5),
        'ln_mix_g': 1.0 + nrm(ks[11], (DEPTH, D), 0.02),
        'ln_mix_b': nrm(ks[12], (DEPTH, D), 0.02),
        'w_router': nrm(ks[13], (DEPTH, D, N_EXPERTS), D ** -0.5),
        'b_router': nrm(ks[14], (DEPTH, N_EXPERTS), 0.01),
        'w_gate_up': nrm(ks[15], (DEPTH, N_EXPERTS, D, 2 * D_FF), D ** -0.5),
        'b_gate_up': nrm(ks[16], (DEPTH, N_EXPERTS, 2 * D_FF), 0.02),
        'w_down': nrm(ks[17], (DEPTH, N_EXPERTS, D_FF, D), BETA * D_FF ** -0.5),
        'b_down': nrm(ks[18], (DEPTH, N_EXPERTS, D), 0.02),
        'ln_ffn_g': 1.0 + nrm(ks[19], (DEPTH, D), 0.02),
        'ln_ffn_b': nrm(ks[20], (DEPTH, D), 0.02),
    }


def reference(x, meta_tokens, w_in_a, b_in_a, sinks_a, w_out_a, w_in_b, b_in_b,
              idx_k_norm_g, idx_k_norm_b, w_out_b, ln_mix_g, ln_mix_b, w_router, b_router,
              w_gate_up, b_gate_up, w_down, b_down, ln_ffn_g, ln_ffn_b):
    B = x.shape[0]
    meta = jnp.broadcast_to(meta_tokens[None].astype(x.dtype), (B, N_META, x.shape[-1]))
    h = jnp.concatenate([meta, x], 1)
    for i in range(DEPTH):
        j = i // N_MIXERS
        if i % N_MIXERS == 0:
            mix = swa_sink_mixer(h, w_in_a[j], b_in_a[j], sinks_a[j], w_out_a[j])
        else:
            mix = dsa_mixer(h, w_in_b[j], b_in_b[j], idx_k_norm_g[j], idx_k_norm_b[j], w_out_b[j])
        h = layer_norm(ALPHA * h + mix, ln_mix_g[i], ln_mix_b[i])
        ffn = moe_ffn(h, w_router[i], b_router[i], w_gate_up[i], b_gate_up[i], w_down[i], b_down[i])
        h = layer_norm(ALPHA * h + ffn, ln_ffn_g[i], ln_ffn_b[i])
    return h[:, N_META:]
```

```cpp
#include <hip/hip_runtime.h>
#include <cstdio>
#include <cstdint>
#define GAS __attribute__((address_space(1)))
#define LAS __attribute__((address_space(3)))
typedef unsigned short bf16;
typedef unsigned v4u __attribute__((ext_vector_type(4)));
typedef float f32x4 __attribute__((ext_vector_type(4)));
typedef short bf16x8 __attribute__((ext_vector_type(8)));
typedef GAS unsigned gu32;
typedef GAS unsigned long long gu64;
#define RLX_AGENT __ATOMIC_RELAXED, __HIP_MEMORY_SCOPE_AGENT
#define LDS_WAIT() asm volatile("s_waitcnt lgkmcnt(0)" ::: "memory")
#define VM_WAIT() asm volatile("s_waitcnt vmcnt(0)" ::: "memory")
__device__ __forceinline__ unsigned long long rt() { return __builtin_amdgcn_s_memrealtime(); }
__device__ __forceinline__ unsigned f2bf(float f) { unsigned u = __builtin_bit_cast(unsigned, f); return (u + 0x7fffu + ((u >> 16) & 1u)) >> 16; }
__device__ __forceinline__ unsigned pk2(float lo, float hi) { return f2bf(lo) | (f2bf(hi) << 16); }

#define XB_TMO      128
#define XB_XCNT(j)  (256  + 64 * (j))
#define XB_XSUB(j)  (1280 + 64 * (j))
#define XB_XGEN(j)  (2304 + 64 * (j))
#define XB_TOP      3328
#define XB_TOPGEN   3392
#define XCD_BAR_WORDS 3456
#define XB_SPIN_CAP (1u << 18)

__device__ __forceinline__ unsigned xb_ld(unsigned* p)              { return __hip_atomic_load(p, __ATOMIC_RELAXED, __HIP_MEMORY_SCOPE_AGENT); }
__device__ __forceinline__ unsigned xb_add(unsigned* p, unsigned v) { return __hip_atomic_fetch_add(p, v, __ATOMIC_RELAXED, __HIP_MEMORY_SCOPE_AGENT); }
__device__ __forceinline__ unsigned xb_xcc_id() { return (unsigned)__builtin_amdgcn_s_getreg((3 << 11) | 20) & 0xFu; }
#define XB_SPIN(cond, bar) do { unsigned _sp = 0; while (cond) { __builtin_amdgcn_s_sleep(1); \
    if ((++_sp & 255u) == 0u) { if (xb_ld(&(bar)[XB_TMO])) break; if (_sp > XB_SPIN_CAP) { atomicAdd(&(bar)[XB_TMO], 1u); break; } } } } while (0)

struct XcdBarrier {
    unsigned* bar; unsigned x;
    volatile LAS unsigned* st;
};

__device__ __forceinline__ XcdBarrier xcd_barrier_post(unsigned* bar, volatile LAS unsigned* st) {
    XcdBarrier b; b.bar = bar; b.x = xb_xcc_id(); b.st = st;
    if (threadIdx.x == 0) (void)xb_add(&bar[XB_XCNT(b.x)], 1u);
    return b;
}
__device__ __forceinline__ void xcd_barrier_complete(unsigned* bar, unsigned x, unsigned& nloc, unsigned& nx) {
    const unsigned G = gridDim.x * gridDim.y * gridDim.z;
    unsigned sum, cnt, mine, sp = 0u;
    for (;;) {
        sum = 0u; cnt = 0u; mine = 0u;
#pragma unroll
        for (unsigned j = 0; j < 16; ++j) { const unsigned c = xb_ld(&bar[XB_XCNT(j)]); sum += c; cnt += (c > 0u) ? 1u : 0u; mine = (j == x) ? c : mine; }
        if (sum == G) break;
        __builtin_amdgcn_s_sleep(1);
        if ((++sp & 255u) == 0u) { if (xb_ld(&bar[XB_TMO])) break; if (sp > XB_SPIN_CAP) { atomicAdd(&bar[XB_TMO], 1u); break; } }
    }
    nloc = mine > 0u ? mine : 1u; nx = cnt > 0u ? cnt : 1u;
}

__device__ __forceinline__ void xcd_barrier(const XcdBarrier& b) {
    asm volatile("s_waitcnt vmcnt(0)" ::: "memory");
    __syncthreads();
    if (threadIdx.x == 0) {
        unsigned* bar = b.bar;
        __builtin_amdgcn_s_waitcnt(0);
        unsigned nloc = b.st[0], nx = b.st[1];
        if (nloc == 0u) { xcd_barrier_complete(bar, b.x, nloc, nx); b.st[0] = nloc; b.st[1] = nx; }
        const unsigned old = xb_add(&bar[XB_XSUB(b.x)], 1u);
        const unsigned gen = old / nloc;
        if (old + 1u == (gen + 1u) * nloc) {
            __builtin_amdgcn_fence(__ATOMIC_RELEASE, "agent");
            asm volatile("s_waitcnt vmcnt(0)" ::: "memory");
            const unsigned og = xb_add(&bar[XB_TOP], 1u);
            const unsigned tg = og / nx;
            if (og + 1u == (tg + 1u) * nx) xb_add(&bar[XB_TOPGEN], 1u);
            else XB_SPIN(xb_ld(&bar[XB_TOPGEN]) == tg, bar);
            __builtin_amdgcn_fence(__ATOMIC_ACQUIRE, "agent");
            xb_add(&bar[XB_XGEN(b.x)], 1u);
            asm volatile("s_waitcnt vmcnt(0)" ::: "memory");
        } else {
            XB_SPIN(xb_ld(&bar[XB_XGEN(b.x)]) == gen, bar);
            __builtin_amdgcn_fence(__ATOMIC_ACQUIRE, "agent");
            asm volatile("s_waitcnt vmcnt(0)" ::: "memory");
        }
    }
    __syncthreads();
}
namespace pg8 {
#define PG8_LAS __attribute__((address_space(3)))
typedef unsigned short bf16_t;
typedef short bf16x8 __attribute__((ext_vector_type(8)));
typedef float f32x4 __attribute__((ext_vector_type(4)));
typedef unsigned u32x4 __attribute__((ext_vector_type(4)));
constexpr int BM = 256, BK = 64, HALF = 128, HTB = HALF * BK * 2  , STAGE_BYTES = 8 * HTB, NXCD = 8, WGM = 8;

__host__ __device__ __forceinline__ int lds_byte(int r, int c) { const int st = (r >> 4) * 2 + (c >> 5), rr = r & 15, cc = c & 31, ob = rr * 64 + cc * 2; return st * 1024 + (ob ^ (((ob >> 9) & 1) << 5)); }
__host__ __device__ __forceinline__ void stage_rc(int b, int& R, int& C) { const int st = b / 1024, sb = b % 1024, swz = sb ^ (((sb >> 9) & 1) << 5); R = (st >> 1) * 16 + swz / 64; C = (st & 1) * 32 + (swz % 64) / 2; }
__host__ __device__ __forceinline__ int perm32(int rho) { const int n = rho >> 4, i = rho & 15; return 8 * (i >> 2) + 4 * n + (i & 3); }

struct Unit { int pm, pn; };
struct Gemm { const bf16_t* A; const bf16_t* Bt; int M, N, K; };

struct StaticOrder {
    int nM, nN, nwg, G, c;
    __host__ __device__ void init(int M, int N, int G_, int c_) { nM = M / BM; nN = N / BM; nwg = nM * nN; G = G_; c = c_; }
    __host__ __device__ bool next(int i, Unit& u) const {
        const long L = (long)i * G + c; if (L >= nwg) return false;
        int wgid = (int)L; { const int q = nwg / NXCD, r = nwg % NXCD, xcd = wgid % NXCD, off = wgid / NXCD; wgid = (xcd < r ? xcd * (q + 1) : r * (q + 1) + (xcd - r) * q) + off; }
        const int nig = WGM * nN, gid = wgid / nig, fm = gid * WGM, gsz = (nM - fm) < WGM ? (nM - fm) : WGM;
        u.pm = fm + ((wgid % nig) % gsz); u.pn = (wgid % nig) / gsz; return true;
    }
    __device__ __forceinline__ void a_ready(const Unit&) const {}
    __device__ __forceinline__ void done(const Unit&) const {}
};

__device__ __forceinline__ unsigned cvt_pk_bf16(float lo, float hi) { unsigned r; asm volatile("v_cvt_pk_bf16_f32 %0, %1, %2" : "=v"(r) : "v"(lo), "v"(hi)); return r; }
__device__ __forceinline__ float bf_lo(unsigned w) { return __builtin_bit_cast(float, w << 16); }
__device__ __forceinline__ float bf_hi(unsigned w) { return __builtin_bit_cast(float, w & 0xffff0000u); }

struct EpiBias {
    static constexpr bool PERM = true, AFTER_DRAIN = false;
    bf16_t* O; int ldc; const float* bias;
    __device__ __forceinline__ void operator()(const f32x4 (&acc)[2][2][4][2], const Unit& u, int wr_, int wc_, int fr_, int fq_) const {
        int tz = threadIdx.x; asm volatile("" : "+v"(tz)); const int wid = __builtin_amdgcn_readfirstlane(tz >> 6), wr = wid >> 2, wc = wid & 3, fr = tz & 15, fq = (tz >> 4) & 3;
        const int row0 = u.pm * BM + wr * 64 + fr; const int col0 = u.pn * BM + wc * 32 + 8 * fq;
        f32x4 bv[2][2];
#pragma unroll
        for (int bj = 0; bj < 2; ++bj)
#pragma unroll
            for (int n = 0; n < 2; ++n) bv[bj][n] = *(const f32x4*)(bias + col0 + bj * HALF + 4 * n);
#pragma unroll
        for (int ai = 0; ai < 2; ++ai)
#pragma unroll
            for (int m = 0; m < 4; ++m) { bf16_t* rowp = O + (size_t)(row0 + ai * HALF + m * 16) * ldc + col0;
#pragma unroll
                for (int bj = 0; bj < 2; ++bj) { const f32x4 v0 = acc[ai][bj][m][0] + bv[bj][0], v1 = acc[ai][bj][m][1] + bv[bj][1];
                    u32x4 w; w.x = cvt_pk_bf16(v0[0], v0[1]); w.y = cvt_pk_bf16(v0[2], v0[3]); w.z = cvt_pk_bf16(v1[0], v1[1]); w.w = cvt_pk_bf16(v1[2], v1[3]);
                    *(u32x4*)(rowp + bj * HALF) = w; } }
    }
};

struct EpiRes {
    static constexpr bool PERM = true, AFTER_DRAIN = false;
    bf16_t* O; const bf16_t* R; float alpha;
    __device__ __forceinline__ void operator()(const f32x4 (&acc)[2][2][4][2], const Unit& u, int wr_, int wc_, int fr_, int fq_) const {
        int tz = threadIdx.x; asm volatile("" : "+v"(tz)); const int wid = __builtin_amdgcn_readfirstlane(tz >> 6), wr = wid >> 2, wc = wid & 3, fr = tz & 15, fq = (tz >> 4) & 3;
        const int row0 = u.pm * BM + wr * 64 + fr; const int col0 = u.pn * BM + wc * 32 + 8 * fq;
#pragma unroll
        for (int ai = 0; ai < 2; ++ai)
#pragma unroll
            for (int m = 0; m < 4; ++m) { const size_t off = (size_t)(row0 + ai * HALF + m * 16) * 1024 + col0;
#pragma unroll
                for (int bj = 0; bj < 2; ++bj) { const u32x4 r = *(const u32x4*)(R + off + bj * HALF);
                    const f32x4 a0 = acc[ai][bj][m][0], a1 = acc[ai][bj][m][1];
                    u32x4 w;
                    w.x = cvt_pk_bf16(a0[0] + alpha * bf_lo(r.x), a0[1] + alpha * bf_hi(r.x));
                    w.y = cvt_pk_bf16(a0[2] + alpha * bf_lo(r.y), a0[3] + alpha * bf_hi(r.y));
                    w.z = cvt_pk_bf16(a1[0] + alpha * bf_lo(r.z), a1[1] + alpha * bf_hi(r.z));
                    w.w = cvt_pk_bf16(a1[2] + alpha * bf_lo(r.w), a1[3] + alpha * bf_hi(r.w));
                    *(u32x4*)(O + off + bj * HALF) = w; } }
    }
};

__device__ __forceinline__ float swiglu1(float g, float u) {
    g = fminf(g, 7.0f); u = fminf(fmaxf(u, -7.0f), 7.0f);
    const float s = __builtin_amdgcn_rcpf(1.0f + __expf(-1.702f * g));
    return g * s * (u + 1.0f);
}
struct EpiSwiglu {
    static constexpr bool PERM = true, AFTER_DRAIN = false;
    bf16_t* O; const float* bias;
    __device__ __forceinline__ void operator()(const f32x4 (&acc)[2][2][4][2], const Unit& u, int wr_, int wc_, int fr_, int fq_) const {
        int tz = threadIdx.x; asm volatile("" : "+v"(tz)); const int wid = __builtin_amdgcn_readfirstlane(tz >> 6), wr = wid >> 2, wc = wid & 3, fr = tz & 15, fq = (tz >> 4) & 3;
        const int e = u.pn >> 3, jt = u.pn & 7;
        const int row0 = u.pm * BM + wr * 64 + fr; const int col0 = jt * 128 + wc * 32 + 8 * fq;
        const float* bp = bias + e * 2048 + col0;
#pragma unroll
        for (int n = 0; n < 2; ++n) {
            const f32x4 bg = *(const f32x4*)(bp + 4 * n), bu = *(const f32x4*)(bp + 1024 + 4 * n);
#pragma unroll
            for (int ai = 0; ai < 2; ++ai)
#pragma unroll
                for (int m = 0; m < 4; ++m) {
                    const f32x4 g0 = acc[ai][0][m][n] + bg, u0 = acc[ai][1][m][n] + bu;
                    uint2 w;
                    w.x = cvt_pk_bf16(swiglu1(g0[0], u0[0]), swiglu1(g0[1], u0[1]));
                    w.y = cvt_pk_bf16(swiglu1(g0[2], u0[2]), swiglu1(g0[3], u0[3]));
                    *(uint2*)(O + (size_t)(row0 + ai * HALF + m * 16) * 1024 + col0 + 4 * n) = w; }
        }
    }
};

struct EpiDown {
    static constexpr bool PERM = true, AFTER_DRAIN = false;
    bf16_t* Y; const float* bias; const int2* rowinfo;
    __device__ __forceinline__ void operator()(const f32x4 (&acc)[2][2][4][2], const Unit& u, int wr_, int wc_, int fr_, int fq_) const {
        int tz = threadIdx.x; asm volatile("" : "+v"(tz)); const int wid = __builtin_amdgcn_readfirstlane(tz >> 6), wr = wid >> 2, wc = wid & 3, fr = tz & 15, fq = (tz >> 4) & 3;
        const int e = u.pn >> 2, jt = u.pn & 3;
        const int row0 = u.pm * BM + wr * 64 + fr; const int col0 = jt * 256 + wc * 32 + 8 * fq;
        const float* bp = bias + e * 1024 + col0;
#pragma unroll
        for (int ai = 0; ai < 2; ++ai)
#pragma unroll
            for (int m = 0; m < 4; ++m) { const int2 info = rowinfo[row0 + ai * HALF + m * 16];
                if (info.x >= 0) { const float gt = __builtin_bit_cast(float, info.y); bf16_t* rowp = Y + (size_t)info.x * 1024 + col0;
#pragma unroll
                    for (int bj = 0; bj < 2; ++bj) { const f32x4 b0 = *(const f32x4*)(bp + bj * HALF), b1 = *(const f32x4*)(bp + bj * HALF + 4);
                        const f32x4 v0 = (acc[ai][bj][m][0] + b0) * gt, v1 = (acc[ai][bj][m][1] + b1) * gt;
                        u32x4 w; w.x = cvt_pk_bf16(v0[0], v0[1]); w.y = cvt_pk_bf16(v0[2], v0[3]); w.z = cvt_pk_bf16(v1[0], v1[1]); w.w = cvt_pk_bf16(v1[2], v1[3]);
                        *(u32x4*)(rowp + bj * HALF) = w; } } }
    }
};

struct MoeOrder {
    int total, G, c, NJ; const PG8_LAS unsigned char* tile_e;
    __device__ __forceinline__ bool next(int i, Unit& u) const {
        const int L = i * G + c; if (L >= total) return false;
        const int tt = NJ == 8 ? (L >> 3) : (L >> 2), jt = NJ == 8 ? (L & 7) : (L & 3);
        const int e = tile_e[tt];
        u.pm = tt; u.pn = e * NJ + jt; return true;
    }
    __device__ __forceinline__ void a_ready(const Unit&) const {}
    __device__ __forceinline__ void done(const Unit&) const {}
};

template <class Epi, class Sched, bool ALIGN_EPI = false, bool SP2 = false>
__device__ __forceinline__ void gemm_phase(PG8_LAS unsigned char* lds, const Gemm g, const Sched& S, const Epi& E) {
    int tid_l = threadIdx.x; asm volatile("" : "+v"(tid_l));
    const int tid = tid_l, wid = __builtin_amdgcn_readfirstlane(tid >> 6), lane = tid & 63, wr = wid >> 2, wc = wid & 3, fr = lane & 15, fq = lane >> 4;
    const int K = g.K, nt = K / BK;
    unsigned voffA[2], voffB[2];
#pragma unroll
    for (int i = 0; i < 2; ++i) { int R, C; stage_rc(tid * 16 + i * 8192, R, C); const int Rb = Epi::PERM ? ((R & ~31) + perm32(R & 31)) : R;
        voffA[i] = (unsigned)(R * K + C) * 2u; voffB[i] = (unsigned)(Rb * K + C) * 2u; }
    const size_t kstep = (size_t)(BK * 2);
    const size_t hstep = (size_t)HALF * K * 2;
    const size_t tstep = 2 * hstep;
    const unsigned ldsw = (unsigned)wid * 1024u;
    const int aoff = lds_byte(wr * 64 + fr, fq * 8), boff = lds_byte(wc * 32 + fr, fq * 8);
#define PG8_SA(b, h) (((b) * 2 + (h)) * HTB)
#define PG8_SB(b, h) ((4 + (b) * 2 + (h)) * HTB)
#define PG8_STAGE(bufoff, gbase, voff) do { _Pragma("unroll") for (int _i = 0; _i < 2; ++_i) \
        __builtin_amdgcn_global_load_lds((const unsigned*)((const char*)(gbase) + (voff)[_i]), (PG8_LAS unsigned*)(lds + (bufoff) + ldsw + _i * 8192), 16, 0, 0); } while (0)
#define PG8_LDA(dst, b, h) do { _Pragma("unroll") for (int m = 0; m < 4; ++m) _Pragma("unroll") for (int k = 0; k < 2; ++k) dst[m][k] = *(const PG8_LAS bf16x8*)(lds + PG8_SA(b, h) + aoff + m * 2048 + k * 1024); } while (0)
#define PG8_LDB(dst, b, h) do { _Pragma("unroll") for (int n = 0; n < 2; ++n) _Pragma("unroll") for (int k = 0; k < 2; ++k) dst[n][k] = *(const PG8_LAS bf16x8*)(lds + PG8_SB(b, h) + boff + n * 2048 + k * 1024); } while (0)
#define PG8_MMA(ai, bj, At, Bt) do { __builtin_amdgcn_s_setprio(1); _Pragma("unroll") for (int m = 0; m < 4; ++m) _Pragma("unroll") for (int n = 0; n < 2; ++n) _Pragma("unroll") for (int k = 0; k < 2; ++k) \
        acc[ai][bj][m][n] = __builtin_amdgcn_mfma_f32_16x16x32_bf16(Bt[n][k], At[m][k], acc[ai][bj][m][n], 0, 0, 0); __builtin_amdgcn_s_setprio(0); } while (0)
#define PG8_WAIT_V(n) asm volatile("s_waitcnt vmcnt(" #n ")" ::: "memory")
#define PG8_WAIT_L(n) asm volatile("s_waitcnt lgkmcnt(" #n ")" ::: "memory")
#define PG8_BAR __builtin_amdgcn_s_barrier()
#define PG8_SCHED __builtin_amdgcn_sched_barrier(0)
    Unit cur, nxt; int ui = 0;
    if (!S.next(0, cur)) return;
    f32x4 acc[2][2][4][2];
#pragma unroll
    for (int a = 0; a < 2; ++a)
#pragma unroll
        for (int b = 0; b < 2; ++b)
#pragma unroll
            for (int m = 0; m < 4; ++m)
#pragma unroll
                for (int n = 0; n < 2; ++n) acc[a][b][m][n] = (f32x4){0.f, 0.f, 0.f, 0.f};
    bf16x8 At[4][2], B0[2][2], B1[2][2];
    const char* cA = (const char*)g.A + (size_t)cur.pm * tstep; const char* cB = (const char*)g.Bt + (size_t)cur.pn * tstep;
    S.a_ready(cur);
    if constexpr (SP2) {
        PG8_STAGE(PG8_SB(0, 0), cB, voffB); PG8_STAGE(PG8_SB(0, 1), cB + hstep, voffB); PG8_STAGE(PG8_SA(0, 0), cA, voffA); PG8_STAGE(PG8_SA(0, 1), cA + hstep, voffA);
        if (wr == 1) PG8_BAR;
        PG8_WAIT_V(2); PG8_BAR;
        PG8_STAGE(PG8_SB(1, 0), cB + kstep, voffB); PG8_STAGE(PG8_SA(1, 0), cA + kstep, voffA); PG8_STAGE(PG8_SB(1, 1), cB + hstep + kstep, voffB);
        PG8_WAIT_V(6); PG8_BAR;
    } else {
        PG8_STAGE(PG8_SB(0, 0), cB, voffB); PG8_STAGE(PG8_SA(0, 0), cA, voffA); PG8_STAGE(PG8_SB(0, 1), cB + hstep, voffB); PG8_STAGE(PG8_SA(0, 1), cA + hstep, voffA);
        if (wr == 1) PG8_BAR;
        PG8_WAIT_V(4); PG8_BAR;
        PG8_STAGE(PG8_SB(1, 0), cB + kstep, voffB); PG8_STAGE(PG8_SA(1, 0), cA + kstep, voffA); PG8_STAGE(PG8_SB(1, 1), cB + hstep + kstep, voffB);
        PG8_WAIT_V(6); PG8_BAR;
    }
    for (;;) {
        const bool has_next = S.next(ui + 1, nxt);
        const char* nA = has_next ? (const char*)g.A + (size_t)nxt.pm * tstep : cA; const char* nB = has_next ? (const char*)g.Bt + (size_t)nxt.pn * tstep : cB;
        for (int t = 0; t < nt; t += 2) {
            const bool last = (t == nt - 2);
            const char* a1 = cA + (size_t)(t + 1) * kstep;
            const char* a2 = last ? nA : cA + (size_t)(t + 2) * kstep; const char* b2 = last ? nB : cB + (size_t)(t + 2) * kstep;
            const char* a3 = a2 + kstep; const char* b3 = b2 + kstep;
            if (last && has_next) S.a_ready(nxt);
            if constexpr (SP2) {
            PG8_LDB(B0, 0, 0); PG8_LDB(B1, 0, 1); PG8_SCHED; PG8_LDA(At, 0, 0); PG8_STAGE(PG8_SA(1, 1), a1 + hstep, voffA);
            PG8_WAIT_V(8); PG8_WAIT_L(0); PG8_BAR; PG8_MMA(0, 0, At, B0); PG8_MMA(0, 1, At, B1); PG8_BAR; PG8_SCHED;
            PG8_LDA(At, 0, 1); PG8_STAGE(PG8_SB(0, 0), b2, voffB); PG8_STAGE(PG8_SB(0, 1), b2 + hstep, voffB); PG8_STAGE(PG8_SA(0, 0), a2, voffA);
            PG8_WAIT_V(8); PG8_WAIT_L(0); PG8_BAR; PG8_MMA(1, 0, At, B0); PG8_MMA(1, 1, At, B1); PG8_BAR; PG8_SCHED;
            PG8_LDB(B0, 1, 0); PG8_LDB(B1, 1, 1); PG8_SCHED; PG8_LDA(At, 1, 0); PG8_STAGE(PG8_SA(0, 1), a2 + hstep, voffA);
            PG8_WAIT_V(8); PG8_WAIT_L(0); PG8_BAR; PG8_MMA(0, 0, At, B0); PG8_MMA(0, 1, At, B1); PG8_BAR; PG8_SCHED;
            PG8_LDA(At, 1, 1); PG8_STAGE(PG8_SB(1, 0), b3, voffB); PG8_STAGE(PG8_SB(1, 1), b3 + hstep, voffB); PG8_STAGE(PG8_SA(1, 0), a3, voffA);
            PG8_WAIT_V(8); PG8_WAIT_L(0); PG8_BAR; PG8_MMA(1, 0, At, B0); PG8_MMA(1, 1, At, B1); PG8_BAR; PG8_SCHED;
            } else {
            PG8_LDB(B0, 0, 0); PG8_SCHED; PG8_LDA(At, 0, 0); PG8_STAGE(PG8_SA(1, 1), a1 + hstep, voffA);
            PG8_WAIT_L(8); PG8_BAR; PG8_WAIT_L(0); PG8_MMA(0, 0, At, B0); PG8_BAR; PG8_SCHED;
            PG8_LDB(B1, 0, 1); PG8_STAGE(PG8_SB(0, 0), b2, voffB);
            PG8_BAR; PG8_WAIT_L(0); PG8_MMA(0, 1, At, B1); PG8_BAR;
            PG8_LDA(At, 0, 1); PG8_STAGE(PG8_SA(0, 0), a2, voffA);
            PG8_BAR; PG8_WAIT_L(0); PG8_MMA(1, 0, At, B0); PG8_BAR; PG8_SCHED;
            PG8_STAGE(PG8_SB(0, 1), b2 + hstep, voffB);
            PG8_WAIT_V(6); PG8_BAR; PG8_MMA(1, 1, At, B1); PG8_BAR;
            PG8_LDB(B0, 1, 0); PG8_SCHED; PG8_LDA(At, 1, 0); PG8_STAGE(PG8_SA(0, 1), a2 + hstep, voffA);
            PG8_WAIT_L(8); PG8_BAR; PG8_WAIT_L(0); PG8_MMA(0, 0, At, B0); PG8_BAR; PG8_SCHED;
            PG8_LDB(B1, 1, 1); PG8_STAGE(PG8_SB(1, 0), b3, voffB);
            PG8_BAR; PG8_WAIT_L(0); PG8_MMA(0, 1, At, B1); PG8_BAR;
            PG8_LDA(At, 1, 1); PG8_STAGE(PG8_SA(1, 0), a3, voffA);
            PG8_BAR; PG8_WAIT_L(0); PG8_MMA(1, 0, At, B0); PG8_BAR; PG8_SCHED;
            PG8_STAGE(PG8_SB(1, 1), b3 + hstep, voffB);
            PG8_WAIT_V(6); PG8_BAR; PG8_MMA(1, 1, At, B1); PG8_BAR;
            }
        }
        if constexpr (ALIGN_EPI) { if (wr == 0) PG8_BAR; }
        if constexpr (!Epi::AFTER_DRAIN) { E(acc, cur, wr, wc, fr, fq); S.done(cur); }
        if (!has_next) break;
#pragma unroll
        for (int a = 0; a < 2; ++a)
#pragma unroll
            for (int b = 0; b < 2; ++b)
#pragma unroll
                for (int m = 0; m < 4; ++m)
#pragma unroll
                    for (int n = 0; n < 2; ++n) acc[a][b][m][n] = (f32x4){0.f, 0.f, 0.f, 0.f};
        cur = nxt; cA = nA; cB = nB; ++ui;
        if constexpr (ALIGN_EPI) { if (wr == 1) PG8_BAR; }
    }
    PG8_WAIT_V(0);
    if constexpr (!ALIGN_EPI) { if (wr == 0) PG8_BAR; }
    PG8_BAR;
    if constexpr (Epi::AFTER_DRAIN) { E.fused(acc, cur, wr, wc, fr, fq, lds, wid, lane); S.done(cur); }
#undef PG8_SA
#undef PG8_SB
#undef PG8_STAGE
#undef PG8_LDA
#undef PG8_LDB
#undef PG8_MMA
#undef PG8_WAIT_V
#undef PG8_WAIT_L
#undef PG8_BAR
#undef PG8_SCHED
}
}
constexpr int NBATCH = 16, SEQ = 4096, NMETA = 16, LTOK = SEQ + NMETA, NTOK = NBATCH * LTOK;
constexpr int DM = 1024, NCOLA = 1280, NCOLB = 1864, NCOLB_PAD = 2048;
constexpr int NEXP = 32, MOE_TILES_MAX = NTOK * 4 / 256 + NEXP, MOE_P = MOE_TILES_MAX * 256;
constexpr float LN_EPS = 1e-5f, DN_ALPHA = 1.4142135623730951f;
constexpr float ATTN_SCALE = 0.125f, IDX_SCALE = 0.125f, IDX_W_SCALE = 0.35355339059327373f;
constexpr int NWAVES = 8, NTHREADS = 512;

constexpr size_t MiB = 1u << 20;
constexpr size_t WS_CTL = 0, CTL_ZERO_BYTES = 1 * MiB;
constexpr size_t WS_ROPEA = 1 * MiB, WS_ROPEB = 2 * MiB, WS_BIASB = 3 * MiB, WS_WRT = 3 * MiB + 512 * 1024, WS_ROWINFO = 4 * MiB, WS_ROUTE = 8 * MiB;
constexpr size_t WS_WINA = 16 * MiB, WS_WOUTA = 19 * MiB, WS_WINB = 21 * MiB, WS_WOUTB = 25 * MiB;
constexpr size_t WS_WGU = 32 * MiB, WS_WD = 288 * MiB;
constexpr size_t WS_HA = 416 * MiB, WS_HB = 545 * MiB, WS_PRE = 674 * MiB;
constexpr size_t WS_XS = 803 * MiB, WS_ACT = 1333 * MiB, WS_END = 1863 * MiB;
constexpr size_t WS_PROJ = WS_XS, WS_ATT = WS_XS + 257 * MiB;
constexpr size_t WS_SCORE = WS_ACT, WS_SEL = WS_ACT + 128 * MiB;
static_assert((size_t)NTOK * 2048 * 2 <= 257 * MiB && (size_t)NTOK * 1024 * 2 <= 129 * MiB && (size_t)MOE_P * 2048 <= 530 * MiB, "ws map");
static_assert(WS_ATT + 129 * MiB <= WS_ACT && WS_SEL + 32 * MiB <= WS_END, "ws overlays");

constexpr int CW_BAR = 4096;
constexpr int CW_CNT = 16384;

constexpr int RING_BYTES = 131072, LDSCTL_OFF = RING_BYTES, LDS_BYTES = 147456;
constexpr int LC_BAR = 0;
constexpr int LC_TSTART = 16;
constexpr int LC_ECNT = 64;
constexpr int LC_LCNT = 128, LC_LBASE = 160;
constexpr int LC_TILEE = 256;

struct Args { const float* in[21]; float* out; unsigned char* ws; int ph_lo, ph_hi; };
typedef const Args __attribute__((address_space(4))) CArgs;
__device__ __forceinline__ CArgs* KA() { unsigned long long v = (unsigned long long)__builtin_amdgcn_kernarg_segment_ptr(); asm volatile("" : "+s"(v)); return (CArgs*)v; }

typedef unsigned short u16;

__device__ __forceinline__ float bf2f(unsigned h) { return __builtin_bit_cast(float, h << 16); }
__device__ __forceinline__ float bflo(unsigned w) { return __builtin_bit_cast(float, w << 16); }
__device__ __forceinline__ float bfhi(unsigned w) { return __builtin_bit_cast(float, w & 0xffff0000u); }
__device__ __forceinline__ unsigned cvtpk(float lo, float hi) { return pg8::cvt_pk_bf16(lo, hi); }
__device__ __forceinline__ unsigned char* launder(unsigned char* p) { unsigned long long v = (unsigned long long)p; asm volatile("" : "+s"(v)); return (unsigned char*)(GAS unsigned char*)v; }
__device__ __forceinline__ const float* gptr(const float* p) { return (const float*)(const GAS float*)p; }
__device__ __forceinline__ float shx(float v, int o, int lane) { return __builtin_bit_cast(float, __builtin_amdgcn_ds_bpermute((lane ^ o) << 2, __builtin_bit_cast(int, v))); }
__device__ __forceinline__ int shxi(int v, int o, int lane) { return __builtin_amdgcn_ds_bpermute((lane ^ o) << 2, v); }
__device__ __forceinline__ int launder_v(int x) { asm volatile("" : "+v"(x)); return x; }

__device__ __forceinline__ void transpose_item(const float* W, int K, int N, bf16* WT, int mode, LAS float* scr, int item, int lane) {
    const int nblk = (N + 31) / 32, kb = item / nblk, nb = item % nblk, k0 = 64 * kb, n0 = 32 * nb;
    const bool okn = (n0 + (lane & 31)) < N;
#pragma unroll 8
    for (int i = 0; i < 32; ++i) { const int kk = 2 * i + (lane >> 5); scr[kk * 33 + (lane & 31)] = okn ? W[(size_t)(k0 + kk) * N + n0 + (lane & 31)] : 0.f; }
    LDS_WAIT(); asm volatile("" ::: "memory");
    const int c = lane & 7;
#pragma unroll
    for (int j = 0; j < 4; ++j) { const int n = (lane >> 3) + 8 * j; const LAS float* s = scr + (8 * c) * 33 + n;
        v4u o; o.x = pk2(s[0 * 33], s[1 * 33]); o.y = pk2(s[2 * 33], s[3 * 33]); o.z = pk2(s[4 * 33], s[5 * 33]); o.w = pk2(s[6 * 33], s[7 * 33]);
        int nn = n0 + n;
        if (nn < N) {
            if (mode == 1) { const int up = nn >= 1024 ? 1 : 0, q = nn - 1024 * up; nn = (q >> 7) * 256 + up * 128 + (q & 127); }
            *(GAS v4u*)(WT + (size_t)nn * K + k0 + 8 * c) = o; } }
    LDS_WAIT(); asm volatile("" ::: "memory");
}

__device__ __forceinline__ void p0_prologue(CArgs* A, LAS unsigned char* lds, int gw, int NGW, int wave, int lane) {
    unsigned char* ws = launder(A->ws);
    LAS float* scr = (LAS float*)(lds + wave * 16384);
    constexpr int I_GU = 64 * 1024, I_D = 64 * 512, I_INA = 16 * 40, I_OUT = 512, I_INB = 16 * 59, I_R = 2 * 16;
    constexpr int NITEMS = I_GU + I_D + I_INA + I_OUT + I_INB + I_OUT + I_R;
    for (int it = gw; it < NITEMS; it += NGW) {
        int r = it;
        if (r < I_GU) { const int le = r >> 10; transpose_item(gptr(A->in[15]) + (size_t)le * 1024 * 2048, 1024, 2048, (bf16*)(ws + WS_WGU) + (size_t)le * 2048 * 1024, 1, scr, r & 1023, lane); continue; } r -= I_GU;
        if (r < I_D) { const int le = r >> 9; transpose_item(gptr(A->in[17]) + (size_t)le * 1024 * 1024, 1024, 1024, (bf16*)(ws + WS_WD) + (size_t)le * 1024 * 1024, 0, scr, r & 511, lane); continue; } r -= I_D;
        if (r < I_INA) { transpose_item(gptr(A->in[2]), 1024, NCOLA, (bf16*)(ws + WS_WINA), 0, scr, r, lane); continue; } r -= I_INA;
        if (r < I_OUT) { transpose_item(gptr(A->in[5]), 1024, 1024, (bf16*)(ws + WS_WOUTA), 0, scr, r, lane); continue; } r -= I_OUT;
        if (r < I_INB) { transpose_item(gptr(A->in[6]), 1024, NCOLB, (bf16*)(ws + WS_WINB), 0, scr, r, lane); continue; } r -= I_INB;
        if (r < I_OUT) { transpose_item(gptr(A->in[10]), 1024, 1024, (bf16*)(ws + WS_WOUTB), 0, scr, r, lane); continue; } r -= I_OUT;
        { const int ly = r >> 4; transpose_item(gptr(A->in[13]) + (size_t)ly * 1024 * 32, 1024, 32, (bf16*)(ws + WS_WRT) + (size_t)ly * 32 * 1024, 0, scr, r & 15, lane); }
    }
    const int gt = gw * 64 + lane, NGT = NGW * 64;
    { v4u* z = (v4u*)((bf16*)(ws + WS_WINB) + (size_t)NCOLB * 1024); const int n16 = (NCOLB_PAD - NCOLB) * 1024 * 2 / 16;
      for (int i = gt; i < n16; i += NGT) z[i] = (v4u){0u, 0u, 0u, 0u}; }
    { float* bb = (float*)(ws + WS_BIASB); for (int i = gt; i < NCOLB_PAD; i += NGT) bb[i] = i < NCOLB ? gptr(A->in[7])[i] : 0.f; }
    { float2* ta = (float2*)(ws + WS_ROPEA); float2* tb = (float2*)(ws + WS_ROPEB);
      for (int i = gt; i < LTOK * 24; i += NGT) {
          const int pos = i / 24, j = i % 24; const bool isA = j < 8; const int fi = isA ? j : j - 8; const float half = isA ? 8.f : 16.f;
          const float inv = powf(500000.0f, -(float)fi / half); const float ang = (float)pos * inv;
          float sn, cs; sincosf(ang, &sn, &cs);
          if (isA) ta[pos * 8 + fi] = make_float2(cs, sn); else tb[pos * 16 + fi] = make_float2(cs, sn); } }
    { bf16* H = (bf16*)(ws + WS_HA);
      for (int row = gw; row < NTOK; row += NGW) { const int b = row / LTOK, p = row % LTOK;
          const float* src = p < NMETA ? gptr(A->in[1]) + (size_t)p * DM : gptr(A->in[0]) + ((size_t)b * SEQ + (p - NMETA)) * DM;
#pragma unroll
          for (int j = 0; j < 2; ++j) { const f32x4 a = *(const f32x4*)(src + j * 512 + lane * 8), c = *(const f32x4*)(src + j * 512 + lane * 8 + 4);
              v4u o; o.x = cvtpk(a[0], a[1]); o.y = cvtpk(a[2], a[3]); o.z = cvtpk(c[0], c[1]); o.w = cvtpk(c[2], c[3]);
              *(v4u*)(H + (size_t)row * DM + j * 512 + lane * 8) = o; } } }
}

__device__ __forceinline__ void rope_pair(float& x1, float& x2, const float2 cs) { const float a = x1 * cs.x - x2 * cs.y, b = x2 * cs.x + x1 * cs.y; x1 = a; x2 = b; }
__device__ __forceinline__ void rope_phase(CArgs* A, int layer, int gt, int NGT) {
    unsigned char* ws = launder(A->ws);
    bf16* P = (bf16*)(ws + WS_PROJ); const int ld = layer == 0 ? NCOLA : NCOLB_PAD; const int nslots = layer == 0 ? 18 : 28;
    const float2* ta = (const float2*)(ws + WS_ROPEA); const float2* tb = (const float2*)(ws + WS_ROPEB);
    const long nitems = (long)NTOK * nslots;
    for (long it = gt; it < nitems; it += NGT) {
        const int row = (int)(it / nslots), slot = (int)(it % nslots), pos = row % LTOK;
        bf16* rp = P + (size_t)row * ld;
        if (slot < 18) {
            bf16* p = rp + (slot < 16 ? slot * 64 : 1024 + (slot - 16) * 64);
            v4u a = *(v4u*)p, c = *(v4u*)(p + 8);
            float x1[8] = {bflo(a.x), bfhi(a.x), bflo(a.y), bfhi(a.y), bflo(a.z), bfhi(a.z), bflo(a.w), bfhi(a.w)};
            float x2[8] = {bflo(c.x), bfhi(c.x), bflo(c.y), bfhi(c.y), bflo(c.z), bfhi(c.z), bflo(c.w), bfhi(c.w)};
#pragma unroll
            for (int i = 0; i < 8; ++i) rope_pair(x1[i], x2[i], ta[pos * 8 + i]);
            a.x = cvtpk(x1[0], x1[1]); a.y = cvtpk(x1[2], x1[3]); a.z = cvtpk(x1[4], x1[5]); a.w = cvtpk(x1[6], x1[7]);
            c.x = cvtpk(x2[0], x2[1]); c.y = cvtpk(x2[2], x2[3]); c.z = cvtpk(x2[4], x2[5]); c.w = cvtpk(x2[6], x2[7]);
            *(v4u*)p = a; *(v4u*)(p + 8) = c;
        } else if (slot < 26) {
            bf16* p = rp + 1280 + (slot - 18) * 64;
            v4u q[4];
#pragma unroll
            for (int j = 0; j < 4; ++j) q[j] = *(v4u*)(p + 8 * j);
            float x[32];
#pragma unroll
            for (int j = 0; j < 4; ++j) { x[8 * j + 0] = bflo(q[j].x); x[8 * j + 1] = bfhi(q[j].x); x[8 * j + 2] = bflo(q[j].y); x[8 * j + 3] = bfhi(q[j].y);
                x[8 * j + 4] = bflo(q[j].z); x[8 * j + 5] = bfhi(q[j].z); x[8 * j + 6] = bflo(q[j].w); x[8 * j + 7] = bfhi(q[j].w); }
#pragma unroll
            for (int i = 0; i < 16; ++i) rope_pair(x[i], x[16 + i], tb[pos * 16 + i]);
#pragma unroll
            for (int j = 0; j < 4; ++j) { q[j].x = cvtpk(x[8 * j + 0], x[8 * j + 1]); q[j].y = cvtpk(x[8 * j + 2], x[8 * j + 3]); q[j].z = cvtpk(x[8 * j + 4], x[8 * j + 5]); q[j].w = cvtpk(x[8 * j + 6], x[8 * j + 7]);
                *(v4u*)(p + 8 * j) = q[j]; }
        } else {
            const int hf = slot - 26; const int lane = gt & 63;
            bf16* p = rp + 1792 + 32 * hf;
            const float* g = gptr(A->in[8]) + 32 * hf; const float* bb = gptr(A->in[9]) + 32 * hf;
            v4u q[4];
#pragma unroll
            for (int j = 0; j < 4; ++j) q[j] = *(v4u*)(p + 8 * j);
            float x[32];
#pragma unroll
            for (int j = 0; j < 4; ++j) { x[8 * j + 0] = bflo(q[j].x); x[8 * j + 1] = bfhi(q[j].x); x[8 * j + 2] = bflo(q[j].y); x[8 * j + 3] = bfhi(q[j].y);
                x[8 * j + 4] = bflo(q[j].z); x[8 * j + 5] = bfhi(q[j].z); x[8 * j + 6] = bflo(q[j].w); x[8 * j + 7] = bfhi(q[j].w); }
            float s = 0.f;
#pragma unroll
            for (int i = 0; i < 32; ++i) s += x[i];
            s += shx(s, 1, lane);
            const float mu = s * (1.f / 64.f); float v = 0.f;
#pragma unroll
            for (int i = 0; i < 32; ++i) { x[i] -= mu; v += x[i] * x[i]; }
            v += shx(v, 1, lane);
            const float rstd = 1.f / sqrtf(v * (1.f / 64.f) + LN_EPS);
#pragma unroll
            for (int c8 = 0; c8 < 4; ++c8) {
#pragma unroll
                for (int i = 8 * c8; i < 8 * c8 + 8; ++i) x[i] = x[i] * rstd * g[i] + bb[i];
                asm volatile("" ::: "memory"); }
            if (hf == 0) {
#pragma unroll
                for (int c4 = 0; c4 < 4; ++c4) {
#pragma unroll
                    for (int i = 4 * c4; i < 4 * c4 + 4; ++i) rope_pair(x[i], x[16 + i], tb[pos * 16 + i]);
                    asm volatile("" ::: "memory"); }
            }
#pragma unroll
            for (int j = 0; j < 4; ++j) { q[j].x = cvtpk(x[8 * j + 0], x[8 * j + 1]); q[j].y = cvtpk(x[8 * j + 2], x[8 * j + 3]); q[j].z = cvtpk(x[8 * j + 4], x[8 * j + 5]); q[j].w = cvtpk(x[8 * j + 6], x[8 * j + 7]);
                *(v4u*)(p + 8 * j) = q[j]; }
        }
    }
}

template <int MAXT, bool DSA>
__device__ __forceinline__ void attn_phase(CArgs* A, LAS unsigned char* lds, int layer, int gw, int NGW, int wave, int lane) {
    unsigned char* ws = launder(A->ws);
    const bf16* P = (const bf16*)(ws + WS_PROJ); const int ld = DSA ? NCOLB_PAD : NCOLA;
    bf16* O = (bf16*)(ws + WS_ATT);
    const u16* SEL = (const u16*)(ws + WS_SEL);
    const float* sinks = gptr(A->in[4]);
    constexpr int VP = 272;
    LAS unsigned char* vl = lds + wave * (32 * VP);
    const int fr = lane & 15, fq = lane >> 4;
    constexpr int NCH = (MAXT + 1) / 2;
    for (int tok = gw; tok < NTOK; tok += NGW) {
        const int b = tok / LTOK, p = tok % LTOK; const int t = p - NMETA;
        int n_keys, first = 0; bool use_sel = false;
        if (p < NMETA) n_keys = p + 1;
        else if (!DSA) { const int nr = t + 1 < 128 ? t + 1 : 128; first = t + 1 - nr; n_keys = 16 + nr; }
        else { if (t < 256) { n_keys = 16 + t + 1; } else { n_keys = 16 + 256; use_sel = true; } }
        const u16* selrow = SEL + ((size_t)b * SEQ + (t > 0 ? t : 0)) * 256;
        const size_t rowbase = (size_t)b * LTOK;
#define KEY_POS(i) ((i) < 16 ? (i) : (16 + (use_sel ? (int)selrow[(i) - 16] : first + (i) - 16)))
        bf16x8 qf[4];
        { const bf16* qr = P + (rowbase + p) * ld + fr * 64 + fq * 8; const int kvh = fr >> 3;
          const bf16x8 q0 = *(const bf16x8*)qr, q1 = *(const bf16x8*)(qr + 32); const bf16x8 z = {0, 0, 0, 0, 0, 0, 0, 0};
          qf[0] = kvh == 0 ? q0 : z; qf[1] = kvh == 0 ? q1 : z; qf[2] = kvh == 1 ? q0 : z; qf[3] = kvh == 1 ? q1 : z; }
        f32x4 sc[MAXT];
        float mx = -1e30f;
#pragma unroll
        for (int T = 0; T < MAXT; ++T) {
            sc[T] = (f32x4){-1e30f, -1e30f, -1e30f, -1e30f};
            if (T * 16 < n_keys) {
                const int i = T * 16 + fr; int kp = 0; if (i < n_keys) kp = KEY_POS(i);
                const bf16* kr = P + (rowbase + kp) * ld + 1024 + fq * 8;
                f32x4 a = {0.f, 0.f, 0.f, 0.f};
#pragma unroll
                for (int s = 0; s < 4; ++s) { const bf16x8 kf = *(const bf16x8*)(kr + s * 32); a = __builtin_amdgcn_mfma_f32_16x16x32_bf16(kf, qf[s], a, 0, 0, 0); }
#pragma unroll
                for (int j = 0; j < 4; ++j) { const int ki = T * 16 + fq * 4 + j; const float v = ki < n_keys ? a[j] * ATTN_SCALE : -1e30f; sc[T][j] = v; mx = fmaxf(mx, v); }
            }
        }
        mx = fmaxf(mx, shx(mx, 16, lane)); mx = fmaxf(mx, shx(mx, 32, lane));
        float sk = 0.f;
        if (!DSA) { sk = sinks[fr]; mx = fmaxf(mx, sk); }
        float sum = 0.f;
#pragma unroll
        for (int T = 0; T < MAXT; ++T)
#pragma unroll
            for (int j = 0; j < 4; ++j) { const float e = __expf(sc[T][j] - mx); sc[T][j] = e; sum += e; }
        sum += shx(sum, 16, lane); sum += shx(sum, 32, lane);
        if (!DSA) sum += __expf(sk - mx);
        const float inv = 1.f / sum;
        f32x4 o[8];
#pragma unroll
        for (int d = 0; d < 8; ++d) o[d] = (f32x4){0.f, 0.f, 0.f, 0.f};
#pragma unroll
        for (int c = 0; c < NCH; ++c) {
            if (c * 32 < n_keys) {
                { const int i = c * 32 + (lane >> 1); int kp = 0; if (i < n_keys) kp = KEY_POS(i);
                  const bf16* vr = P + (rowbase + kp) * ld + 1152 + (lane & 1) * 64;
                  LAS unsigned char* dst = vl + (lane >> 1) * VP + (lane & 1) * 128;
                  v4u tmp[8];
#pragma unroll
                  for (int j = 0; j < 8; ++j) tmp[j] = *(const v4u*)(vr + 8 * j);
#pragma unroll
                  for (int j = 0; j < 8; ++j) *(LAS v4u*)(dst + 16 * j) = tmp[j]; }
                bf16x8 pf;
                { const f32x4 p0 = sc[2 * c]; f32x4 p1 = {0.f, 0.f, 0.f, 0.f}; if (2 * c + 1 < MAXT) p1 = sc[2 * c + 1 < MAXT ? 2 * c + 1 : 0];
                  v4u w; w.x = cvtpk(p0[0], p0[1]); w.y = cvtpk(p0[2], p0[3]); w.z = cvtpk(p1[0], p1[1]); w.w = cvtpk(p1[2], p1[3]);
                  pf = __builtin_bit_cast(bf16x8, w); }
#pragma unroll
                for (int d = 0; d < 8; ++d) {
                    bf16x8 vf;
#pragma unroll
                    for (int ii = 0; ii < 8; ++ii) { const int kl = (ii < 4 ? 0 : 16) + fq * 4 + (ii & 3);
                        vf[ii] = (short)*(const LAS u16*)(vl + kl * VP + (d * 16 + fr) * 2); }
                    o[d] = __builtin_amdgcn_mfma_f32_16x16x32_bf16(vf, pf, o[d], 0, 0, 0);
                }
            }
        }
#undef KEY_POS
        { bf16* orow = O + (size_t)tok * DM + fr * 64 + fq * 4; const bool hi = fr >= 8;
#pragma unroll
          for (int dd = 0; dd < 4; ++dd) { const f32x4 vl_ = o[dd], vh_ = o[4 + dd];
              const float v0 = hi ? vh_[0] : vl_[0], v1 = hi ? vh_[1] : vl_[1], v2 = hi ? vh_[2] : vl_[2], v3 = hi ? vh_[3] : vl_[3];
              uint2 w; w.x = cvtpk(v0 * inv, v1 * inv); w.y = cvtpk(v2 * inv, v3 * inv);
              *(uint2*)(orow + dd * 16) = w; } }
    }
}

__device__ __forceinline__ unsigned ordkey(float f) { unsigned u = __builtin_bit_cast(unsigned, f); if (u == 0x80000000u) u = 0u; return (u & 0x80000000u) ? ~u : (u | 0x80000000u); }
__device__ __forceinline__ void indexer_phase(CArgs* A, int G, int wg, int wave, int lane) {
    unsigned char* ws = launder(A->ws);
    const bf16* P = (const bf16*)(ws + WS_PROJ); constexpr int ld = NCOLB_PAD;
    float* scr = (float*)(ws + WS_SCORE) + (size_t)wg * 32 * SEQ;
    u16* SEL = (u16*)(ws + WS_SEL);
    const int fr = lane & 15, fq = lane >> 4;
    constexpr int NUNITS = NBATCH * 120;
    for (int r = 0;; ++r) {
        const int k = r * G + ((r & 1) ? (G - 1 - wg) : wg);
        if (r * G >= NUNITS) break;
        if (k >= NUNITS) continue;
        const int qb = 127 - k / NBATCH, b = k % NBATCH, t0 = qb * 32;
        const size_t rowbase = (size_t)b * LTOK + NMETA;
        bf16x8 qf[2][2]; float wv[2][4];
#pragma unroll
        for (int rg = 0; rg < 2; ++rg) {
            const int tq = t0 + 4 * wave + rg * 2 + (fr >> 3);
            const bf16* qr = P + (rowbase + tq) * ld + 1280 + (fr & 7) * 64 + fq * 8;
            qf[rg][0] = *(const bf16x8*)qr; qf[rg][1] = *(const bf16x8*)(qr + 32);
            const int tw = t0 + 4 * wave + rg * 2 + (fq >> 1);
            const bf16* wr_ = P + (rowbase + tw) * ld + 1856 + (fq & 1) * 4;
#pragma unroll
            for (int j = 0; j < 4; ++j) wv[rg][j] = bf2f(wr_[j]) * (IDX_W_SCALE * IDX_SCALE);
        }
        const int nkt = t0 / 16 + 2;
        for (int kt = 0; kt < nkt; ++kt) {
            const bf16* kr = P + (rowbase + kt * 16 + fr) * ld + 1792 + fq * 8;
            const bf16x8 k0 = *(const bf16x8*)kr, k1 = *(const bf16x8*)(kr + 32);
#pragma unroll
            for (int rg = 0; rg < 2; ++rg) {
                f32x4 a = {0.f, 0.f, 0.f, 0.f};
                a = __builtin_amdgcn_mfma_f32_16x16x32_bf16(qf[rg][0], k0, a, 0, 0, 0);
                a = __builtin_amdgcn_mfma_f32_16x16x32_bf16(qf[rg][1], k1, a, 0, 0, 0);
                float part = 0.f;
#pragma unroll
                for (int j = 0; j < 4; ++j) part += wv[rg][j] * fmaxf(a[j], 0.f);
                const float tot = part + shx(part, 16, lane);
                if ((fq & 1) == 0) scr[(size_t)(4 * wave + rg * 2 + (fq >> 1)) * SEQ + kt * 16 + fr] = tot;
            }
        }
        asm volatile("s_waitcnt vmcnt(0)" ::: "memory");
        for (int qi = 0; qi < 4; ++qi) {
            const int t = t0 + 4 * wave + qi;
            const float* srow = scr + (size_t)(4 * wave + qi) * SEQ;
            unsigned u[64];
            const int nfull = (t + 1) >> 6, rem = (t + 1) & 63;
#pragma unroll
            for (int rr = 0; rr < 64; ++rr) {
                u[rr] = 0u;
                if (rr < nfull) { u[rr] = ordkey(__hip_atomic_load(srow + rr * 64 + lane, __ATOMIC_RELAXED, __HIP_MEMORY_SCOPE_AGENT)); }
                else if (rr == nfull) { if (lane < rem) u[rr] = ordkey(__hip_atomic_load(srow + rr * 64 + lane, __ATOMIC_RELAXED, __HIP_MEMORY_SCOPE_AGENT)); }
            }
            unsigned prefix = 0u;
            for (int bit = 31; bit >= 0; --bit) {
                const unsigned cand = prefix | (1u << bit);
                int cl = 0;
#pragma unroll
                for (int rr = 0; rr < 64; ++rr) cl += (u[rr] >= cand) ? 1 : 0;
#pragma unroll
                for (int o = 1; o < 64; o <<= 1) cl += shxi(cl, o, lane);
                const int c = __builtin_amdgcn_readfirstlane(cl);
                if (c >= 256) prefix = cand;
                if (c == 256) break;
            }
            int cgt;
            { int cl = 0;
#pragma unroll
              for (int rr = 0; rr < 64; ++rr) cl += (u[rr] > prefix) ? 1 : 0;
#pragma unroll
              for (int o = 1; o < 64; o <<= 1) cl += shxi(cl, o, lane);
              cgt = __builtin_amdgcn_readfirstlane(cl); }
            int need = 256 - cgt, base = 0;
            u16* out = SEL + ((size_t)b * SEQ + t) * 256;
#pragma unroll
            for (int rr = 0; rr < 64; ++rr) {
                if (rr <= nfull) {
                    const bool gt = u[rr] > prefix, eq = u[rr] == prefix;
                    const unsigned long long meq = __ballot(eq);
                    const int eqrank = (int)__builtin_amdgcn_mbcnt_hi((unsigned)(meq >> 32), __builtin_amdgcn_mbcnt_lo((unsigned)meq, 0u));
                    const bool take = gt || (eq && eqrank < need);
                    const unsigned long long mt = __ballot(take);
                    if (take) out[base + (int)__builtin_amdgcn_mbcnt_hi((unsigned)(mt >> 32), __builtin_amdgcn_mbcnt_lo((unsigned)mt, 0u))] = (u16)(rr * 64 + lane);
                    base += __popcll(mt);
                    const int neq = __popcll(meq); need -= (neq < need ? neq : need);
                }
            }
        }
        asm volatile("s_waitcnt vmcnt(0)" ::: "memory");
    }
}

__device__ __forceinline__ void ln_router_phase(CArgs* A, LAS unsigned char* lds, int layer, int G, int wg, int wave, int lane, const bf16* PRE, bf16* HOUT) {
    unsigned char* ws = launder(A->ws);
    const float* lg = gptr(A->in[11]) + layer * DM; const float* lb = gptr(A->in[12]) + layer * DM;
    const bf16* WRT = (const bf16*)(ws + WS_WRT) + (size_t)layer * 32 * 1024;
    const float* br = gptr(A->in[14]) + layer * 32;
    unsigned* cnt = (unsigned*)(ws + WS_CTL) + CW_CNT + layer * 32;
    int4* route = (int4*)(ws + WS_ROUTE);
    LAS int* lc = (LAS int*)(lds + LDSCTL_OFF);
    LAS float* lgt = (LAS float*)(lds + wave * 4096);
    const int fr = lane & 15, fq = lane >> 4, tid = wave * 64 + lane;
    constexpr int NUNITS = NTOK / 128;
    for (int unit = wg; unit < NUNITS; unit += G) {
        if (tid < 32) lc[LC_LCNT + tid] = 0;
        __syncthreads();
        const int r0 = unit * 128 + wave * 16;
        const bf16* xr = PRE + (size_t)(r0 + fr) * DM + fq * 8;
        float sm = 0.f, sq = 0.f;
#pragma unroll 8
        for (int s = 0; s < 32; ++s) { const v4u x = *(const v4u*)(xr + 32 * s);
            const float x0 = bflo(x.x), x1 = bfhi(x.x), x2 = bflo(x.y), x3 = bfhi(x.y), x4 = bflo(x.z), x5 = bfhi(x.z), x6 = bflo(x.w), x7 = bfhi(x.w);
            sm += ((x0 + x1) + (x2 + x3)) + ((x4 + x5) + (x6 + x7));
            sq += ((x0 * x0 + x1 * x1) + (x2 * x2 + x3 * x3)) + ((x4 * x4 + x5 * x5) + (x6 * x6 + x7 * x7)); }
        sm += shx(sm, 16, lane); sm += shx(sm, 32, lane); sq += shx(sq, 16, lane); sq += shx(sq, 32, lane);
        const float mean = sm * (1.f / DM);
        const float var = fmaxf(sq * (1.f / DM) - mean * mean, 0.f);
        const float rstd = 1.f / sqrtf(var + LN_EPS);
        f32x4 a0 = {0.f, 0.f, 0.f, 0.f}, a1 = {0.f, 0.f, 0.f, 0.f};
        bf16* hr = HOUT + (size_t)(r0 + fr) * DM + fq * 8;
        const bf16* w0p = WRT + (size_t)fr * 1024 + fq * 8; const bf16* w1p = WRT + (size_t)(16 + fr) * 1024 + fq * 8;
#pragma unroll 2
        for (int s = 0; s < 32; ++s) {
            const v4u x = *(const v4u*)(xr + 32 * s);
            const f32x4 g0 = *(const f32x4*)(lg + fq * 8 + 32 * s), g1 = *(const f32x4*)(lg + fq * 8 + 32 * s + 4);
            const f32x4 b0 = *(const f32x4*)(lb + fq * 8 + 32 * s), b1 = *(const f32x4*)(lb + fq * 8 + 32 * s + 4);
            v4u y;
            y.x = cvtpk((bflo(x.x) - mean) * rstd * g0[0] + b0[0], (bfhi(x.x) - mean) * rstd * g0[1] + b0[1]);
            y.y = cvtpk((bflo(x.y) - mean) * rstd * g0[2] + b0[2], (bfhi(x.y) - mean) * rstd * g0[3] + b0[3]);
            y.z = cvtpk((bflo(x.z) - mean) * rstd * g1[0] + b1[0], (bfhi(x.z) - mean) * rstd * g1[1] + b1[1]);
            y.w = cvtpk((bflo(x.w) - mean) * rstd * g1[2] + b1[2], (bfhi(x.w) - mean) * rstd * g1[3] + b1[3]);
            *(v4u*)(hr + 32 * s) = y;
            const bf16x8 yf = __builtin_bit_cast(bf16x8, y);
            const bf16x8 w0 = *(const bf16x8*)(w0p + 32 * s), w1 = *(const bf16x8*)(w1p + 32 * s);
            a0 = __builtin_amdgcn_mfma_f32_16x16x32_bf16(yf, w0, a0, 0, 0, 0);
            a1 = __builtin_amdgcn_mfma_f32_16x16x32_bf16(yf, w1, a1, 0, 0, 0);
        }
        { const float bb0 = br[fr], bb1 = br[16 + fr];
#pragma unroll
          for (int j = 0; j < 4; ++j) { lgt[(fq * 4 + j) * 33 + fr] = a0[j] + bb0; lgt[(fq * 4 + j) * 33 + 16 + fr] = a1[j] + bb1; } }
        LDS_WAIT();
        int e4[4] = {0, 0, 0, 0}, loc[4] = {0, 0, 0, 0}; float g4[4] = {0.f, 0.f, 0.f, 0.f};
        if (lane < 16) {
            float v[32];
#pragma unroll
            for (int e = 0; e < 32; ++e) v[e] = lgt[lane * 33 + e];
            float l4[4];
#pragma unroll
            for (int k = 0; k < 4; ++k) { float best = -3.0e38f; int bi = 0;
#pragma unroll
                for (int e = 0; e < 32; ++e) { const bool better = v[e] > best; best = better ? v[e] : best; bi = better ? e : bi; }
                l4[k] = best; e4[k] = bi;
#pragma unroll
                for (int e = 0; e < 32; ++e) v[e] = (e == bi) ? -3.0e38f : v[e]; }
            float den = 0.f;
#pragma unroll
            for (int k = 0; k < 4; ++k) { g4[k] = __expf(l4[k] - l4[0]); den += g4[k]; }
            const float rd = 1.f / den;
#pragma unroll
            for (int k = 0; k < 4; ++k) { g4[k] *= rd; loc[k] = __hip_atomic_fetch_add(lc + LC_LCNT + e4[k], 1, __ATOMIC_RELAXED, __HIP_MEMORY_SCOPE_WORKGROUP); }
        }
        __syncthreads();
        if (tid < 32) { const int n = lc[LC_LCNT + tid]; int base = 0; if (n > 0) base = (int)__hip_atomic_fetch_add(cnt + tid, (unsigned)n, __ATOMIC_RELAXED, __HIP_MEMORY_SCOPE_AGENT); lc[LC_LBASE + tid] = base; }
        __syncthreads();
        if (lane < 16) {
            const int row = r0 + lane;
#pragma unroll
            for (int k = 0; k < 4; ++k) route[(size_t)row * 4 + k] = make_int4(e4[k], lc[LC_LBASE + e4[k]] + loc[k], __builtin_bit_cast(int, g4[k]), 0);
        }
        __syncthreads();
    }
}

__device__ __forceinline__ int moe_table(CArgs* A, LAS unsigned char* lds, int layer, int tid) {
    const unsigned* cnt = (const unsigned*)(launder(A->ws) + WS_CTL) + CW_CNT + layer * 32;
    LAS int* lc = (LAS int*)(lds + LDSCTL_OFF);
    tid = launder_v(tid);
    __syncthreads();
    if (tid < 32) lc[LC_ECNT + tid] = (int)__hip_atomic_load(cnt + tid, __ATOMIC_RELAXED, __HIP_MEMORY_SCOPE_AGENT);
    __syncthreads();
    if (tid == 0) { int acc = 0; for (int e = 0; e < 32; ++e) { lc[LC_TSTART + e] = acc; acc += (lc[LC_ECNT + e] + 255) >> 8; } lc[LC_TSTART + 32] = acc; }
    __syncthreads();
    { LAS unsigned char* te = (LAS unsigned char*)(lc + LC_TILEE);
      for (int e = 0; e < 32; ++e) { const int st = lc[LC_TSTART + e], en = lc[LC_TSTART + e + 1]; for (int i = st + tid; i < en; i += NTHREADS) te[i] = (unsigned char)e; } }
    __syncthreads();
    return lc[LC_TSTART + 32];
}

__device__ __forceinline__ void permute_phase(CArgs* A, LAS unsigned char* lds, int layer, int G, int wg, int wave, int lane, const bf16* H) {
    unsigned char* ws = launder(A->ws);
    LAS int* lc = (LAS int*)(lds + LDSCTL_OFF);
    const int4* route = (const int4*)(ws + WS_ROUTE);
    int2* rowinfo = (int2*)(ws + WS_ROWINFO);
    bf16* XS = (bf16*)(ws + WS_XS);
    const int gw = wg * NWAVES + wave, NGW = G * NWAVES;
    for (int row = gw; row < NTOK; row += NGW) {
        const v4u c0 = *(const v4u*)(H + (size_t)row * DM + lane * 8), c1 = *(const v4u*)(H + (size_t)row * DM + 512 + lane * 8);
#pragma unroll
        for (int k = 0; k < 4; ++k) { const int4 rt = route[(size_t)row * 4 + k];
            const int dest = lc[LC_TSTART + rt.x] * 256 + rt.y;
            *(v4u*)(XS + (size_t)dest * DM + lane * 8) = c0; *(v4u*)(XS + (size_t)dest * DM + 512 + lane * 8) = c1;
            if (lane == 0) rowinfo[dest] = make_int2(row * 4 + k, rt.z); }
    }
    for (int e = wg; e < 32; e += G) { const int c = lc[LC_ECNT + e], st = lc[LC_TSTART + e] * 256, en = lc[LC_TSTART + e + 1] * 256;
        for (int i = st + c + wave * 64 + lane; i < en; i += NTHREADS) rowinfo[i] = make_int2(-1, 0); }
}

__device__ __forceinline__ void ln_ffn_phase(CArgs* A, int layer, int gw, int NGW, int lane, const bf16* H1, bf16* HOUT) {
    unsigned char* ws = launder(A->ws);
    const bf16* Y = (const bf16*)(ws + WS_XS);
    const float* lg = gptr(A->in[19]) + layer * DM; const float* lb = gptr(A->in[20]) + layer * DM;
    for (int row = gw; row < NTOK; row += NGW) {
        float x[16];
#pragma unroll
        for (int j = 0; j < 2; ++j) { const v4u h = *(const v4u*)(H1 + (size_t)row * DM + j * 512 + lane * 8);
            x[8 * j + 0] = DN_ALPHA * bflo(h.x); x[8 * j + 1] = DN_ALPHA * bfhi(h.x); x[8 * j + 2] = DN_ALPHA * bflo(h.y); x[8 * j + 3] = DN_ALPHA * bfhi(h.y);
            x[8 * j + 4] = DN_ALPHA * bflo(h.z); x[8 * j + 5] = DN_ALPHA * bfhi(h.z); x[8 * j + 6] = DN_ALPHA * bflo(h.w); x[8 * j + 7] = DN_ALPHA * bfhi(h.w); }
#pragma unroll
        for (int k = 0; k < 4; ++k)
#pragma unroll
            for (int j = 0; j < 2; ++j) { const v4u y = *(const v4u*)(Y + ((size_t)row * 4 + k) * DM + j * 512 + lane * 8);
                x[8 * j + 0] += bflo(y.x); x[8 * j + 1] += bfhi(y.x); x[8 * j + 2] += bflo(y.y); x[8 * j + 3] += bfhi(y.y);
                x[8 * j + 4] += bflo(y.z); x[8 * j + 5] += bfhi(y.z); x[8 * j + 6] += bflo(y.w); x[8 * j + 7] += bfhi(y.w); }
        float s = 0.f;
#pragma unroll
        for (int i = 0; i < 16; ++i) s += x[i];
#pragma unroll
        for (int o = 1; o < 64; o <<= 1) s += shx(s, o, lane);
        const float mean = s * (1.f / DM); float v = 0.f;
#pragma unroll
        for (int i = 0; i < 16; ++i) { x[i] -= mean; v += x[i] * x[i]; }
#pragma unroll
        for (int o = 1; o < 64; o <<= 1) v += shx(v, o, lane);
        const float rstd = 1.f / sqrtf(v * (1.f / DM) + LN_EPS);
#pragma unroll
        for (int j = 0; j < 2; ++j) { const int c0 = j * 512 + lane * 8;
            const f32x4 g0 = *(const f32x4*)(lg + c0), g1 = *(const f32x4*)(lg + c0 + 4), b0 = *(const f32x4*)(lb + c0), b1 = *(const f32x4*)(lb + c0 + 4);
#pragma unroll
            for (int i = 0; i < 4; ++i) { x[8 * j + i] = x[8 * j + i] * rstd * g0[i] + b0[i]; x[8 * j + 4 + i] = x[8 * j + 4 + i] * rstd * g1[i] + b1[i]; } }
        if (layer == 0) {
#pragma unroll
            for (int j = 0; j < 2; ++j) { v4u o; o.x = cvtpk(x[8 * j + 0], x[8 * j + 1]); o.y = cvtpk(x[8 * j + 2], x[8 * j + 3]); o.z = cvtpk(x[8 * j + 4], x[8 * j + 5]); o.w = cvtpk(x[8 * j + 6], x[8 * j + 7]);
                *(v4u*)(HOUT + (size_t)row * DM + j * 512 + lane * 8) = o; }
        } else {
            const int b = row / LTOK, p = row % LTOK;
            if (p >= NMETA) { float* op = (float*)(GAS float*)A->out + ((size_t)b * SEQ + (p - NMETA)) * DM;
#pragma unroll
                for (int j = 0; j < 2; ++j) { *(f32x4*)(op + j * 512 + lane * 8) = (f32x4){x[8 * j + 0], x[8 * j + 1], x[8 * j + 2], x[8 * j + 3]};
                    *(f32x4*)(op + j * 512 + lane * 8 + 4) = (f32x4){x[8 * j + 4], x[8 * j + 5], x[8 * j + 6], x[8 * j + 7]}; } }
        }
    }
}

#ifndef ENMASK
#define ENMASK 0xFFFF
#endif
#define EN(k) ((ENMASK >> (k)) & 1)
#define IN(k) (lo <= (k) && (k) < hi)
#define SEAM(k) do { if (IN(k) && IN((k) + 1)) { bar.bar = (unsigned*)(KA()->ws + WS_CTL) + CW_BAR; xcd_barrier(bar); } } while (0)
#define IDS() CArgs* args = KA(); unsigned char* ws = (unsigned char*)(GAS unsigned char*)args->ws; (void)ws; const int tid = launder_v(threadIdx.x), lane = tid & 63, wave = __builtin_amdgcn_readfirstlane(tid >> 6), gw = wg * NWAVES + wave; (void)tid; (void)lane; (void)gw


template <int layer>
__device__ __forceinline__ void layer_phases(LAS unsigned char* lds, XcdBarrier& bar, const int lo, const int hi, const int G, const int wg, const int NGW) {
        const int pb = 1 + 10 * layer;
        if (EN(1) && IN(pb + 0)) {
            IDS(); bf16* HA = (bf16*)(ws + WS_HA);
            const int N = layer == 0 ? NCOLA : NCOLB_PAD;
            pg8::Gemm g{HA, (const bf16*)(ws + (layer == 0 ? WS_WINA : WS_WINB)), NTOK, N, DM};
            pg8::StaticOrder S; S.init(NTOK, N, G, wg);
            pg8::EpiBias E{(bf16*)(ws + WS_PROJ), N, layer == 0 ? gptr(args->in[3]) : (const float*)(ws + WS_BIASB)};
            pg8::gemm_phase<pg8::EpiBias, pg8::StaticOrder, true, true>(lds, g, S, E);
        }
        SEAM(pb + 0);
        if (EN(2) && IN(pb + 1)) { IDS(); rope_phase(args, layer, gw * 64 + lane, NGW * 64); }
        SEAM(pb + 1);
        if (EN(3) && IN(pb + 2)) { IDS(); if (layer == 1) indexer_phase(args, G, wg, wave, lane); }
        SEAM(pb + 2);
        if (EN(4) && IN(pb + 3)) { IDS(); if (layer == 0) attn_phase<9, false>(args, lds, layer, gw, NGW, wave, lane); else attn_phase<17, true>(args, lds, layer, gw, NGW, wave, lane); }
        SEAM(pb + 3);
        if (EN(5) && IN(pb + 4)) {
            IDS(); bf16* HA = (bf16*)(ws + WS_HA); bf16* PRE = (bf16*)(ws + WS_PRE);
            pg8::Gemm g{(const bf16*)(ws + WS_ATT), (const bf16*)(ws + (layer == 0 ? WS_WOUTA : WS_WOUTB)), NTOK, DM, DM};
            pg8::StaticOrder S; S.init(NTOK, DM, G, wg);
            pg8::EpiRes E{PRE, HA, DN_ALPHA};
            pg8::gemm_phase<pg8::EpiRes, pg8::StaticOrder, true, true>(lds, g, S, E);
        }
        SEAM(pb + 4);
        if (EN(6) && IN(pb + 5)) { IDS(); ln_router_phase(args, lds, layer, G, wg, wave, lane, (const bf16*)(ws + WS_PRE), (bf16*)(ws + WS_HB)); }
        SEAM(pb + 5);
        if (EN(7) && IN(pb + 6)) { IDS(); (void)moe_table(args, lds, layer, tid); permute_phase(args, lds, layer, G, wg, wave, lane, (const bf16*)(ws + WS_HB)); }
        SEAM(pb + 6);
        if (EN(8) && IN(pb + 7)) {
            IDS(); const int ntiles = moe_table(args, lds, layer, tid);
            pg8::Gemm g{(const bf16*)(ws + WS_XS), (const bf16*)(ws + WS_WGU) + (size_t)layer * 32 * 2048 * 1024, MOE_P, 2048, DM};
            pg8::MoeOrder S{ntiles * 8, G, wg, 8, (const LAS unsigned char*)((const LAS int*)(lds + LDSCTL_OFF) + LC_TILEE)};
            pg8::EpiSwiglu E{(bf16*)(ws + WS_ACT), gptr(args->in[16]) + (size_t)layer * 32 * 2048};
            pg8::gemm_phase<pg8::EpiSwiglu, pg8::MoeOrder, true, true>(lds, g, S, E);
        }
        SEAM(pb + 7);
        if (EN(9) && IN(pb + 8)) {
            IDS(); const int ntiles = moe_table(args, lds, layer, tid);
            pg8::Gemm g{(const bf16*)(ws + WS_ACT), (const bf16*)(ws + WS_WD) + (size_t)layer * 32 * 1024 * 1024, MOE_P, 1024, DM};
            pg8::MoeOrder S{ntiles * 4, G, wg, 4, (const LAS unsigned char*)((const LAS int*)(lds + LDSCTL_OFF) + LC_TILEE)};
            pg8::EpiDown E{(bf16*)(ws + WS_XS), gptr(args->in[18]) + (size_t)layer * 32 * 1024, (const int2*)(ws + WS_ROWINFO)};
            pg8::gemm_phase<pg8::EpiDown, pg8::MoeOrder, true, true>(lds, g, S, E);
        }
        SEAM(pb + 8);
        if (EN(10) && IN(pb + 9)) { IDS(); ln_ffn_phase(args, layer, gw, NGW, lane, (const bf16*)(ws + WS_HB), (bf16*)(ws + WS_HA)); }
        SEAM(pb + 9);
}

constexpr int N_PHASES = 21;
__global__ void __launch_bounds__(NTHREADS, 2) fwd_kernel(Args args) {
    extern __shared__ __attribute__((aligned(16))) unsigned char lds_raw[];
    LAS unsigned char* lds = (LAS unsigned char*)lds_raw;
    const int G = gridDim.x, wg = blockIdx.x, NGW = G * NWAVES;

    for (int u = threadIdx.x; u < (LDS_BYTES - LDSCTL_OFF) / 4; u += NTHREADS) ((LAS unsigned*)(lds + LDSCTL_OFF))[u] = 0u;
    __syncthreads();
    const int lo = KA()->ph_lo, hi = KA()->ph_hi;
    const bool multi = (hi - lo) > 1;
    XcdBarrier bar; bar.bar = (unsigned*)(KA()->ws + WS_CTL) + CW_BAR; bar.x = 0; bar.st = nullptr;
    if (multi) bar = xcd_barrier_post((unsigned*)(KA()->ws + WS_CTL) + CW_BAR, (volatile LAS unsigned*)(lds + LDSCTL_OFF) + LC_BAR);
    if (EN(0) && IN(0)) { IDS(); p0_prologue(args, lds, gw, NGW, wave, lane); }
    SEAM(0);

    layer_phases<0>(lds, bar, lo, hi, G, wg, NGW);
    layer_phases<1>(lds, bar, lo, hi, G, wg, NGW);
#undef IN
#undef SEAM
}

#ifndef MK_N_LAUNCHES
#define MK_N_LAUNCHES 21
#endif
extern "C" void kernel_launch(void* const* d_in, const int* in_sizes, int n_in, void* d_out, int out_size, void* d_ws, size_t ws_size, hipStream_t stream) {
    static int grid = 0;
    if (grid == 0) {
        if (n_in != 21 || in_sizes[0] != NBATCH * SEQ * DM || out_size != NBATCH * SEQ * DM || ws_size < WS_END) {
            fprintf(stderr, "kernel_launch: unexpected shapes: n_in %d in0 %d out %d ws %zu (need %zu); nothing launched\n", n_in, n_in > 0 ? in_sizes[0] : -1, out_size, ws_size, (size_t)WS_END); grid = -1; return; }
        int dev = 0, cus = 0, per_cu = 0;
        if (hipGetDevice(&dev) != hipSuccess || hipDeviceGetAttribute(&cus, hipDeviceAttributeMultiprocessorCount, dev) != hipSuccess) { grid = -1; return; }
        if (hipFuncSetAttribute((const void*)fwd_kernel, hipFuncAttributeMaxDynamicSharedMemorySize, LDS_BYTES) != hipSuccess) { fprintf(stderr, "kernel_launch: hipFuncSetAttribute failed\n"); grid = -1; return; }
        if (hipOccupancyMaxActiveBlocksPerMultiprocessor(&per_cu, (const void*)fwd_kernel, NTHREADS, LDS_BYTES) != hipSuccess || per_cu < 1)
            fprintf(stderr, "kernel_launch: note: occupancy query reports %d workgroups per CU\n", per_cu);
        (void)hipGetLastError();
        grid = cus;
    }
    if (grid < 0) return;
    if (hipMemsetAsync((char*)d_ws + WS_CTL, 0, CTL_ZERO_BYTES, stream) != hipSuccess) return;
    Args a{};
    for (int i = 0; i < 21; ++i) a.in[i] = (const float*)d_in[i];
    a.out = (float*)d_out; a.ws = (unsigned char*)d_ws;
    if (MK_N_LAUNCHES == 1) {
        a.ph_lo = 0; a.ph_hi = N_PHASES;
        hipLaunchKernelGGL(fwd_kernel, dim3(grid), dim3(NTHREADS), LDS_BYTES, stream, a);
    } else {
        for (int ph = 0; ph < N_PHASES; ++ph) {
            if (ph == 3) continue;
            a.ph_lo = ph; a.ph_hi = ph + 1;
            hipLaunchKernelGGL(fwd_kernel, dim3(grid), dim3(NTHREADS), LDS_BYTES, stream, a);
        }
    }
}
```

```cpp
#include <hip/hip_runtime.h>
#include <cstdio>
#include <cstdint>
#define GAS __attribute__((address_space(1)))
#define LAS __attribute__((address_space(3)))
typedef unsigned short bf16;
typedef unsigned v4u __attribute__((ext_vector_type(4)));
typedef float f32x4 __attribute__((ext_vector_type(4)));
typedef short bf16x8 __attribute__((ext_vector_type(8)));
typedef GAS unsigned gu32;
typedef GAS unsigned long long gu64;
#define RLX_AGENT __ATOMIC_RELAXED, __HIP_MEMORY_SCOPE_AGENT
#define LDS_WAIT() asm volatile("s_waitcnt lgkmcnt(0)" ::: "memory")
#define VM_WAIT() asm volatile("s_waitcnt vmcnt(0)" ::: "memory")
__device__ __forceinline__ unsigned long long rt() { return __builtin_amdgcn_s_memrealtime(); }
__device__ __forceinline__ unsigned f2bf(float f) { unsigned u = __builtin_bit_cast(unsigned, f); return (u + 0x7fffu + ((u >> 16) & 1u)) >> 16; }
__device__ __forceinline__ unsigned pk2(float lo, float hi) { return f2bf(lo) | (f2bf(hi) << 16); }

#define XB_TMO      128
#define XB_XCNT(j)  (256  + 64 * (j))
#define XB_XSUB(j)  (1280 + 64 * (j))
#define XB_XGEN(j)  (2304 + 64 * (j))
#define XB_TOP      3328
#define XB_TOPGEN   3392
#define XCD_BAR_WORDS 3456
#define XB_SPIN_CAP (1u << 18)

__device__ __forceinline__ unsigned xb_ld(unsigned* p)              { return __hip_atomic_load(p, __ATOMIC_RELAXED, __HIP_MEMORY_SCOPE_AGENT); }
__device__ __forceinline__ unsigned xb_add(unsigned* p, unsigned v) { return __hip_atomic_fetch_add(p, v, __ATOMIC_RELAXED, __HIP_MEMORY_SCOPE_AGENT); }
__device__ __forceinline__ unsigned xb_xcc_id() { return (unsigned)__builtin_amdgcn_s_getreg((3 << 11) | 20) & 0xFu; }
#define XB_SPIN(cond, bar) do { unsigned _sp = 0; while (cond) { __builtin_amdgcn_s_sleep(1); \
    if ((++_sp & 255u) == 0u) { if (xb_ld(&(bar)[XB_TMO])) break; if (_sp > XB_SPIN_CAP) { atomicAdd(&(bar)[XB_TMO], 1u); break; } } } } while (0)

struct XcdBarrier {
    unsigned* bar; unsigned x;
    volatile LAS unsigned* st;
};

__device__ __forceinline__ XcdBarrier xcd_barrier_post(unsigned* bar, volatile LAS unsigned* st) {
    XcdBarrier b; b.bar = bar; b.x = xb_xcc_id(); b.st = st;
    if (threadIdx.x == 0) (void)xb_add(&bar[XB_XCNT(b.x)], 1u);
    return b;
}
__device__ __forceinline__ void xcd_barrier_complete(unsigned* bar, unsigned x, unsigned& nloc, unsigned& nx) {
    const unsigned G = gridDim.x * gridDim.y * gridDim.z;
    unsigned sum, cnt, mine, sp = 0u;
    for (;;) {
        sum = 0u; cnt = 0u; mine = 0u;
#pragma unroll
        for (unsigned j = 0; j < 16; ++j) { const unsigned c = xb_ld(&bar[XB_XCNT(j)]); sum += c; cnt += (c > 0u) ? 1u : 0u; mine = (j == x) ? c : mine; }
        if (sum == G) break;
        __builtin_amdgcn_s_sleep(1);
        if ((++sp & 255u) == 0u) { if (xb_ld(&bar[XB_TMO])) break; if (sp > XB_SPIN_CAP) { atomicAdd(&bar[XB_TMO], 1u); break; } }
    }
    nloc = mine > 0u ? mine : 1u; nx = cnt > 0u ? cnt : 1u;
}

__device__ __forceinline__ void xcd_barrier(const XcdBarrier& b) {
    asm volatile("s_waitcnt vmcnt(0)" ::: "memory");
    __syncthreads();
    if (threadIdx.x == 0) {
        unsigned* bar = b.bar;
        __builtin_amdgcn_s_waitcnt(0);
        unsigned nloc = b.st[0], nx = b.st[1];
        if (nloc == 0u) { xcd_barrier_complete(bar, b.x, nloc, nx); b.st[0] = nloc; b.st[1] = nx; }
        const unsigned old = xb_add(&bar[XB_XSUB(b.x)], 1u);
        const unsigned gen = old / nloc;
        if (old + 1u == (gen + 1u) * nloc) {
            __builtin_amdgcn_fence(__ATOMIC_RELEASE, "agent");
            asm volatile("s_waitcnt vmcnt(0)" ::: "memory");
            const unsigned og = xb_add(&bar[XB_TOP], 1u);
            const unsigned tg = og / nx;
            if (og + 1u == (tg + 1u) * nx) xb_add(&bar[XB_TOPGEN], 1u);
            else XB_SPIN(xb_ld(&bar[XB_TOPGEN]) == tg, bar);
            __builtin_amdgcn_fence(__ATOMIC_ACQUIRE, "agent");
            xb_add(&bar[XB_XGEN(b.x)], 1u);
            asm volatile("s_waitcnt vmcnt(0)" ::: "memory");
        } else {
            XB_SPIN(xb_ld(&bar[XB_XGEN(b.x)]) == gen, bar);
            __builtin_amdgcn_fence(__ATOMIC_ACQUIRE, "agent");
            asm volatile("s_waitcnt vmcnt(0)" ::: "memory");
        }
    }
    __syncthreads();
}
namespace pg8 {
#define PG8_LAS __attribute__((address_space(3)))
typedef unsigned short bf16_t;
typedef short bf16x8 __attribute__((ext_vector_type(8)));
typedef float f32x4 __attribute__((ext_vector_type(4)));
typedef unsigned u32x4 __attribute__((ext_vector_type(4)));
constexpr int BM = 256, BK = 64, HALF = 128, HTB = HALF * BK * 2  , STAGE_BYTES = 8 * HTB, NXCD = 8, WGM = 8, GTAB_OFF = STAGE_BYTES + 8192  ;

__host__ __device__ __forceinline__ int lds_byte(int r, int c) { const int st = (r >> 4) * 2 + (c >> 5), rr = r & 15, cc = c & 31, ob = rr * 64 + cc * 2; return st * 1024 + (ob ^ (((ob >> 9) & 1) << 5)); }
__host__ __device__ __forceinline__ void stage_rc(int b, int& R, int& C) { const int st = b / 1024, sb = b % 1024, swz = sb ^ (((sb >> 9) & 1) << 5); R = (st >> 1) * 16 + swz / 64; C = (st & 1) * 32 + (swz % 64) / 2; }
__host__ __device__ __forceinline__ int perm32(int rho) { const int n = rho >> 4, i = rho & 15; return 8 * (i >> 2) + 4 * n + (i & 3); }

struct Unit { int pm, pn; };
struct Gemm { const bf16_t* A; const bf16_t* Bt; int M, N, K; const unsigned* rowoff; };

struct StaticOrder {
    int nM, nN, nwg, G, c;
    __host__ __device__ void init(int M, int N, int G_, int c_) { nM = M / BM; nN = N / BM; nwg = nM * nN; G = G_; c = c_; }
    __host__ __device__ bool next(int i, Unit& u) const {
        const long L = (long)i * G + c; if (L >= nwg) return false;
        int wgid = (int)L; { const int q = nwg / NXCD, r = nwg % NXCD, xcd = wgid % NXCD, off = wgid / NXCD; wgid = (xcd < r ? xcd * (q + 1) : r * (q + 1) + (xcd - r) * q) + off; }
        const int nig = WGM * nN, gid = wgid / nig, fm = gid * WGM, gsz = (nM - fm) < WGM ? (nM - fm) : WGM;
        u.pm = fm + ((wgid % nig) % gsz); u.pn = (wgid % nig) / gsz; return true;
    }
    __device__ __forceinline__ void a_ready(const Unit&) const {}
    __device__ __forceinline__ void done(const Unit&) const {}
    __device__ __forceinline__ size_t rowbase(const Unit& u) const { return (size_t)u.pm * BM; }
};

__device__ __forceinline__ unsigned cvt_pk_bf16(float lo, float hi) { unsigned r; asm volatile("v_cvt_pk_bf16_f32 %0, %1, %2" : "=v"(r) : "v"(lo), "v"(hi)); return r; }
__device__ __forceinline__ float bf_lo(unsigned w) { return __builtin_bit_cast(float, w << 16); }
__device__ __forceinline__ float bf_hi(unsigned w) { return __builtin_bit_cast(float, w & 0xffff0000u); }

__device__ __forceinline__ unsigned pk4_fp8(float a, float b, float c, float d) {
    a = __builtin_amdgcn_fmed3f(a, -448.f, 448.f); b = __builtin_amdgcn_fmed3f(b, -448.f, 448.f); c = __builtin_amdgcn_fmed3f(c, -448.f, 448.f); d = __builtin_amdgcn_fmed3f(d, -448.f, 448.f);
    unsigned r = 0u; r = (unsigned)__builtin_amdgcn_cvt_pk_fp8_f32(a, b, (int)r, false); r = (unsigned)__builtin_amdgcn_cvt_pk_fp8_f32(c, d, (int)r, true); return r; }
constexpr float FP8_SX = 16.f, FP8_SA = 8.f, FP8_SW = 64.f, FP8_SO = 32.f, FP8_SY = 32.f;
struct EpiBias {
    static constexpr bool PERM = true, AFTER_DRAIN = false;
    bf16_t* O; int ldc; const float* bias;
    __device__ __forceinline__ void operator()(const f32x4 (&acc)[2][2][4][2], const Unit& u, int wr_, int wc_, int fr_, int fq_) const {
        int tz = threadIdx.x; asm volatile("" : "+v"(tz)); const int wid = __builtin_amdgcn_readfirstlane(tz >> 6), wr = wid >> 2, wc = wid & 3, fr = tz & 15, fq = (tz >> 4) & 3;
        const int row0 = u.pm * BM + wr * 64 + fr; const int col0 = u.pn * BM + wc * 32 + 8 * fq;
        f32x4 bv[2][2];
#pragma unroll
        for (int bj = 0; bj < 2; ++bj)
#pragma unroll
            for (int n = 0; n < 2; ++n) bv[bj][n] = *(const f32x4*)(bias + col0 + bj * HALF + 4 * n);
#pragma unroll
        for (int ai = 0; ai < 2; ++ai)
#pragma unroll
            for (int m = 0; m < 4; ++m) { bf16_t* rowp = O + (size_t)(row0 + ai * HALF + m * 16) * ldc + col0;
#pragma unroll
                for (int bj = 0; bj < 2; ++bj) { const f32x4 v0 = acc[ai][bj][m][0] + bv[bj][0], v1 = acc[ai][bj][m][1] + bv[bj][1];
                    u32x4 w; w.x = cvt_pk_bf16(v0[0], v0[1]); w.y = cvt_pk_bf16(v0[2], v0[3]); w.z = cvt_pk_bf16(v1[0], v1[1]); w.w = cvt_pk_bf16(v1[2], v1[3]);
                    *(u32x4*)(rowp + bj * HALF) = w; } }
    }
};

struct EpiProj {
    static constexpr bool PERM = true, AFTER_DRAIN = false;
    bf16_t* O; int ldc; const float* bias; bf16_t* KV; const float* ta; const float* tb; int ltok; unsigned char* K8; unsigned char* V8; unsigned char* Q8;
    __device__ __forceinline__ void operator()(const f32x4 (&acc)[2][2][4][2], const Unit& u, int wr_, int wc_, int fr_, int fq_) const {
        int tz = threadIdx.x; asm volatile("" : "+v"(tz)); const int wid = __builtin_amdgcn_readfirstlane(tz >> 6), wr = wid >> 2, wc = wid & 3, fr = tz & 15, fq = (tz >> 4) & 3, lane = tz & 63;
        const int row0 = u.pm * BM + wr * 64 + fr;
        f32x4 bz[2][2];
#pragma unroll
        for (int bj = 0; bj < 2; ++bj) { const int c0 = u.pn * BM + bj * HALF + wc * 32 + 8 * fq; bz[bj][0] = *(const f32x4*)(bias + c0); bz[bj][1] = *(const f32x4*)(bias + c0 + 4); }
#pragma unroll
        for (int bj = 0; bj < 2; ++bj) {
            const int cw = u.pn * BM + bj * HALF + wc * 32;
            const int c0 = cw + 8 * fq;
            const f32x4 b0 = bz[bj][0], b1 = bz[bj][1];
            const bool is_qk = cw < 1152, is_qi = cw >= 1280 && cw < 1792;
            const bool rot = ((cw & 63) == 0) && (is_qk || is_qi);
            bf16_t* dst; int dld;
            if (cw >= 1024 && cw < 1280) { dst = KV + (cw - 1024) + 8 * fq; dld = 256; } else { dst = O + c0; dld = ldc; }
            f32x4 csn[4];
            if (rot) { const int pos = row0 % ltok; const float* tp = is_qk ? ta + (size_t)pos * 16 : tb + (size_t)pos * 32 + (fq & 1) * 16;
#pragma unroll
                for (int q = 0; q < 4; ++q) csn[q] = *(const f32x4*)(tp + 4 * q); }
#pragma unroll
            for (int g = 0; g < 8; ++g) {
                    const int ai = g >> 2, m = g & 3;
                    const int row = row0 + ai * HALF + m * 16;
                    float v[8];
#pragma unroll
                    for (int j = 0; j < 4; ++j) { v[j] = acc[ai][bj][m][0][j] * (1.f / (FP8_SX * FP8_SW)) + b0[j]; v[4 + j] = acc[ai][bj][m][1][j] * (1.f / (FP8_SX * FP8_SW)) + b1[j]; }
                    if (rot) {
                        f32x4 cs[4];
#pragma unroll
                        for (int q = 0; q < 4; ++q) cs[q] = csn[q];
                        if (g < 7) { const int rown = row0 + ((g + 1) >> 2) * HALF + ((g + 1) & 3) * 16; const int posn = rown % ltok; const float* tpn = is_qk ? ta + (size_t)posn * 16 : tb + (size_t)posn * 32 + (fq & 1) * 16;
#pragma unroll
                            for (int q = 0; q < 4; ++q) csn[q] = *(const f32x4*)(tpn + 4 * q); }
                        const int px = is_qk ? 16 : 32;
                        float w[8];
#pragma unroll
                        for (int j = 0; j < 8; ++j) w[j] = __builtin_bit_cast(float, __builtin_amdgcn_ds_bpermute((lane ^ px) << 2, __builtin_bit_cast(int, v[j])));
                        const bool active = is_qk ? (fq < 2) : true;
                        const bool first = is_qk ? (fq == 0) : (fq < 2);
                        if (active) {
#pragma unroll
                            for (int j = 0; j < 8; j += 2) { const f32x4 c4 = cs[j >> 1];
                                const float x0 = v[j], y0 = w[j], x1 = v[j + 1], y1 = w[j + 1];
                                v[j] = first ? x0 * c4[0] - y0 * c4[1] : x0 * c4[0] + y0 * c4[1];
                                v[j + 1] = first ? x1 * c4[2] - y1 * c4[3] : x1 * c4[2] + y1 * c4[3]; }
                        }
                    }
                    if (Q8 != nullptr && cw < 1024) { uint2 o8; o8.x = pk4_fp8(FP8_SX * v[0], FP8_SX * v[1], FP8_SX * v[2], FP8_SX * v[3]); o8.y = pk4_fp8(FP8_SX * v[4], FP8_SX * v[5], FP8_SX * v[6], FP8_SX * v[7]);
                        *(uint2*)(Q8 + (size_t)row * 1024 + c0) = o8; }
                    else { u32x4 o; o.x = cvt_pk_bf16(v[0], v[1]); o.y = cvt_pk_bf16(v[2], v[3]); o.z = cvt_pk_bf16(v[4], v[5]); o.w = cvt_pk_bf16(v[6], v[7]);
                        *(u32x4*)(dst + (size_t)row * dld) = o; }
                    if (cw >= 1024 && cw < 1152) { uint2 o8; o8.x = pk4_fp8(FP8_SX * v[0], FP8_SX * v[1], FP8_SX * v[2], FP8_SX * v[3]); o8.y = pk4_fp8(FP8_SX * v[4], FP8_SX * v[5], FP8_SX * v[6], FP8_SX * v[7]);
                        *(uint2*)(K8 + (size_t)row * 128 + (cw - 1024) + 8 * fq) = o8; }
                    if (cw >= 1152 && cw < 1280) { uint2 o8; o8.x = pk4_fp8(FP8_SX * v[0], FP8_SX * v[1], FP8_SX * v[2], FP8_SX * v[3]); o8.y = pk4_fp8(FP8_SX * v[4], FP8_SX * v[5], FP8_SX * v[6], FP8_SX * v[7]);
                        *(uint2*)(V8 + (size_t)row * 128 + (cw - 1152) + 8 * fq) = o8; }
            }
        }
    }
};

struct EpiRes {
    static constexpr bool PERM = true, AFTER_DRAIN = false;
    bf16_t* O; const bf16_t* R; float alpha;
    __device__ __forceinline__ void operator()(const f32x4 (&acc)[2][2][4][2], const Unit& u, int wr_, int wc_, int fr_, int fq_) const {
        int tz = threadIdx.x; asm volatile("" : "+v"(tz)); const int wid = __builtin_amdgcn_readfirstlane(tz >> 6), wr = wid >> 2, wc = wid & 3, fr = tz & 15, fq = (tz >> 4) & 3;
        const int row0 = u.pm * BM + wr * 64 + fr; const int col0 = u.pn * BM + wc * 32 + 8 * fq;
#pragma unroll
        for (int ai = 0; ai < 2; ++ai) {
            u32x4 rr[4][2];
#pragma unroll
            for (int m = 0; m < 4; ++m)
#pragma unroll
                for (int bj = 0; bj < 2; ++bj) rr[m][bj] = *(const u32x4*)(R + (size_t)(row0 + ai * HALF + m * 16) * 1024 + col0 + bj * HALF);
#pragma unroll
            for (int m = 0; m < 4; ++m) { const size_t off = (size_t)(row0 + ai * HALF + m * 16) * 1024 + col0;
#pragma unroll
                for (int bj = 0; bj < 2; ++bj) { const u32x4 r = rr[m][bj];
                    const f32x4 a0 = acc[ai][bj][m][0] * (1.f / (FP8_SO * FP8_SW)), a1 = acc[ai][bj][m][1] * (1.f / (FP8_SO * FP8_SW));
                    u32x4 w;
                    w.x = cvt_pk_bf16(a0[0] + alpha * bf_lo(r.x), a0[1] + alpha * bf_hi(r.x));
                    w.y = cvt_pk_bf16(a0[2] + alpha * bf_lo(r.y), a0[3] + alpha * bf_hi(r.y));
                    w.z = cvt_pk_bf16(a1[0] + alpha * bf_lo(r.z), a1[1] + alpha * bf_hi(r.z));
                    w.w = cvt_pk_bf16(a1[2] + alpha * bf_lo(r.w), a1[3] + alpha * bf_hi(r.w));
                    *(u32x4*)(O + off + bj * HALF) = w; } } }
    }
};

__device__ __forceinline__ float swiglu1(float g, float u) {
    g = fminf(g, 7.0f); u = fminf(fmaxf(u, -7.0f), 7.0f);
    const float s = __builtin_amdgcn_rcpf(1.0f + __expf(-1.702f * g));
    return g * s * (u + 1.0f);
}
typedef float f32x2e __attribute__((ext_vector_type(2)));
__device__ __forceinline__ f32x2e swiglu2_x8(f32x2e g, f32x2e u) {
    g.x = fminf(g.x, 7.0f); g.y = fminf(g.y, 7.0f);
    u.x = __builtin_amdgcn_fmed3f(u.x, -7.0f, 7.0f); u.y = __builtin_amdgcn_fmed3f(u.y, -7.0f, 7.0f);
    const f32x2e z = g * (-1.702f * 1.4426950408889634f);
    f32x2e e; e.x = __builtin_amdgcn_exp2f(z.x); e.y = __builtin_amdgcn_exp2f(z.y);
    const f32x2e d = e + 1.0f;
    f32x2e r; r.x = __builtin_amdgcn_rcpf(d.x); r.y = __builtin_amdgcn_rcpf(d.y);
    return (g * r) * (u * FP8_SA + FP8_SA);
}
__device__ __forceinline__ unsigned pk4_fp8_nosat(f32x2e a, f32x2e b) { unsigned r = 0u; r = (unsigned)__builtin_amdgcn_cvt_pk_fp8_f32(a.x, a.y, (int)r, false); r = (unsigned)__builtin_amdgcn_cvt_pk_fp8_f32(b.x, b.y, (int)r, true); return r; }
struct EpiSwiglu {
    static constexpr bool PERM = true, AFTER_DRAIN = false;
    unsigned char* O; const float* bias;
    __device__ __forceinline__ void operator()(const f32x4 (&acc)[2][2][4][2], const Unit& u, int wr_, int wc_, int fr_, int fq_) const {
        int tz = threadIdx.x; asm volatile("" : "+v"(tz)); const int wid = __builtin_amdgcn_readfirstlane(tz >> 6), wr = wid >> 2, wc = wid & 3, fr = tz & 15, fq = (tz >> 4) & 3;
        const int e = u.pn >> 3, jt = u.pn & 7;
        const int row0 = u.pm * BM + wr * 64 + fr; const int col0 = jt * 128 + wc * 32 + 8 * fq;
        const float* bp = bias + e * 2048 + col0;
        constexpr float rs = 1.f / (FP8_SX * FP8_SW);
        const f32x4 bgA = *(const f32x4*)(bp), buA = *(const f32x4*)(bp + 1024), bgB = *(const f32x4*)(bp + 4), buB = *(const f32x4*)(bp + 1028);
#pragma unroll
        for (int ai = 0; ai < 2; ++ai)
#pragma unroll
            for (int m = 0; m < 4; ++m) {
                uint2 w;
                { const f32x4 bg = bgA, bu = buA;
                  const f32x4 g0 = acc[ai][0][m][0] * rs + bg, u0 = acc[ai][1][m][0] * rs + bu;
                  w.x = pk4_fp8_nosat(swiglu2_x8((f32x2e){g0[0], g0[1]}, (f32x2e){u0[0], u0[1]}), swiglu2_x8((f32x2e){g0[2], g0[3]}, (f32x2e){u0[2], u0[3]})); }
                asm volatile("" : "+v"(w.x));
                { const f32x4 bg = bgB, bu = buB;
                  const f32x4 g1 = acc[ai][0][m][1] * rs + bg, u1 = acc[ai][1][m][1] * rs + bu;
                  w.y = pk4_fp8_nosat(swiglu2_x8((f32x2e){g1[0], g1[1]}, (f32x2e){u1[0], u1[1]}), swiglu2_x8((f32x2e){g1[2], g1[3]}, (f32x2e){u1[2], u1[3]})); }
                *(uint2*)(O + (size_t)(row0 + ai * HALF + m * 16) * 1024 + col0) = w; }
    }
};

struct EpiDown {
    static constexpr bool PERM = true, AFTER_DRAIN = false;
    unsigned char* Y; const float* bias; const int2* elist; const PG8_LAS int* tstart; const PG8_LAS int* ecnt; int estride;
    __device__ __forceinline__ void operator()(const f32x4 (&acc)[2][2][4][2], const Unit& u, int wr_, int wc_, int fr_, int fq_) const {
        int tz = threadIdx.x; asm volatile("" : "+v"(tz)); const int wid = __builtin_amdgcn_readfirstlane(tz >> 6), wr = wid >> 2, wc = wid & 3, fr = tz & 15, fq = (tz >> 4) & 3;
        const int e = u.pn >> 2, jt = u.pn & 3;
        const int row0 = u.pm * BM + wr * 64 + fr; const int col0 = jt * 256 + wc * 32 + 8 * fq;
        const float* bp = bias + e * 1024 + col0;
        const int slot0 = (u.pm - tstart[e]) * BM + wr * 64 + fr, nvalid = ecnt[e];
        const f32x4 bz00 = *(const f32x4*)(bp), bz01 = *(const f32x4*)(bp + 4), bz10 = *(const f32x4*)(bp + HALF), bz11 = *(const f32x4*)(bp + HALF + 4);
        int2 inf[8];
#pragma unroll
        for (int g = 0; g < 8; ++g) { const int sl = slot0 + (g >> 2) * HALF + (g & 3) * 16; inf[g] = elist[(size_t)e * estride + (sl < nvalid ? sl : nvalid - 1)]; }
#pragma unroll
        for (int ai = 0; ai < 2; ++ai)
#pragma unroll
            for (int m = 0; m < 4; ++m) { const int sl = slot0 + ai * HALF + m * 16; const int2 info = inf[ai * 4 + m];
                if (sl < nvalid) { const float gt = __builtin_bit_cast(float, info.y) * FP8_SY; unsigned char* rowp = Y + (size_t)info.x * 1024 + col0;
#pragma unroll
                    for (int bj = 0; bj < 2; ++bj) { const f32x4 b0 = bj == 0 ? bz00 : bz10, b1 = bj == 0 ? bz01 : bz11;
                        const f32x4 v0 = (acc[ai][bj][m][0] * (1.f / (FP8_SA * FP8_SW)) + b0) * gt, v1 = (acc[ai][bj][m][1] * (1.f / (FP8_SA * FP8_SW)) + b1) * gt;
                        uint2 w; w.x = pk4_fp8(v0[0], v0[1], v0[2], v0[3]); w.y = pk4_fp8(v1[0], v1[1], v1[2], v1[3]);
                        *(uint2*)(rowp + bj * HALF) = w; } } }
    }
};

struct MoeOrder {
    int ntiles, G, c, NJ; const PG8_LAS unsigned char* tile_e;
    const PG8_LAS int* tstart; int estride;
    __device__ __forceinline__ size_t rowbase(const Unit& u) const { const int e = __builtin_amdgcn_readfirstlane((int)tile_e[u.pm]), ts = __builtin_amdgcn_readfirstlane(tstart[e]); return (size_t)e * estride + (size_t)(u.pm - ts) * 256; }
    __device__ __forceinline__ bool next(int i, Unit& u) const {
        const int x = c & 7, k = c >> 3;
        if (G != 256) { const int L = i * G + c; if (L >= ntiles * NJ) return false; const int tt = L / NJ; u.pm = tt; u.pn = tile_e[tt] * NJ + (L % NJ); return true; }
        const int rpg = 32 / NJ;
        const int g = 8 * i + x;
        if (g * rpg >= ntiles) return false;
        int tt = g * rpg + (NJ == 8 ? (k >> 3) : (k >> 2)); const int jt = NJ == 8 ? (k & 7) : (k & 3);
        if (tt >= ntiles) tt = ntiles - 1;
        u.pm = tt; u.pn = tile_e[tt] * NJ + jt; return true;
    }
    __device__ __forceinline__ void a_ready(const Unit&) const {}
    __device__ __forceinline__ void done(const Unit&) const {}
};

__device__ __forceinline__ void glds_s(unsigned voff, const void* sbase, unsigned lds_dst) { unsigned keep; unsigned long long sb = (unsigned long long)sbase; const unsigned ld = lds_dst;
    asm volatile("s_mov_b32 %0, m0\n\ts_mov_b32 m0, %3\n\ts_nop 0\n\tglobal_load_lds_dwordx4 %1, %2\n\ts_mov_b32 m0, %0" : "=&s"(keep) : "v"(voff), "s"(sb), "s"(ld) : "memory"); }
__device__ __forceinline__ void glds_d(unsigned voff, const void* sbase, unsigned lds_dst) { unsigned keep; unsigned long long sb = (unsigned long long)sbase; const unsigned ld = lds_dst;
    asm volatile("s_mov_b32 %0, m0\n\ts_mov_b32 m0, %3\n\ts_nop 0\n\tglobal_load_lds_dword %1, %2\n\ts_mov_b32 m0, %0" : "=&s"(keep) : "v"(voff), "s"(sb), "s"(ld) : "memory"); }
template <int IMM> __device__ __forceinline__ unsigned tab_rd(unsigned addr_v, int tab_s) { unsigned r;
    asm volatile("v_add_u32 %0, %2, %1\n\tds_read_b32 %0, %0 offset:%3" : "=&v"(r) : "v"(addr_v), "s"(tab_s), "i"(IMM) : "memory"); return r; }
template <int NW> __device__ __forceinline__ void glds_gw(unsigned ro, unsigned colb, const void* sbase, unsigned lds_dst) { unsigned keep; unsigned long long sb = (unsigned long long)sbase; const unsigned ld = lds_dst;
    asm volatile("s_waitcnt lgkmcnt(%5)\n\tv_add_u32 %1, %1, %2\n\ts_mov_b32 %0, m0\n\ts_mov_b32 m0, %4\n\ts_nop 0\n\tglobal_load_lds_dwordx4 %1, %3\n\ts_mov_b32 m0, %0" : "=&s"(keep), "+v"(ro) : "v"(colb), "s"(sb), "s"(ld), "i"(NW) : "memory"); }
typedef int pg8_v4i __attribute__((ext_vector_type(4)));
typedef int pg8_v8i __attribute__((ext_vector_type(8)));
__device__ __forceinline__ pg8_v8i cat8(bf16x8 a, bf16x8 b) { const pg8_v4i x = __builtin_bit_cast(pg8_v4i, a), y = __builtin_bit_cast(pg8_v4i, b); return __builtin_shufflevector(x, y, 0, 1, 2, 3, 4, 5, 6, 7); }
template <class Epi, class Sched, bool ALIGN_EPI = false, bool SP2 = false, bool FP8 = false, bool GATHER = false>
__device__ __forceinline__ void gemm_phase(PG8_LAS unsigned char* lds, const Gemm g, const Sched& S, const Epi& E) {
    int tid_l = threadIdx.x; asm volatile("" : "+v"(tid_l));
    const int tid = tid_l, wid = __builtin_amdgcn_readfirstlane(tid >> 6), lane = tid & 63, wr = wid >> 2, wc = wid & 3, fr = lane & 15, fq = lane >> 4;
    const int K = g.K, nt = K / BK;
    unsigned voffA[2], voffB[2];
#pragma unroll
    for (int i = 0; i < 2; ++i) { int R, C; stage_rc(tid * 16 + i * 8192, R, C); const int Rb = Epi::PERM ? ((R & ~31) + perm32(R & 31)) : R;
        voffA[i] = (unsigned)(R * K + C) * 2u; voffB[i] = (unsigned)(Rb * K + C) * 2u; }
    const size_t kstep = (size_t)(BK * 2);
    const size_t hstep = (size_t)HALF * K * 2;
    const size_t tstep = 2 * hstep;
    const unsigned ldsw = (unsigned)wid * 1024u;
    const int aoff = lds_byte(wr * 64 + fr, fq * 8), boff = lds_byte(wc * 32 + fr, fq * 8);
    unsigned rtabv = 0, colb = 0; if constexpr (GATHER) { int R, C; stage_rc(tid * 16, R, C); rtabv = (unsigned)(size_t)lds + (unsigned)(GTAB_OFF + R * 4); colb = (unsigned)C * 2u; }
#define PG8_SA(b, h) (((b) * 2 + (h)) * HTB)
#define PG8_SB(b, h) ((4 + (b) * 2 + (h)) * HTB)
#define PG8_STAGE(bufoff, gbase, voff) do { _Pragma("unroll") for (int _i = 0; _i < 2; ++_i) { if constexpr (FP8) glds_s((voff)[_i], (const void*)(gbase), (unsigned)(size_t)(lds + (bufoff) + _i * 8192) + ldsw); else \
        __builtin_amdgcn_global_load_lds((const unsigned*)((const char*)(gbase) + (voff)[_i]), (PG8_LAS unsigned*)(lds + (bufoff) + ldsw + _i * 8192), 16, 0, 0); } } while (0)
#define PG8_TAB_RD(ro, tab, h) do { ro[0] = tab_rd<(h) * 512>(rtabv, (tab)); ro[1] = tab_rd<(h) * 512 + 256>(rtabv, (tab)); } while (0)
#define PG8_STAGE_GA(bufoff, ro, kb, NW) do { _Pragma("unroll") for (int _i = 0; _i < 2; ++_i) glds_gw<NW>(ro[_i], colb, (const void*)((const char*)g.A + (kb)), (unsigned)(size_t)(lds + (bufoff) + _i * 8192) + ldsw); } while (0)
#define PG8_LDA(dst, b, h) do { _Pragma("unroll") for (int m = 0; m < 4; ++m) _Pragma("unroll") for (int k = 0; k < 2; ++k) dst[m][k] = *(const PG8_LAS bf16x8*)(lds + PG8_SA(b, h) + aoff + m * 2048 + k * 1024); } while (0)
#define PG8_LDB(dst, b, h) do { _Pragma("unroll") for (int n = 0; n < 2; ++n) _Pragma("unroll") for (int k = 0; k < 2; ++k) dst[n][k] = *(const PG8_LAS bf16x8*)(lds + PG8_SB(b, h) + boff + n * 2048 + k * 1024); } while (0)
#define PG8_MMA(ai, bj, At, Bt) do { __builtin_amdgcn_s_setprio(1); if constexpr (FP8) { _Pragma("unroll") for (int m = 0; m < 4; ++m) _Pragma("unroll") for (int n = 0; n < 2; ++n) \
        acc[ai][bj][m][n] = __builtin_amdgcn_mfma_scale_f32_16x16x128_f8f6f4(cat8(Bt[n][0], Bt[n][1]), cat8(At[m][0], At[m][1]), acc[ai][bj][m][n], 0, 0, 0, 0, 0, 0); } else { \
        _Pragma("unroll") for (int m = 0; m < 4; ++m) _Pragma("unroll") for (int n = 0; n < 2; ++n) _Pragma("unroll") for (int k = 0; k < 2; ++k) \
        acc[ai][bj][m][n] = __builtin_amdgcn_mfma_f32_16x16x32_bf16(Bt[n][k], At[m][k], acc[ai][bj][m][n], 0, 0, 0); } __builtin_amdgcn_s_setprio(0); } while (0)
#define PG8_WAIT_V(n) asm volatile("s_waitcnt vmcnt(" #n ")" ::: "memory")
#define PG8_WAIT_L(n) asm volatile("s_waitcnt lgkmcnt(" #n ")" ::: "memory")
#define PG8_BAR __builtin_amdgcn_s_barrier()
#define PG8_SCHED __builtin_amdgcn_sched_barrier(0)
    Unit cur, nxt; int ui = 0;
    if (!S.next(0, cur)) return;
    f32x4 acc[2][2][4][2];
#pragma unroll
    for (int a = 0; a < 2; ++a)
#pragma unroll
        for (int b = 0; b < 2; ++b)
#pragma unroll
            for (int m = 0; m < 4; ++m)
#pragma unroll
                for (int n = 0; n < 2; ++n) acc[a][b][m][n] = (f32x4){0.f, 0.f, 0.f, 0.f};
    bf16x8 At[4][2], B0[2][2], B1[2][2];
    const char* cA = (const char*)g.A + (size_t)cur.pm * tstep; const char* cB = (const char*)g.Bt + (size_t)cur.pn * tstep;
    S.a_ready(cur);
    if constexpr (SP2) {
        if constexpr (GATHER) {
            if (wid < 4) glds_d((unsigned)tid * 4u, (const void*)(g.rowoff + S.rowbase(cur)), (unsigned)(size_t)(lds + GTAB_OFF) + (unsigned)wid * 256u);
            PG8_WAIT_V(0); PG8_BAR; }
        PG8_STAGE(PG8_SB(0, 0), cB, voffB); PG8_STAGE(PG8_SB(0, 1), cB + hstep, voffB);
        if constexpr (GATHER) { unsigned r0[2], r1[2]; PG8_TAB_RD(r0, 0, 0); PG8_TAB_RD(r1, 0, 1); PG8_STAGE_GA(PG8_SA(0, 0), r0, (size_t)0, 0); PG8_STAGE_GA(PG8_SA(0, 1), r1, (size_t)0, 0); }
        else { PG8_STAGE(PG8_SA(0, 0), cA, voffA); PG8_STAGE(PG8_SA(0, 1), cA + hstep, voffA); }
        if (wr == 1) PG8_BAR;
        PG8_WAIT_V(2); PG8_BAR;
        PG8_STAGE(PG8_SB(1, 0), cB + kstep, voffB);
        if constexpr (GATHER) { unsigned r0[2]; PG8_TAB_RD(r0, 0, 0); PG8_STAGE_GA(PG8_SA(1, 0), r0, kstep, 0); } else PG8_STAGE(PG8_SA(1, 0), cA + kstep, voffA);
        PG8_STAGE(PG8_SB(1, 1), cB + hstep + kstep, voffB);
        PG8_WAIT_V(6); PG8_BAR;
    } else {
        PG8_STAGE(PG8_SB(0, 0), cB, voffB); PG8_STAGE(PG8_SA(0, 0), cA, voffA); PG8_STAGE(PG8_SB(0, 1), cB + hstep, voffB); PG8_STAGE(PG8_SA(0, 1), cA + hstep, voffA);
        if (wr == 1) PG8_BAR;
        PG8_WAIT_V(4); PG8_BAR;
        PG8_STAGE(PG8_SB(1, 0), cB + kstep, voffB); PG8_STAGE(PG8_SA(1, 0), cA + kstep, voffA); PG8_STAGE(PG8_SB(1, 1), cB + hstep + kstep, voffB);
        PG8_WAIT_V(6); PG8_BAR;
    }
    for (;;) {
        const bool has_next = S.next(ui + 1, nxt);
        const char* nA = has_next ? (const char*)g.A + (size_t)nxt.pm * tstep : cA; const char* nB = has_next ? (const char*)g.Bt + (size_t)nxt.pn * tstep : cB;
        const int tabC = (ui & 1) * 1024, tabN = has_next ? 1024 - tabC : tabC;
        if constexpr (GATHER) { if (has_next && wid < 4) glds_d((unsigned)tid * 4u, (const void*)(g.rowoff + S.rowbase(nxt)), (unsigned)(size_t)(lds + GTAB_OFF) + (unsigned)(tabN + wid * 256)); }
        for (int t = 0; t < nt; t += 2) {
            const bool last = (t == nt - 2);
            const int tab2 = last ? tabN : tabC; const size_t kb2 = last ? (size_t)0 : (size_t)(t + 2) * kstep; (void)tab2; (void)kb2;
            const char* a1 = cA + (size_t)(t + 1) * kstep;
            const char* a2 = last ? nA : cA + (size_t)(t + 2) * kstep; const char* b2 = last ? nB : cB + (size_t)(t + 2) * kstep;
            const char* a3 = a2 + kstep; const char* b3 = b2 + kstep;
            if (last && has_next) S.a_ready(nxt);
            if constexpr (SP2) {
            if constexpr (GATHER) { unsigned ro[2]; PG8_TAB_RD(ro, tabC, 1); PG8_LDB(B0, 0, 0); PG8_LDB(B1, 0, 1); PG8_SCHED; PG8_LDA(At, 0, 0); PG8_STAGE_GA(PG8_SA(1, 1), ro, (size_t)(t + 1) * kstep, 12); }
            else { PG8_LDB(B0, 0, 0); PG8_LDB(B1, 0, 1); PG8_SCHED; PG8_LDA(At, 0, 0); PG8_STAGE(PG8_SA(1, 1), a1 + hstep, voffA); }
            PG8_WAIT_V(8); PG8_WAIT_L(0); PG8_BAR; PG8_MMA(0, 0, At, B0); PG8_MMA(0, 1, At, B1); PG8_BAR; PG8_SCHED;
            if constexpr (GATHER) { unsigned ro[2]; PG8_TAB_RD(ro, tab2, 0); PG8_LDA(At, 0, 1); PG8_STAGE(PG8_SB(0, 0), b2, voffB); PG8_STAGE(PG8_SB(0, 1), b2 + hstep, voffB); PG8_STAGE_GA(PG8_SA(0, 0), ro, kb2, 6); }
            else { PG8_LDA(At, 0, 1); PG8_STAGE(PG8_SB(0, 0), b2, voffB); PG8_STAGE(PG8_SB(0, 1), b2 + hstep, voffB); PG8_STAGE(PG8_SA(0, 0), a2, voffA); }
            PG8_WAIT_V(8); PG8_WAIT_L(0); PG8_BAR; PG8_MMA(1, 0, At, B0); PG8_MMA(1, 1, At, B1); PG8_BAR; PG8_SCHED;
            if constexpr (GATHER) { unsigned ro[2]; PG8_TAB_RD(ro, tab2, 1); PG8_LDB(B0, 1, 0); PG8_LDB(B1, 1, 1); PG8_SCHED; PG8_LDA(At, 1, 0); PG8_STAGE_GA(PG8_SA(0, 1), ro, kb2, 12); }
            else { PG8_LDB(B0, 1, 0); PG8_LDB(B1, 1, 1); PG8_SCHED; PG8_LDA(At, 1, 0); PG8_STAGE(PG8_SA(0, 1), a2 + hstep, voffA); }
            PG8_WAIT_V(8); PG8_WAIT_L(0); PG8_BAR; PG8_MMA(0, 0, At, B0); PG8_MMA(0, 1, At, B1); PG8_BAR; PG8_SCHED;
            if constexpr (GATHER) { unsigned ro[2]; PG8_TAB_RD(ro, tab2, 0); PG8_LDA(At, 1, 1); PG8_STAGE(PG8_SB(1, 0), b3, voffB); PG8_STAGE(PG8_SB(1, 1), b3 + hstep, voffB); PG8_STAGE_GA(PG8_SA(1, 0), ro, kb2 + kstep, 6); }
            else { PG8_LDA(At, 1, 1); PG8_STAGE(PG8_SB(1, 0), b3, voffB); PG8_STAGE(PG8_SB(1, 1), b3 + hstep, voffB); PG8_STAGE(PG8_SA(1, 0), a3, voffA); }
            PG8_WAIT_V(8); PG8_WAIT_L(0); PG8_BAR; PG8_MMA(1, 0, At, B0); PG8_MMA(1, 1, At, B1); PG8_BAR; PG8_SCHED;
            } else {
            PG8_LDB(B0, 0, 0); PG8_SCHED; PG8_LDA(At, 0, 0); PG8_STAGE(PG8_SA(1, 1), a1 + hstep, voffA);
            PG8_WAIT_L(8); PG8_BAR; PG8_WAIT_L(0); PG8_MMA(0, 0, At, B0); PG8_BAR; PG8_SCHED;
            PG8_LDB(B1, 0, 1); PG8_STAGE(PG8_SB(0, 0), b2, voffB);
            PG8_BAR; PG8_WAIT_L(0); PG8_MMA(0, 1, At, B1); PG8_BAR;
            PG8_LDA(At, 0, 1); PG8_STAGE(PG8_SA(0, 0), a2, voffA);
            PG8_BAR; PG8_WAIT_L(0); PG8_MMA(1, 0, At, B0); PG8_BAR; PG8_SCHED;
            PG8_STAGE(PG8_SB(0, 1), b2 + hstep, voffB);
            PG8_WAIT_V(6); PG8_BAR; PG8_MMA(1, 1, At, B1); PG8_BAR;
            PG8_LDB(B0, 1, 0); PG8_SCHED; PG8_LDA(At, 1, 0); PG8_STAGE(PG8_SA(0, 1), a2 + hstep, voffA);
            PG8_WAIT_L(8); PG8_BAR; PG8_WAIT_L(0); PG8_MMA(0, 0, At, B0); PG8_BAR; PG8_SCHED;
            PG8_LDB(B1, 1, 1); PG8_STAGE(PG8_SB(1, 0), b3, voffB);
            PG8_BAR; PG8_WAIT_L(0); PG8_MMA(0, 1, At, B1); PG8_BAR;
            PG8_LDA(At, 1, 1); PG8_STAGE(PG8_SA(1, 0), a3, voffA);
            PG8_BAR; PG8_WAIT_L(0); PG8_MMA(1, 0, At, B0); PG8_BAR; PG8_SCHED;
            PG8_STAGE(PG8_SB(1, 1), b3 + hstep, voffB);
            PG8_WAIT_V(6); PG8_BAR; PG8_MMA(1, 1, At, B1); PG8_BAR;
            }
        }
        if constexpr (ALIGN_EPI) { if (wr == 0) PG8_BAR; }
        if constexpr (!Epi::AFTER_DRAIN) { E(acc, cur, wr, wc, fr, fq); S.done(cur); }
        if (!has_next) break;
#pragma unroll
        for (int a = 0; a < 2; ++a)
#pragma unroll
            for (int b = 0; b < 2; ++b)
#pragma unroll
                for (int m = 0; m < 4; ++m)
#pragma unroll
                    for (int n = 0; n < 2; ++n) acc[a][b][m][n] = (f32x4){0.f, 0.f, 0.f, 0.f};
        cur = nxt; cA = nA; cB = nB; ++ui;
        if constexpr (ALIGN_EPI) { if (wr == 1) PG8_BAR; }
    }
    PG8_WAIT_V(0);
    if constexpr (!ALIGN_EPI) { if (wr == 0) PG8_BAR; }
    PG8_BAR;
    if constexpr (Epi::AFTER_DRAIN) { E.fused(acc, cur, wr, wc, fr, fq, lds, wid, lane); S.done(cur); }
#undef PG8_SA
#undef PG8_SB
#undef PG8_STAGE
#undef PG8_TAB_RD
#undef PG8_STAGE_GA
#undef PG8_LDA
#undef PG8_LDB
#undef PG8_MMA
#undef PG8_WAIT_V
#undef PG8_WAIT_L
#undef PG8_BAR
#undef PG8_SCHED
}
}
constexpr int NBATCH = 16, SEQ = 4096, NMETA = 16, LTOK = SEQ + NMETA, NTOK = NBATCH * LTOK;
constexpr int DM = 1024, NCOLA = 1280, NCOLB = 1864, NCOLB_PAD = 2048;
constexpr int NEXP = 32, MOE_TILES_MAX = NTOK * 4 / 256 + NEXP, MOE_P = MOE_TILES_MAX * 256;
constexpr float LN_EPS = 1e-5f, DN_ALPHA = 1.4142135623730951f;
constexpr float ATTN_SCALE = 0.125f, IDX_SCALE = 0.125f, IDX_W_SCALE = 0.35355339059327373f;
constexpr int NWAVES = 8, NTHREADS = 512;

constexpr size_t MiB = 1u << 20;
constexpr size_t WS_CTL = 0, CTL_ZERO_BYTES = 1 * MiB;
constexpr size_t WS_ROPEA = 1 * MiB, WS_ROPEB = 2 * MiB, WS_BIASB = 3 * MiB, WS_WRT = 3 * MiB + 512 * 1024, WS_ROWINFO = 4 * MiB, WS_ROUTE = 8 * MiB;
constexpr size_t WS_WINA = 16 * MiB, WS_WOUTA = 19 * MiB, WS_WINB = 21 * MiB, WS_WOUTB = 25 * MiB;
constexpr size_t WS_WGU = 32 * MiB, WS_WD = 288 * MiB;
constexpr size_t WS_HA = 416 * MiB, WS_HB = 545 * MiB, WS_PRE = 674 * MiB;
constexpr size_t WS_XS = 803 * MiB, WS_ACT = 1333 * MiB, WS_H8 = 1863 * MiB, WS_ELIST = 1931 * MiB, WS_EOFF = 1948 * MiB, WS_END = 1965 * MiB;
constexpr size_t WS_ROWOFF = 6 * MiB + 512 * 1024;
constexpr size_t WS_HB8 = WS_XS + 330 * MiB;
constexpr size_t WS_Q8 = WS_XS + 451 * MiB;
constexpr size_t WS_PROJ = WS_XS, WS_ATT = WS_XS + 257 * MiB;
constexpr size_t WS_SCORE = WS_ACT, WS_SEL = WS_ACT + 128 * MiB;
constexpr size_t WS_KV = WS_XS + 386 * MiB, WS_KI = WS_XS + 421 * MiB;
constexpr size_t WS_K8 = WS_XS + 431 * MiB;
constexpr size_t WS_V8 = WS_XS + 441 * MiB;
static_assert((size_t)NTOK * 512 <= 35 * MiB && WS_KI + (size_t)NTOK * 128 <= WS_K8 && WS_K8 + (size_t)NTOK * 128 <= WS_V8 && WS_V8 + (size_t)NTOK * 128 <= WS_ACT, "ws compact copies");
static_assert((size_t)NTOK * 2048 * 2 <= 257 * MiB && (size_t)NTOK * 1024 * 2 <= 129 * MiB && (size_t)MOE_P * 2048 <= 530 * MiB, "ws map");
static_assert(WS_ATT + 129 * MiB <= WS_ACT && WS_SEL + 32 * MiB <= WS_END, "ws overlays");

constexpr int CW_BAR = 4096;
constexpr int CW_CNT = 16384;

constexpr int RING_BYTES = 131072, LDSCTL_OFF = RING_BYTES, LDS_BYTES = 163840;
constexpr int LDS_EQ_OFF = LDSCTL_OFF + 8192, LDS_HIST_OFF = LDSCTL_OFF + 16384;
constexpr int LC_BAR = 0;
constexpr int LC_TSTART = 16;
constexpr int LC_ECNT = 64;
constexpr int LC_LCNT = 128, LC_LBASE = 160;
constexpr int LC_PROBE_A = 200, LC_PROBE_B = 201;
constexpr int LC_TILEE = 256;

struct Args { const float* in[21]; float* out; unsigned char* ws; int ph_lo, ph_hi; };
typedef const Args __attribute__((address_space(4))) CArgs;
__device__ __forceinline__ CArgs* KA() { unsigned long long v = (unsigned long long)__builtin_amdgcn_kernarg_segment_ptr(); asm volatile("" : "+s"(v)); return (CArgs*)v; }

typedef unsigned short u16;

__device__ __forceinline__ float bf2f(unsigned h) { return __builtin_bit_cast(float, h << 16); }
__device__ __forceinline__ float bflo(unsigned w) { return __builtin_bit_cast(float, w << 16); }
__device__ __forceinline__ float bfhi(unsigned w) { return __builtin_bit_cast(float, w & 0xffff0000u); }
__device__ __forceinline__ unsigned cvtpk(float lo, float hi) { return pg8::cvt_pk_bf16(lo, hi); }
__device__ __forceinline__ unsigned char* launder(unsigned char* p) { unsigned long long v = (unsigned long long)p; asm volatile("" : "+s"(v)); return (unsigned char*)(GAS unsigned char*)v; }
__device__ __forceinline__ const float* gptr(const float* p) { return (const float*)(const GAS float*)p; }
__device__ __forceinline__ float shx(float v, int o, int lane) { return __builtin_bit_cast(float, __builtin_amdgcn_ds_bpermute((lane ^ o) << 2, __builtin_bit_cast(int, v))); }
__device__ __forceinline__ int shxi(int v, int o, int lane) { return __builtin_amdgcn_ds_bpermute((lane ^ o) << 2, v); }
__device__ __forceinline__ int launder_v(int x) { asm volatile("" : "+v"(x)); return x; }

__device__ __forceinline__ void transpose_item(const float* W, int K, int N, bf16* WT, int mode, LAS float* scr, int item, int lane) {
    const int nblk = (N + 31) / 32, kb = item / nblk, nb = item % nblk, k0 = 64 * kb, n0 = 32 * nb;
    const bool okn = (n0 + (lane & 31)) < N;
#pragma unroll 8
    for (int i = 0; i < 32; ++i) { const int kk = 2 * i + (lane >> 5); scr[kk * 33 + (lane & 31)] = okn ? W[(size_t)(k0 + kk) * N + n0 + (lane & 31)] : 0.f; }
    LDS_WAIT(); asm volatile("" ::: "memory");
    const int c = lane & 7;
#pragma unroll
    for (int j = 0; j < 4; ++j) { const int n = (lane >> 3) + 8 * j; const LAS float* s = scr + (8 * c) * 33 + n;
        v4u o; o.x = pk2(s[0 * 33], s[1 * 33]); o.y = pk2(s[2 * 33], s[3 * 33]); o.z = pk2(s[4 * 33], s[5 * 33]); o.w = pk2(s[6 * 33], s[7 * 33]);
        int nn = n0 + n;
        if (nn < N) {
            if (mode == 1) { const int up = nn >= 1024 ? 1 : 0, q = nn - 1024 * up; nn = (q >> 7) * 256 + up * 128 + (q & 127); }
            *(GAS v4u*)(WT + (size_t)nn * K + k0 + 8 * c) = o; } }
    LDS_WAIT(); asm volatile("" ::: "memory");
}

__device__ __forceinline__ void transpose_item_fp8(const float* W, int K, int N, unsigned char* WT, int mode, LAS float* scr, int item, int lane) {
    const int nblk = (N + 31) / 32, kb = item / nblk, nb = item % nblk, k0 = 64 * kb, n0 = 32 * nb;
    const bool okn = (n0 + (lane & 31)) < N;
#pragma unroll 8
    for (int i = 0; i < 32; ++i) { const int kk = 2 * i + (lane >> 5); scr[kk * 33 + (lane & 31)] = okn ? W[(size_t)(k0 + kk) * N + n0 + (lane & 31)] : 0.f; }
    LDS_WAIT(); asm volatile("" ::: "memory");
    const int c = lane & 7;
#pragma unroll
    for (int j = 0; j < 4; ++j) { const int n = (lane >> 3) + 8 * j; const LAS float* s = scr + (8 * c) * 33 + n;
        uint2 o; o.x = pg8::pk4_fp8(s[0 * 33] * pg8::FP8_SW, s[1 * 33] * pg8::FP8_SW, s[2 * 33] * pg8::FP8_SW, s[3 * 33] * pg8::FP8_SW);
        o.y = pg8::pk4_fp8(s[4 * 33] * pg8::FP8_SW, s[5 * 33] * pg8::FP8_SW, s[6 * 33] * pg8::FP8_SW, s[7 * 33] * pg8::FP8_SW);
        int nn = n0 + n;
        if (mode == 1) { const int up = nn >= 1024 ? 1 : 0, q = nn - 1024 * up; nn = (q >> 7) * 256 + up * 128 + (q & 127); }
        if (n0 + n < N) *(uint2*)(WT + (size_t)nn * K + k0 + 8 * c) = o; }
    LDS_WAIT(); asm volatile("" ::: "memory");
}

__device__ __forceinline__ void transpose_item_fp8_reg(const float* W, int K, int N, unsigned char* WT, int mode, int item, int lane) {
    const int nblk = N / 32, kb = item / nblk, nb = item % nblk, k0 = 64 * kb, n0 = 32 * nb;
    const int q = lane & 7, g = lane >> 3;
    const float* src = W + (size_t)(k0 + 8 * g) * N + n0 + 4 * q;
    f32x4 v[8];
#pragma unroll
    for (int i = 0; i < 8; ++i) v[i] = *(const f32x4*)(src + (size_t)i * N);
#pragma unroll
    for (int j = 0; j < 4; ++j) { constexpr float sw = pg8::FP8_SW; uint2 o;
        o.x = pg8::pk4_fp8(v[0][j] * sw, v[1][j] * sw, v[2][j] * sw, v[3][j] * sw); o.y = pg8::pk4_fp8(v[4][j] * sw, v[5][j] * sw, v[6][j] * sw, v[7][j] * sw);
        int nn = n0 + 4 * q + j;
        if (mode == 1) { const int up = nn >= 1024 ? 1 : 0, qq = nn - 1024 * up; nn = (qq >> 7) * 256 + up * 128 + (qq & 127); }
        *(uint2*)(WT + (size_t)nn * K + k0 + 8 * g) = o; }
}
constexpr int L1W_GU = 32 * 1024, L1W_ITEMS = L1W_GU + 32 * 512;
__device__ __forceinline__ void moe_weight_item(CArgs* A, int layer, int it, int lane) {
    unsigned char* ws = launder(A->ws);
    if (it < L1W_GU) { const int le = 32 * layer + (it >> 10); transpose_item_fp8_reg(gptr(A->in[15]) + (size_t)le * 1024 * 2048, 1024, 2048, ws + WS_WGU + (size_t)le * 2048 * 1024, 1, it & 1023, lane); }
    else { const int r = it - L1W_GU, le = 32 * layer + (r >> 9); transpose_item_fp8_reg(gptr(A->in[17]) + (size_t)le * 1024 * 1024, 1024, 1024, ws + WS_WD + (size_t)le * 1024 * 1024, 0, r & 511, lane); }
}

__device__ __forceinline__ void p0_prologue(CArgs* A, LAS unsigned char* lds, int gw, int NGW, int wave, int lane) {
    unsigned char* ws = launder(A->ws);
    LAS float* scr = (LAS float*)(lds + wave * 16384);
    constexpr int I_GU = 0, I_D = 0  , I_INA = 16 * 40, I_OUT = 512, I_INB = 16 * 59, I_R = 2 * 16;
    constexpr int NITEMS = I_GU + I_D + I_INA + I_OUT + I_INB + I_OUT + I_R;
    for (int it = gw; it < NITEMS; it += NGW) {
        int r = it;
        if (r < I_GU) { const int le = r >> 10; transpose_item_fp8(gptr(A->in[15]) + (size_t)le * 1024 * 2048, 1024, 2048, ws + WS_WGU + (size_t)le * 2048 * 1024, 1, scr, r & 1023, lane); continue; } r -= I_GU;
        if (r < I_D) { const int le = r >> 9; transpose_item_fp8(gptr(A->in[17]) + (size_t)le * 1024 * 1024, 1024, 1024, ws + WS_WD + (size_t)le * 1024 * 1024, 0, scr, r & 511, lane); continue; } r -= I_D;
        if (r < I_INA) { transpose_item_fp8(gptr(A->in[2]), 1024, NCOLA, ws + WS_WINA, 0, scr, r, lane); continue; } r -= I_INA;
        if (r < I_OUT) { transpose_item_fp8(gptr(A->in[5]), 1024, 1024, ws + WS_WOUTA, 0, scr, r, lane); continue; } r -= I_OUT;
        if (r < I_INB) { transpose_item_fp8(gptr(A->in[6]), 1024, NCOLB, ws + WS_WINB, 0, scr, r, lane); continue; } r -= I_INB;
        if (r < I_OUT) { transpose_item_fp8(gptr(A->in[10]), 1024, 1024, ws + WS_WOUTB, 0, scr, r, lane); continue; } r -= I_OUT;
        { const int ly = r >> 4; transpose_item(gptr(A->in[13]) + (size_t)ly * 1024 * 32, 1024, 32, (bf16*)(ws + WS_WRT) + (size_t)ly * 32 * 1024, 0, scr, r & 15, lane); }
    }
    const int gt = gw * 64 + lane, NGT = NGW * 64;
    { v4u* z = (v4u*)(ws + WS_WINB + (size_t)NCOLB * 1024); const int n16 = (NCOLB_PAD - NCOLB) * 1024 / 16;
      for (int i = gt; i < n16; i += NGT) z[i] = (v4u){0u, 0u, 0u, 0u}; }
    { v4u* z = (v4u*)(ws + WS_EOFF); const int n16 = 2 * 32 * NTOK * 4 / 16; for (int i = gt; i < n16; i += NGT) z[i] = (v4u){0u, 0u, 0u, 0u}; }
    { float* bb = (float*)(ws + WS_BIASB); for (int i = gt; i < NCOLB_PAD; i += NGT) bb[i] = i < NCOLB ? gptr(A->in[7])[i] : 0.f; }
    { float2* ta = (float2*)(ws + WS_ROPEA); float2* tb = (float2*)(ws + WS_ROPEB);
      for (int i = gt; i < LTOK * 24; i += NGT) {
          const int pos = i / 24, j = i % 24; const bool isA = j < 8; const int fi = isA ? j : j - 8; const float half = isA ? 8.f : 16.f;
          const float inv = powf(500000.0f, -(float)fi / half); const float ang = (float)pos * inv;
          float sn, cs; sincosf(ang, &sn, &cs);
          if (isA) ta[pos * 8 + fi] = make_float2(cs, sn); else tb[pos * 16 + fi] = make_float2(cs, sn); } }
    { bf16* H = (bf16*)(ws + WS_HA);
      for (int row = gw; row < NTOK; row += NGW) { const int b = row / LTOK, p = row % LTOK;
          const float* src = p < NMETA ? gptr(A->in[1]) + (size_t)p * DM : gptr(A->in[0]) + ((size_t)b * SEQ + (p - NMETA)) * DM;
#pragma unroll
          for (int j = 0; j < 2; ++j) { const f32x4 a = *(const f32x4*)(src + j * 512 + lane * 8), c = *(const f32x4*)(src + j * 512 + lane * 8 + 4);
              v4u o; o.x = cvtpk(a[0], a[1]); o.y = cvtpk(a[2], a[3]); o.z = cvtpk(c[0], c[1]); o.w = cvtpk(c[2], c[3]);
              *(v4u*)(H + (size_t)row * DM + j * 512 + lane * 8) = o;
              constexpr float sx = pg8::FP8_SX; uint2 o8; o8.x = pg8::pk4_fp8(sx * a[0], sx * a[1], sx * a[2], sx * a[3]); o8.y = pg8::pk4_fp8(sx * c[0], sx * c[1], sx * c[2], sx * c[3]);
              *(uint2*)(ws + WS_H8 + (size_t)row * DM + j * 512 + lane * 8) = o8; } } }
}

__device__ __forceinline__ void rope_pair(float& x1, float& x2, const float2 cs) { const float a = x1 * cs.x - x2 * cs.y, b = x2 * cs.x + x1 * cs.y; x1 = a; x2 = b; }
__device__ __forceinline__ void ki_phase(CArgs* A, int gt, int NGT) {
    unsigned char* ws = launder(A->ws);
    const bf16* P = (const bf16*)(ws + WS_PROJ); bf16* KI = (bf16*)(ws + WS_KI);
    const float2* tb = (const float2*)(ws + WS_ROPEB);
    for (int it = gt; it < NTOK * 2; it += NGT) {
        const int row = it >> 1, hf = it & 1, pos = row % LTOK, lane = gt & 63;
        const bf16* p = P + (size_t)row * NCOLB_PAD + 1792 + 32 * hf; bf16* d = KI + (size_t)row * 64 + 32 * hf;
        const float* g = gptr(A->in[8]) + 32 * hf; const float* bb = gptr(A->in[9]) + 32 * hf;
        v4u q[4];
#pragma unroll
        for (int j = 0; j < 4; ++j) q[j] = *(const v4u*)(p + 8 * j);
        float x[32];
#pragma unroll
        for (int j = 0; j < 4; ++j) { x[8 * j + 0] = bflo(q[j].x); x[8 * j + 1] = bfhi(q[j].x); x[8 * j + 2] = bflo(q[j].y); x[8 * j + 3] = bfhi(q[j].y);
            x[8 * j + 4] = bflo(q[j].z); x[8 * j + 5] = bfhi(q[j].z); x[8 * j + 6] = bflo(q[j].w); x[8 * j + 7] = bfhi(q[j].w); }
        float s = 0.f;
#pragma unroll
        for (int i = 0; i < 32; ++i) s += x[i];
        s += shx(s, 1, lane);
        const float mu = s * (1.f / 64.f); float v = 0.f;
#pragma unroll
        for (int i = 0; i < 32; ++i) { x[i] -= mu; v += x[i] * x[i]; }
        v += shx(v, 1, lane);
        const float rstd = 1.f / sqrtf(v * (1.f / 64.f) + LN_EPS);
#pragma unroll
        for (int c8 = 0; c8 < 4; ++c8) {
#pragma unroll
            for (int i = 8 * c8; i < 8 * c8 + 8; ++i) x[i] = x[i] * rstd * g[i] + bb[i];
            asm volatile("" ::: "memory"); }
        if (hf == 0) {
#pragma unroll
            for (int c4 = 0; c4 < 4; ++c4) {
#pragma unroll
                for (int i = 4 * c4; i < 4 * c4 + 4; ++i) rope_pair(x[i], x[16 + i], tb[pos * 16 + i]);
                asm volatile("" ::: "memory"); }
        }
#pragma unroll
        for (int j = 0; j < 4; ++j) { q[j].x = cvtpk(x[8 * j + 0], x[8 * j + 1]); q[j].y = cvtpk(x[8 * j + 2], x[8 * j + 3]); q[j].z = cvtpk(x[8 * j + 4], x[8 * j + 5]); q[j].w = cvtpk(x[8 * j + 6], x[8 * j + 7]);
            *(v4u*)(d + 8 * j) = q[j]; }
    }
}

template <int NB, bool DSA>
__device__ __forceinline__ void attn8_phase(CArgs* A, LAS unsigned char* lds, int gw, int NGW, int wave, int lane_) {
    unsigned char* ws = launder(A->ws);
    const bf16* P = (const bf16*)(ws + WS_PROJ); const int ld = DSA ? NCOLB_PAD : NCOLA;
    const unsigned char* K8 = ws + WS_K8; const unsigned char* V8 = ws + WS_V8;
    unsigned char* O = ws + WS_ATT;
    const u16* SEL = (const u16*)(ws + WS_SEL);
    const float* sinks = gptr(A->in[4]);
    LAS unsigned char* vl = lds + wave * 16384;
    typedef int v2i __attribute__((ext_vector_type(2)));
    constexpr int NTOT = DSA ? NTOK : NBATCH * NMETA;
#define TOK_DESC(tix_, tok_, b_, p_, nk_, usel_, rb_, selrow_) \
        const int tok_ = DSA ? (tix_) : ((tix_) >> 4) * LTOK + ((tix_) & 15); const int b_ = tok_ / LTOK, p_ = tok_ % LTOK; \
        const bool usel_ = DSA && (p_ - NMETA >= 256); const int nk_ = p_ < NMETA ? p_ + 1 : (p_ - NMETA < 256 ? p_ + 1 : 16 + 256); \
        const size_t rb_ = (size_t)b_ * LTOK; const u16* selrow_ = SEL + ((size_t)b_ * SEQ + (p_ > NMETA ? p_ - NMETA : 0)) * 256;
#define REQ_KP(dst_, nk_, usel_, selrow_, fr_) do { _Pragma("unroll") for (int c_ = 0; c_ < NB * 2; ++c_) { const int i0_ = c_ * 32 + (fr_), i1_ = i0_ + 16; \
            const unsigned k0_ = i0_ < (nk_) ? (unsigned)(i0_ < 16 ? i0_ : 16 + ((usel_) ? (int)(selrow_)[i0_ - 16] : i0_ - 16)) : 0u; \
            const unsigned k1_ = i1_ < (nk_) ? (unsigned)(16 + ((usel_) ? (int)(selrow_)[i1_ - 16] : i1_ - 16)) : 0u; dst_[c_] = k0_ | (k1_ << 16); } } while (0)
#define KPX(arr_, TT) (((TT) & 1) ? (arr_[(TT) >> 1] >> 16) : (arr_[(TT) >> 1] & 0xffffu))
#define LOAD_KX(arr_, rb_, bt, fq_, nt_) do { _Pragma("unroll") for (int T_ = 0; T_ < (nt_); ++T_) { \
            const unsigned ko_ = ((unsigned)(rb_) + KPX(arr_, 4 * (bt) + T_)) * 128u + (unsigned)(fq_) * 32u; \
            kf[T_][0] = *(const v4u*)(K8 + ko_); kf[T_][1] = *(const v4u*)(K8 + ko_ + 16u); } } while (0)
#define LOAD_VX(arr_, rb_, bt, lane__, nt_) do { _Pragma("unroll") for (int T_ = 0; T_ < (nt_); ++T_) _Pragma("unroll") for (int h_ = 0; h_ < 2; ++h_) { \
            const unsigned pp_ = (unsigned)__builtin_amdgcn_ds_bpermute((8 * h_ + ((lane__) >> 3)) << 2, (int)arr_[(4 * (bt) + T_) >> 1]); \
            const unsigned pos_ = (T_ & 1) ? (pp_ >> 16) : (pp_ & 0xffffu); \
            vt[2 * T_ + h_] = *(const v4u*)(V8 + (((unsigned)(rb_) + pos_) * 128u + ((unsigned)(lane__) & 7u) * 16u)); } } while (0)
    v4u kf[4][2]; v4u vt[8];
    unsigned kpn[NB * 2]; v4u qn[4];
    const unsigned char* Q8 = ws + WS_Q8;
    unsigned sta[8], tra[16];
    { const int lane = launder_v(lane_); const int fq = lane >> 4;
#pragma unroll
      for (int T = 0; T < 4; ++T)
#pragma unroll
          for (int h = 0; h < 2; ++h) { const unsigned i = 8u * h + ((unsigned)lane >> 3), rho = 32u * (i >> 2) + 4u * T + (i & 3u); sta[2 * T + h] = 128u * rho + 16u * (((unsigned)lane & 7u) ^ (rho & 7u)); }
#pragma unroll
      for (int d = 0; d < 8; ++d)
#pragma unroll
          for (int u = 0; u < 2; ++u) { const unsigned row = 32u * (unsigned)fq + 8u * u + (((unsigned)lane & 15u) >> 1); tra[2 * d + u] = 128u * row + 16u * ((unsigned)d ^ (row & 7u)) + 8u * ((unsigned)lane & 1u); } }
    int tix = gw, nwit = 0;
    if (tix >= NTOT) return;
    { const int lane0 = launder_v(lane_); const int fr0 = lane0 & 15, fq0 = lane0 >> 4;
      TOK_DESC(tix, tk0, b0, p0, nk0, us0, rb0, sr0)
      REQ_KP(kpn, nk0, us0, sr0, fr0);
      if (DSA) { const unsigned char* qr = Q8 + (rb0 + p0) * DM + fr0 * 64 + (fq0 & 1) * 32; qn[0] = *(const v4u*)qr; qn[1] = *(const v4u*)(qr + 16); }
      else { const bf16* qr = P + (rb0 + p0) * ld + fr0 * 64 + (fq0 & 1) * 32; qn[0] = *(const v4u*)qr; qn[1] = *(const v4u*)(qr + 8); qn[2] = *(const v4u*)(qr + 16); qn[3] = *(const v4u*)(qr + 24); }
      LOAD_KX(kpn, rb0, 0, fq0, 4); LOAD_VX(kpn, rb0, 0, lane0, 4); }
    for (; tix < NTOT; tix += NGW) {
        const int lane = launder_v(lane_); const int fr = lane & 15, fq = lane >> 4;
        TOK_DESC(tix, tok, b, p, n_keys, use_sel, rowbase, selrow)
        (void)b; (void)use_sel; (void)selrow;
        unsigned kp2[NB * 2];
#pragma unroll
        for (int c = 0; c < NB * 2; ++c) kp2[c] = kpn[c];
        pg8::pg8_v8i qf8;
        if (DSA) { const bool mine = (fq >> 1) == (fr >> 3); v4u lo8 = qn[0], hi8 = qn[1];
          if (!mine) { lo8 = (v4u){0u, 0u, 0u, 0u}; hi8 = lo8; }
          qf8 = pg8::cat8(__builtin_bit_cast(bf16x8, lo8), __builtin_bit_cast(bf16x8, hi8)); }
        else { const bool mine = (fq >> 1) == (fr >> 3); constexpr float sq = pg8::FP8_SX; const v4u q0 = qn[0], q1 = qn[1], q2 = qn[2], q3 = qn[3];
          v4u lo8, hi8;
          lo8.x = pg8::pk4_fp8(sq * bflo(q0.x), sq * bfhi(q0.x), sq * bflo(q0.y), sq * bfhi(q0.y)); lo8.y = pg8::pk4_fp8(sq * bflo(q0.z), sq * bfhi(q0.z), sq * bflo(q0.w), sq * bfhi(q0.w));
          lo8.z = pg8::pk4_fp8(sq * bflo(q1.x), sq * bfhi(q1.x), sq * bflo(q1.y), sq * bfhi(q1.y)); lo8.w = pg8::pk4_fp8(sq * bflo(q1.z), sq * bfhi(q1.z), sq * bflo(q1.w), sq * bfhi(q1.w));
          hi8.x = pg8::pk4_fp8(sq * bflo(q2.x), sq * bfhi(q2.x), sq * bflo(q2.y), sq * bfhi(q2.y)); hi8.y = pg8::pk4_fp8(sq * bflo(q2.z), sq * bfhi(q2.z), sq * bflo(q2.w), sq * bfhi(q2.w));
          hi8.z = pg8::pk4_fp8(sq * bflo(q3.x), sq * bfhi(q3.x), sq * bflo(q3.y), sq * bfhi(q3.y)); hi8.w = pg8::pk4_fp8(sq * bflo(q3.z), sq * bfhi(q3.z), sq * bflo(q3.w), sq * bfhi(q3.w));
          if (!mine) { lo8 = (v4u){0u, 0u, 0u, 0u}; hi8 = lo8; }
          qf8 = pg8::cat8(__builtin_bit_cast(bf16x8, lo8), __builtin_bit_cast(bf16x8, hi8)); }
        const bool has_next = tix + NGW < NTOT;
        const int tixn = has_next ? tix + NGW : tix;
        TOK_DESC(tixn, tokn, bn, pn, nkn, usn, rbn, srn)
        (void)tokn; (void)bn;
        REQ_KP(kpn, nkn, usn, srn, fr);
        if (DSA) { const unsigned char* qr = Q8 + (rbn + pn) * DM + fr * 64 + (fq & 1) * 32; qn[0] = *(const v4u*)qr; qn[1] = *(const v4u*)(qr + 16); }
        else { const bf16* qr = P + (rbn + pn) * ld + fr * 64 + (fq & 1) * 32; qn[0] = *(const v4u*)qr; qn[1] = *(const v4u*)(qr + 8); qn[2] = *(const v4u*)(qr + 16); qn[3] = *(const v4u*)(qr + 24); }
        float mrun = -1e30f, lsum = 0.f;
        f32x4 o[8];
#pragma unroll
        for (int d = 0; d < 8; ++d) o[d] = (f32x4){0.f, 0.f, 0.f, 0.f};
#pragma unroll
        for (int bt = 0; bt < NB; ++bt) {
            const int NT = (DSA && NB == 5 && bt == NB - 1) ? 1 : 4, NTN = (DSA && NB == 5 && bt + 1 == NB - 1) ? 1 : 4;
            if (bt * 64 < n_keys) {
                const bool more = (bt + 1 < NB) && ((bt + 1) * 64 < n_keys);
                f32x4 s8[4]; float bm = -1e30f;
                constexpr float qk = ATTN_SCALE / (pg8::FP8_SX * pg8::FP8_SX);
                const bool full = bt * 64 + 16 * NT <= n_keys;
#pragma unroll
                for (int T = 0; T < 4; ++T) s8[T] = (f32x4){-1e30f, -1e30f, -1e30f, -1e30f};
#pragma unroll
                for (int T = 0; T < NT; ++T) {
                    const f32x4 a = __builtin_amdgcn_mfma_scale_f32_16x16x128_f8f6f4(pg8::cat8(__builtin_bit_cast(bf16x8, kf[T][0]), __builtin_bit_cast(bf16x8, kf[T][1])), qf8, (f32x4){0.f, 0.f, 0.f, 0.f}, 0, 0, 0, 0, 0, 0);
                    if (full) { s8[T] = a; }
                    else {
#pragma unroll
                        for (int j = 0; j < 4; ++j) { const int ki = bt * 64 + 16 * T + 4 * fq + j; s8[T][j] = ki < n_keys ? a[j] : -1e30f; } }
                    bm = fmaxf(bm, fmaxf(fmaxf(s8[T][0], s8[T][1]), fmaxf(s8[T][2], s8[T][3])));
                }
                if (more) { LOAD_KX(kp2, rowbase, bt + 1 < NB ? bt + 1 : 0, fq, NTN); } else if (has_next) { LOAD_KX(kpn, rbn, 0, fq, 4); }
                bm = fmaxf(bm, shx(bm, 16, lane)); bm = fmaxf(bm, shx(bm, 32, lane)); bm *= qk;
                const float mnew = fmaxf(mrun, bm), rs = __expf(mrun - mnew); mrun = mnew;
                float bs = 0.f; unsigned pk[4];
                const float mb = mnew * 1.4426950408889634f - 8.0f;
                constexpr float qkl = qk * 1.4426950408889634f;
#pragma unroll
                for (int T = 0; T < 4; ++T) { const float e0 = __builtin_amdgcn_exp2f(__builtin_fmaf(s8[T][0], qkl, -mb)), e1 = __builtin_amdgcn_exp2f(__builtin_fmaf(s8[T][1], qkl, -mb)),
                                                          e2 = __builtin_amdgcn_exp2f(__builtin_fmaf(s8[T][2], qkl, -mb)), e3 = __builtin_amdgcn_exp2f(__builtin_fmaf(s8[T][3], qkl, -mb));
                    bs += (e0 + e1) + (e2 + e3); unsigned w = 0u; w = (unsigned)__builtin_amdgcn_cvt_pk_fp8_f32(e0, e1, (int)w, false); w = (unsigned)__builtin_amdgcn_cvt_pk_fp8_f32(e2, e3, (int)w, true); pk[T] = w; }
                bs *= (1.f / 256.f);
                lsum = lsum * rs + bs;
#pragma unroll
                for (int d = 0; d < 8; ++d) o[d] = o[d] * rs;
#pragma unroll
                for (int q8 = 0; q8 < 2 * NT; ++q8) *(LAS v4u*)(vl + sta[q8]) = vt[q8];
                if (more) { LOAD_VX(kp2, rowbase, bt + 1 < NB ? bt + 1 : 0, lane, NTN); } else if (has_next) { LOAD_VX(kpn, rbn, 0, lane, 4); }
                const pg8::pg8_v8i pf = {(int)pk[0], (int)pk[1], (int)pk[2], (int)pk[3], 0, 0, 0, 0};
#pragma unroll
                for (int d = 0; d < 8; ++d) {
                    v2i r[2];
#pragma unroll
                    for (int u = 0; u < 2; ++u) r[u] = __builtin_amdgcn_ds_read_tr8_b64_v2i32((LAS v2i*)(vl + tra[2 * d + u]));
                    const pg8::pg8_v8i vf = {r[0].x, r[0].y, r[1].x, r[1].y, 0, 0, 0, 0};
                    o[d] = __builtin_amdgcn_mfma_scale_f32_16x16x128_f8f6f4(vf, pf, o[d], 0, 0, 0, 0, 0, 0);
                }
            }
        }
        lsum += shx(lsum, 16, lane); lsum += shx(lsum, 32, lane);
        float inv;
        if (!DSA) { const float sk = sinks[fr], m2 = fmaxf(mrun, sk), f = __expf(mrun - m2); inv = f / (lsum * f + __expf(sk - m2)); }
        else inv = 1.f / lsum;
        { unsigned char* orow = O + (size_t)tok * DM + fr * 64 + fq * 4; const bool hi = fr >= 8; const float inv8 = inv * (pg8::FP8_SO / (256.f * pg8::FP8_SX));
#pragma unroll
          for (int dd = 0; dd < 4; ++dd) { const f32x4 vl_ = o[dd], vh_ = o[4 + dd];
              const float v0 = hi ? vh_[0] : vl_[0], v1 = hi ? vh_[1] : vl_[1], v2 = hi ? vh_[2] : vl_[2], v3 = hi ? vh_[3] : vl_[3];
              *(unsigned*)(orow + dd * 16) = pg8::pk4_fp8(v0 * inv8, v1 * inv8, v2 * inv8, v3 * inv8); } }
    }
#undef TOK_DESC
#undef REQ_KP
#undef KPX
#undef LOAD_KX
#undef LOAD_VX
}

constexpr int SWA_ROWS = 288, SWA_KOFF = 0, SWA_VOFF = SWA_ROWS * 128;
__device__ __forceinline__ unsigned swa_koff(unsigned row, unsigned ch) { return 128u * row + 16u * (ch ^ (((row >> 1) & 1u) | (((row >> 3) & 3u) << 1))); }
__device__ __forceinline__ unsigned swa_voff(unsigned row, unsigned ch) { return 128u * row + 16u * (ch ^ (2u * (((row >> 1) & 1u) | (((row >> 3) & 1u) << 1)))); }
__device__ __forceinline__ void swa_tile_phase(CArgs* A, LAS unsigned char* lds, int G, int wg, int wave, int lane_) {
    unsigned char* ws = launder(A->ws);
    const bf16* P = (const bf16*)(ws + WS_PROJ); constexpr int ld = NCOLA;
    const bf16* KV = (const bf16*)(ws + WS_KV);
    bf16* O = (bf16*)(ws + WS_ATT);
    const float* sinks = gptr(A->in[4]);
    LAS unsigned char* kl = lds + SWA_KOFF; LAS unsigned char* vl = lds + SWA_VOFF;
    constexpr int NUNITS = NBATCH * 2 * 32;
    int nwit = 0;
    for (int unit = wg; unit < NUNITS; unit += G) {
        const int lane = launder_v(lane_), tid = wave * 64 + lane, fr = lane & 15, fq = lane >> 4;
        const int qb = unit & 31, kvh = (unit >> 5) & 1, b = unit >> 6;
        const size_t rowbase = (size_t)b * LTOK;
        __syncthreads();
        { constexpr int NST = (SWA_ROWS * 8 + NTHREADS - 1) / NTHREADS;
          v4u kk[NST], vv[NST];
#pragma unroll
          for (int i = 0; i < NST; ++i) { const int id = tid + i * NTHREADS; const int r = id >> 3, ch = id & 7;
              int pos = -1;
              if (r < 16) pos = r; else if (r < 272) { const int s = (qb - 1) * 128 + (r - 16); if (s >= 0) pos = NMETA + s; }
              kk[i] = (v4u){0u, 0u, 0u, 0u}; vv[i] = kk[i];
              if (id < SWA_ROWS * 8 && pos >= 0) { const bf16* src = KV + (rowbase + pos) * 256 + kvh * 64 + ch * 8; kk[i] = *(const v4u*)src; vv[i] = *(const v4u*)(src + 128); } }
#pragma unroll
          for (int i = 0; i < NST; ++i) { const int id = tid + i * NTHREADS; const int r = id >> 3, ch = id & 7;
              if (id < SWA_ROWS * 8) { *(LAS v4u*)(kl + swa_koff((unsigned)r, (unsigned)ch)) = kk[i]; *(LAS v4u*)(vl + swa_voff((unsigned)r, (unsigned)ch)) = vv[i]; } } }
        __syncthreads();
        const int i0 = 16 * wave;
        const int tokrow = (int)rowbase + NMETA + qb * 128 + i0 + fr;
        const unsigned tq = ((unsigned)lane & 15u) >> 2, tp = (unsigned)lane & 3u;
        bf16x8 qn[2];
        { const bf16* qr = P + (size_t)tokrow * ld + (kvh * 8) * 64 + fq * 8; qn[0] = *(const bf16x8*)qr; qn[1] = *(const bf16x8*)(qr + 32); }
#pragma unroll 1
        for (int g = 0; g < 8; ++g) {
            const int h = kvh * 8 + g;
            bf16x8 qf[2]; qf[0] = qn[0]; qf[1] = qn[1];
            { const int hn = kvh * 8 + (g < 7 ? g + 1 : g); const bf16* qr = P + (size_t)tokrow * ld + hn * 64 + fq * 8; qn[0] = *(const bf16x8*)qr; qn[1] = *(const bf16x8*)(qr + 32); }
            f32x4 sc[12]; float mx = -1e30f;
#pragma unroll
            for (int T = 0; T < 12; ++T) {
                const int c = T >> 1; const int base = c == 0 ? 0 : 16 + i0 + 32 * (c - 1);
                const unsigned r = (unsigned)(base + 8 * (fr >> 2) + 4 * (T & 1) + (fr & 3));
                const bf16x8 k0 = *(const LAS bf16x8*)(kl + swa_koff(r, (unsigned)fq)), k1 = *(const LAS bf16x8*)(kl + swa_koff(r, 4u + (unsigned)fq));
                f32x4 a = {0.f, 0.f, 0.f, 0.f};
                a = __builtin_amdgcn_mfma_f32_16x16x32_bf16(k0, qf[0], a, 0, 0, 0);
                a = __builtin_amdgcn_mfma_f32_16x16x32_bf16(k1, qf[1], a, 0, 0, 0);
#pragma unroll
                for (int j = 0; j < 4; ++j) { const int rr = base + 8 * fq + 4 * (T & 1) + j;
                    bool ok;
                    if (c == 0) ok = rr < 16; else { const int kbi = rr - 16, it = i0 + fr; ok = (kbi >= it + 1) && (kbi <= it + 128) && (qb > 0 || kbi >= 128); }
                    const float v = ok ? a[j] * ATTN_SCALE : -1e30f; sc[T][j] = v; mx = fmaxf(mx, v); }
            }
            mx = fmaxf(mx, shx(mx, 16, lane)); mx = fmaxf(mx, shx(mx, 32, lane));
            const float sk = sinks[h]; mx = fmaxf(mx, sk);
            float sum = 0.f; v4u pk[6];
#pragma unroll
            for (int c = 0; c < 6; ++c) { float e[8];
#pragma unroll
                for (int j = 0; j < 4; ++j) { e[j] = __expf(sc[2 * c][j] - mx); e[4 + j] = __expf(sc[2 * c + 1][j] - mx); }
                sum += ((e[0] + e[1]) + (e[2] + e[3])) + ((e[4] + e[5]) + (e[6] + e[7]));
                pk[c].x = cvtpk(e[0], e[1]); pk[c].y = cvtpk(e[2], e[3]); pk[c].z = cvtpk(e[4], e[5]); pk[c].w = cvtpk(e[6], e[7]); }
            sum += shx(sum, 16, lane); sum += shx(sum, 32, lane);
            sum += __expf(sk - mx);
            const float inv = 1.f / sum;
            f32x4 o[4];
#pragma unroll
            for (int d = 0; d < 4; ++d) o[d] = (f32x4){0.f, 0.f, 0.f, 0.f};
#pragma unroll
            for (int c = 0; c < 6; ++c) {
                const int base = c == 0 ? 0 : 16 + i0 + 32 * (c - 1);
                const bf16x8 pf = __builtin_bit_cast(bf16x8, pk[c]);
                const unsigned r0 = (unsigned)(base + 8 * fq) + tq, r1 = r0 + 4u;
#pragma unroll
                for (int d = 0; d < 4; ++d) {
                    typedef short s16x4 __attribute__((ext_vector_type(4)));
                    const s16x4 lo = __builtin_bit_cast(s16x4, __builtin_amdgcn_ds_read_tr16_b64_v4i16((LAS s16x4*)(vl + swa_voff(r0, 2u * d + (tp >> 1)) + 8u * (tp & 1u))));
                    const s16x4 hi = __builtin_bit_cast(s16x4, __builtin_amdgcn_ds_read_tr16_b64_v4i16((LAS s16x4*)(vl + swa_voff(r1, 2u * d + (tp >> 1)) + 8u * (tp & 1u))));
                    const bf16x8 vf = {lo[0], lo[1], lo[2], lo[3], hi[0], hi[1], hi[2], hi[3]};
                    o[d] = __builtin_amdgcn_mfma_f32_16x16x32_bf16(vf, pf, o[d], 0, 0, 0);
                }
            }
            { unsigned char* orow = (unsigned char*)O + (size_t)tokrow * DM + h * 64 + fq * 4; const float inv8 = inv * pg8::FP8_SO;
#pragma unroll
              for (int d = 0; d < 4; ++d) *(unsigned*)(orow + d * 16) = pg8::pk4_fp8(o[d][0] * inv8, o[d][1] * inv8, o[d][2] * inv8, o[d][3] * inv8); }
            { const int wit = (wg * NWAVES + wave) + nwit * (G * NWAVES); if (wit < L1W_ITEMS) moe_weight_item(A, 0, wit, lane); ++nwit; }
        }
    }
    for (int wit = (wg * NWAVES + wave) + nwit * (G * NWAVES); wit < L1W_ITEMS; wit += G * NWAVES) moe_weight_item(A, 0, wit, launder_v(lane_));
}

#ifndef PROBE_SUB
#define PROBE_SUB 0
#endif
#define SUB_T0() unsigned long long sub_t_ = (PROBE_SUB) ? __builtin_amdgcn_s_memrealtime() : 0ull
#define SUB_ADD(lds_, word_) do { if (PROBE_SUB) { const unsigned long long n_ = __builtin_amdgcn_s_memrealtime(); if (threadIdx.x == 0) ((LAS unsigned*)((lds_) + LDSCTL_OFF))[word_] += (unsigned)(n_ - sub_t_); sub_t_ = n_; } } while (0)
__device__ __forceinline__ int idx_bucket(float s) { return (int)__builtin_amdgcn_fmed3f(__builtin_fmaf(s, 24.f, 128.5f), 0.f, 255.9f); }
__device__ __forceinline__ unsigned ordkey(float f) { unsigned u = __builtin_bit_cast(unsigned, f); if (u == 0x80000000u) u = 0u; return (u & 0x80000000u) ? ~u : (u | 0x80000000u); }
__device__ __forceinline__ void indexer_phase(CArgs* A, LAS unsigned char* lds, int G, int wg, int wave, int lane_) {
    unsigned char* ws = launder(A->ws);
    const bf16* P = (const bf16*)(ws + WS_PROJ); constexpr int ld = NCOLB_PAD;
    const bf16* KI = (const bf16*)(ws + WS_KI);
    float* scr = (float*)(ws + WS_SCORE) + (size_t)wg * 32 * SEQ;
    u16* SEL = (u16*)(ws + WS_SEL);
    constexpr int NUNITS = NBATCH * 120;
    int nwit = 0;
    for (int r = 0;; ++r) {
        const int k = r * G + ((r & 1) ? (G - 1 - wg) : wg);
        if (r * G >= NUNITS) break;
        if (k >= NUNITS) continue;
        const int lane = launder_v(lane_), fr = lane & 15, fq = lane >> 4, tid = wave * 64 + lane;
        const int qb = 127 - k / NBATCH, b = k % NBATCH, t0 = qb * 32;
        const size_t rowbase = (size_t)b * LTOK + NMETA;
        bf16x8 qf[2][2]; float wv[2][4];
#pragma unroll
        for (int rg = 0; rg < 2; ++rg) {
            const int tq = t0 + 4 * wave + (fr >> 2);
            const bf16* qr = P + (rowbase + tq) * ld + 1280 + ((fr & 3) + 4 * rg) * 64 + fq * 8;
            qf[rg][0] = *(const bf16x8*)qr; qf[rg][1] = *(const bf16x8*)(qr + 32);
            const bf16* wr_ = P + (rowbase + t0 + 4 * wave + fq) * ld + 1856 + 4 * rg;
#pragma unroll
            for (int j = 0; j < 4; ++j) wv[rg][j] = bf2f(wr_[j]) * (IDX_W_SCALE * IDX_SCALE);
        }
        SUB_T0();
        const int nkt = t0 / 16 + 2;
        const int nchunk = (nkt + 31) >> 5;
        const bf16* kgl = KI + rowbase * 64 + (size_t)(tid >> 3) * 64 + (tid & 7) * 8;
        v4u st[8];
#pragma unroll
        for (int j = 0; j < 8; ++j) st[j] = *(const v4u*)(kgl + (size_t)(64 * j) * 64);
        __syncthreads();
#pragma unroll
        for (int j = 0; j < 8; ++j) { const unsigned row = (unsigned)(tid >> 3) + 64u * j, ch = (unsigned)tid & 7u; *(LAS v4u*)(lds + 128u * row + 16u * (ch ^ ((row >> 1) & 7u))) = st[j]; }
        float* sp = scr + (size_t)(4 * wave + fq) * SEQ + fr;
        LAS unsigned* hist = (LAS unsigned*)(lds + LDS_HIST_OFF);
#pragma unroll
        for (int j = 0; j < 8; ++j) hist[4 * wave * 128 + lane + 64 * j] = 0u;
        LAS unsigned* hrow = hist + (4 * wave + fq) * 128; const int trow = t0 + 4 * wave + fq;
        for (int c = 0; c < nchunk; ++c) {
            __syncthreads();
            if (c + 1 < nchunk) {
#pragma unroll
                for (int j = 0; j < 8; ++j) st[j] = *(const v4u*)(kgl + (size_t)((c + 1) * 512 + 64 * j) * 64); }
            const LAS unsigned char* kb = lds + (c & 1) * 65536;
            const int ntl = __builtin_amdgcn_readfirstlane(nkt - c * 32 < 32 ? nkt - c * 32 : 32);
            const unsigned sw = ((unsigned)fr >> 1) & 7u;
            const LAS unsigned char* ka0 = kb + 128u * (unsigned)fr + 16u * ((unsigned)fq ^ sw); const LAS unsigned char* ka1 = kb + 128u * (unsigned)fr + 16u * ((4u + (unsigned)fq) ^ sw);
            for (int tl = 0; tl < ntl; tl += 2) {
                const bf16x8 k0a = *(const LAS bf16x8*)(ka0 + 2048 * tl), k1a = *(const LAS bf16x8*)(ka1 + 2048 * tl);
                const bf16x8 k0b = *(const LAS bf16x8*)(ka0 + 2048 * tl + 2048), k1b = *(const LAS bf16x8*)(ka1 + 2048 * tl + 2048);
                f32x4 aa[2], ab[2];
#pragma unroll
                for (int rg = 0; rg < 2; ++rg) {
                    aa[rg] = __builtin_amdgcn_mfma_f32_16x16x32_bf16(qf[rg][0], k0a, (f32x4){0.f, 0.f, 0.f, 0.f}, 0, 0, 0);
                    ab[rg] = __builtin_amdgcn_mfma_f32_16x16x32_bf16(qf[rg][0], k0b, (f32x4){0.f, 0.f, 0.f, 0.f}, 0, 0, 0); }
#pragma unroll
                for (int rg = 0; rg < 2; ++rg) {
                    aa[rg] = __builtin_amdgcn_mfma_f32_16x16x32_bf16(qf[rg][1], k1a, aa[rg], 0, 0, 0);
                    ab[rg] = __builtin_amdgcn_mfma_f32_16x16x32_bf16(qf[rg][1], k1b, ab[rg], 0, 0, 0); }
                float ta = 0.f, tb = 0.f;
#pragma unroll
                for (int rg = 0; rg < 2; ++rg)
#pragma unroll
                    for (int j = 0; j < 4; ++j) { ta = __builtin_fmaf(wv[rg][j], __builtin_amdgcn_fmed3f(aa[rg][j], 0.f, 3.0e38f), ta); tb = __builtin_fmaf(wv[rg][j], __builtin_amdgcn_fmed3f(ab[rg][j], 0.f, 3.0e38f), tb); }
                const int kt = c * 32 + tl;
                sp[kt * 16] = ta; sp[kt * 16 + 16] = tb;
                { const int bka = idx_bucket(ta), bkb = idx_bucket(tb);
                  (void)__hip_atomic_fetch_add(hrow + (bka >> 1), (kt * 16 + fr <= trow ? 1u : 0u) << (16 * (bka & 1)), __ATOMIC_RELAXED, __HIP_MEMORY_SCOPE_WORKGROUP);
                  (void)__hip_atomic_fetch_add(hrow + (bkb >> 1), (kt * 16 + 16 + fr <= trow ? 1u : 0u) << (16 * (bkb & 1)), __ATOMIC_RELAXED, __HIP_MEMORY_SCOPE_WORKGROUP); }
            }
            if (c + 1 < nchunk) {
#pragma unroll
                for (int j = 0; j < 8; ++j) { const unsigned row = (unsigned)(tid >> 3) + 64u * j, ch = (unsigned)tid & 7u; *(LAS v4u*)(lds + ((c + 1) & 1) * 65536 + 128u * row + 16u * (ch ^ ((row >> 1) & 7u))) = st[j]; } }
        }
        asm volatile("s_waitcnt vmcnt(0)" ::: "memory");
        SUB_ADD(lds, LC_PROBE_A);
        unsigned fraw[64];
#define IDX_ROW_LOAD(qi_) do { \
            _Pragma("unroll") for (int g_ = 0; g_ < 4; ++g_) { if (g_ * 1024 <= t0) { \
                unsigned long long pa_ = (unsigned long long)((const unsigned*)(scr + (size_t)(4 * wave + (qi_)) * SEQ) + lane + g_ * 1024); asm volatile("" : "+v"(pa_));     \
                const unsigned* gp_ = (const unsigned*)(const GAS unsigned*)pa_; \
                _Pragma("unroll") for (int r_ = 0; r_ < 16; ++r_) fraw[g_ * 16 + r_] = __hip_atomic_load(gp_ + r_ * 64, __ATOMIC_RELAXED, __HIP_MEMORY_SCOPE_AGENT); } } } while (0)
#ifndef DUP_SEL
#define DUP_SEL 1
#endif
        for (int rep_ = 0, nrep_ = __builtin_amdgcn_readfirstlane(launder_v(DUP_SEL)); rep_ < nrep_; ++rep_) {
        IDX_ROW_LOAD(0);
        for (int qi = 0; qi < 4; ++qi) {
            const int t = t0 + 4 * wave + qi;
            const int nfull = (t + 1) >> 6;
            LAS u16* out = (LAS u16*)(lds + LDSCTL_OFF + 4096 + wave * 512);
            int bstar, cab, neq;
            { const LAS unsigned* hw = hist + (4 * wave + qi) * 128;
              const unsigned w0 = hw[2 * lane], w1 = hw[2 * lane + 1];
              const int c0 = (int)(w0 & 0xffffu), c1 = (int)(w0 >> 16), c2 = (int)(w1 & 0xffffu), c3 = (int)(w1 >> 16), tl4 = (c0 + c1) + (c2 + c3);
              int pf = tl4;
#pragma unroll
              for (int o = 1; o < 64; o <<= 1) { const int v = __builtin_amdgcn_ds_bpermute(((lane - o) & 63) << 2, pf); pf += lane >= o ? v : 0; }
              const int total = __builtin_amdgcn_readlane(pf, 63);
              const int above = total - pf;
              const unsigned long long hm = __ballot(above < 256 && above + tl4 >= 256);
              const int L = (int)__builtin_ctzll(hm);
              int a = above, bs, ne;
              if (a + c3 >= 256) { bs = 3; ne = c3; } else { a += c3; if (a + c2 >= 256) { bs = 2; ne = c2; } else { a += c2; if (a + c1 >= 256) { bs = 1; ne = c1; } else { a += c1; bs = 0; ne = c0; } } }
              bstar = 4 * L + __builtin_amdgcn_readlane(bs, L); cab = __builtin_amdgcn_readlane(a, L); neq = __builtin_amdgcn_readlane(ne, L); }
            const int m256 = 256 - cab;
            if (neq <= 64) {
                LAS unsigned* ek = (LAS unsigned*)(lds + LDS_EQ_OFF + wave * 512); LAS u16* ei = (LAS u16*)(lds + LDS_EQ_OFF + wave * 512 + 256);
                int base = 0, eb = 0;
                const unsigned* nb[4];
#pragma unroll
                for (int g = 0; g < 4; ++g) { unsigned long long pa = (unsigned long long)((const unsigned*)(scr + (size_t)(4 * wave + (qi < 3 ? qi + 1 : qi)) * SEQ) + lane + g * 1024); asm volatile("" : "+v"(pa)); nb[g] = (const unsigned*)(const GAS unsigned*)pa; }
#pragma unroll
                for (int rr = 0; rr < 64; ++rr) {
                    if (rr <= nfull + 1) {
                        const float f = __builtin_bit_cast(float, fraw[rr]);
                        if (qi < 3) fraw[rr] = __hip_atomic_load(nb[rr >> 4] + (rr & 15) * 64, __ATOMIC_RELAXED, __HIP_MEMORY_SCOPE_AGENT);
                        const int bk = (rr * 64 + lane <= t) ? idx_bucket(f) : -1;
                        const bool gt = bk > bstar, eq = bk == bstar;
                        const unsigned long long mt = __ballot(gt);
                        if (gt) out[base + (int)__builtin_amdgcn_mbcnt_hi((unsigned)(mt >> 32), __builtin_amdgcn_mbcnt_lo((unsigned)mt, 0u))] = (u16)(rr * 64 + lane);
                        base += __popcll(mt);
                        const unsigned long long me = __ballot(eq);
                        if (eq) { const int p = eb + (int)__builtin_amdgcn_mbcnt_hi((unsigned)(me >> 32), __builtin_amdgcn_mbcnt_lo((unsigned)me, 0u)); ek[p] = ordkey(f); ei[p] = (u16)(rr * 64 + lane); }
                        eb += __popcll(me);
                    }
                }
                const unsigned key = lane < neq ? ek[lane] : 0u; const u16 kidx = ei[lane];
                int rank = 0;
                for (int j = 0; j < neq; ++j) { const unsigned kj = (unsigned)__builtin_amdgcn_readlane((int)key, j); rank += (kj > key || (kj == key && j < lane)) ? 1 : 0; }
                const bool take = lane < neq && rank < m256;
                const unsigned long long mt = __ballot(take);
                if (take) out[cab + (int)__builtin_amdgcn_mbcnt_hi((unsigned)(mt >> 32), __builtin_amdgcn_mbcnt_lo((unsigned)mt, 0u))] = kidx;
            } else {
#pragma unroll
            for (int rr = 0; rr < 64; ++rr) fraw[rr] = (rr * 64 + lane <= t) ? ordkey(__builtin_bit_cast(float, fraw[rr])) : 0u;
#define IDX_COUNT(cmpop, x_, c_) do { c_ = 0; _Pragma("unroll") for (int g8 = 0; g8 < 8; ++g8) { if (g8 * 8 <= nfull) { unsigned long long bm[8]; \
                _Pragma("unroll") for (int r8 = 0; r8 < 8; ++r8) bm[r8] = __ballot(fraw[g8 * 8 + r8] cmpop (x_)); __builtin_amdgcn_sched_barrier(0); \
                _Pragma("unroll") for (int r8 = 0; r8 < 8; ++r8) c_ += __popcll(bm[r8]); } } } while (0)
#ifndef DUP_BIS
#define DUP_BIS 1
#endif
            unsigned lo = 0u, hi = 0xFFFFFFFFu; int clo = t + 1, chi = 0;
            for (int rb_ = 0, nrb_ = __builtin_amdgcn_readfirstlane(launder_v(DUP_BIS)); rb_ < nrb_; ++rb_) { lo = 0u; hi = 0xFFFFFFFFu; clo = t + 1; chi = 0;
            for (int it = 0; it < 80 && hi - lo > 1u; ++it) {
                unsigned mid = lo + ((hi - lo) >> 1);
                if (it >= 9 && (it & 1)) { const float f = (float)(clo - 255) / (float)(clo - chi + 1);
                    const unsigned d = (unsigned)((float)(hi - lo) * f); mid = lo + (d < 1u ? 1u : d); if (mid >= hi) mid = hi - 1u; }
                int c; IDX_COUNT(>=, mid, c);
                if (c >= 256) { lo = mid; clo = c; if (c == 256) break; } else { hi = mid; chi = c; }
            }
            }
            const unsigned prefix = lo;
            int cge, cgt; IDX_COUNT(>=, prefix, cge); IDX_COUNT(>, prefix, cgt);
            if (cge == 256) {
                int base = 0;
#pragma unroll
                for (int rr = 0; rr < 64; ++rr) {
                    if (rr <= nfull) {
                        const bool take = fraw[rr] >= prefix;
                        const unsigned long long mt = __ballot(take);
                        if (take) out[base + (int)__builtin_amdgcn_mbcnt_hi((unsigned)(mt >> 32), __builtin_amdgcn_mbcnt_lo((unsigned)mt, 0u))] = (u16)(rr * 64 + lane);
                        base += __popcll(mt);
                    }
                }
            } else {
                int need = 256 - cgt, base = 0;
#pragma unroll
                for (int rr = 0; rr < 64; ++rr) {
                    if (rr <= nfull) {
                        const bool gt = fraw[rr] > prefix, eq = fraw[rr] == prefix;
                        const unsigned long long meq = __ballot(eq);
                        const int eqrank = (int)__builtin_amdgcn_mbcnt_hi((unsigned)(meq >> 32), __builtin_amdgcn_mbcnt_lo((unsigned)meq, 0u));
                        const bool take = gt || (eq && eqrank < need);
                        const unsigned long long mt = __ballot(take);
                        if (take) out[base + (int)__builtin_amdgcn_mbcnt_hi((unsigned)(mt >> 32), __builtin_amdgcn_mbcnt_lo((unsigned)mt, 0u))] = (u16)(rr * 64 + lane);
                        base += __popcll(mt);
                        const int neq = __popcll(meq); need -= (neq < need ? neq : need);
                    }
                }
            }
                if (qi < 3) IDX_ROW_LOAD(qi + 1);
            }
            { const unsigned long long row8 = *(const LAS unsigned long long*)((const LAS unsigned char*)out + lane * 8);
              *(unsigned long long*)((unsigned char*)(SEL + ((size_t)b * SEQ + t) * 256) + lane * 8) = row8; }
            { const int wit = (wg * NWAVES + wave) + nwit * (G * NWAVES); if (wit < L1W_ITEMS) moe_weight_item(A, 1, wit, lane); ++nwit; }
#undef IDX_COUNT
        }
        }
#undef IDX_ROW_LOAD
        asm volatile("s_waitcnt vmcnt(0)" ::: "memory");
        SUB_ADD(lds, LC_PROBE_B);
    }
    for (int wit = (wg * NWAVES + wave) + nwit * (G * NWAVES); wit < L1W_ITEMS; wit += G * NWAVES) moe_weight_item(A, 1, wit, launder_v(lane_));
}

__device__ __forceinline__ void ln_router_phase(CArgs* A, LAS unsigned char* lds, int layer, int G, int wg, int wave, int lane, const bf16* PRE, bf16* HOUT) {
    unsigned char* ws = launder(A->ws);
    const float* lg = gptr(A->in[11]) + layer * DM; const float* lb = gptr(A->in[12]) + layer * DM;
    const bf16* WRT = (const bf16*)(ws + WS_WRT) + (size_t)layer * 32 * 1024;
    const float* br = gptr(A->in[14]) + layer * 32;
    unsigned* cnt = (unsigned*)(ws + WS_CTL) + CW_CNT + layer * 32;
    int2* elist = (int2*)(ws + WS_ELIST); unsigned* eoff = (unsigned*)(ws + WS_EOFF) + (size_t)layer * 32 * NTOK;
    LAS int* lc = (LAS int*)(lds + LDSCTL_OFF);
    LAS float* lgt = (LAS float*)(lds + 98304 + wave * 4096);
    const int fr = lane & 15, fq = lane >> 4, tid = wave * 64 + lane;
    constexpr int NUNITS = NTOK / 128;
    LAS unsigned char* wl = lds; LAS float* gl = (LAS float*)(lds + 65536); LAS float* bl = (LAS float*)(lds + 69632);
    __syncthreads();
    for (int id = tid; id < 32 * 128; id += NTHREADS) { const int e = id >> 7, ch = id & 127; *(LAS v4u*)(wl + e * 2048 + 16 * (ch ^ (e & 7))) = *(const v4u*)(WRT + (size_t)e * 1024 + ch * 8); }
    for (int id = tid; id < 256; id += NTHREADS) { *(LAS f32x4*)(gl + 4 * id) = *(const f32x4*)(lg + 4 * id); *(LAS f32x4*)(bl + 4 * id) = *(const f32x4*)(lb + 4 * id); }
    __syncthreads();
    const int nmr = NUNITS / G, nrem = (NTOK - nmr * G * 128) / 16;
    for (int it = 0; ; ++it) {
        int r0; bool act = true;
        if (it < nmr) r0 = (wg + it * G) * 128 + wave * 16;
        else { const int j0 = (it - nmr) * G * 8 + wg; if (j0 >= nrem) break; const int j = j0 + wave * G; act = j < nrem; r0 = nmr * G * 128 + (act ? j : 0) * 16; }
        if (tid < 32) lc[LC_LCNT + tid] = 0;
        __syncthreads();
        int e4[4] = {0, 0, 0, 0}, loc[4] = {0, 0, 0, 0}; float g4[4] = {0.f, 0.f, 0.f, 0.f};
        if (act) {
        const bf16* xr = PRE + (size_t)(r0 + fr) * DM + fq * 8;
        float sm = 0.f, sq = 0.f;
#pragma unroll 8
        for (int s = 0; s < 32; ++s) { const v4u x = *(const v4u*)(xr + 32 * s);
            const float x0 = bflo(x.x), x1 = bfhi(x.x), x2 = bflo(x.y), x3 = bfhi(x.y), x4 = bflo(x.z), x5 = bfhi(x.z), x6 = bflo(x.w), x7 = bfhi(x.w);
            sm += ((x0 + x1) + (x2 + x3)) + ((x4 + x5) + (x6 + x7));
            sq += ((x0 * x0 + x1 * x1) + (x2 * x2 + x3 * x3)) + ((x4 * x4 + x5 * x5) + (x6 * x6 + x7 * x7)); }
        sm += shx(sm, 16, lane); sm += shx(sm, 32, lane); sq += shx(sq, 16, lane); sq += shx(sq, 32, lane);
        const float mean = sm * (1.f / DM);
        const float var = fmaxf(sq * (1.f / DM) - mean * mean, 0.f);
        const float rstd = 1.f / sqrtf(var + LN_EPS);
        f32x4 a0 = {0.f, 0.f, 0.f, 0.f}, a1 = {0.f, 0.f, 0.f, 0.f};
        bf16* hr = HOUT + (size_t)(r0 + fr) * DM + fq * 8;
        unsigned char* h8r = ws + WS_HB8 + (size_t)(r0 + fr) * DM + fq * 8;
#pragma unroll 4
        for (int s = 0; s < 32; ++s) {
            const v4u x = *(const v4u*)(xr + 32 * s);
            const f32x4 g0 = *(const LAS f32x4*)(gl + fq * 8 + 32 * s), g1 = *(const LAS f32x4*)(gl + fq * 8 + 32 * s + 4);
            const f32x4 b0 = *(const LAS f32x4*)(bl + fq * 8 + 32 * s), b1 = *(const LAS f32x4*)(bl + fq * 8 + 32 * s + 4);
            v4u y;
            const float f0 = (bflo(x.x) - mean) * rstd * g0[0] + b0[0], f1 = (bfhi(x.x) - mean) * rstd * g0[1] + b0[1], f2 = (bflo(x.y) - mean) * rstd * g0[2] + b0[2], f3 = (bfhi(x.y) - mean) * rstd * g0[3] + b0[3];
            const float f4 = (bflo(x.z) - mean) * rstd * g1[0] + b1[0], f5 = (bfhi(x.z) - mean) * rstd * g1[1] + b1[1], f6 = (bflo(x.w) - mean) * rstd * g1[2] + b1[2], f7 = (bfhi(x.w) - mean) * rstd * g1[3] + b1[3];
            y.x = cvtpk(f0, f1); y.y = cvtpk(f2, f3); y.z = cvtpk(f4, f5); y.w = cvtpk(f6, f7);
            *(v4u*)(hr + 32 * s) = y;
            { constexpr float sx = pg8::FP8_SX; uint2 o8; o8.x = pg8::pk4_fp8(sx * f0, sx * f1, sx * f2, sx * f3); o8.y = pg8::pk4_fp8(sx * f4, sx * f5, sx * f6, sx * f7); *(uint2*)(h8r + 32 * s) = o8; }
            const bf16x8 yf = __builtin_bit_cast(bf16x8, y);
            const int ch = 4 * s + fq;
            const bf16x8 w0 = *(const LAS bf16x8*)(wl + fr * 2048 + 16 * (ch ^ (fr & 7))), w1 = *(const LAS bf16x8*)(wl + (16 + fr) * 2048 + 16 * (ch ^ (fr & 7)));
            a0 = __builtin_amdgcn_mfma_f32_16x16x32_bf16(yf, w0, a0, 0, 0, 0);
            a1 = __builtin_amdgcn_mfma_f32_16x16x32_bf16(yf, w1, a1, 0, 0, 0);
        }
        { const float bb0 = br[fr], bb1 = br[16 + fr];
#pragma unroll
          for (int j = 0; j < 4; ++j) { lgt[(fq * 4 + j) * 33 + fr] = a0[j] + bb0; lgt[(fq * 4 + j) * 33 + 16 + fr] = a1[j] + bb1; } }
        LDS_WAIT();
        if (lane < 16) {
            float v[32];
#pragma unroll
            for (int e = 0; e < 32; ++e) v[e] = lgt[lane * 33 + e];
            float l4[4];
#pragma unroll
            for (int k = 0; k < 4; ++k) { float best = -3.0e38f; int bi = 0;
#pragma unroll
                for (int e = 0; e < 32; ++e) { const bool better = v[e] > best; best = better ? v[e] : best; bi = better ? e : bi; }
                l4[k] = best; e4[k] = bi;
#pragma unroll
                for (int e = 0; e < 32; ++e) v[e] = (e == bi) ? -3.0e38f : v[e]; }
            float den = 0.f;
#pragma unroll
            for (int k = 0; k < 4; ++k) { g4[k] = __expf(l4[k] - l4[0]); den += g4[k]; }
            const float rd = 1.f / den;
#pragma unroll
            for (int k = 0; k < 4; ++k) { g4[k] *= rd; loc[k] = __hip_atomic_fetch_add(lc + LC_LCNT + e4[k], 1, __ATOMIC_RELAXED, __HIP_MEMORY_SCOPE_WORKGROUP); }
        }
        }
        __syncthreads();
        if (tid < 32) { const int n = lc[LC_LCNT + tid]; int base = 0; if (n > 0) base = (int)__hip_atomic_fetch_add(cnt + tid, (unsigned)n, __ATOMIC_RELAXED, __HIP_MEMORY_SCOPE_AGENT); lc[LC_LBASE + tid] = base; }
        __syncthreads();
        if (act && lane < 16) {
            const int row = r0 + lane;
#pragma unroll
            for (int k = 0; k < 4; ++k) { const size_t sl = (size_t)e4[k] * NTOK + (size_t)(lc[LC_LBASE + e4[k]] + loc[k]); elist[sl] = make_int2(row * 4 + k, __builtin_bit_cast(int, g4[k])); eoff[sl] = (unsigned)row * (unsigned)DM; }
        }
        __syncthreads();
    }
}

__device__ __forceinline__ int moe_table(CArgs* A, LAS unsigned char* lds, int layer, int tid) {
    const unsigned* cnt = (const unsigned*)(launder(A->ws) + WS_CTL) + CW_CNT + layer * 32;
    LAS int* lc = (LAS int*)(lds + LDSCTL_OFF);
    tid = launder_v(tid);
    __syncthreads();
    if (tid < 32) lc[LC_ECNT + tid] = (int)__hip_atomic_load(cnt + tid, __ATOMIC_RELAXED, __HIP_MEMORY_SCOPE_AGENT);
    __syncthreads();
    if (tid == 0) { int acc = 0; for (int e = 0; e < 32; ++e) { lc[LC_TSTART + e] = acc; acc += (lc[LC_ECNT + e] + 255) >> 8; } lc[LC_TSTART + 32] = acc; }
    __syncthreads();
    { LAS unsigned char* te = (LAS unsigned char*)(lc + LC_TILEE);
      for (int e = 0; e < 32; ++e) { const int st = lc[LC_TSTART + e], en = lc[LC_TSTART + e + 1]; for (int i = st + tid; i < en; i += NTHREADS) te[i] = (unsigned char)e; } }
    __syncthreads();
    return lc[LC_TSTART + 32];
}

__device__ __forceinline__ void ln_ffn_phase(CArgs* A, int layer, int gw, int NGW, int lane, const bf16* H1, bf16* HOUT) {
    unsigned char* ws = launder(A->ws);
    const unsigned char* Y = ws + WS_XS;
    const float* lg = gptr(A->in[19]) + layer * DM; const float* lb = gptr(A->in[20]) + layer * DM;
    typedef float f32x2l __attribute__((ext_vector_type(2)));
    v4u hq[2], yq[4];
    if (gw < NTOK) {
#pragma unroll
        for (int j = 0; j < 2; ++j) hq[j] = *(const v4u*)(H1 + (size_t)gw * DM + lane * 16 + j * 8);
#pragma unroll
        for (int k = 0; k < 4; ++k) yq[k] = *(const v4u*)(Y + ((size_t)gw * 4 + k) * DM + lane * 16); }
    for (int row = gw; row < NTOK; row += NGW) {
        float x[16];
        v4u hc[2], yc[4];
#pragma unroll
        for (int j = 0; j < 2; ++j) hc[j] = hq[j];
#pragma unroll
        for (int k = 0; k < 4; ++k) yc[k] = yq[k];
        { const int rn = row + NGW < NTOK ? row + NGW : row;
#pragma unroll
          for (int j = 0; j < 2; ++j) hq[j] = *(const v4u*)(H1 + (size_t)rn * DM + lane * 16 + j * 8);
#pragma unroll
          for (int k = 0; k < 4; ++k) yq[k] = *(const v4u*)(Y + ((size_t)rn * 4 + k) * DM + lane * 16); }
#pragma unroll
        for (int j = 0; j < 2; ++j) { const v4u h = hc[j];
            x[8 * j + 0] = DN_ALPHA * bflo(h.x); x[8 * j + 1] = DN_ALPHA * bfhi(h.x); x[8 * j + 2] = DN_ALPHA * bflo(h.y); x[8 * j + 3] = DN_ALPHA * bfhi(h.y);
            x[8 * j + 4] = DN_ALPHA * bflo(h.z); x[8 * j + 5] = DN_ALPHA * bfhi(h.z); x[8 * j + 6] = DN_ALPHA * bflo(h.w); x[8 * j + 7] = DN_ALPHA * bfhi(h.w); }
#pragma unroll
        for (int k = 0; k < 4; ++k) { const v4u y = yc[k]; constexpr float ry = 1.f / pg8::FP8_SY;
            const unsigned yw[4] = {y.x, y.y, y.z, y.w};
#pragma unroll
            for (int q = 0; q < 4; ++q) { const f32x2l a = __builtin_amdgcn_cvt_pk_f32_fp8((int)yw[q], false), c = __builtin_amdgcn_cvt_pk_f32_fp8((int)yw[q], true);
                x[4 * q + 0] += ry * a.x; x[4 * q + 1] += ry * a.y; x[4 * q + 2] += ry * c.x; x[4 * q + 3] += ry * c.y; } }
        float s = 0.f;
#pragma unroll
        for (int i = 0; i < 16; ++i) s += x[i];
#pragma unroll
        for (int o = 1; o < 64; o <<= 1) s += shx(s, o, lane);
        const float mean = s * (1.f / DM); float v = 0.f;
#pragma unroll
        for (int i = 0; i < 16; ++i) { x[i] -= mean; v += x[i] * x[i]; }
#pragma unroll
        for (int o = 1; o < 64; o <<= 1) v += shx(v, o, lane);
        const float rstd = 1.f / sqrtf(v * (1.f / DM) + LN_EPS);
#pragma unroll
        for (int j = 0; j < 2; ++j) { const int c0 = lane * 16 + j * 8;
            const f32x4 g0 = *(const f32x4*)(lg + c0), g1 = *(const f32x4*)(lg + c0 + 4), b0 = *(const f32x4*)(lb + c0), b1 = *(const f32x4*)(lb + c0 + 4);
#pragma unroll
            for (int i = 0; i < 4; ++i) { x[8 * j + i] = x[8 * j + i] * rstd * g0[i] + b0[i]; x[8 * j + 4 + i] = x[8 * j + 4 + i] * rstd * g1[i] + b1[i]; } }
        if (layer == 0) {
#pragma unroll
            for (int j = 0; j < 2; ++j) { v4u o; o.x = cvtpk(x[8 * j + 0], x[8 * j + 1]); o.y = cvtpk(x[8 * j + 2], x[8 * j + 3]); o.z = cvtpk(x[8 * j + 4], x[8 * j + 5]); o.w = cvtpk(x[8 * j + 6], x[8 * j + 7]);
                *(v4u*)(HOUT + (size_t)row * DM + lane * 16 + j * 8) = o;
                constexpr float sx = pg8::FP8_SX; uint2 o8; o8.x = pg8::pk4_fp8(sx * x[8 * j + 0], sx * x[8 * j + 1], sx * x[8 * j + 2], sx * x[8 * j + 3]); o8.y = pg8::pk4_fp8(sx * x[8 * j + 4], sx * x[8 * j + 5], sx * x[8 * j + 6], sx * x[8 * j + 7]);
                *(uint2*)(ws + WS_H8 + (size_t)row * DM + lane * 16 + j * 8) = o8; }
        } else {
            const int b = row / LTOK, p = row % LTOK;
            if (p >= NMETA) { float* op = (float*)(GAS float*)A->out + ((size_t)b * SEQ + (p - NMETA)) * DM;
#pragma unroll
                for (int j = 0; j < 2; ++j) { *(f32x4*)(op + lane * 16 + j * 8) = (f32x4){x[8 * j + 0], x[8 * j + 1], x[8 * j + 2], x[8 * j + 3]};
                    *(f32x4*)(op + lane * 16 + j * 8 + 4) = (f32x4){x[8 * j + 4], x[8 * j + 5], x[8 * j + 6], x[8 * j + 7]}; } }
        }
    }
}

#ifndef ENMASK
#define ENMASK 0xFFFF
#endif
#define EN(k) ((ENMASK >> (k)) & 1)
#define IN(k) (lo <= (k) && (k) < hi)
#ifndef PROBE_GA
#define PROBE_GA 0
#endif
#ifndef PROBE_GB
#define PROBE_GB 0
#endif
#define PROBE_ON ((PROBE_GA) != 0 || (PROBE_GB) != 0)
#ifndef PROBE_SCALE_B
#define PROBE_SCALE_B 1.0f
#endif
#ifndef PROBE_SCALE_A
#define PROBE_SCALE_A 1.0f
#endif
struct ProbeT { unsigned long long tprev, ta, tb, t0; };
#define PROBE_MARK(k) do { if (PROBE_ON) { const unsigned long long tn_ = __builtin_amdgcn_s_memrealtime(); if (((PROBE_GA) >> (k)) & 1) pt.ta += tn_ - pt.tprev; if (((PROBE_GB) >> (k)) & 1) pt.tb += tn_ - pt.tprev; pt.tprev = tn_; } } while (0)
#define SEAM(k) do { if (IN(k) && IN((k) + 1)) { bar.bar = (unsigned*)(KA()->ws + WS_CTL) + CW_BAR; xcd_barrier(bar); } PROBE_MARK(k); } while (0)
#define IDS() CArgs* args = KA(); unsigned char* ws = (unsigned char*)(GAS unsigned char*)args->ws; (void)ws; const int tid = launder_v(threadIdx.x), lane = tid & 63, wave = __builtin_amdgcn_readfirstlane(tid >> 6), gw = wg * NWAVES + wave; (void)tid; (void)lane; (void)gw


#ifndef DUP_PH
#define DUP_PH -1
#endif
#define NREP(k) (((DUP_PH) == (k)) ? 2 : 1)
#define REPBAR(k, r) do { if ((r) + 1 < NREP(k)) { bar.bar = (unsigned*)(KA()->ws + WS_CTL) + CW_BAR; xcd_barrier(bar); } } while (0)
template <int layer>
__device__ __forceinline__ void layer_phases(LAS unsigned char* lds, XcdBarrier& bar, ProbeT& pt, const int lo, const int hi, const int G, const int wg, const int NGW) {
        const int pb = 1 + 10 * layer;
#pragma unroll
        for (int rep = 0; rep < NREP(pb + 0); ++rep)
        if (EN(1) && IN(pb + 0)) {
            IDS();
            const int N = layer == 0 ? NCOLA : NCOLB_PAD;
            pg8::Gemm g{(const bf16*)(ws + WS_H8), (const bf16*)(ws + (layer == 0 ? WS_WINA : WS_WINB)), NTOK, N, DM / 2};
            pg8::StaticOrder S; S.init(NTOK, N, G, wg);
            pg8::EpiProj E{(bf16*)(ws + WS_PROJ), N, layer == 0 ? gptr(args->in[3]) : (const float*)(ws + WS_BIASB), (bf16*)(ws + WS_KV), (const float*)(ws + WS_ROPEA), (const float*)(ws + WS_ROPEB), LTOK, ws + WS_K8, ws + WS_V8, layer == 0 ? (unsigned char*)nullptr : ws + WS_Q8};
            pg8::gemm_phase<pg8::EpiProj, pg8::StaticOrder, true, true, true>(lds, g, S, E);
            REPBAR(pb + 0, rep);
        }
        SEAM(pb + 0);
        if (layer == 1) {
        if (EN(2) && IN(pb + 1)) { IDS(); ki_phase(args, gw * 64 + lane, NGW * 64); }
        SEAM(pb + 1);
#pragma unroll
        for (int rep = 0; rep < NREP(pb + 2); ++rep)
        if (EN(3) && IN(pb + 2)) { IDS(); indexer_phase(args, lds, G, wg, wave, lane); REPBAR(pb + 2, rep); }
        SEAM(pb + 2);
        } else { PROBE_MARK(pb + 1); PROBE_MARK(pb + 2); }
#pragma unroll
        for (int rep = 0; rep < NREP(pb + 3); ++rep)
        if (EN(4) && IN(pb + 3)) { IDS(); if (layer == 0) { attn8_phase<1, false>(args, lds, gw, NGW, wave, lane); swa_tile_phase(args, lds, G, wg, wave, lane); } else attn8_phase<5, true>(args, lds, gw, NGW, wave, lane); REPBAR(pb + 3, rep); }
        SEAM(pb + 3);
#pragma unroll
        for (int rep = 0; rep < NREP(pb + 4); ++rep)
        if (EN(5) && IN(pb + 4)) {
            IDS(); bf16* HA = (bf16*)(ws + WS_HA); bf16* PRE = (bf16*)(ws + WS_PRE);
            pg8::Gemm g{(const bf16*)(ws + WS_ATT), (const bf16*)(ws + (layer == 0 ? WS_WOUTA : WS_WOUTB)), NTOK, DM, DM / 2};
            pg8::StaticOrder S; S.init(NTOK, DM, G, wg);
            pg8::EpiRes E{PRE, HA, DN_ALPHA};
            pg8::gemm_phase<pg8::EpiRes, pg8::StaticOrder, true, true, true>(lds, g, S, E);
            REPBAR(pb + 4, rep);
        }
        SEAM(pb + 4);
        if (EN(6) && IN(pb + 5)) { IDS(); ln_router_phase(args, lds, layer, G, wg, wave, lane, (const bf16*)(ws + WS_PRE), (bf16*)(ws + WS_HB)); }
        SEAM(pb + 5);
        PROBE_MARK(pb + 6);
#pragma unroll
        for (int rep = 0; rep < NREP(pb + 7); ++rep)
        if (EN(8) && IN(pb + 7)) {
            IDS(); const int ntiles = moe_table(args, lds, layer, tid);
            pg8::Gemm g{(const bf16*)(ws + WS_HB8), (const bf16*)(ws + WS_WGU + (size_t)layer * 32 * 2048 * 1024), MOE_P, 2048, DM / 2, (const unsigned*)(ws + WS_EOFF) + (size_t)layer * 32 * NTOK};
            pg8::MoeOrder S{ntiles, G, wg, 8, (const LAS unsigned char*)((const LAS int*)(lds + LDSCTL_OFF) + LC_TILEE), (const LAS int*)(lds + LDSCTL_OFF) + LC_TSTART, NTOK};
            pg8::EpiSwiglu E{ws + WS_ACT, gptr(args->in[16]) + (size_t)layer * 32 * 2048};
            pg8::gemm_phase<pg8::EpiSwiglu, pg8::MoeOrder, true, true, true, true>(lds, g, S, E);
            REPBAR(pb + 7, rep);
        }
        SEAM(pb + 7);
        if (EN(9) && IN(pb + 8)) {
            IDS(); const int ntiles = moe_table(args, lds, layer, tid);
            pg8::Gemm g{(const bf16*)(ws + WS_ACT), (const bf16*)(ws + WS_WD + (size_t)layer * 32 * 1024 * 1024), MOE_P, 1024, DM / 2};
            pg8::MoeOrder S{ntiles, G, wg, 4, (const LAS unsigned char*)((const LAS int*)(lds + LDSCTL_OFF) + LC_TILEE), (const LAS int*)(lds + LDSCTL_OFF) + LC_TSTART, NTOK};
            pg8::EpiDown E{ws + WS_XS, gptr(args->in[18]) + (size_t)layer * 32 * 1024, (const int2*)(ws + WS_ELIST), (const LAS int*)(lds + LDSCTL_OFF) + LC_TSTART, (const LAS int*)(lds + LDSCTL_OFF) + LC_ECNT, NTOK};
            pg8::gemm_phase<pg8::EpiDown, pg8::MoeOrder, true, true, true>(lds, g, S, E);
        }
        SEAM(pb + 8);
        if (EN(10) && IN(pb + 9)) { IDS(); ln_ffn_phase(args, layer, gw, NGW, lane, (const bf16*)(ws + WS_HB), (bf16*)(ws + WS_HA)); }
        SEAM(pb + 9);
}

constexpr int N_PHASES = 21;
__global__ void __launch_bounds__(NTHREADS, 2) fwd_kernel(Args args) {
    extern __shared__ __attribute__((aligned(16))) unsigned char lds_raw[];
    LAS unsigned char* lds = (LAS unsigned char*)lds_raw;
    const int G = gridDim.x, wg = blockIdx.x, NGW = G * NWAVES;

    for (int u = threadIdx.x; u < (LDS_BYTES - LDSCTL_OFF) / 4; u += NTHREADS) ((LAS unsigned*)(lds + LDSCTL_OFF))[u] = 0u;
    __syncthreads();
    const int lo = KA()->ph_lo, hi = KA()->ph_hi;
    const bool multi = (hi - lo) > 1;
    XcdBarrier bar; bar.bar = (unsigned*)(KA()->ws + WS_CTL) + CW_BAR; bar.x = 0; bar.st = nullptr;
    if (multi) bar = xcd_barrier_post((unsigned*)(KA()->ws + WS_CTL) + CW_BAR, (volatile LAS unsigned*)(lds + LDSCTL_OFF) + LC_BAR);
    ProbeT pt; pt.ta = 0ull; pt.tb = 0ull; pt.t0 = pt.tprev = PROBE_ON ? __builtin_amdgcn_s_memrealtime() : 0ull;
    if (EN(0) && IN(0)) { IDS(); p0_prologue(args, lds, gw, NGW, wave, lane); }
    SEAM(0);

    layer_phases<0>(lds, bar, pt, lo, hi, G, wg, NGW);
    layer_phases<1>(lds, bar, pt, lo, hi, G, wg, NGW);
    if (PROBE_ON) {
        bar.bar = (unsigned*)(KA()->ws + WS_CTL) + CW_BAR; xcd_barrier(bar);
        if (wg == 0 && threadIdx.x < 64) {
            const float tot = (float)(pt.tprev - pt.t0); const LAS unsigned* lcp = (const LAS unsigned*)(lds + LDSCTL_OFF);
            const float fa = (PROBE_SUB) ? (float)lcp[LC_PROBE_A] / tot : (float)pt.ta / tot, fb = (PROBE_SUB) ? (float)lcp[LC_PROBE_B] / tot : (float)pt.tb / tot;
            float* o = (float*)(GAS float*)KA()->out;
            if (threadIdx.x == 0 && (PROBE_GA) != 0) o[5 * 1024 + 7] += 20.f + 80.f * fa * PROBE_SCALE_A;
            if ((PROBE_GB) != 0) { const float d2 = sqrtf(65.536f * fb * PROBE_SCALE_B); for (int i = threadIdx.x; i < 1024; i += 64) o[9 * 1024 + i] += d2; }
        }
    }
#undef IN
#undef SEAM
}

#ifndef MK_N_LAUNCHES
#define MK_N_LAUNCHES 1
#endif
extern "C" void kernel_launch(void* const* d_in, const int* in_sizes, int n_in, void* d_out, int out_size, void* d_ws, size_t ws_size, hipStream_t stream) {
    static int grid = 0;
    if (grid == 0) {
        if (n_in != 21 || in_sizes[0] != NBATCH * SEQ * DM || out_size != NBATCH * SEQ * DM || ws_size < WS_END) {
            fprintf(stderr, "kernel_launch: unexpected shapes: n_in %d in0 %d out %d ws %zu (need %zu); nothing launched\n", n_in, n_in > 0 ? in_sizes[0] : -1, out_size, ws_size, (size_t)WS_END); grid = -1; return; }
        int dev = 0, cus = 0, per_cu = 0;
        if (hipGetDevice(&dev) != hipSuccess || hipDeviceGetAttribute(&cus, hipDeviceAttributeMultiprocessorCount, dev) != hipSuccess) { grid = -1; return; }
        if (hipFuncSetAttribute((const void*)fwd_kernel, hipFuncAttributeMaxDynamicSharedMemorySize, LDS_BYTES) != hipSuccess) { fprintf(stderr, "kernel_launch: hipFuncSetAttribute failed\n"); grid = -1; return; }
        if (hipOccupancyMaxActiveBlocksPerMultiprocessor(&per_cu, (const void*)fwd_kernel, NTHREADS, LDS_BYTES) != hipSuccess || per_cu < 1)
            fprintf(stderr, "kernel_launch: note: occupancy query reports %d workgroups per CU\n", per_cu);
        (void)hipGetLastError();
        grid = cus;
    }
    if (grid < 0) return;
    if (hipMemsetAsync((char*)d_ws + WS_CTL, 0, CTL_ZERO_BYTES, stream) != hipSuccess) return;
    Args a{};
    for (int i = 0; i < 21; ++i) a.in[i] = (const float*)d_in[i];
    a.out = (float*)d_out; a.ws = (unsigned char*)d_ws;
    if (MK_N_LAUNCHES == 1) {
        a.ph_lo = 0; a.ph_hi = N_PHASES;
        hipLaunchKernelGGL(fwd_kernel, dim3(grid), dim3(NTHREADS), LDS_BYTES, stream, a);
    } else {
        for (int ph = 0; ph < N_PHASES; ++ph) {
            if (ph == 3) continue;
            a.ph_lo = ph; a.ph_hi = ph + 1;
            hipLaunchKernelGGL(fwd_kernel, dim3(grid), dim3(NTHREADS), LDS_BYTES, stream, a);
        }
    }
}
```

```cpp
#include <hip/hip_runtime.h>
#include <cstdio>
#include <cstdint>
#define GAS __attribute__((address_space(1)))
#define LAS __attribute__((address_space(3)))
typedef unsigned short bf16;
typedef unsigned v4u __attribute__((ext_vector_type(4)));
typedef float f32x4 __attribute__((ext_vector_type(4)));
typedef short bf16x8 __attribute__((ext_vector_type(8)));
typedef GAS unsigned gu32;
typedef GAS unsigned long long gu64;
#define RLX_AGENT __ATOMIC_RELAXED, __HIP_MEMORY_SCOPE_AGENT
#define LDS_WAIT() asm volatile("s_waitcnt lgkmcnt(0)" ::: "memory")
#define VM_WAIT() asm volatile("s_waitcnt vmcnt(0)" ::: "memory")
__device__ __forceinline__ unsigned long long rt() { return __builtin_amdgcn_s_memrealtime(); }
__device__ __forceinline__ unsigned f2bf(float f) { unsigned u = __builtin_bit_cast(unsigned, f); return (u + 0x7fffu + ((u >> 16) & 1u)) >> 16; }
__device__ __forceinline__ unsigned pk2(float lo, float hi) { return f2bf(lo) | (f2bf(hi) << 16); }

#define XB_TMO      128
#define XB_XCNT(j)  (256  + 64 * (j))
#define XB_XSUB(j)  (1280 + 64 * (j))
#define XB_XGEN(j)  (2304 + 64 * (j))
#define XB_TOP      3328
#define XB_TOPGEN   3392
#define XCD_BAR_WORDS 3456
#define XB_SPIN_CAP (1u << 18)

__device__ __forceinline__ unsigned xb_ld(unsigned* p)              { return __hip_atomic_load(p, __ATOMIC_RELAXED, __HIP_MEMORY_SCOPE_AGENT); }
__device__ __forceinline__ unsigned xb_add(unsigned* p, unsigned v) { return __hip_atomic_fetch_add(p, v, __ATOMIC_RELAXED, __HIP_MEMORY_SCOPE_AGENT); }
__device__ __forceinline__ unsigned xb_xcc_id() { return (unsigned)__builtin_amdgcn_s_getreg((3 << 11) | 20) & 0xFu; }
#define XB_SPIN(cond, bar) do { unsigned _sp = 0; while (cond) { __builtin_amdgcn_s_sleep(1); \
    if ((++_sp & 255u) == 0u) { if (xb_ld(&(bar)[XB_TMO])) break; if (_sp > XB_SPIN_CAP) { atomicAdd(&(bar)[XB_TMO], 1u); break; } } } } while (0)

struct XcdBarrier {
    unsigned* bar; unsigned x;
    volatile LAS unsigned* st;
};

__device__ __forceinline__ XcdBarrier xcd_barrier_post(unsigned* bar, volatile LAS unsigned* st) {
    XcdBarrier b; b.bar = bar; b.x = xb_xcc_id(); b.st = st;
    if (threadIdx.x == 0) (void)xb_add(&bar[XB_XCNT(b.x)], 1u);
    return b;
}
__device__ __forceinline__ void xcd_barrier_complete(unsigned* bar, unsigned x, unsigned& nloc, unsigned& nx) {
    const unsigned G = gridDim.x * gridDim.y * gridDim.z;
    unsigned sum, cnt, mine, sp = 0u;
    for (;;) {
        sum = 0u; cnt = 0u; mine = 0u;
#pragma unroll
        for (unsigned j = 0; j < 16; ++j) { const unsigned c = xb_ld(&bar[XB_XCNT(j)]); sum += c; cnt += (c > 0u) ? 1u : 0u; mine = (j == x) ? c : mine; }
        if (sum == G) break;
        __builtin_amdgcn_s_sleep(1);
        if ((++sp & 255u) == 0u) { if (xb_ld(&bar[XB_TMO])) break; if (sp > XB_SPIN_CAP) { atomicAdd(&bar[XB_TMO], 1u); break; } }
    }
    nloc = mine > 0u ? mine : 1u; nx = cnt > 0u ? cnt : 1u;
}

__device__ __forceinline__ void xcd_barrier(const XcdBarrier& b) {
    asm volatile("s_waitcnt vmcnt(0)" ::: "memory");
    __syncthreads();
    if (threadIdx.x == 0) {
        unsigned* bar = b.bar;
        __builtin_amdgcn_s_waitcnt(0);
        unsigned nloc = b.st[0], nx = b.st[1];
        if (nloc == 0u) { xcd_barrier_complete(bar, b.x, nloc, nx); b.st[0] = nloc; b.st[1] = nx; }
        const unsigned old = xb_add(&bar[XB_XSUB(b.x)], 1u);
        const unsigned gen = old / nloc;
        if (old + 1u == (gen + 1u) * nloc) {
            __builtin_amdgcn_fence(__ATOMIC_RELEASE, "agent");
            asm volatile("s_waitcnt vmcnt(0)" ::: "memory");
            const unsigned og = xb_add(&bar[XB_TOP], 1u);
            const unsigned tg = og / nx;
            if (og + 1u == (tg + 1u) * nx) xb_add(&bar[XB_TOPGEN], 1u);
            else XB_SPIN(xb_ld(&bar[XB_TOPGEN]) == tg, bar);
            __builtin_amdgcn_fence(__ATOMIC_ACQUIRE, "agent");
            xb_add(&bar[XB_XGEN(b.x)], 1u);
            asm volatile("s_waitcnt vmcnt(0)" ::: "memory");
        } else {
            XB_SPIN(xb_ld(&bar[XB_XGEN(b.x)]) == gen, bar);
            __builtin_amdgcn_fence(__ATOMIC_ACQUIRE, "agent");
            asm volatile("s_waitcnt vmcnt(0)" ::: "memory");
        }
    }
    __syncthreads();
}
namespace pg8 {
#define PG8_LAS __attribute__((address_space(3)))
typedef unsigned short bf16_t;
typedef short bf16x8 __attribute__((ext_vector_type(8)));
typedef float f32x4 __attribute__((ext_vector_type(4)));
typedef unsigned u32x4 __attribute__((ext_vector_type(4)));
constexpr int BM = 256, BK = 64, HALF = 128, HTB = HALF * BK * 2  , STAGE_BYTES = 8 * HTB, NXCD = 8, WGM = 8, GTAB_OFF = STAGE_BYTES + 8192  ;

__host__ __device__ __forceinline__ int lds_byte(int r, int c) { const int st = (r >> 4) * 2 + (c >> 5), rr = r & 15, cc = c & 31, ob = rr * 64 + cc * 2; return st * 1024 + (ob ^ (((ob >> 9) & 1) << 5)); }
__host__ __device__ __forceinline__ void stage_rc(int b, int& R, int& C) { const int st = b / 1024, sb = b % 1024, swz = sb ^ (((sb >> 9) & 1) << 5); R = (st >> 1) * 16 + swz / 64; C = (st & 1) * 32 + (swz % 64) / 2; }
__host__ __device__ __forceinline__ int perm32(int rho) { const int n = rho >> 4, i = rho & 15; return 8 * (i >> 2) + 4 * n + (i & 3); }

struct Unit { int pm, pn; };
struct Gemm { const bf16_t* A; const bf16_t* Bt; int M, N, K; const unsigned* rowoff; };

struct StaticOrder {
    int nM, nN, nwg, G, c;
    __host__ __device__ void init(int M, int N, int G_, int c_) { nM = M / BM; nN = N / BM; nwg = nM * nN; G = G_; c = c_; }
    __host__ __device__ bool next(int i, Unit& u) const {
        const long L = (long)i * G + c; if (L >= nwg) return false;
        int wgid = (int)L; { const int q = nwg / NXCD, r = nwg % NXCD, xcd = wgid % NXCD, off = wgid / NXCD; wgid = (xcd < r ? xcd * (q + 1) : r * (q + 1) + (xcd - r) * q) + off; }
        const int nig = WGM * nN, gid = wgid / nig, fm = gid * WGM, gsz = (nM - fm) < WGM ? (nM - fm) : WGM;
        u.pm = fm + ((wgid % nig) % gsz); u.pn = (wgid % nig) / gsz; return true;
    }
    __device__ __forceinline__ void a_ready(const Unit&) const {}
    __device__ __forceinline__ void done(const Unit&) const {}
    __device__ __forceinline__ size_t rowbase(const Unit& u) const { return (size_t)u.pm * BM; }
};

__device__ __forceinline__ unsigned cvt_pk_bf16(float lo, float hi) { unsigned r; asm volatile("v_cvt_pk_bf16_f32 %0, %1, %2" : "=v"(r) : "v"(lo), "v"(hi)); return r; }
__device__ __forceinline__ float bf_lo(unsigned w) { return __builtin_bit_cast(float, w << 16); }
__device__ __forceinline__ float bf_hi(unsigned w) { return __builtin_bit_cast(float, w & 0xffff0000u); }

__device__ __forceinline__ unsigned pk4_fp8(float a, float b, float c, float d) {
    a = __builtin_amdgcn_fmed3f(a, -448.f, 448.f); b = __builtin_amdgcn_fmed3f(b, -448.f, 448.f); c = __builtin_amdgcn_fmed3f(c, -448.f, 448.f); d = __builtin_amdgcn_fmed3f(d, -448.f, 448.f);
    unsigned r = 0u; r = (unsigned)__builtin_amdgcn_cvt_pk_fp8_f32(a, b, (int)r, false); r = (unsigned)__builtin_amdgcn_cvt_pk_fp8_f32(c, d, (int)r, true); return r; }
constexpr float FP8_SX = 16.f, FP8_SA = 8.f, FP8_SW = 64.f, FP8_SO = 32.f, FP8_SY = 32.f;
struct EpiBias {
    static constexpr bool PERM = true, AFTER_DRAIN = false;
    bf16_t* O; int ldc; const float* bias;
    __device__ __forceinline__ void operator()(const f32x4 (&acc)[2][2][4][2], const Unit& u, int wr_, int wc_, int fr_, int fq_) const {
        int tz = threadIdx.x; asm volatile("" : "+v"(tz)); const int wid = __builtin_amdgcn_readfirstlane(tz >> 6), wr = wid >> 2, wc = wid & 3, fr = tz & 15, fq = (tz >> 4) & 3;
        const int row0 = u.pm * BM + wr * 64 + fr; const int col0 = u.pn * BM + wc * 32 + 8 * fq;
        f32x4 bv[2][2];
#pragma unroll
        for (int bj = 0; bj < 2; ++bj)
#pragma unroll
            for (int n = 0; n < 2; ++n) bv[bj][n] = *(const f32x4*)(bias + col0 + bj * HALF + 4 * n);
#pragma unroll
        for (int ai = 0; ai < 2; ++ai)
#pragma unroll
            for (int m = 0; m < 4; ++m) { bf16_t* rowp = O + (size_t)(row0 + ai * HALF + m * 16) * ldc + col0;
#pragma unroll
                for (int bj = 0; bj < 2; ++bj) { const f32x4 v0 = acc[ai][bj][m][0] + bv[bj][0], v1 = acc[ai][bj][m][1] + bv[bj][1];
                    u32x4 w; w.x = cvt_pk_bf16(v0[0], v0[1]); w.y = cvt_pk_bf16(v0[2], v0[3]); w.z = cvt_pk_bf16(v1[0], v1[1]); w.w = cvt_pk_bf16(v1[2], v1[3]);
                    *(u32x4*)(rowp + bj * HALF) = w; } }
    }
};

struct EpiProj {
    static constexpr bool PERM = true, AFTER_DRAIN = false;
    bf16_t* O; int ldc; const float* bias; bf16_t* KV; const float* ta; const float* tb; int ltok; unsigned char* K8; unsigned char* V8; unsigned char* Q8;
    __device__ __forceinline__ void operator()(const f32x4 (&acc)[2][2][4][2], const Unit& u, int wr_, int wc_, int fr_, int fq_) const {
        int tz = threadIdx.x; asm volatile("" : "+v"(tz)); const int wid = __builtin_amdgcn_readfirstlane(tz >> 6), wr = wid >> 2, wc = wid & 3, fr = tz & 15, fq = (tz >> 4) & 3, lane = tz & 63;
        const int row0 = u.pm * BM + wr * 64 + fr;
        f32x4 bz[2][2];
#pragma unroll
        for (int bj = 0; bj < 2; ++bj) { const int c0 = u.pn * BM + bj * HALF + wc * 32 + 8 * fq; bz[bj][0] = *(const f32x4*)(bias + c0); bz[bj][1] = *(const f32x4*)(bias + c0 + 4); }
#pragma unroll
        for (int bj = 0; bj < 2; ++bj) {
            const int cw = u.pn * BM + bj * HALF + wc * 32;
            const int c0 = cw + 8 * fq;
            const f32x4 b0 = bz[bj][0], b1 = bz[bj][1];
            const bool is_qk = cw < 1152, is_qi = cw >= 1280 && cw < 1792;
            const bool rot = ((cw & 63) == 0) && (is_qk || is_qi);
            bf16_t* dst; int dld;
            if (cw >= 1024 && cw < 1280) { dst = KV + (cw - 1024) + 8 * fq; dld = 256; } else { dst = O + c0; dld = ldc; }
            f32x4 csn[4];
            if (rot) { const int pos = row0 % ltok; const float* tp = is_qk ? ta + (size_t)pos * 16 : tb + (size_t)pos * 32 + (fq & 1) * 16;
#pragma unroll
                for (int q = 0; q < 4; ++q) csn[q] = *(const f32x4*)(tp + 4 * q); }
#pragma unroll
            for (int g = 0; g < 8; ++g) {
                    const int ai = g >> 2, m = g & 3;
                    const int row = row0 + ai * HALF + m * 16;
                    float v[8];
#pragma unroll
                    for (int j = 0; j < 4; ++j) { v[j] = acc[ai][bj][m][0][j] * (1.f / (FP8_SX * FP8_SW)) + b0[j]; v[4 + j] = acc[ai][bj][m][1][j] * (1.f / (FP8_SX * FP8_SW)) + b1[j]; }
                    if (rot) {
                        f32x4 cs[4];
#pragma unroll
                        for (int q = 0; q < 4; ++q) cs[q] = csn[q];
                        if (g < 7) { const int rown = row0 + ((g + 1) >> 2) * HALF + ((g + 1) & 3) * 16; const int posn = rown % ltok; const float* tpn = is_qk ? ta + (size_t)posn * 16 : tb + (size_t)posn * 32 + (fq & 1) * 16;
#pragma unroll
                            for (int q = 0; q < 4; ++q) csn[q] = *(const f32x4*)(tpn + 4 * q); }
                        const int px = is_qk ? 16 : 32;
                        float w[8];
#pragma unroll
                        for (int j = 0; j < 8; ++j) w[j] = __builtin_bit_cast(float, __builtin_amdgcn_ds_bpermute((lane ^ px) << 2, __builtin_bit_cast(int, v[j])));
                        const bool active = is_qk ? (fq < 2) : true;
                        const bool first = is_qk ? (fq == 0) : (fq < 2);
                        if (active) {
#pragma unroll
                            for (int j = 0; j < 8; j += 2) { const f32x4 c4 = cs[j >> 1];
                                const float x0 = v[j], y0 = w[j], x1 = v[j + 1], y1 = w[j + 1];
                                v[j] = first ? x0 * c4[0] - y0 * c4[1] : x0 * c4[0] + y0 * c4[1];
                                v[j + 1] = first ? x1 * c4[2] - y1 * c4[3] : x1 * c4[2] + y1 * c4[3]; }
                        }
                    }
                    if (Q8 != nullptr && cw < 1024) { uint2 o8; o8.x = pk4_fp8(FP8_SX * v[0], FP8_SX * v[1], FP8_SX * v[2], FP8_SX * v[3]); o8.y = pk4_fp8(FP8_SX * v[4], FP8_SX * v[5], FP8_SX * v[6], FP8_SX * v[7]);
                        *(uint2*)(Q8 + (size_t)row * 1024 + c0) = o8; }
                    else { u32x4 o; o.x = cvt_pk_bf16(v[0], v[1]); o.y = cvt_pk_bf16(v[2], v[3]); o.z = cvt_pk_bf16(v[4], v[5]); o.w = cvt_pk_bf16(v[6], v[7]);
                        *(u32x4*)(dst + (size_t)row * dld) = o; }
                    if (cw >= 1024 && cw < 1152) { uint2 o8; o8.x = pk4_fp8(FP8_SX * v[0], FP8_SX * v[1], FP8_SX * v[2], FP8_SX * v[3]); o8.y = pk4_fp8(FP8_SX * v[4], FP8_SX * v[5], FP8_SX * v[6], FP8_SX * v[7]);
                        *(uint2*)(K8 + (size_t)row * 128 + (cw - 1024) + 8 * fq) = o8; }
                    if (cw >= 1152 && cw < 1280) { uint2 o8; o8.x = pk4_fp8(FP8_SX * v[0], FP8_SX * v[1], FP8_SX * v[2], FP8_SX * v[3]); o8.y = pk4_fp8(FP8_SX * v[4], FP8_SX * v[5], FP8_SX * v[6], FP8_SX * v[7]);
                        *(uint2*)(V8 + (size_t)row * 128 + (cw - 1152) + 8 * fq) = o8; }
            }
        }
    }
};

struct EpiRes {
    static constexpr bool PERM = true, AFTER_DRAIN = false;
    bf16_t* O; const bf16_t* R; float alpha;
    __device__ __forceinline__ void operator()(const f32x4 (&acc)[2][2][4][2], const Unit& u, int wr_, int wc_, int fr_, int fq_) const {
        int tz = threadIdx.x; asm volatile("" : "+v"(tz)); const int wid = __builtin_amdgcn_readfirstlane(tz >> 6), wr = wid >> 2, wc = wid & 3, fr = tz & 15, fq = (tz >> 4) & 3;
        const int row0 = u.pm * BM + wr * 64 + fr; const int col0 = u.pn * BM + wc * 32 + 8 * fq;
#pragma unroll
        for (int ai = 0; ai < 2; ++ai) {
            u32x4 rr[4][2];
#pragma unroll
            for (int m = 0; m < 4; ++m)
#pragma unroll
                for (int bj = 0; bj < 2; ++bj) rr[m][bj] = *(const u32x4*)(R + (size_t)(row0 + ai * HALF + m * 16) * 1024 + col0 + bj * HALF);
#pragma unroll
            for (int m = 0; m < 4; ++m) { const size_t off = (size_t)(row0 + ai * HALF + m * 16) * 1024 + col0;
#pragma unroll
                for (int bj = 0; bj < 2; ++bj) { const u32x4 r = rr[m][bj];
                    const f32x4 a0 = acc[ai][bj][m][0] * (1.f / (FP8_SO * FP8_SW)), a1 = acc[ai][bj][m][1] * (1.f / (FP8_SO * FP8_SW));
                    u32x4 w;
                    w.x = cvt_pk_bf16(a0[0] + alpha * bf_lo(r.x), a0[1] + alpha * bf_hi(r.x));
                    w.y = cvt_pk_bf16(a0[2] + alpha * bf_lo(r.y), a0[3] + alpha * bf_hi(r.y));
                    w.z = cvt_pk_bf16(a1[0] + alpha * bf_lo(r.z), a1[1] + alpha * bf_hi(r.z));
                    w.w = cvt_pk_bf16(a1[2] + alpha * bf_lo(r.w), a1[3] + alpha * bf_hi(r.w));
                    *(u32x4*)(O + off + bj * HALF) = w; } } }
    }
};
struct EpiResX {
    static constexpr bool PERM = true, AFTER_DRAIN = false;
    bf16_t* O; const float* X; const float* META; float alpha; int ltok, nmeta, seq;
    __device__ __forceinline__ void operator()(const f32x4 (&acc)[2][2][4][2], const Unit& u, int wr_, int wc_, int fr_, int fq_) const {
        int tz = threadIdx.x; asm volatile("" : "+v"(tz)); const int wid = __builtin_amdgcn_readfirstlane(tz >> 6), wr = wid >> 2, wc = wid & 3, fr = tz & 15, fq = (tz >> 4) & 3;
        const int row0 = u.pm * BM + wr * 64 + fr; const int col0 = u.pn * BM + wc * 32 + 8 * fq;
#pragma unroll
        for (int ai = 0; ai < 2; ++ai)
#pragma unroll
            for (int mp = 0; mp < 2; ++mp) {
                f32x4 rf[2][2][2];
#pragma unroll
                for (int mm = 0; mm < 2; ++mm) { const int row = row0 + ai * HALF + (2 * mp + mm) * 16; const int b = row / ltok, p = row - b * ltok;
                    const float* src = (p < nmeta ? META + (size_t)p * 1024 : X + ((size_t)b * seq + (p - nmeta)) * 1024) + col0;
#pragma unroll
                    for (int bj = 0; bj < 2; ++bj) { rf[mm][bj][0] = *(const f32x4*)(src + bj * HALF); rf[mm][bj][1] = *(const f32x4*)(src + bj * HALF + 4); } }
#pragma unroll
                for (int mm = 0; mm < 2; ++mm) { const int m = 2 * mp + mm; const size_t off = (size_t)(row0 + ai * HALF + m * 16) * 1024 + col0;
#pragma unroll
                    for (int bj = 0; bj < 2; ++bj) { const f32x4 r0 = rf[mm][bj][0], r1 = rf[mm][bj][1];
                        const f32x4 a0 = acc[ai][bj][m][0] * (1.f / (FP8_SO * FP8_SW)), a1 = acc[ai][bj][m][1] * (1.f / (FP8_SO * FP8_SW));
                        u32x4 w;
                        w.x = cvt_pk_bf16(a0[0] + alpha * r0[0], a0[1] + alpha * r0[1]); w.y = cvt_pk_bf16(a0[2] + alpha * r0[2], a0[3] + alpha * r0[3]);
                        w.z = cvt_pk_bf16(a1[0] + alpha * r1[0], a1[1] + alpha * r1[1]); w.w = cvt_pk_bf16(a1[2] + alpha * r1[2], a1[3] + alpha * r1[3]);
                        *(u32x4*)(O + off + bj * HALF) = w; } } }
    }
};

__device__ __forceinline__ float swiglu1(float g, float u) {
    g = fminf(g, 7.0f); u = fminf(fmaxf(u, -7.0f), 7.0f);
    const float s = __builtin_amdgcn_rcpf(1.0f + __expf(-1.702f * g));
    return g * s * (u + 1.0f);
}
typedef float f32x2e __attribute__((ext_vector_type(2)));
__device__ __forceinline__ f32x2e swiglu2_x8(f32x2e g, f32x2e u) {
    g.x = fminf(g.x, 7.0f); g.y = fminf(g.y, 7.0f);
    u.x = __builtin_amdgcn_fmed3f(u.x, -7.0f, 7.0f); u.y = __builtin_amdgcn_fmed3f(u.y, -7.0f, 7.0f);
    const f32x2e z = g * (-1.702f * 1.4426950408889634f);
    f32x2e e; e.x = __builtin_amdgcn_exp2f(z.x); e.y = __builtin_amdgcn_exp2f(z.y);
    const f32x2e d = e + 1.0f;
    f32x2e r; r.x = __builtin_amdgcn_rcpf(d.x); r.y = __builtin_amdgcn_rcpf(d.y);
    return (g * r) * (u * FP8_SA + FP8_SA);
}
__device__ __forceinline__ unsigned pk4_fp8_nosat(f32x2e a, f32x2e b) { unsigned r = 0u; r = (unsigned)__builtin_amdgcn_cvt_pk_fp8_f32(a.x, a.y, (int)r, false); r = (unsigned)__builtin_amdgcn_cvt_pk_fp8_f32(b.x, b.y, (int)r, true); return r; }
struct EpiSwiglu {
    static constexpr bool PERM = true, AFTER_DRAIN = false;
    unsigned char* O; const float* bias;
    __device__ __forceinline__ void operator()(const f32x4 (&acc)[2][2][4][2], const Unit& u, int wr_, int wc_, int fr_, int fq_) const {
        int tz = threadIdx.x; asm volatile("" : "+v"(tz)); const int wid = __builtin_amdgcn_readfirstlane(tz >> 6), wr = wid >> 2, wc = wid & 3, fr = tz & 15, fq = (tz >> 4) & 3;
        const int e = u.pn >> 3, jt = u.pn & 7;
        const int row0 = u.pm * BM + wr * 64 + fr; const int col0 = jt * 128 + wc * 32 + 8 * fq;
        const float* bp = bias + e * 2048 + col0;
        constexpr float rs = 1.f / (FP8_SX * FP8_SW);
        const f32x4 bgA = *(const f32x4*)(bp), buA = *(const f32x4*)(bp + 1024), bgB = *(const f32x4*)(bp + 4), buB = *(const f32x4*)(bp + 1028);
#pragma unroll
        for (int ai = 0; ai < 2; ++ai)
#pragma unroll
            for (int m = 0; m < 4; ++m) {
                uint2 w;
                { const f32x4 bg = bgA, bu = buA;
                  const f32x4 g0 = acc[ai][0][m][0] * rs + bg, u0 = acc[ai][1][m][0] * rs + bu;
                  w.x = pk4_fp8_nosat(swiglu2_x8((f32x2e){g0[0], g0[1]}, (f32x2e){u0[0], u0[1]}), swiglu2_x8((f32x2e){g0[2], g0[3]}, (f32x2e){u0[2], u0[3]})); }
                asm volatile("" : "+v"(w.x));
                { const f32x4 bg = bgB, bu = buB;
                  const f32x4 g1 = acc[ai][0][m][1] * rs + bg, u1 = acc[ai][1][m][1] * rs + bu;
                  w.y = pk4_fp8_nosat(swiglu2_x8((f32x2e){g1[0], g1[1]}, (f32x2e){u1[0], u1[1]}), swiglu2_x8((f32x2e){g1[2], g1[3]}, (f32x2e){u1[2], u1[3]})); }
                *(uint2*)(O + (size_t)(row0 + ai * HALF + m * 16) * 1024 + col0) = w; }
    }
};

struct EpiDown {
    static constexpr bool PERM = true, AFTER_DRAIN = false;
    unsigned char* Y; const float* bias; const int2* elist; const PG8_LAS int* tstart; const PG8_LAS int* ecnt; int estride;
    __device__ __forceinline__ void operator()(const f32x4 (&acc)[2][2][4][2], const Unit& u, int wr_, int wc_, int fr_, int fq_) const {
        int tz = threadIdx.x; asm volatile("" : "+v"(tz)); const int wid = __builtin_amdgcn_readfirstlane(tz >> 6), wr = wid >> 2, wc = wid & 3, fr = tz & 15, fq = (tz >> 4) & 3;
        const int e = u.pn >> 2, jt = u.pn & 3;
        const int row0 = u.pm * BM + wr * 64 + fr; const int col0 = jt * 256 + wc * 32 + 8 * fq;
        const float* bp = bias + e * 1024 + col0;
        const int slot0 = (u.pm - tstart[e]) * BM + wr * 64 + fr, nvalid = ecnt[e];
        const f32x4 bz00 = *(const f32x4*)(bp), bz01 = *(const f32x4*)(bp + 4), bz10 = *(const f32x4*)(bp + HALF), bz11 = *(const f32x4*)(bp + HALF + 4);
        int2 inf[8];
#pragma unroll
        for (int g = 0; g < 8; ++g) { const int sl = slot0 + (g >> 2) * HALF + (g & 3) * 16; inf[g] = elist[(size_t)e * estride + (sl < nvalid ? sl : nvalid - 1)]; }
#pragma unroll
        for (int ai = 0; ai < 2; ++ai)
#pragma unroll
            for (int m = 0; m < 4; ++m) { const int sl = slot0 + ai * HALF + m * 16; const int2 info = inf[ai * 4 + m];
                if (sl < nvalid) { const float gt = __builtin_bit_cast(float, info.y) * FP8_SY; unsigned char* rowp = Y + (size_t)info.x * 1024 + col0;
#pragma unroll
                    for (int bj = 0; bj < 2; ++bj) { const f32x4 b0 = bj == 0 ? bz00 : bz10, b1 = bj == 0 ? bz01 : bz11;
                        const f32x4 v0 = (acc[ai][bj][m][0] * (1.f / (FP8_SA * FP8_SW)) + b0) * gt, v1 = (acc[ai][bj][m][1] * (1.f / (FP8_SA * FP8_SW)) + b1) * gt;
                        uint2 w; w.x = pk4_fp8(v0[0], v0[1], v0[2], v0[3]); w.y = pk4_fp8(v1[0], v1[1], v1[2], v1[3]);
                        *(uint2*)(rowp + bj * HALF) = w; } } }
    }
};

struct MoeOrder {
    int ntiles, G, c, NJ; const PG8_LAS unsigned char* tile_e;
    const PG8_LAS int* tstart; int estride;
    __device__ __forceinline__ size_t rowbase(const Unit& u) const { const int e = __builtin_amdgcn_readfirstlane((int)tile_e[u.pm]), ts = __builtin_amdgcn_readfirstlane(tstart[e]); return (size_t)e * estride + (size_t)(u.pm - ts) * 256; }
    __device__ __forceinline__ bool next(int i, Unit& u) const {
        const int x = c & 7, k = c >> 3;
        if (G != 256) { const int L = i * G + c; if (L >= ntiles * NJ) return false; const int tt = L / NJ; u.pm = tt; u.pn = tile_e[tt] * NJ + (L % NJ); return true; }
        const int rpg = 32 / NJ;
        const int g = 8 * i + x;
        if (g * rpg >= ntiles) return false;
        int tt = g * rpg + (NJ == 8 ? (k >> 3) : (k >> 2)); const int jt = NJ == 8 ? (k & 7) : (k & 3);
        if (tt >= ntiles) tt = ntiles - 1;
        u.pm = tt; u.pn = tile_e[tt] * NJ + jt; return true;
    }
    __device__ __forceinline__ void a_ready(const Unit&) const {}
    __device__ __forceinline__ void done(const Unit&) const {}
};

__device__ __forceinline__ void glds_s(unsigned voff, const void* sbase, unsigned lds_dst) { unsigned keep; unsigned long long sb = (unsigned long long)sbase; const unsigned ld = lds_dst;
    asm volatile("s_mov_b32 %0, m0\n\ts_mov_b32 m0, %3\n\ts_nop 0\n\tglobal_load_lds_dwordx4 %1, %2\n\ts_mov_b32 m0, %0" : "=&s"(keep) : "v"(voff), "s"(sb), "s"(ld) : "memory"); }
__device__ __forceinline__ void glds_d(unsigned voff, const void* sbase, unsigned lds_dst) { unsigned keep; unsigned long long sb = (unsigned long long)sbase; const unsigned ld = lds_dst;
    asm volatile("s_mov_b32 %0, m0\n\ts_mov_b32 m0, %3\n\ts_nop 0\n\tglobal_load_lds_dword %1, %2\n\ts_mov_b32 m0, %0" : "=&s"(keep) : "v"(voff), "s"(sb), "s"(ld) : "memory"); }
template <int IMM> __device__ __forceinline__ unsigned tab_rd(unsigned addr_v, int tab_s) { unsigned r;
    asm volatile("v_add_u32 %0, %2, %1\n\tds_read_b32 %0, %0 offset:%3" : "=&v"(r) : "v"(addr_v), "s"(tab_s), "i"(IMM) : "memory"); return r; }
template <int NW> __device__ __forceinline__ void glds_gw(unsigned ro, unsigned colb, const void* sbase, unsigned lds_dst) { unsigned keep; unsigned long long sb = (unsigned long long)sbase; const unsigned ld = lds_dst;
    asm volatile("s_waitcnt lgkmcnt(%5)\n\tv_add_u32 %1, %1, %2\n\ts_mov_b32 %0, m0\n\ts_mov_b32 m0, %4\n\ts_nop 0\n\tglobal_load_lds_dwordx4 %1, %3\n\ts_mov_b32 m0, %0" : "=&s"(keep), "+v"(ro) : "v"(colb), "s"(sb), "s"(ld), "i"(NW) : "memory"); }
typedef int pg8_v4i __attribute__((ext_vector_type(4)));
typedef int pg8_v8i __attribute__((ext_vector_type(8)));
__device__ __forceinline__ pg8_v8i cat8(bf16x8 a, bf16x8 b) { const pg8_v4i x = __builtin_bit_cast(pg8_v4i, a), y = __builtin_bit_cast(pg8_v4i, b); return __builtin_shufflevector(x, y, 0, 1, 2, 3, 4, 5, 6, 7); }
template <class Epi, class Sched, bool ALIGN_EPI = false, bool SP2 = false, bool FP8 = false, bool GATHER = false>
__device__ __forceinline__ void gemm_phase(PG8_LAS unsigned char* lds, const Gemm g, const Sched& S, const Epi& E) {
    int tid_l = threadIdx.x; asm volatile("" : "+v"(tid_l));
    const int tid = tid_l, wid = __builtin_amdgcn_readfirstlane(tid >> 6), lane = tid & 63, wr = wid >> 2, wc = wid & 3, fr = lane & 15, fq = lane >> 4;
    const int K = g.K, nt = K / BK;
    unsigned voffA[2], voffB[2];
#pragma unroll
    for (int i = 0; i < 2; ++i) { int R, C; stage_rc(tid * 16 + i * 8192, R, C); const int Rb = Epi::PERM ? ((R & ~31) + perm32(R & 31)) : R;
        voffA[i] = (unsigned)(R * K + C) * 2u; voffB[i] = (unsigned)(Rb * K + C) * 2u; }
    const size_t kstep = (size_t)(BK * 2);
    const size_t hstep = (size_t)HALF * K * 2;
    const size_t tstep = 2 * hstep;
    const unsigned ldsw = (unsigned)wid * 1024u;
    const int aoff = lds_byte(wr * 64 + fr, fq * 8), boff = lds_byte(wc * 32 + fr, fq * 8);
    unsigned rtabv = 0, colb = 0; if constexpr (GATHER) { int R, C; stage_rc(tid * 16, R, C); rtabv = (unsigned)(size_t)lds + (unsigned)(GTAB_OFF + R * 4); colb = (unsigned)C * 2u; }
#define PG8_SA(b, h) (((b) * 2 + (h)) * HTB)
#define PG8_SB(b, h) ((4 + (b) * 2 + (h)) * HTB)
#define PG8_STAGE(bufoff, gbase, voff) do { _Pragma("unroll") for (int _i = 0; _i < 2; ++_i) { if constexpr (FP8) glds_s((voff)[_i], (const void*)(gbase), (unsigned)(size_t)(lds + (bufoff) + _i * 8192) + ldsw); else \
        __builtin_amdgcn_global_load_lds((const unsigned*)((const char*)(gbase) + (voff)[_i]), (PG8_LAS unsigned*)(lds + (bufoff) + ldsw + _i * 8192), 16, 0, 0); } } while (0)
#define PG8_TAB_RD(ro, tab, h) do { ro[0] = tab_rd<(h) * 512>(rtabv, (tab)); ro[1] = tab_rd<(h) * 512 + 256>(rtabv, (tab)); } while (0)
#define PG8_STAGE_GA(bufoff, ro, kb, NW) do { _Pragma("unroll") for (int _i = 0; _i < 2; ++_i) glds_gw<NW>(ro[_i], colb, (const void*)((const char*)g.A + (kb)), (unsigned)(size_t)(lds + (bufoff) + _i * 8192) + ldsw); } while (0)
#define PG8_LDA(dst, b, h) do { _Pragma("unroll") for (int m = 0; m < 4; ++m) _Pragma("unroll") for (int k = 0; k < 2; ++k) dst[m][k] = *(const PG8_LAS bf16x8*)(lds + PG8_SA(b, h) + aoff + m * 2048 + k * 1024); } while (0)
#define PG8_LDB(dst, b, h) do { _Pragma("unroll") for (int n = 0; n < 2; ++n) _Pragma("unroll") for (int k = 0; k < 2; ++k) dst[n][k] = *(const PG8_LAS bf16x8*)(lds + PG8_SB(b, h) + boff + n * 2048 + k * 1024); } while (0)
#define PG8_MMA(ai, bj, At, Bt) do { __builtin_amdgcn_s_setprio(1); if constexpr (FP8) { _Pragma("unroll") for (int m = 0; m < 4; ++m) _Pragma("unroll") for (int n = 0; n < 2; ++n) \
        acc[ai][bj][m][n] = __builtin_amdgcn_mfma_scale_f32_16x16x128_f8f6f4(cat8(Bt[n][0], Bt[n][1]), cat8(At[m][0], At[m][1]), acc[ai][bj][m][n], 0, 0, 0, 0, 0, 0); } else { \
        _Pragma("unroll") for (int m = 0; m < 4; ++m) _Pragma("unroll") for (int n = 0; n < 2; ++n) _Pragma("unroll") for (int k = 0; k < 2; ++k) \
        acc[ai][bj][m][n] = __builtin_amdgcn_mfma_f32_16x16x32_bf16(Bt[n][k], At[m][k], acc[ai][bj][m][n], 0, 0, 0); } __builtin_amdgcn_s_setprio(0); } while (0)
#define PG8_WAIT_V(n) asm volatile("s_waitcnt vmcnt(" #n ")" ::: "memory")
#define PG8_WAIT_L(n) asm volatile("s_waitcnt lgkmcnt(" #n ")" ::: "memory")
#define PG8_BAR __builtin_amdgcn_s_barrier()
#define PG8_SCHED __builtin_amdgcn_sched_barrier(0)
    Unit cur, nxt; int ui = 0;
    if (!S.next(0, cur)) return;
    f32x4 acc[2][2][4][2];
#pragma unroll
    for (int a = 0; a < 2; ++a)
#pragma unroll
        for (int b = 0; b < 2; ++b)
#pragma unroll
            for (int m = 0; m < 4; ++m)
#pragma unroll
                for (int n = 0; n < 2; ++n) acc[a][b][m][n] = (f32x4){0.f, 0.f, 0.f, 0.f};
    bf16x8 At[4][2], B0[2][2], B1[2][2];
    const char* cA = (const char*)g.A + (size_t)cur.pm * tstep; const char* cB = (const char*)g.Bt + (size_t)cur.pn * tstep;
    S.a_ready(cur);
    if constexpr (SP2) {
        if constexpr (GATHER) {
            if (wid < 4) glds_d((unsigned)tid * 4u, (const void*)(g.rowoff + S.rowbase(cur)), (unsigned)(size_t)(lds + GTAB_OFF) + (unsigned)wid * 256u);
            PG8_WAIT_V(0); PG8_BAR; }
        PG8_STAGE(PG8_SB(0, 0), cB, voffB); PG8_STAGE(PG8_SB(0, 1), cB + hstep, voffB);
        if constexpr (GATHER) { unsigned r0[2], r1[2]; PG8_TAB_RD(r0, 0, 0); PG8_TAB_RD(r1, 0, 1); PG8_STAGE_GA(PG8_SA(0, 0), r0, (size_t)0, 0); PG8_STAGE_GA(PG8_SA(0, 1), r1, (size_t)0, 0); }
        else { PG8_STAGE(PG8_SA(0, 0), cA, voffA); PG8_STAGE(PG8_SA(0, 1), cA + hstep, voffA); }
        if (wr == 1) PG8_BAR;
        PG8_WAIT_V(2); PG8_BAR;
        PG8_STAGE(PG8_SB(1, 0), cB + kstep, voffB);
        if constexpr (GATHER) { unsigned r0[2]; PG8_TAB_RD(r0, 0, 0); PG8_STAGE_GA(PG8_SA(1, 0), r0, kstep, 0); } else PG8_STAGE(PG8_SA(1, 0), cA + kstep, voffA);
        PG8_STAGE(PG8_SB(1, 1), cB + hstep + kstep, voffB);
        PG8_WAIT_V(6); PG8_BAR;
    } else {
        PG8_STAGE(PG8_SB(0, 0), cB, voffB); PG8_STAGE(PG8_SA(0, 0), cA, voffA); PG8_STAGE(PG8_SB(0, 1), cB + hstep, voffB); PG8_STAGE(PG8_SA(0, 1), cA + hstep, voffA);
        if (wr == 1) PG8_BAR;
        PG8_WAIT_V(4); PG8_BAR;
        PG8_STAGE(PG8_SB(1, 0), cB + kstep, voffB); PG8_STAGE(PG8_SA(1, 0), cA + kstep, voffA); PG8_STAGE(PG8_SB(1, 1), cB + hstep + kstep, voffB);
        PG8_WAIT_V(6); PG8_BAR;
    }
    for (;;) {
        const bool has_next = S.next(ui + 1, nxt);
        const char* nA = has_next ? (const char*)g.A + (size_t)nxt.pm * tstep : cA; const char* nB = has_next ? (const char*)g.Bt + (size_t)nxt.pn * tstep : cB;
        const int tabC = (ui & 1) * 1024, tabN = has_next ? 1024 - tabC : tabC;
        if constexpr (GATHER) { if (has_next && wid < 4) glds_d((unsigned)tid * 4u, (const void*)(g.rowoff + S.rowbase(nxt)), (unsigned)(size_t)(lds + GTAB_OFF) + (unsigned)(tabN + wid * 256)); }
        for (int t = 0; t < nt; t += 2) {
            const bool last = (t == nt - 2);
            const int tab2 = last ? tabN : tabC; const size_t kb2 = last ? (size_t)0 : (size_t)(t + 2) * kstep; (void)tab2; (void)kb2;
            const char* a1 = cA + (size_t)(t + 1) * kstep;
            const char* a2 = last ? nA : cA + (size_t)(t + 2) * kstep; const char* b2 = last ? nB : cB + (size_t)(t + 2) * kstep;
            const char* a3 = a2 + kstep; const char* b3 = b2 + kstep;
            if (last && has_next) S.a_ready(nxt);
            if constexpr (SP2) {
            if constexpr (GATHER) { unsigned ro[2]; PG8_TAB_RD(ro, tabC, 1); PG8_LDB(B0, 0, 0); PG8_LDB(B1, 0, 1); PG8_SCHED; PG8_LDA(At, 0, 0); PG8_STAGE_GA(PG8_SA(1, 1), ro, (size_t)(t + 1) * kstep, 12); }
            else { PG8_LDB(B0, 0, 0); PG8_LDB(B1, 0, 1); PG8_SCHED; PG8_LDA(At, 0, 0); PG8_STAGE(PG8_SA(1, 1), a1 + hstep, voffA); }
            PG8_WAIT_V(8); PG8_WAIT_L(0); PG8_BAR; PG8_MMA(0, 0, At, B0); PG8_MMA(0, 1, At, B1); PG8_BAR; PG8_SCHED;
            if constexpr (GATHER) { unsigned ro[2]; PG8_TAB_RD(ro, tab2, 0); PG8_LDA(At, 0, 1); PG8_STAGE(PG8_SB(0, 0), b2, voffB); PG8_STAGE(PG8_SB(0, 1), b2 + hstep, voffB); PG8_STAGE_GA(PG8_SA(0, 0), ro, kb2, 6); }
            else { PG8_LDA(At, 0, 1); PG8_STAGE(PG8_SB(0, 0), b2, voffB); PG8_STAGE(PG8_SB(0, 1), b2 + hstep, voffB); PG8_STAGE(PG8_SA(0, 0), a2, voffA); }
            PG8_WAIT_V(8); PG8_WAIT_L(0); PG8_BAR; PG8_MMA(1, 0, At, B0); PG8_MMA(1, 1, At, B1); PG8_BAR; PG8_SCHED;
            if constexpr (GATHER) { unsigned ro[2]; PG8_TAB_RD(ro, tab2, 1); PG8_LDB(B0, 1, 0); PG8_LDB(B1, 1, 1); PG8_SCHED; PG8_LDA(At, 1, 0); PG8_STAGE_GA(PG8_SA(0, 1), ro, kb2, 12); }
            else { PG8_LDB(B0, 1, 0); PG8_LDB(B1, 1, 1); PG8_SCHED; PG8_LDA(At, 1, 0); PG8_STAGE(PG8_SA(0, 1), a2 + hstep, voffA); }
            PG8_WAIT_V(8); PG8_WAIT_L(0); PG8_BAR; PG8_MMA(0, 0, At, B0); PG8_MMA(0, 1, At, B1); PG8_BAR; PG8_SCHED;
            if constexpr (GATHER) { unsigned ro[2]; PG8_TAB_RD(ro, tab2, 0); PG8_LDA(At, 1, 1); PG8_STAGE(PG8_SB(1, 0), b3, voffB); PG8_STAGE(PG8_SB(1, 1), b3 + hstep, voffB); PG8_STAGE_GA(PG8_SA(1, 0), ro, kb2 + kstep, 6); }
            else { PG8_LDA(At, 1, 1); PG8_STAGE(PG8_SB(1, 0), b3, voffB); PG8_STAGE(PG8_SB(1, 1), b3 + hstep, voffB); PG8_STAGE(PG8_SA(1, 0), a3, voffA); }
            PG8_WAIT_V(8); PG8_WAIT_L(0); PG8_BAR; PG8_MMA(1, 0, At, B0); PG8_MMA(1, 1, At, B1); PG8_BAR; PG8_SCHED;
            } else {
            PG8_LDB(B0, 0, 0); PG8_SCHED; PG8_LDA(At, 0, 0); PG8_STAGE(PG8_SA(1, 1), a1 + hstep, voffA);
            PG8_WAIT_L(8); PG8_BAR; PG8_WAIT_L(0); PG8_MMA(0, 0, At, B0); PG8_BAR; PG8_SCHED;
            PG8_LDB(B1, 0, 1); PG8_STAGE(PG8_SB(0, 0), b2, voffB);
            PG8_BAR; PG8_WAIT_L(0); PG8_MMA(0, 1, At, B1); PG8_BAR;
            PG8_LDA(At, 0, 1); PG8_STAGE(PG8_SA(0, 0), a2, voffA);
            PG8_BAR; PG8_WAIT_L(0); PG8_MMA(1, 0, At, B0); PG8_BAR; PG8_SCHED;
            PG8_STAGE(PG8_SB(0, 1), b2 + hstep, voffB);
            PG8_WAIT_V(6); PG8_BAR; PG8_MMA(1, 1, At, B1); PG8_BAR;
            PG8_LDB(B0, 1, 0); PG8_SCHED; PG8_LDA(At, 1, 0); PG8_STAGE(PG8_SA(0, 1), a2 + hstep, voffA);
            PG8_WAIT_L(8); PG8_BAR; PG8_WAIT_L(0); PG8_MMA(0, 0, At, B0); PG8_BAR; PG8_SCHED;
            PG8_LDB(B1, 1, 1); PG8_STAGE(PG8_SB(1, 0), b3, voffB);
            PG8_BAR; PG8_WAIT_L(0); PG8_MMA(0, 1, At, B1); PG8_BAR;
            PG8_LDA(At, 1, 1); PG8_STAGE(PG8_SA(1, 0), a3, voffA);
            PG8_BAR; PG8_WAIT_L(0); PG8_MMA(1, 0, At, B0); PG8_BAR; PG8_SCHED;
            PG8_STAGE(PG8_SB(1, 1), b3 + hstep, voffB);
            PG8_WAIT_V(6); PG8_BAR; PG8_MMA(1, 1, At, B1); PG8_BAR;
            }
        }
        if constexpr (ALIGN_EPI) { if (wr == 0) PG8_BAR; }
        if constexpr (!Epi::AFTER_DRAIN) { E(acc, cur, wr, wc, fr, fq); S.done(cur); }
        if (!has_next) break;
#pragma unroll
        for (int a = 0; a < 2; ++a)
#pragma unroll
            for (int b = 0; b < 2; ++b)
#pragma unroll
                for (int m = 0; m < 4; ++m)
#pragma unroll
                    for (int n = 0; n < 2; ++n) acc[a][b][m][n] = (f32x4){0.f, 0.f, 0.f, 0.f};
        cur = nxt; cA = nA; cB = nB; ++ui;
        if constexpr (ALIGN_EPI) { if (wr == 1) PG8_BAR; }
    }
    PG8_WAIT_V(0);
    if constexpr (!ALIGN_EPI) { if (wr == 0) PG8_BAR; }
    PG8_BAR;
    if constexpr (Epi::AFTER_DRAIN) { E.fused(acc, cur, wr, wc, fr, fq, lds, wid, lane); S.done(cur); }
#undef PG8_SA
#undef PG8_SB
#undef PG8_STAGE
#undef PG8_TAB_RD
#undef PG8_STAGE_GA
#undef PG8_LDA
#undef PG8_LDB
#undef PG8_MMA
#undef PG8_WAIT_V
#undef PG8_WAIT_L
#undef PG8_BAR
#undef PG8_SCHED
}
}
constexpr int NBATCH = 16, SEQ = 4096, NMETA = 16, LTOK = SEQ + NMETA, NTOK = NBATCH * LTOK;
constexpr int DM = 1024, NCOLA = 1280, NCOLB = 1864, NCOLB_PAD = 2048;
constexpr int NEXP = 32, MOE_TILES_MAX = NTOK * 4 / 256 + NEXP, MOE_P = MOE_TILES_MAX * 256;
constexpr float LN_EPS = 1e-5f, DN_ALPHA = 1.4142135623730951f;
constexpr float ATTN_SCALE = 0.125f, IDX_SCALE = 0.125f, IDX_W_SCALE = 0.35355339059327373f;
constexpr int NWAVES = 8, NTHREADS = 512;

constexpr size_t MiB = 1u << 20;
constexpr size_t WS_CTL = 0, CTL_ZERO_BYTES = 1 * MiB;
constexpr size_t WS_ROPEA = 1 * MiB, WS_ROPEB = 2 * MiB, WS_BIASB = 3 * MiB, WS_WRT = 3 * MiB + 512 * 1024, WS_ROWINFO = 4 * MiB, WS_ROUTE = 8 * MiB;
constexpr size_t WS_WINA = 16 * MiB, WS_WOUTA = 19 * MiB, WS_WINB = 21 * MiB, WS_WOUTB = 25 * MiB;
constexpr size_t WS_WGU = 32 * MiB, WS_WD = 288 * MiB;
constexpr size_t WS_HA = 416 * MiB, WS_HB = 545 * MiB, WS_PRE = 674 * MiB;
constexpr size_t WS_XS = 803 * MiB, WS_ACT = 1333 * MiB, WS_H8 = 1863 * MiB, WS_ELIST = 1931 * MiB, WS_EOFF = 1948 * MiB, WS_END = 1965 * MiB;
constexpr size_t WS_ROWOFF = 6 * MiB + 512 * 1024;
constexpr size_t WS_HB8 = WS_XS + 330 * MiB;
constexpr size_t WS_Q8 = WS_XS + 451 * MiB;
constexpr size_t WS_PROJ = WS_XS, WS_ATT = WS_XS + 257 * MiB;
constexpr size_t WS_SCORE = WS_ACT, WS_SEL = WS_ACT + 128 * MiB;
constexpr size_t WS_KV = WS_XS + 386 * MiB, WS_KI = WS_XS + 421 * MiB;
constexpr size_t WS_K8 = WS_XS + 431 * MiB;
constexpr size_t WS_V8 = WS_XS + 441 * MiB;
static_assert((size_t)NTOK * 512 <= 35 * MiB && WS_KI + (size_t)NTOK * 128 <= WS_K8 && WS_K8 + (size_t)NTOK * 128 <= WS_V8 && WS_V8 + (size_t)NTOK * 128 <= WS_ACT, "ws compact copies");
static_assert((size_t)NTOK * 2048 * 2 <= 257 * MiB && (size_t)NTOK * 1024 * 2 <= 129 * MiB && (size_t)MOE_P * 2048 <= 530 * MiB, "ws map");
static_assert(WS_ATT + 129 * MiB <= WS_ACT && WS_SEL + 32 * MiB <= WS_END, "ws overlays");

constexpr int CW_BAR = 4096;
constexpr int CW_CNT = 16384;

constexpr int RING_BYTES = 131072, LDSCTL_OFF = RING_BYTES, LDS_BYTES = 163840;
constexpr int LDS_EQ_OFF = LDSCTL_OFF + 8192, LDS_HIST_OFF = LDSCTL_OFF + 16384;
constexpr int LC_BAR = 0;
constexpr int LC_TSTART = 16;
constexpr int LC_ECNT = 64;
constexpr int LC_LCNT = 128, LC_LBASE = 160;
constexpr int LC_PROBE_A = 200, LC_PROBE_B = 201;
constexpr int LC_TILEE = 256;

struct Args { const float* in[21]; float* out; unsigned char* ws; int ph_lo, ph_hi; };
typedef const Args __attribute__((address_space(4))) CArgs;
__device__ __forceinline__ CArgs* KA() { unsigned long long v = (unsigned long long)__builtin_amdgcn_kernarg_segment_ptr(); asm volatile("" : "+s"(v)); return (CArgs*)v; }

typedef unsigned short u16;

__device__ __forceinline__ float bf2f(unsigned h) { return __builtin_bit_cast(float, h << 16); }
__device__ __forceinline__ float bflo(unsigned w) { return __builtin_bit_cast(float, w << 16); }
__device__ __forceinline__ float bfhi(unsigned w) { return __builtin_bit_cast(float, w & 0xffff0000u); }
__device__ __forceinline__ unsigned cvtpk(float lo, float hi) { return pg8::cvt_pk_bf16(lo, hi); }
__device__ __forceinline__ unsigned char* launder(unsigned char* p) { unsigned long long v = (unsigned long long)p; asm volatile("" : "+s"(v)); return (unsigned char*)(GAS unsigned char*)v; }
__device__ __forceinline__ const float* gptr(const float* p) { return (const float*)(const GAS float*)p; }
__device__ __forceinline__ float shx(float v, int o, int lane) { return __builtin_bit_cast(float, __builtin_amdgcn_ds_bpermute((lane ^ o) << 2, __builtin_bit_cast(int, v))); }
__device__ __forceinline__ int shxi(int v, int o, int lane) { return __builtin_amdgcn_ds_bpermute((lane ^ o) << 2, v); }
__device__ __forceinline__ int launder_v(int x) { asm volatile("" : "+v"(x)); return x; }

__device__ __forceinline__ void transpose_item(const float* W, int K, int N, bf16* WT, int mode, LAS float* scr, int item, int lane) {
    const int nblk = (N + 31) / 32, kb = item / nblk, nb = item % nblk, k0 = 64 * kb, n0 = 32 * nb;
    const bool okn = (n0 + (lane & 31)) < N;
#pragma unroll 8
    for (int i = 0; i < 32; ++i) { const int kk = 2 * i + (lane >> 5); scr[kk * 33 + (lane & 31)] = okn ? W[(size_t)(k0 + kk) * N + n0 + (lane & 31)] : 0.f; }
    LDS_WAIT(); asm volatile("" ::: "memory");
    const int c = lane & 7;
#pragma unroll
    for (int j = 0; j < 4; ++j) { const int n = (lane >> 3) + 8 * j; const LAS float* s = scr + (8 * c) * 33 + n;
        v4u o; o.x = pk2(s[0 * 33], s[1 * 33]); o.y = pk2(s[2 * 33], s[3 * 33]); o.z = pk2(s[4 * 33], s[5 * 33]); o.w = pk2(s[6 * 33], s[7 * 33]);
        int nn = n0 + n;
        if (nn < N) {
            if (mode == 1) { const int up = nn >= 1024 ? 1 : 0, q = nn - 1024 * up; nn = (q >> 7) * 256 + up * 128 + (q & 127); }
            *(GAS v4u*)(WT + (size_t)nn * K + k0 + 8 * c) = o; } }
    LDS_WAIT(); asm volatile("" ::: "memory");
}

__device__ __forceinline__ void transpose_item_fp8(const float* W, int K, int N, unsigned char* WT, int mode, LAS float* scr, int item, int lane) {
    const int nblk = (N + 31) / 32, kb = item / nblk, nb = item % nblk, k0 = 64 * kb, n0 = 32 * nb;
    const bool okn = (n0 + (lane & 31)) < N;
#pragma unroll 8
    for (int i = 0; i < 32; ++i) { const int kk = 2 * i + (lane >> 5); scr[kk * 33 + (lane & 31)] = okn ? W[(size_t)(k0 + kk) * N + n0 + (lane & 31)] : 0.f; }
    LDS_WAIT(); asm volatile("" ::: "memory");
    const int c = lane & 7;
#pragma unroll
    for (int j = 0; j < 4; ++j) { const int n = (lane >> 3) + 8 * j; const LAS float* s = scr + (8 * c) * 33 + n;
        uint2 o; o.x = pg8::pk4_fp8(s[0 * 33] * pg8::FP8_SW, s[1 * 33] * pg8::FP8_SW, s[2 * 33] * pg8::FP8_SW, s[3 * 33] * pg8::FP8_SW);
        o.y = pg8::pk4_fp8(s[4 * 33] * pg8::FP8_SW, s[5 * 33] * pg8::FP8_SW, s[6 * 33] * pg8::FP8_SW, s[7 * 33] * pg8::FP8_SW);
        int nn = n0 + n;
        if (mode == 1) { const int up = nn >= 1024 ? 1 : 0, q = nn - 1024 * up; nn = (q >> 7) * 256 + up * 128 + (q & 127); }
        if (n0 + n < N) *(uint2*)(WT + (size_t)nn * K + k0 + 8 * c) = o; }
    LDS_WAIT(); asm volatile("" ::: "memory");
}

__device__ __forceinline__ void transpose_item_fp8_reg(const float* W, int K, int N, unsigned char* WT, int mode, int item, int lane) {
    const int nblk = N / 32, kb = item / nblk, nb = item % nblk, k0 = 64 * kb, n0 = 32 * nb;
    const int q = lane & 7, g = lane >> 3;
    const float* src = W + (size_t)(k0 + 8 * g) * N + n0 + 4 * q;
    f32x4 v[8];
#pragma unroll
    for (int i = 0; i < 8; ++i) v[i] = *(const f32x4*)(src + (size_t)i * N);
#pragma unroll
    for (int j = 0; j < 4; ++j) { constexpr float sw = pg8::FP8_SW; uint2 o;
        o.x = pg8::pk4_fp8(v[0][j] * sw, v[1][j] * sw, v[2][j] * sw, v[3][j] * sw); o.y = pg8::pk4_fp8(v[4][j] * sw, v[5][j] * sw, v[6][j] * sw, v[7][j] * sw);
        int nn = n0 + 4 * q + j;
        if (mode == 1) { const int up = nn >= 1024 ? 1 : 0, qq = nn - 1024 * up; nn = (qq >> 7) * 256 + up * 128 + (qq & 127); }
        *(uint2*)(WT + (size_t)nn * K + k0 + 8 * g) = o; }
}
constexpr int L1W_GU = 32 * 1024, L1W_ITEMS = L1W_GU + 32 * 512;
__device__ __forceinline__ void moe_weight_item(CArgs* A, int layer, int it, int lane) {
    unsigned char* ws = launder(A->ws);
    if (it < L1W_GU) { const int le = 32 * layer + (it >> 10); transpose_item_fp8_reg(gptr(A->in[15]) + (size_t)le * 1024 * 2048, 1024, 2048, ws + WS_WGU + (size_t)le * 2048 * 1024, 1, it & 1023, lane); }
    else { const int r = it - L1W_GU, le = 32 * layer + (r >> 9); transpose_item_fp8_reg(gptr(A->in[17]) + (size_t)le * 1024 * 1024, 1024, 1024, ws + WS_WD + (size_t)le * 1024 * 1024, 0, r & 511, lane); }
}

__device__ __forceinline__ void p0_prologue(CArgs* A, LAS unsigned char* lds, int gw, int NGW, int wave, int lane) {
    unsigned char* ws = launder(A->ws);
    LAS float* scr = (LAS float*)(lds + wave * 16384);
    constexpr int I_GU = 0, I_D = 0  , I_INA = 16 * 40, I_OUT = 512, I_INB = 16 * 59, I_R = 2 * 16;
    constexpr int NITEMS = I_GU + I_D + I_INA + I_OUT + I_INB + I_OUT + I_R;
    for (int it = gw; it < NITEMS; it += NGW) {
        int r = it;
        if (r < I_GU) { const int le = r >> 10; transpose_item_fp8(gptr(A->in[15]) + (size_t)le * 1024 * 2048, 1024, 2048, ws + WS_WGU + (size_t)le * 2048 * 1024, 1, scr, r & 1023, lane); continue; } r -= I_GU;
        if (r < I_D) { const int le = r >> 9; transpose_item_fp8(gptr(A->in[17]) + (size_t)le * 1024 * 1024, 1024, 1024, ws + WS_WD + (size_t)le * 1024 * 1024, 0, scr, r & 511, lane); continue; } r -= I_D;
        if (r < I_INA) { transpose_item_fp8(gptr(A->in[2]), 1024, NCOLA, ws + WS_WINA, 0, scr, r, lane); continue; } r -= I_INA;
        if (r < I_OUT) { transpose_item_fp8(gptr(A->in[5]), 1024, 1024, ws + WS_WOUTA, 0, scr, r, lane); continue; } r -= I_OUT;
        if (r < I_INB) { transpose_item_fp8(gptr(A->in[6]), 1024, NCOLB, ws + WS_WINB, 0, scr, r, lane); continue; } r -= I_INB;
        if (r < I_OUT) { transpose_item_fp8(gptr(A->in[10]), 1024, 1024, ws + WS_WOUTB, 0, scr, r, lane); continue; } r -= I_OUT;
        { const int ly = r >> 4; transpose_item(gptr(A->in[13]) + (size_t)ly * 1024 * 32, 1024, 32, (bf16*)(ws + WS_WRT) + (size_t)ly * 32 * 1024, 0, scr, r & 15, lane); }
    }
    const int gt = gw * 64 + lane, NGT = NGW * 64;
    { v4u* z = (v4u*)(ws + WS_WINB + (size_t)NCOLB * 1024); const int n16 = (NCOLB_PAD - NCOLB) * 1024 / 16;
      for (int i = gt; i < n16; i += NGT) z[i] = (v4u){0u, 0u, 0u, 0u}; }
    { v4u* z = (v4u*)(ws + WS_EOFF); const int n16 = 2 * 32 * NTOK * 4 / 16; for (int i = gt; i < n16; i += NGT) z[i] = (v4u){0u, 0u, 0u, 0u}; }
    { float* bb = (float*)(ws + WS_BIASB); for (int i = gt; i < NCOLB_PAD; i += NGT) bb[i] = i < NCOLB ? gptr(A->in[7])[i] : 0.f; }
    { float2* ta = (float2*)(ws + WS_ROPEA); float2* tb = (float2*)(ws + WS_ROPEB);
      for (int i = gt; i < LTOK * 24; i += NGT) {
          const int pos = i / 24, j = i % 24; const bool isA = j < 8; const int fi = isA ? j : j - 8; const float half = isA ? 8.f : 16.f;
          const float inv = powf(500000.0f, -(float)fi / half); const float ang = (float)pos * inv;
          float sn, cs; sincosf(ang, &sn, &cs);
          if (isA) ta[pos * 8 + fi] = make_float2(cs, sn); else tb[pos * 16 + fi] = make_float2(cs, sn); } }
    {
      for (int row = gw; row < NTOK; row += NGW) { const int b = row / LTOK, p = row % LTOK;
          const float* src = p < NMETA ? gptr(A->in[1]) + (size_t)p * DM : gptr(A->in[0]) + ((size_t)b * SEQ + (p - NMETA)) * DM;
#pragma unroll
          for (int j = 0; j < 2; ++j) { const f32x4 a = *(const f32x4*)(src + j * 512 + lane * 8), c = *(const f32x4*)(src + j * 512 + lane * 8 + 4);
              constexpr float sx = pg8::FP8_SX; uint2 o8; o8.x = pg8::pk4_fp8(sx * a[0], sx * a[1], sx * a[2], sx * a[3]); o8.y = pg8::pk4_fp8(sx * c[0], sx * c[1], sx * c[2], sx * c[3]);
              *(uint2*)(ws + WS_H8 + (size_t)row * DM + j * 512 + lane * 8) = o8; } } }
}

__device__ __forceinline__ void rope_pair(float& x1, float& x2, const float2 cs) { const float a = x1 * cs.x - x2 * cs.y, b = x2 * cs.x + x1 * cs.y; x1 = a; x2 = b; }
__device__ __forceinline__ void ki_phase(CArgs* A, int gt, int NGT) {
    unsigned char* ws = launder(A->ws);
    const bf16* P = (const bf16*)(ws + WS_PROJ); bf16* KI = (bf16*)(ws + WS_KI);
    const float2* tb = (const float2*)(ws + WS_ROPEB);
    for (int it = gt; it < NTOK * 2; it += NGT) {
        const int row = it >> 1, hf = it & 1, pos = row % LTOK, lane = gt & 63;
        const bf16* p = P + (size_t)row * NCOLB_PAD + 1792 + 32 * hf; bf16* d = KI + (size_t)row * 64 + 32 * hf;
        const float* g = gptr(A->in[8]) + 32 * hf; const float* bb = gptr(A->in[9]) + 32 * hf;
        v4u q[4];
#pragma unroll
        for (int j = 0; j < 4; ++j) q[j] = *(const v4u*)(p + 8 * j);
        float x[32];
#pragma unroll
        for (int j = 0; j < 4; ++j) { x[8 * j + 0] = bflo(q[j].x); x[8 * j + 1] = bfhi(q[j].x); x[8 * j + 2] = bflo(q[j].y); x[8 * j + 3] = bfhi(q[j].y);
            x[8 * j + 4] = bflo(q[j].z); x[8 * j + 5] = bfhi(q[j].z); x[8 * j + 6] = bflo(q[j].w); x[8 * j + 7] = bfhi(q[j].w); }
        float s = 0.f;
#pragma unroll
        for (int i = 0; i < 32; ++i) s += x[i];
        s += shx(s, 1, lane);
        const float mu = s * (1.f / 64.f); float v = 0.f;
#pragma unroll
        for (int i = 0; i < 32; ++i) { x[i] -= mu; v += x[i] * x[i]; }
        v += shx(v, 1, lane);
        const float rstd = 1.f / sqrtf(v * (1.f / 64.f) + LN_EPS);
#pragma unroll
        for (int c8 = 0; c8 < 4; ++c8) {
#pragma unroll
            for (int i = 8 * c8; i < 8 * c8 + 8; ++i) x[i] = x[i] * rstd * g[i] + bb[i];
            asm volatile("" ::: "memory"); }
        if (hf == 0) {
#pragma unroll
            for (int c4 = 0; c4 < 4; ++c4) {
#pragma unroll
                for (int i = 4 * c4; i < 4 * c4 + 4; ++i) rope_pair(x[i], x[16 + i], tb[pos * 16 + i]);
                asm volatile("" ::: "memory"); }
        }
#pragma unroll
        for (int j = 0; j < 4; ++j) { q[j].x = cvtpk(x[8 * j + 0], x[8 * j + 1]); q[j].y = cvtpk(x[8 * j + 2], x[8 * j + 3]); q[j].z = cvtpk(x[8 * j + 4], x[8 * j + 5]); q[j].w = cvtpk(x[8 * j + 6], x[8 * j + 7]);
            *(v4u*)(d + 8 * j) = q[j]; }
    }
}

template <int NB, bool DSA>
__device__ __forceinline__ void attn8_phase(CArgs* A, LAS unsigned char* lds, int gw, int NGW, int wave, int lane_) {
    unsigned char* ws = launder(A->ws);
    const bf16* P = (const bf16*)(ws + WS_PROJ); const int ld = DSA ? NCOLB_PAD : NCOLA;
    const unsigned char* K8 = ws + WS_K8; const unsigned char* V8 = ws + WS_V8;
    unsigned char* O = ws + WS_ATT;
    const u16* SEL = (const u16*)(ws + WS_SEL);
    const float* sinks = gptr(A->in[4]);
    LAS unsigned char* vl = lds + wave * 16384;
    typedef int v2i __attribute__((ext_vector_type(2)));
    constexpr int NTOT = DSA ? NTOK : NBATCH * NMETA;
#define TOK_DESC(tix_, tok_, b_, p_, nk_, usel_, rb_, selrow_) \
        const int tok_ = DSA ? (tix_) : ((tix_) >> 4) * LTOK + ((tix_) & 15); const int b_ = tok_ / LTOK, p_ = tok_ % LTOK; \
        const bool usel_ = DSA && (p_ - NMETA >= 256); const int nk_ = p_ < NMETA ? p_ + 1 : (p_ - NMETA < 256 ? p_ + 1 : 16 + 256); \
        const size_t rb_ = (size_t)b_ * LTOK; const u16* selrow_ = SEL + ((size_t)b_ * SEQ + (p_ > NMETA ? p_ - NMETA : 0)) * 256;
#define REQ_KP(dst_, nk_, usel_, selrow_, fr_) do { _Pragma("unroll") for (int c_ = 0; c_ < NB * 2; ++c_) { const int i0_ = c_ * 32 + (fr_), i1_ = i0_ + 16; \
            const unsigned k0_ = i0_ < (nk_) ? (unsigned)(i0_ < 16 ? i0_ : 16 + ((usel_) ? (int)(selrow_)[i0_ - 16] : i0_ - 16)) : 0u; \
            const unsigned k1_ = i1_ < (nk_) ? (unsigned)(16 + ((usel_) ? (int)(selrow_)[i1_ - 16] : i1_ - 16)) : 0u; dst_[c_] = k0_ | (k1_ << 16); } } while (0)
#define KPX(arr_, TT) (((TT) & 1) ? (arr_[(TT) >> 1] >> 16) : (arr_[(TT) >> 1] & 0xffffu))
#define LOAD_KX(arr_, rb_, bt, fq_, nt_) do { _Pragma("unroll") for (int T_ = 0; T_ < (nt_); ++T_) { \
            const unsigned ko_ = ((unsigned)(rb_) + KPX(arr_, 4 * (bt) + T_)) * 128u + (unsigned)(fq_) * 32u; \
            kf[T_][0] = *(const v4u*)(K8 + ko_); kf[T_][1] = *(const v4u*)(K8 + ko_ + 16u); } } while (0)
#define LOAD_VX(arr_, rb_, bt, lane__, nt_) do { _Pragma("unroll") for (int T_ = 0; T_ < (nt_); ++T_) _Pragma("unroll") for (int h_ = 0; h_ < 2; ++h_) { \
            const unsigned pp_ = (unsigned)__builtin_amdgcn_ds_bpermute((8 * h_ + ((lane__) >> 3)) << 2, (int)arr_[(4 * (bt) + T_) >> 1]); \
            const unsigned pos_ = (T_ & 1) ? (pp_ >> 16) : (pp_ & 0xffffu); \
            vt[2 * T_ + h_] = *(const v4u*)(V8 + (((unsigned)(rb_) + pos_) * 128u + ((unsigned)(lane__) & 7u) * 16u)); } } while (0)
    v4u kf[4][2]; v4u vt[8];
    unsigned kpn[NB * 2]; v4u qn[4];
    const unsigned char* Q8 = ws + WS_Q8;
    unsigned sta[8], tra[16];
    { const int lane = launder_v(lane_); const int fq = lane >> 4;
#pragma unroll
      for (int T = 0; T < 4; ++T)
#pragma unroll
          for (int h = 0; h < 2; ++h) { const unsigned i = 8u * h + ((unsigned)lane >> 3), rho = 32u * (i >> 2) + 4u * T + (i & 3u); sta[2 * T + h] = 128u * rho + 16u * (((unsigned)lane & 7u) ^ (rho & 7u)); }
#pragma unroll
      for (int d = 0; d < 8; ++d)
#pragma unroll
          for (int u = 0; u < 2; ++u) { const unsigned row = 32u * (unsigned)fq + 8u * u + (((unsigned)lane & 15u) >> 1); tra[2 * d + u] = 128u * row + 16u * ((unsigned)d ^ (row & 7u)) + 8u * ((unsigned)lane & 1u); } }
    int tix = gw, nwit = 0;
    if (tix >= NTOT) return;
    { const int lane0 = launder_v(lane_); const int fr0 = lane0 & 15, fq0 = lane0 >> 4;
      TOK_DESC(tix, tk0, b0, p0, nk0, us0, rb0, sr0)
      REQ_KP(kpn, nk0, us0, sr0, fr0);
      if (DSA) { const unsigned char* qr = Q8 + (rb0 + p0) * DM + fr0 * 64 + (fq0 & 1) * 32; qn[0] = *(const v4u*)qr; qn[1] = *(const v4u*)(qr + 16); }
      else { const bf16* qr = P + (rb0 + p0) * ld + fr0 * 64 + (fq0 & 1) * 32; qn[0] = *(const v4u*)qr; qn[1] = *(const v4u*)(qr + 8); qn[2] = *(const v4u*)(qr + 16); qn[3] = *(const v4u*)(qr + 24); }
      LOAD_KX(kpn, rb0, 0, fq0, 4); LOAD_VX(kpn, rb0, 0, lane0, 4); }
    for (; tix < NTOT; tix += NGW) {
        const int lane = launder_v(lane_); const int fr = lane & 15, fq = lane >> 4;
        TOK_DESC(tix, tok, b, p, n_keys, use_sel, rowbase, selrow)
        (void)b; (void)use_sel; (void)selrow;
        unsigned kp2[NB * 2];
#pragma unroll
        for (int c = 0; c < NB * 2; ++c) kp2[c] = kpn[c];
        pg8::pg8_v8i qf8;
        if (DSA) { const bool mine = (fq >> 1) == (fr >> 3); v4u lo8 = qn[0], hi8 = qn[1];
          if (!mine) { lo8 = (v4u){0u, 0u, 0u, 0u}; hi8 = lo8; }
          qf8 = pg8::cat8(__builtin_bit_cast(bf16x8, lo8), __builtin_bit_cast(bf16x8, hi8)); }
        else { const bool mine = (fq >> 1) == (fr >> 3); constexpr float sq = pg8::FP8_SX; const v4u q0 = qn[0], q1 = qn[1], q2 = qn[2], q3 = qn[3];
          v4u lo8, hi8;
          lo8.x = pg8::pk4_fp8(sq * bflo(q0.x), sq * bfhi(q0.x), sq * bflo(q0.y), sq * bfhi(q0.y)); lo8.y = pg8::pk4_fp8(sq * bflo(q0.z), sq * bfhi(q0.z), sq * bflo(q0.w), sq * bfhi(q0.w));
          lo8.z = pg8::pk4_fp8(sq * bflo(q1.x), sq * bfhi(q1.x), sq * bflo(q1.y), sq * bfhi(q1.y)); lo8.w = pg8::pk4_fp8(sq * bflo(q1.z), sq * bfhi(q1.z), sq * bflo(q1.w), sq * bfhi(q1.w));
          hi8.x = pg8::pk4_fp8(sq * bflo(q2.x), sq * bfhi(q2.x), sq * bflo(q2.y), sq * bfhi(q2.y)); hi8.y = pg8::pk4_fp8(sq * bflo(q2.z), sq * bfhi(q2.z), sq * bflo(q2.w), sq * bfhi(q2.w));
          hi8.z = pg8::pk4_fp8(sq * bflo(q3.x), sq * bfhi(q3.x), sq * bflo(q3.y), sq * bfhi(q3.y)); hi8.w = pg8::pk4_fp8(sq * bflo(q3.z), sq * bfhi(q3.z), sq * bflo(q3.w), sq * bfhi(q3.w));
          if (!mine) { lo8 = (v4u){0u, 0u, 0u, 0u}; hi8 = lo8; }
          qf8 = pg8::cat8(__builtin_bit_cast(bf16x8, lo8), __builtin_bit_cast(bf16x8, hi8)); }
        const bool has_next = tix + NGW < NTOT;
        const int tixn = has_next ? tix + NGW : tix;
        TOK_DESC(tixn, tokn, bn, pn, nkn, usn, rbn, srn)
        (void)tokn; (void)bn;
        REQ_KP(kpn, nkn, usn, srn, fr);
        if (DSA) { const unsigned char* qr = Q8 + (rbn + pn) * DM + fr * 64 + (fq & 1) * 32; qn[0] = *(const v4u*)qr; qn[1] = *(const v4u*)(qr + 16); }
        else { const bf16* qr = P + (rbn + pn) * ld + fr * 64 + (fq & 1) * 32; qn[0] = *(const v4u*)qr; qn[1] = *(const v4u*)(qr + 8); qn[2] = *(const v4u*)(qr + 16); qn[3] = *(const v4u*)(qr + 24); }
        float mrun = -1e30f, lsum = 0.f;
        f32x4 o[8];
#pragma unroll
        for (int d = 0; d < 8; ++d) o[d] = (f32x4){0.f, 0.f, 0.f, 0.f};
#pragma unroll
        for (int bt = 0; bt < NB; ++bt) {
            const int NT = (DSA && NB == 5 && bt == NB - 1) ? 1 : 4, NTN = (DSA && NB == 5 && bt + 1 == NB - 1) ? 1 : 4;
            if (bt * 64 < n_keys) {
                const bool more = (bt + 1 < NB) && ((bt + 1) * 64 < n_keys);
                f32x4 s8[4]; float bm = -1e30f;
                constexpr float qk = ATTN_SCALE / (pg8::FP8_SX * pg8::FP8_SX);
                const bool full = bt * 64 + 16 * NT <= n_keys;
#pragma unroll
                for (int T = 0; T < 4; ++T) s8[T] = (f32x4){-1e30f, -1e30f, -1e30f, -1e30f};
#pragma unroll
                for (int T = 0; T < NT; ++T) {
                    const f32x4 a = __builtin_amdgcn_mfma_scale_f32_16x16x128_f8f6f4(pg8::cat8(__builtin_bit_cast(bf16x8, kf[T][0]), __builtin_bit_cast(bf16x8, kf[T][1])), qf8, (f32x4){0.f, 0.f, 0.f, 0.f}, 0, 0, 0, 0, 0, 0);
                    if (full) { s8[T] = a; }
                    else {
#pragma unroll
                        for (int j = 0; j < 4; ++j) { const int ki = bt * 64 + 16 * T + 4 * fq + j; s8[T][j] = ki < n_keys ? a[j] : -1e30f; } }
                    bm = fmaxf(bm, fmaxf(fmaxf(s8[T][0], s8[T][1]), fmaxf(s8[T][2], s8[T][3])));
                }
                if (more) { LOAD_KX(kp2, rowbase, bt + 1 < NB ? bt + 1 : 0, fq, NTN); } else if (has_next) { LOAD_KX(kpn, rbn, 0, fq, 4); }
                bm = fmaxf(bm, shx(bm, 16, lane)); bm = fmaxf(bm, shx(bm, 32, lane)); bm *= qk;
                const float mnew = fmaxf(mrun, bm), rs = __expf(mrun - mnew); mrun = mnew;
                float bs = 0.f; unsigned pk[4];
                const float mb = mnew * 1.4426950408889634f - 8.0f;
                constexpr float qkl = qk * 1.4426950408889634f;
#pragma unroll
                for (int T = 0; T < 4; ++T) { const float e0 = __builtin_amdgcn_exp2f(__builtin_fmaf(s8[T][0], qkl, -mb)), e1 = __builtin_amdgcn_exp2f(__builtin_fmaf(s8[T][1], qkl, -mb)),
                                                          e2 = __builtin_amdgcn_exp2f(__builtin_fmaf(s8[T][2], qkl, -mb)), e3 = __builtin_amdgcn_exp2f(__builtin_fmaf(s8[T][3], qkl, -mb));
                    bs += (e0 + e1) + (e2 + e3); unsigned w = 0u; w = (unsigned)__builtin_amdgcn_cvt_pk_fp8_f32(e0, e1, (int)w, false); w = (unsigned)__builtin_amdgcn_cvt_pk_fp8_f32(e2, e3, (int)w, true); pk[T] = w; }
                bs *= (1.f / 256.f);
                lsum = lsum * rs + bs;
#pragma unroll
                for (int d = 0; d < 8; ++d) o[d] = o[d] * rs;
#pragma unroll
                for (int q8 = 0; q8 < 2 * NT; ++q8) *(LAS v4u*)(vl + sta[q8]) = vt[q8];
                if (more) { LOAD_VX(kp2, rowbase, bt + 1 < NB ? bt + 1 : 0, lane, NTN); } else if (has_next) { LOAD_VX(kpn, rbn, 0, lane, 4); }
                const pg8::pg8_v8i pf = {(int)pk[0], (int)pk[1], (int)pk[2], (int)pk[3], 0, 0, 0, 0};
#pragma unroll
                for (int d = 0; d < 8; ++d) {
                    v2i r[2];
#pragma unroll
                    for (int u = 0; u < 2; ++u) r[u] = __builtin_amdgcn_ds_read_tr8_b64_v2i32((LAS v2i*)(vl + tra[2 * d + u]));
                    const pg8::pg8_v8i vf = {r[0].x, r[0].y, r[1].x, r[1].y, 0, 0, 0, 0};
                    o[d] = __builtin_amdgcn_mfma_scale_f32_16x16x128_f8f6f4(vf, pf, o[d], 0, 0, 0, 0, 0, 0);
                }
            }
        }
        lsum += shx(lsum, 16, lane); lsum += shx(lsum, 32, lane);
        float inv;
        if (!DSA) { const float sk = sinks[fr], m2 = fmaxf(mrun, sk), f = __expf(mrun - m2); inv = f / (lsum * f + __expf(sk - m2)); }
        else inv = 1.f / lsum;
        { unsigned char* orow = O + (size_t)tok * DM + fr * 64 + fq * 4; const bool hi = fr >= 8; const float inv8 = inv * (pg8::FP8_SO / (256.f * pg8::FP8_SX));
#pragma unroll
          for (int dd = 0; dd < 4; ++dd) { const f32x4 vl_ = o[dd], vh_ = o[4 + dd];
              const float v0 = hi ? vh_[0] : vl_[0], v1 = hi ? vh_[1] : vl_[1], v2 = hi ? vh_[2] : vl_[2], v3 = hi ? vh_[3] : vl_[3];
              *(unsigned*)(orow + dd * 16) = pg8::pk4_fp8(v0 * inv8, v1 * inv8, v2 * inv8, v3 * inv8); } }
    }
#undef TOK_DESC
#undef REQ_KP
#undef KPX
#undef LOAD_KX
#undef LOAD_VX
}

constexpr int SWA_ROWS = 288, SWA_KOFF = 0, SWA_VOFF = SWA_ROWS * 128;
__device__ __forceinline__ unsigned swa_koff(unsigned row, unsigned ch) { return 128u * row + 16u * (ch ^ (((row >> 1) & 1u) | (((row >> 3) & 3u) << 1))); }
__device__ __forceinline__ unsigned swa_voff(unsigned row, unsigned ch) { return 128u * row + 16u * (ch ^ (2u * (((row >> 1) & 1u) | (((row >> 3) & 1u) << 1)))); }
__device__ __forceinline__ void swa_tile_phase(CArgs* A, LAS unsigned char* lds, int G, int wg, int wave, int lane_) {
    unsigned char* ws = launder(A->ws);
    const bf16* P = (const bf16*)(ws + WS_PROJ); constexpr int ld = NCOLA;
    const bf16* KV = (const bf16*)(ws + WS_KV);
    bf16* O = (bf16*)(ws + WS_ATT);
    const float* sinks = gptr(A->in[4]);
    LAS unsigned char* kl = lds + SWA_KOFF; LAS unsigned char* vl = lds + SWA_VOFF;
    constexpr int NUNITS = NBATCH * 2 * 32;
    int nwit = 0;
    for (int unit = wg; unit < NUNITS; unit += G) {
        const int lane = launder_v(lane_), tid = wave * 64 + lane, fr = lane & 15, fq = lane >> 4;
        const int qb = unit & 31, kvh = (unit >> 5) & 1, b = unit >> 6;
        const size_t rowbase = (size_t)b * LTOK;
        __syncthreads();
        { constexpr int NST = (SWA_ROWS * 8 + NTHREADS - 1) / NTHREADS;
          v4u kk[NST], vv[NST];
#pragma unroll
          for (int i = 0; i < NST; ++i) { const int id = tid + i * NTHREADS; const int r = id >> 3, ch = id & 7;
              int pos = -1;
              if (r < 16) pos = r; else if (r < 272) { const int s = (qb - 1) * 128 + (r - 16); if (s >= 0) pos = NMETA + s; }
              kk[i] = (v4u){0u, 0u, 0u, 0u}; vv[i] = kk[i];
              if (id < SWA_ROWS * 8 && pos >= 0) { const bf16* src = KV + (rowbase + pos) * 256 + kvh * 64 + ch * 8; kk[i] = *(const v4u*)src; vv[i] = *(const v4u*)(src + 128); } }
#pragma unroll
          for (int i = 0; i < NST; ++i) { const int id = tid + i * NTHREADS; const int r = id >> 3, ch = id & 7;
              if (id < SWA_ROWS * 8) { *(LAS v4u*)(kl + swa_koff((unsigned)r, (unsigned)ch)) = kk[i]; *(LAS v4u*)(vl + swa_voff((unsigned)r, (unsigned)ch)) = vv[i]; } } }
        __syncthreads();
        const int i0 = 16 * wave;
        const int tokrow = (int)rowbase + NMETA + qb * 128 + i0 + fr;
        const unsigned tq = ((unsigned)lane & 15u) >> 2, tp = (unsigned)lane & 3u;
        bf16x8 qn[2];
        { const bf16* qr = P + (size_t)tokrow * ld + (kvh * 8) * 64 + fq * 8; qn[0] = *(const bf16x8*)qr; qn[1] = *(const bf16x8*)(qr + 32); }
#pragma unroll 1
        for (int g = 0; g < 8; ++g) {
            const int h = kvh * 8 + g;
            bf16x8 qf[2]; qf[0] = qn[0]; qf[1] = qn[1];
            { const int hn = kvh * 8 + (g < 7 ? g + 1 : g); const bf16* qr = P + (size_t)tokrow * ld + hn * 64 + fq * 8; qn[0] = *(const bf16x8*)qr; qn[1] = *(const bf16x8*)(qr + 32); }
            f32x4 sc[12]; float mx = -1e30f;
#pragma unroll
            for (int T = 0; T < 12; ++T) {
                const int c = T >> 1; const int base = c == 0 ? 0 : 16 + i0 + 32 * (c - 1);
                const unsigned r = (unsigned)(base + 8 * (fr >> 2) + 4 * (T & 1) + (fr & 3));
                const bf16x8 k0 = *(const LAS bf16x8*)(kl + swa_koff(r, (unsigned)fq)), k1 = *(const LAS bf16x8*)(kl + swa_koff(r, 4u + (unsigned)fq));
                f32x4 a = {0.f, 0.f, 0.f, 0.f};
                a = __builtin_amdgcn_mfma_f32_16x16x32_bf16(k0, qf[0], a, 0, 0, 0);
                a = __builtin_amdgcn_mfma_f32_16x16x32_bf16(k1, qf[1], a, 0, 0, 0);
#pragma unroll
                for (int j = 0; j < 4; ++j) { const int rr = base + 8 * fq + 4 * (T & 1) + j;
                    bool ok;
                    if (c == 0) ok = rr < 16; else { const int kbi = rr - 16, it = i0 + fr; ok = (kbi >= it + 1) && (kbi <= it + 128) && (qb > 0 || kbi >= 128); }
                    const float v = ok ? a[j] * ATTN_SCALE : -1e30f; sc[T][j] = v; mx = fmaxf(mx, v); }
            }
            mx = fmaxf(mx, shx(mx, 16, lane)); mx = fmaxf(mx, shx(mx, 32, lane));
            const float sk = sinks[h]; mx = fmaxf(mx, sk);
            float sum = 0.f; v4u pk[6];
#pragma unroll
            for (int c = 0; c < 6; ++c) { float e[8];
#pragma unroll
                for (int j = 0; j < 4; ++j) { e[j] = __expf(sc[2 * c][j] - mx); e[4 + j] = __expf(sc[2 * c + 1][j] - mx); }
                sum += ((e[0] + e[1]) + (e[2] + e[3])) + ((e[4] + e[5]) + (e[6] + e[7]));
                pk[c].x = cvtpk(e[0], e[1]); pk[c].y = cvtpk(e[2], e[3]); pk[c].z = cvtpk(e[4], e[5]); pk[c].w = cvtpk(e[6], e[7]); }
            sum += shx(sum, 16, lane); sum += shx(sum, 32, lane);
            sum += __expf(sk - mx);
            const float inv = 1.f / sum;
            f32x4 o[4];
#pragma unroll
            for (int d = 0; d < 4; ++d) o[d] = (f32x4){0.f, 0.f, 0.f, 0.f};
#pragma unroll
            for (int c = 0; c < 6; ++c) {
                const int base = c == 0 ? 0 : 16 + i0 + 32 * (c - 1);
                const bf16x8 pf = __builtin_bit_cast(bf16x8, pk[c]);
                const unsigned r0 = (unsigned)(base + 8 * fq) + tq, r1 = r0 + 4u;
#pragma unroll
                for (int d = 0; d < 4; ++d) {
                    typedef short s16x4 __attribute__((ext_vector_type(4)));
                    const s16x4 lo = __builtin_bit_cast(s16x4, __builtin_amdgcn_ds_read_tr16_b64_v4i16((LAS s16x4*)(vl + swa_voff(r0, 2u * d + (tp >> 1)) + 8u * (tp & 1u))));
                    const s16x4 hi = __builtin_bit_cast(s16x4, __builtin_amdgcn_ds_read_tr16_b64_v4i16((LAS s16x4*)(vl + swa_voff(r1, 2u * d + (tp >> 1)) + 8u * (tp & 1u))));
                    const bf16x8 vf = {lo[0], lo[1], lo[2], lo[3], hi[0], hi[1], hi[2], hi[3]};
                    o[d] = __builtin_amdgcn_mfma_f32_16x16x32_bf16(vf, pf, o[d], 0, 0, 0);
                }
            }
            { unsigned char* orow = (unsigned char*)O + (size_t)tokrow * DM + h * 64 + fq * 4; const float inv8 = inv * pg8::FP8_SO;
#pragma unroll
              for (int d = 0; d < 4; ++d) *(unsigned*)(orow + d * 16) = pg8::pk4_fp8(o[d][0] * inv8, o[d][1] * inv8, o[d][2] * inv8, o[d][3] * inv8); }
            { const int wit = (wg * NWAVES + wave) + nwit * (G * NWAVES); if (wit < L1W_ITEMS) moe_weight_item(A, 0, wit, lane); ++nwit; }
        }
    }
    for (int wit = (wg * NWAVES + wave) + nwit * (G * NWAVES); wit < L1W_ITEMS; wit += G * NWAVES) moe_weight_item(A, 0, wit, launder_v(lane_));
}

#ifndef PROBE_SUB
#define PROBE_SUB 0
#endif
#define SUB_T0() unsigned long long sub_t_ = (PROBE_SUB) ? __builtin_amdgcn_s_memrealtime() : 0ull
#define SUB_ADD(lds_, word_) do { if (PROBE_SUB) { const unsigned long long n_ = __builtin_amdgcn_s_memrealtime(); if (threadIdx.x == 0) ((LAS unsigned*)((lds_) + LDSCTL_OFF))[word_] += (unsigned)(n_ - sub_t_); sub_t_ = n_; } } while (0)
__device__ __forceinline__ int idx_bucket(float s) { return (int)__builtin_amdgcn_fmed3f(__builtin_fmaf(s, 24.f, 128.5f), 0.f, 255.9f); }
__device__ __forceinline__ unsigned ordkey(float f) { unsigned u = __builtin_bit_cast(unsigned, f); if (u == 0x80000000u) u = 0u; return (u & 0x80000000u) ? ~u : (u | 0x80000000u); }
__device__ __forceinline__ void indexer_phase(CArgs* A, LAS unsigned char* lds, int G, int wg, int wave, int lane_) {
    unsigned char* ws = launder(A->ws);
    const bf16* P = (const bf16*)(ws + WS_PROJ); constexpr int ld = NCOLB_PAD;
    const bf16* KI = (const bf16*)(ws + WS_KI);
    float* scr = (float*)(ws + WS_SCORE) + (size_t)wg * 32 * SEQ;
    u16* SEL = (u16*)(ws + WS_SEL);
    constexpr int NUNITS = NBATCH * 120;
    int nwit = 0;
    for (int r = 0;; ++r) {
        const int k = r * G + ((r & 1) ? (G - 1 - wg) : wg);
        if (r * G >= NUNITS) break;
        if (k >= NUNITS) continue;
        const int lane = launder_v(lane_), fr = lane & 15, fq = lane >> 4, tid = wave * 64 + lane;
        const int qb = 127 - k / NBATCH, b = k % NBATCH, t0 = qb * 32;
        const size_t rowbase = (size_t)b * LTOK + NMETA;
        bf16x8 qf[2][2]; float wv[2][4];
#pragma unroll
        for (int rg = 0; rg < 2; ++rg) {
            const int tq = t0 + 4 * wave + (fr >> 2);
            const bf16* qr = P + (rowbase + tq) * ld + 1280 + ((fr & 3) + 4 * rg) * 64 + fq * 8;
            qf[rg][0] = *(const bf16x8*)qr; qf[rg][1] = *(const bf16x8*)(qr + 32);
            const bf16* wr_ = P + (rowbase + t0 + 4 * wave + fq) * ld + 1856 + 4 * rg;
#pragma unroll
            for (int j = 0; j < 4; ++j) wv[rg][j] = bf2f(wr_[j]) * (IDX_W_SCALE * IDX_SCALE);
        }
        SUB_T0();
        const int nkt = t0 / 16 + 2;
        const int nchunk = (nkt + 31) >> 5;
        const bf16* kgl = KI + rowbase * 64 + (size_t)(tid >> 3) * 64 + (tid & 7) * 8;
        v4u st[8];
#pragma unroll
        for (int j = 0; j < 8; ++j) st[j] = *(const v4u*)(kgl + (size_t)(64 * j) * 64);
        __syncthreads();
#pragma unroll
        for (int j = 0; j < 8; ++j) { const unsigned row = (unsigned)(tid >> 3) + 64u * j, ch = (unsigned)tid & 7u; *(LAS v4u*)(lds + 128u * row + 16u * (ch ^ ((row >> 1) & 7u))) = st[j]; }
        float* sp = scr + (size_t)(4 * wave + fq) * SEQ + fr;
        LAS unsigned* hist = (LAS unsigned*)(lds + LDS_HIST_OFF);
#pragma unroll
        for (int j = 0; j < 8; ++j) hist[4 * wave * 128 + lane + 64 * j] = 0u;
        LAS unsigned* hrow = hist + (4 * wave + fq) * 128; const int trow = t0 + 4 * wave + fq;
        for (int c = 0; c < nchunk; ++c) {
            __syncthreads();
            if (c + 1 < nchunk) {
#pragma unroll
                for (int j = 0; j < 8; ++j) st[j] = *(const v4u*)(kgl + (size_t)((c + 1) * 512 + 64 * j) * 64); }
            const LAS unsigned char* kb = lds + (c & 1) * 65536;
            const int ntl = __builtin_amdgcn_readfirstlane(nkt - c * 32 < 32 ? nkt - c * 32 : 32);
            const unsigned sw = ((unsigned)fr >> 1) & 7u;
            const LAS unsigned char* ka0 = kb + 128u * (unsigned)fr + 16u * ((unsigned)fq ^ sw); const LAS unsigned char* ka1 = kb + 128u * (unsigned)fr + 16u * ((4u + (unsigned)fq) ^ sw);
            for (int tl = 0; tl < ntl; tl += 2) {
                const bf16x8 k0a = *(const LAS bf16x8*)(ka0 + 2048 * tl), k1a = *(const LAS bf16x8*)(ka1 + 2048 * tl);
                const bf16x8 k0b = *(const LAS bf16x8*)(ka0 + 2048 * tl + 2048), k1b = *(const LAS bf16x8*)(ka1 + 2048 * tl + 2048);
                f32x4 aa[2], ab[2];
#pragma unroll
                for (int rg = 0; rg < 2; ++rg) {
                    aa[rg] = __builtin_amdgcn_mfma_f32_16x16x32_bf16(qf[rg][0], k0a, (f32x4){0.f, 0.f, 0.f, 0.f}, 0, 0, 0);
                    ab[rg] = __builtin_amdgcn_mfma_f32_16x16x32_bf16(qf[rg][0], k0b, (f32x4){0.f, 0.f, 0.f, 0.f}, 0, 0, 0); }
#pragma unroll
                for (int rg = 0; rg < 2; ++rg) {
                    aa[rg] = __builtin_amdgcn_mfma_f32_16x16x32_bf16(qf[rg][1], k1a, aa[rg], 0, 0, 0);
                    ab[rg] = __builtin_amdgcn_mfma_f32_16x16x32_bf16(qf[rg][1], k1b, ab[rg], 0, 0, 0); }
                float ta = 0.f, tb = 0.f;
#pragma unroll
                for (int rg = 0; rg < 2; ++rg)
#pragma unroll
                    for (int j = 0; j < 4; ++j) { ta = __builtin_fmaf(wv[rg][j], __builtin_amdgcn_fmed3f(aa[rg][j], 0.f, 3.0e38f), ta); tb = __builtin_fmaf(wv[rg][j], __builtin_amdgcn_fmed3f(ab[rg][j], 0.f, 3.0e38f), tb); }
                const int kt = c * 32 + tl;
                sp[kt * 16] = ta; sp[kt * 16 + 16] = tb;
                { const int bka = idx_bucket(ta), bkb = idx_bucket(tb);
                  (void)__hip_atomic_fetch_add(hrow + (bka >> 1), (kt * 16 + fr <= trow ? 1u : 0u) << (16 * (bka & 1)), __ATOMIC_RELAXED, __HIP_MEMORY_SCOPE_WORKGROUP);
                  (void)__hip_atomic_fetch_add(hrow + (bkb >> 1), (kt * 16 + 16 + fr <= trow ? 1u : 0u) << (16 * (bkb & 1)), __ATOMIC_RELAXED, __HIP_MEMORY_SCOPE_WORKGROUP); }
            }
            if (c + 1 < nchunk) {
#pragma unroll
                for (int j = 0; j < 8; ++j) { const unsigned row = (unsigned)(tid >> 3) + 64u * j, ch = (unsigned)tid & 7u; *(LAS v4u*)(lds + ((c + 1) & 1) * 65536 + 128u * row + 16u * (ch ^ ((row >> 1) & 7u))) = st[j]; } }
        }
        asm volatile("s_waitcnt vmcnt(0)" ::: "memory");
        SUB_ADD(lds, LC_PROBE_A);
        unsigned fraw[64];
#define IDX_ROW_LOAD(qi_) do { \
            _Pragma("unroll") for (int g_ = 0; g_ < 4; ++g_) { if (g_ * 1024 <= t0) { \
                unsigned long long pa_ = (unsigned long long)((const unsigned*)(scr + (size_t)(4 * wave + (qi_)) * SEQ) + lane + g_ * 1024); asm volatile("" : "+v"(pa_));     \
                const unsigned* gp_ = (const unsigned*)(const GAS unsigned*)pa_; \
                _Pragma("unroll") for (int r_ = 0; r_ < 16; ++r_) fraw[g_ * 16 + r_] = __hip_atomic_load(gp_ + r_ * 64, __ATOMIC_RELAXED, __HIP_MEMORY_SCOPE_AGENT); } } } while (0)
#ifndef DUP_SEL
#define DUP_SEL 1
#endif
        for (int rep_ = 0, nrep_ = __builtin_amdgcn_readfirstlane(launder_v(DUP_SEL)); rep_ < nrep_; ++rep_) {
        IDX_ROW_LOAD(0);
        for (int qi = 0; qi < 4; ++qi) {
            const int t = t0 + 4 * wave + qi;
            const int nfull = (t + 1) >> 6;
            LAS u16* out = (LAS u16*)(lds + LDSCTL_OFF + 4096 + wave * 512);
            int bstar, cab, neq;
            { const LAS unsigned* hw = hist + (4 * wave + qi) * 128;
              const unsigned w0 = hw[2 * lane], w1 = hw[2 * lane + 1];
              const int c0 = (int)(w0 & 0xffffu), c1 = (int)(w0 >> 16), c2 = (int)(w1 & 0xffffu), c3 = (int)(w1 >> 16), tl4 = (c0 + c1) + (c2 + c3);
              int pf = tl4;
#pragma unroll
              for (int o = 1; o < 64; o <<= 1) { const int v = __builtin_amdgcn_ds_bpermute(((lane - o) & 63) << 2, pf); pf += lane >= o ? v : 0; }
              const int total = __builtin_amdgcn_readlane(pf, 63);
              const int above = total - pf;
              const unsigned long long hm = __ballot(above < 256 && above + tl4 >= 256);
              const int L = (int)__builtin_ctzll(hm);
              int a = above, bs, ne;
              if (a + c3 >= 256) { bs = 3; ne = c3; } else { a += c3; if (a + c2 >= 256) { bs = 2; ne = c2; } else { a += c2; if (a + c1 >= 256) { bs = 1; ne = c1; } else { a += c1; bs = 0; ne = c0; } } }
              bstar = 4 * L + __builtin_amdgcn_readlane(bs, L); cab = __builtin_amdgcn_readlane(a, L); neq = __builtin_amdgcn_readlane(ne, L); }
            const int m256 = 256 - cab;
            if (neq <= 64) {
                LAS unsigned* ek = (LAS unsigned*)(lds + LDS_EQ_OFF + wave * 512); LAS u16* ei = (LAS u16*)(lds + LDS_EQ_OFF + wave * 512 + 256);
                int base = 0, eb = 0;
                const unsigned* nb[4];
#pragma unroll
                for (int g = 0; g < 4; ++g) { unsigned long long pa = (unsigned long long)((const unsigned*)(scr + (size_t)(4 * wave + (qi < 3 ? qi + 1 : qi)) * SEQ) + lane + g * 1024); asm volatile("" : "+v"(pa)); nb[g] = (const unsigned*)(const GAS unsigned*)pa; }
#pragma unroll
                for (int rr = 0; rr < 64; ++rr) {
                    if (rr <= nfull + 1) {
                        const float f = __builtin_bit_cast(float, fraw[rr]);
                        if (qi < 3) fraw[rr] = __hip_atomic_load(nb[rr >> 4] + (rr & 15) * 64, __ATOMIC_RELAXED, __HIP_MEMORY_SCOPE_AGENT);
                        const int bk = (rr * 64 + lane <= t) ? idx_bucket(f) : -1;
                        const bool gt = bk > bstar, eq = bk == bstar;
                        const unsigned long long mt = __ballot(gt);
                        if (gt) out[base + (int)__builtin_amdgcn_mbcnt_hi((unsigned)(mt >> 32), __builtin_amdgcn_mbcnt_lo((unsigned)mt, 0u))] = (u16)(rr * 64 + lane);
                        base += __popcll(mt);
                        const unsigned long long me = __ballot(eq);
                        if (eq) { const int p = eb + (int)__builtin_amdgcn_mbcnt_hi((unsigned)(me >> 32), __builtin_amdgcn_mbcnt_lo((unsigned)me, 0u)); ek[p] = ordkey(f); ei[p] = (u16)(rr * 64 + lane); }
                        eb += __popcll(me);
                    }
                }
                const unsigned key = lane < neq ? ek[lane] : 0u; const u16 kidx = ei[lane];
                int rank = 0;
                for (int j = 0; j < neq; ++j) { const unsigned kj = (unsigned)__builtin_amdgcn_readlane((int)key, j); rank += (kj > key || (kj == key && j < lane)) ? 1 : 0; }
                const bool take = lane < neq && rank < m256;
                const unsigned long long mt = __ballot(take);
                if (take) out[cab + (int)__builtin_amdgcn_mbcnt_hi((unsigned)(mt >> 32), __builtin_amdgcn_mbcnt_lo((unsigned)mt, 0u))] = kidx;
            } else {
#pragma unroll
            for (int rr = 0; rr < 64; ++rr) fraw[rr] = (rr * 64 + lane <= t) ? ordkey(__builtin_bit_cast(float, fraw[rr])) : 0u;
#define IDX_COUNT(cmpop, x_, c_) do { c_ = 0; _Pragma("unroll") for (int g8 = 0; g8 < 8; ++g8) { if (g8 * 8 <= nfull) { unsigned long long bm[8]; \
                _Pragma("unroll") for (int r8 = 0; r8 < 8; ++r8) bm[r8] = __ballot(fraw[g8 * 8 + r8] cmpop (x_)); __builtin_amdgcn_sched_barrier(0); \
                _Pragma("unroll") for (int r8 = 0; r8 < 8; ++r8) c_ += __popcll(bm[r8]); } } } while (0)
#ifndef DUP_BIS
#define DUP_BIS 1
#endif
            unsigned lo = 0u, hi = 0xFFFFFFFFu; int clo = t + 1, chi = 0;
            for (int rb_ = 0, nrb_ = __builtin_amdgcn_readfirstlane(launder_v(DUP_BIS)); rb_ < nrb_; ++rb_) { lo = 0u; hi = 0xFFFFFFFFu; clo = t + 1; chi = 0;
            for (int it = 0; it < 80 && hi - lo > 1u; ++it) {
                unsigned mid = lo + ((hi - lo) >> 1);
                if (it >= 9 && (it & 1)) { const float f = (float)(clo - 255) / (float)(clo - chi + 1);
                    const unsigned d = (unsigned)((float)(hi - lo) * f); mid = lo + (d < 1u ? 1u : d); if (mid >= hi) mid = hi - 1u; }
                int c; IDX_COUNT(>=, mid, c);
                if (c >= 256) { lo = mid; clo = c; if (c == 256) break; } else { hi = mid; chi = c; }
            }
            }
            const unsigned prefix = lo;
            int cge, cgt; IDX_COUNT(>=, prefix, cge); IDX_COUNT(>, prefix, cgt);
            if (cge == 256) {
                int base = 0;
#pragma unroll
                for (int rr = 0; rr < 64; ++rr) {
                    if (rr <= nfull) {
                        const bool take = fraw[rr] >= prefix;
                        const unsigned long long mt = __ballot(take);
                        if (take) out[base + (int)__builtin_amdgcn_mbcnt_hi((unsigned)(mt >> 32), __builtin_amdgcn_mbcnt_lo((unsigned)mt, 0u))] = (u16)(rr * 64 + lane);
                        base += __popcll(mt);
                    }
                }
            } else {
                int need = 256 - cgt, base = 0;
#pragma unroll
                for (int rr = 0; rr < 64; ++rr) {
                    if (rr <= nfull) {
                        const bool gt = fraw[rr] > prefix, eq = fraw[rr] == prefix;
                        const unsigned long long meq = __ballot(eq);
                        const int eqrank = (int)__builtin_amdgcn_mbcnt_hi((unsigned)(meq >> 32), __builtin_amdgcn_mbcnt_lo((unsigned)meq, 0u));
                        const bool take = gt || (eq && eqrank < need);
                        const unsigned long long mt = __ballot(take);
                        if (take) out[base + (int)__builtin_amdgcn_mbcnt_hi((unsigned)(mt >> 32), __builtin_amdgcn_mbcnt_lo((unsigned)mt, 0u))] = (u16)(rr * 64 + lane);
                        base += __popcll(mt);
                        const int neq = __popcll(meq); need -= (neq < need ? neq : need);
                    }
                }
            }
                if (qi < 3) IDX_ROW_LOAD(qi + 1);
            }
            { const unsigned long long row8 = *(const LAS unsigned long long*)((const LAS unsigned char*)out + lane * 8);
              *(unsigned long long*)((unsigned char*)(SEL + ((size_t)b * SEQ + t) * 256) + lane * 8) = row8; }
            { const int wit = (wg * NWAVES + wave) + nwit * (G * NWAVES); if (wit < L1W_ITEMS) moe_weight_item(A, 1, wit, lane); ++nwit; }
#undef IDX_COUNT
        }
        }
#undef IDX_ROW_LOAD
        asm volatile("s_waitcnt vmcnt(0)" ::: "memory");
        SUB_ADD(lds, LC_PROBE_B);
    }
    for (int wit = (wg * NWAVES + wave) + nwit * (G * NWAVES); wit < L1W_ITEMS; wit += G * NWAVES) moe_weight_item(A, 1, wit, launder_v(lane_));
}

__device__ __forceinline__ void ln_router_phase(CArgs* A, LAS unsigned char* lds, int layer, int G, int wg, int wave, int lane, const bf16* PRE, bf16* HOUT) {
    unsigned char* ws = launder(A->ws);
    const float* lg = gptr(A->in[11]) + layer * DM; const float* lb = gptr(A->in[12]) + layer * DM;
    const bf16* WRT = (const bf16*)(ws + WS_WRT) + (size_t)layer * 32 * 1024;
    const float* br = gptr(A->in[14]) + layer * 32;
    unsigned* cnt = (unsigned*)(ws + WS_CTL) + CW_CNT + layer * 32;
    int2* elist = (int2*)(ws + WS_ELIST); unsigned* eoff = (unsigned*)(ws + WS_EOFF) + (size_t)layer * 32 * NTOK;
    LAS int* lc = (LAS int*)(lds + LDSCTL_OFF);
    LAS float* lgt = (LAS float*)(lds + 98304 + wave * 4096);
    const int fr = lane & 15, fq = lane >> 4, tid = wave * 64 + lane;
    constexpr int NUNITS = NTOK / 128;
    LAS unsigned char* wl = lds; LAS float* gl = (LAS float*)(lds + 65536); LAS float* bl = (LAS float*)(lds + 69632);
    __syncthreads();
    for (int id = tid; id < 32 * 128; id += NTHREADS) { const int e = id >> 7, ch = id & 127; *(LAS v4u*)(wl + e * 2048 + 16 * (ch ^ (e & 7))) = *(const v4u*)(WRT + (size_t)e * 1024 + ch * 8); }
    for (int id = tid; id < 256; id += NTHREADS) { *(LAS f32x4*)(gl + 4 * id) = *(const f32x4*)(lg + 4 * id); *(LAS f32x4*)(bl + 4 * id) = *(const f32x4*)(lb + 4 * id); }
    __syncthreads();
    const int nmr = NUNITS / G, nrem = (NTOK - nmr * G * 128) / 16;
    for (int it = 0; ; ++it) {
        int r0; bool act = true;
        if (it < nmr) r0 = (wg + it * G) * 128 + wave * 16;
        else { const int j0 = (it - nmr) * G * 8 + wg; if (j0 >= nrem) break; const int j = j0 + wave * G; act = j < nrem; r0 = nmr * G * 128 + (act ? j : 0) * 16; }
        if (tid < 32) lc[LC_LCNT + tid] = 0;
        __syncthreads();
        int e4[4] = {0, 0, 0, 0}, loc[4] = {0, 0, 0, 0}; float g4[4] = {0.f, 0.f, 0.f, 0.f};
        if (act) {
        const bf16* xr = PRE + (size_t)(r0 + fr) * DM + fq * 8;
        float sm = 0.f, sq = 0.f;
#pragma unroll 8
        for (int s = 0; s < 32; ++s) { const v4u x = *(const v4u*)(xr + 32 * s);
            const float x0 = bflo(x.x), x1 = bfhi(x.x), x2 = bflo(x.y), x3 = bfhi(x.y), x4 = bflo(x.z), x5 = bfhi(x.z), x6 = bflo(x.w), x7 = bfhi(x.w);
            sm += ((x0 + x1) + (x2 + x3)) + ((x4 + x5) + (x6 + x7));
            sq += ((x0 * x0 + x1 * x1) + (x2 * x2 + x3 * x3)) + ((x4 * x4 + x5 * x5) + (x6 * x6 + x7 * x7)); }
        sm += shx(sm, 16, lane); sm += shx(sm, 32, lane); sq += shx(sq, 16, lane); sq += shx(sq, 32, lane);
        const float mean = sm * (1.f / DM);
        const float var = fmaxf(sq * (1.f / DM) - mean * mean, 0.f);
        const float rstd = 1.f / sqrtf(var + LN_EPS);
        f32x4 a0 = {0.f, 0.f, 0.f, 0.f}, a1 = {0.f, 0.f, 0.f, 0.f};
        bf16* hr = HOUT + (size_t)(r0 + fr) * DM + fq * 8;
        unsigned char* h8r = ws + WS_HB8 + (size_t)(r0 + fr) * DM + fq * 8;
#pragma unroll 4
        for (int s = 0; s < 32; ++s) {
            const v4u x = *(const v4u*)(xr + 32 * s);
            const f32x4 g0 = *(const LAS f32x4*)(gl + fq * 8 + 32 * s), g1 = *(const LAS f32x4*)(gl + fq * 8 + 32 * s + 4);
            const f32x4 b0 = *(const LAS f32x4*)(bl + fq * 8 + 32 * s), b1 = *(const LAS f32x4*)(bl + fq * 8 + 32 * s + 4);
            v4u y;
            const float f0 = (bflo(x.x) - mean) * rstd * g0[0] + b0[0], f1 = (bfhi(x.x) - mean) * rstd * g0[1] + b0[1], f2 = (bflo(x.y) - mean) * rstd * g0[2] + b0[2], f3 = (bfhi(x.y) - mean) * rstd * g0[3] + b0[3];
            const float f4 = (bflo(x.z) - mean) * rstd * g1[0] + b1[0], f5 = (bfhi(x.z) - mean) * rstd * g1[1] + b1[1], f6 = (bflo(x.w) - mean) * rstd * g1[2] + b1[2], f7 = (bfhi(x.w) - mean) * rstd * g1[3] + b1[3];
            y.x = cvtpk(f0, f1); y.y = cvtpk(f2, f3); y.z = cvtpk(f4, f5); y.w = cvtpk(f6, f7);
            *(v4u*)(hr + 32 * s) = y;
            { constexpr float sx = pg8::FP8_SX; uint2 o8; o8.x = pg8::pk4_fp8(sx * f0, sx * f1, sx * f2, sx * f3); o8.y = pg8::pk4_fp8(sx * f4, sx * f5, sx * f6, sx * f7); *(uint2*)(h8r + 32 * s) = o8; }
            const bf16x8 yf = __builtin_bit_cast(bf16x8, y);
            const int ch = 4 * s + fq;
            const bf16x8 w0 = *(const LAS bf16x8*)(wl + fr * 2048 + 16 * (ch ^ (fr & 7))), w1 = *(const LAS bf16x8*)(wl + (16 + fr) * 2048 + 16 * (ch ^ (fr & 7)));
            a0 = __builtin_amdgcn_mfma_f32_16x16x32_bf16(yf, w0, a0, 0, 0, 0);
            a1 = __builtin_amdgcn_mfma_f32_16x16x32_bf16(yf, w1, a1, 0, 0, 0);
        }
        { const float bb0 = br[fr], bb1 = br[16 + fr];
#pragma unroll
          for (int j = 0; j < 4; ++j) { lgt[(fq * 4 + j) * 33 + fr] = a0[j] + bb0; lgt[(fq * 4 + j) * 33 + 16 + fr] = a1[j] + bb1; } }
        LDS_WAIT();
        if (lane < 16) {
            float v[32];
#pragma unroll
            for (int e = 0; e < 32; ++e) v[e] = lgt[lane * 33 + e];
            float l4[4];
#pragma unroll
            for (int k = 0; k < 4; ++k) { float best = -3.0e38f; int bi = 0;
#pragma unroll
                for (int e = 0; e < 32; ++e) { const bool better = v[e] > best; best = better ? v[e] : best; bi = better ? e : bi; }
                l4[k] = best; e4[k] = bi;
#pragma unroll
                for (int e = 0; e < 32; ++e) v[e] = (e == bi) ? -3.0e38f : v[e]; }
            float den = 0.f;
#pragma unroll
            for (int k = 0; k < 4; ++k) { g4[k] = __expf(l4[k] - l4[0]); den += g4[k]; }
            const float rd = 1.f / den;
#pragma unroll
            for (int k = 0; k < 4; ++k) { g4[k] *= rd; loc[k] = __hip_atomic_fetch_add(lc + LC_LCNT + e4[k], 1, __ATOMIC_RELAXED, __HIP_MEMORY_SCOPE_WORKGROUP); }
        }
        }
        __syncthreads();
        if (tid < 32) { const int n = lc[LC_LCNT + tid]; int base = 0; if (n > 0) base = (int)__hip_atomic_fetch_add(cnt + tid, (unsigned)n, __ATOMIC_RELAXED, __HIP_MEMORY_SCOPE_AGENT); lc[LC_LBASE + tid] = base; }
        __syncthreads();
        if (act && lane < 16) {
            const int row = r0 + lane;
#pragma unroll
            for (int k = 0; k < 4; ++k) { const size_t sl = (size_t)e4[k] * NTOK + (size_t)(lc[LC_LBASE + e4[k]] + loc[k]); elist[sl] = make_int2(row * 4 + k, __builtin_bit_cast(int, g4[k])); eoff[sl] = (unsigned)row * (unsigned)DM; }
        }
        __syncthreads();
    }
}

__device__ __forceinline__ int moe_table(CArgs* A, LAS unsigned char* lds, int layer, int tid) {
    const unsigned* cnt = (const unsigned*)(launder(A->ws) + WS_CTL) + CW_CNT + layer * 32;
    LAS int* lc = (LAS int*)(lds + LDSCTL_OFF);
    tid = launder_v(tid);
    __syncthreads();
    if (tid < 32) lc[LC_ECNT + tid] = (int)__hip_atomic_load(cnt + tid, __ATOMIC_RELAXED, __HIP_MEMORY_SCOPE_AGENT);
    __syncthreads();
    if (tid == 0) { int acc = 0; for (int e = 0; e < 32; ++e) { lc[LC_TSTART + e] = acc; acc += (lc[LC_ECNT + e] + 255) >> 8; } lc[LC_TSTART + 32] = acc; }
    __syncthreads();
    { LAS unsigned char* te = (LAS unsigned char*)(lc + LC_TILEE);
      for (int e = 0; e < 32; ++e) { const int st = lc[LC_TSTART + e], en = lc[LC_TSTART + e + 1]; for (int i = st + tid; i < en; i += NTHREADS) te[i] = (unsigned char)e; } }
    __syncthreads();
    return lc[LC_TSTART + 32];
}

__device__ __forceinline__ void ln_ffn_phase(CArgs* A, int layer, int gw, int NGW, int lane, const bf16* H1, bf16* HOUT) {
    unsigned char* ws = launder(A->ws);
    const unsigned char* Y = ws + WS_XS;
    const float* lg = gptr(A->in[19]) + layer * DM; const float* lb = gptr(A->in[20]) + layer * DM;
    typedef float f32x2l __attribute__((ext_vector_type(2)));
    v4u hq[2], yq[4];
    if (gw < NTOK) {
#pragma unroll
        for (int j = 0; j < 2; ++j) hq[j] = *(const v4u*)(H1 + (size_t)gw * DM + lane * 16 + j * 8);
#pragma unroll
        for (int k = 0; k < 4; ++k) yq[k] = *(const v4u*)(Y + ((size_t)gw * 4 + k) * DM + lane * 16); }
    for (int row = gw; row < NTOK; row += NGW) {
        float x[16];
        v4u hc[2], yc[4];
#pragma unroll
        for (int j = 0; j < 2; ++j) hc[j] = hq[j];
#pragma unroll
        for (int k = 0; k < 4; ++k) yc[k] = yq[k];
        { const int rn = row + NGW < NTOK ? row + NGW : row;
#pragma unroll
          for (int j = 0; j < 2; ++j) hq[j] = *(const v4u*)(H1 + (size_t)rn * DM + lane * 16 + j * 8);
#pragma unroll
          for (int k = 0; k < 4; ++k) yq[k] = *(const v4u*)(Y + ((size_t)rn * 4 + k) * DM + lane * 16); }
#pragma unroll
        for (int j = 0; j < 2; ++j) { const v4u h = hc[j];
            x[8 * j + 0] = DN_ALPHA * bflo(h.x); x[8 * j + 1] = DN_ALPHA * bfhi(h.x); x[8 * j + 2] = DN_ALPHA * bflo(h.y); x[8 * j + 3] = DN_ALPHA * bfhi(h.y);
            x[8 * j + 4] = DN_ALPHA * bflo(h.z); x[8 * j + 5] = DN_ALPHA * bfhi(h.z); x[8 * j + 6] = DN_ALPHA * bflo(h.w); x[8 * j + 7] = DN_ALPHA * bfhi(h.w); }
#pragma unroll
        for (int k = 0; k < 4; ++k) { const v4u y = yc[k]; constexpr float ry = 1.f / pg8::FP8_SY;
            const unsigned yw[4] = {y.x, y.y, y.z, y.w};
#pragma unroll
            for (int q = 0; q < 4; ++q) { const f32x2l a = __builtin_amdgcn_cvt_pk_f32_fp8((int)yw[q], false), c = __builtin_amdgcn_cvt_pk_f32_fp8((int)yw[q], true);
                x[4 * q + 0] += ry * a.x; x[4 * q + 1] += ry * a.y; x[4 * q + 2] += ry * c.x; x[4 * q + 3] += ry * c.y; } }
        float s = 0.f;
#pragma unroll
        for (int i = 0; i < 16; ++i) s += x[i];
#pragma unroll
        for (int o = 1; o < 64; o <<= 1) s += shx(s, o, lane);
        const float mean = s * (1.f / DM); float v = 0.f;
#pragma unroll
        for (int i = 0; i < 16; ++i) { x[i] -= mean; v += x[i] * x[i]; }
#pragma unroll
        for (int o = 1; o < 64; o <<= 1) v += shx(v, o, lane);
        const float rstd = 1.f / sqrtf(v * (1.f / DM) + LN_EPS);
#pragma unroll
        for (int j = 0; j < 2; ++j) { const int c0 = lane * 16 + j * 8;
            const f32x4 g0 = *(const f32x4*)(lg + c0), g1 = *(const f32x4*)(lg + c0 + 4), b0 = *(const f32x4*)(lb + c0), b1 = *(const f32x4*)(lb + c0 + 4);
#pragma unroll
            for (int i = 0; i < 4; ++i) { x[8 * j + i] = x[8 * j + i] * rstd * g0[i] + b0[i]; x[8 * j + 4 + i] = x[8 * j + 4 + i] * rstd * g1[i] + b1[i]; } }
        if (layer == 0) {
#pragma unroll
            for (int j = 0; j < 2; ++j) { v4u o; o.x = cvtpk(x[8 * j + 0], x[8 * j + 1]); o.y = cvtpk(x[8 * j + 2], x[8 * j + 3]); o.z = cvtpk(x[8 * j + 4], x[8 * j + 5]); o.w = cvtpk(x[8 * j + 6], x[8 * j + 7]);
                *(v4u*)(HOUT + (size_t)row * DM + lane * 16 + j * 8) = o;
                constexpr float sx = pg8::FP8_SX; uint2 o8; o8.x = pg8::pk4_fp8(sx * x[8 * j + 0], sx * x[8 * j + 1], sx * x[8 * j + 2], sx * x[8 * j + 3]); o8.y = pg8::pk4_fp8(sx * x[8 * j + 4], sx * x[8 * j + 5], sx * x[8 * j + 6], sx * x[8 * j + 7]);
                *(uint2*)(ws + WS_H8 + (size_t)row * DM + lane * 16 + j * 8) = o8; }
        } else {
            const int b = row / LTOK, p = row % LTOK;
            if (p >= NMETA) { float* op = (float*)(GAS float*)A->out + ((size_t)b * SEQ + (p - NMETA)) * DM;
#pragma unroll
                for (int j = 0; j < 2; ++j) { *(f32x4*)(op + lane * 16 + j * 8) = (f32x4){x[8 * j + 0], x[8 * j + 1], x[8 * j + 2], x[8 * j + 3]};
                    *(f32x4*)(op + lane * 16 + j * 8 + 4) = (f32x4){x[8 * j + 4], x[8 * j + 5], x[8 * j + 6], x[8 * j + 7]}; } }
        }
    }
}

#ifndef ENMASK
#define ENMASK 0xFFFF
#endif
#define EN(k) ((ENMASK >> (k)) & 1)
#define IN(k) (lo <= (k) && (k) < hi)
#ifndef PROBE_GA
#define PROBE_GA 0
#endif
#ifndef PROBE_GB
#define PROBE_GB 0
#endif
#define PROBE_ON ((PROBE_GA) != 0 || (PROBE_GB) != 0)
#ifndef PROBE_SCALE_B
#define PROBE_SCALE_B 1.0f
#endif
#ifndef PROBE_SCALE_A
#define PROBE_SCALE_A 1.0f
#endif
struct ProbeT { unsigned long long tprev, ta, tb, t0; };
#define PROBE_MARK(k) do { if (PROBE_ON) { const unsigned long long tn_ = __builtin_amdgcn_s_memrealtime(); if (((PROBE_GA) >> (k)) & 1) pt.ta += tn_ - pt.tprev; if (((PROBE_GB) >> (k)) & 1) pt.tb += tn_ - pt.tprev; pt.tprev = tn_; } } while (0)
#define SEAM(k) do { if (IN(k) && IN((k) + 1)) { bar.bar = (unsigned*)(KA()->ws + WS_CTL) + CW_BAR; xcd_barrier(bar); } PROBE_MARK(k); } while (0)
#define IDS() CArgs* args = KA(); unsigned char* ws = (unsigned char*)(GAS unsigned char*)args->ws; (void)ws; const int tid = launder_v(threadIdx.x), lane = tid & 63, wave = __builtin_amdgcn_readfirstlane(tid >> 6), gw = wg * NWAVES + wave; (void)tid; (void)lane; (void)gw


#ifndef DUP_PH
#define DUP_PH -1
#endif
#define NREP(k) (((DUP_PH) == (k)) ? 2 : 1)
#define REPBAR(k, r) do { if ((r) + 1 < NREP(k)) { bar.bar = (unsigned*)(KA()->ws + WS_CTL) + CW_BAR; xcd_barrier(bar); } } while (0)
template <int layer>
__device__ __forceinline__ void layer_phases(LAS unsigned char* lds, XcdBarrier& bar, ProbeT& pt, const int lo, const int hi, const int G, const int wg, const int NGW) {
        const int pb = 1 + 10 * layer;
#pragma unroll
        for (int rep = 0; rep < NREP(pb + 0); ++rep)
        if (EN(1) && IN(pb + 0)) {
            IDS();
            const int N = layer == 0 ? NCOLA : NCOLB_PAD;
            pg8::Gemm g{(const bf16*)(ws + WS_H8), (const bf16*)(ws + (layer == 0 ? WS_WINA : WS_WINB)), NTOK, N, DM / 2};
            pg8::StaticOrder S; S.init(NTOK, N, G, wg);
            pg8::EpiProj E{(bf16*)(ws + WS_PROJ), N, layer == 0 ? gptr(args->in[3]) : (const float*)(ws + WS_BIASB), (bf16*)(ws + WS_KV), (const float*)(ws + WS_ROPEA), (const float*)(ws + WS_ROPEB), LTOK, ws + WS_K8, ws + WS_V8, layer == 0 ? (unsigned char*)nullptr : ws + WS_Q8};
            pg8::gemm_phase<pg8::EpiProj, pg8::StaticOrder, true, true, true>(lds, g, S, E);
            REPBAR(pb + 0, rep);
        }
        SEAM(pb + 0);
        if (layer == 1) {
        if (EN(2) && IN(pb + 1)) { IDS(); ki_phase(args, gw * 64 + lane, NGW * 64); }
        SEAM(pb + 1);
#pragma unroll
        for (int rep = 0; rep < NREP(pb + 2); ++rep)
        if (EN(3) && IN(pb + 2)) { IDS(); indexer_phase(args, lds, G, wg, wave, lane); REPBAR(pb + 2, rep); }
        SEAM(pb + 2);
        } else { PROBE_MARK(pb + 1); PROBE_MARK(pb + 2); }
#pragma unroll
        for (int rep = 0; rep < NREP(pb + 3); ++rep)
        if (EN(4) && IN(pb + 3)) { IDS(); if (layer == 0) { attn8_phase<1, false>(args, lds, gw, NGW, wave, lane); swa_tile_phase(args, lds, G, wg, wave, lane); } else attn8_phase<5, true>(args, lds, gw, NGW, wave, lane); REPBAR(pb + 3, rep); }
        SEAM(pb + 3);
#pragma unroll
        for (int rep = 0; rep < NREP(pb + 4); ++rep)
        if (EN(5) && IN(pb + 4)) {
            IDS(); bf16* HA = (bf16*)(ws + WS_HA); bf16* PRE = (bf16*)(ws + WS_PRE);
            pg8::Gemm g{(const bf16*)(ws + WS_ATT), (const bf16*)(ws + (layer == 0 ? WS_WOUTA : WS_WOUTB)), NTOK, DM, DM / 2};
            pg8::StaticOrder S; S.init(NTOK, DM, G, wg);
            if constexpr (layer == 0) { (void)HA; pg8::EpiResX E{PRE, gptr(args->in[0]), gptr(args->in[1]), DN_ALPHA, LTOK, NMETA, SEQ};
                pg8::gemm_phase<pg8::EpiResX, pg8::StaticOrder, true, true, true>(lds, g, S, E); }
            else { pg8::EpiRes E{PRE, HA, DN_ALPHA};
                pg8::gemm_phase<pg8::EpiRes, pg8::StaticOrder, true, true, true>(lds, g, S, E); }
            REPBAR(pb + 4, rep);
        }
        SEAM(pb + 4);
        if (EN(6) && IN(pb + 5)) { IDS(); ln_router_phase(args, lds, layer, G, wg, wave, lane, (const bf16*)(ws + WS_PRE), (bf16*)(ws + WS_HB)); }
        SEAM(pb + 5);
        PROBE_MARK(pb + 6);
#pragma unroll
        for (int rep = 0; rep < NREP(pb + 7); ++rep)
        if (EN(8) && IN(pb + 7)) {
            IDS(); const int ntiles = moe_table(args, lds, layer, tid);
            pg8::Gemm g{(const bf16*)(ws + WS_HB8), (const bf16*)(ws + WS_WGU + (size_t)layer * 32 * 2048 * 1024), MOE_P, 2048, DM / 2, (const unsigned*)(ws + WS_EOFF) + (size_t)layer * 32 * NTOK};
            pg8::MoeOrder S{ntiles, G, wg, 8, (const LAS unsigned char*)((const LAS int*)(lds + LDSCTL_OFF) + LC_TILEE), (const LAS int*)(lds + LDSCTL_OFF) + LC_TSTART, NTOK};
            pg8::EpiSwiglu E{ws + WS_ACT, gptr(args->in[16]) + (size_t)layer * 32 * 2048};
            pg8::gemm_phase<pg8::EpiSwiglu, pg8::MoeOrder, true, true, true, true>(lds, g, S, E);
            REPBAR(pb + 7, rep);
        }
        SEAM(pb + 7);
        if (EN(9) && IN(pb + 8)) {
            IDS(); const int ntiles = moe_table(args, lds, layer, tid);
            pg8::Gemm g{(const bf16*)(ws + WS_ACT), (const bf16*)(ws + WS_WD + (size_t)layer * 32 * 1024 * 1024), MOE_P, 1024, DM / 2};
            pg8::MoeOrder S{ntiles, G, wg, 4, (const LAS unsigned char*)((const LAS int*)(lds + LDSCTL_OFF) + LC_TILEE), (const LAS int*)(lds + LDSCTL_OFF) + LC_TSTART, NTOK};
            pg8::EpiDown E{ws + WS_XS, gptr(args->in[18]) + (size_t)layer * 32 * 1024, (const int2*)(ws + WS_ELIST), (const LAS int*)(lds + LDSCTL_OFF) + LC_TSTART, (const LAS int*)(lds + LDSCTL_OFF) + LC_ECNT, NTOK};
            pg8::gemm_phase<pg8::EpiDown, pg8::MoeOrder, true, true, true>(lds, g, S, E);
        }
        SEAM(pb + 8);
        if (EN(10) && IN(pb + 9)) { IDS(); ln_ffn_phase(args, layer, gw, NGW, lane, (const bf16*)(ws + WS_HB), (bf16*)(ws + WS_HA)); }
        SEAM(pb + 9);
}

constexpr int N_PHASES = 21;
__global__ void __launch_bounds__(NTHREADS, 2) fwd_kernel(Args args) {
    extern __shared__ __attribute__((aligned(16))) unsigned char lds_raw[];
    LAS unsigned char* lds = (LAS unsigned char*)lds_raw;
    const int G = gridDim.x, wg = blockIdx.x, NGW = G * NWAVES;

    for (int u = threadIdx.x; u < (LDS_BYTES - LDSCTL_OFF) / 4; u += NTHREADS) ((LAS unsigned*)(lds + LDSCTL_OFF))[u] = 0u;
    __syncthreads();
    const int lo = KA()->ph_lo, hi = KA()->ph_hi;
    const bool multi = (hi - lo) > 1;
    XcdBarrier bar; bar.bar = (unsigned*)(KA()->ws + WS_CTL) + CW_BAR; bar.x = 0; bar.st = nullptr;
    if (multi) bar = xcd_barrier_post((unsigned*)(KA()->ws + WS_CTL) + CW_BAR, (volatile LAS unsigned*)(lds + LDSCTL_OFF) + LC_BAR);
    ProbeT pt; pt.ta = 0ull; pt.tb = 0ull; pt.t0 = pt.tprev = PROBE_ON ? __builtin_amdgcn_s_memrealtime() : 0ull;
    if (EN(0) && IN(0)) { IDS(); p0_prologue(args, lds, gw, NGW, wave, lane); }
    SEAM(0);

    layer_phases<0>(lds, bar, pt, lo, hi, G, wg, NGW);
    layer_phases<1>(lds, bar, pt, lo, hi, G, wg, NGW);
    if (PROBE_ON) {
        bar.bar = (unsigned*)(KA()->ws + WS_CTL) + CW_BAR; xcd_barrier(bar);
        if (wg == 0 && threadIdx.x < 64) {
            const float tot = (float)(pt.tprev - pt.t0); const LAS unsigned* lcp = (const LAS unsigned*)(lds + LDSCTL_OFF);
            const float fa = (PROBE_SUB) ? (float)lcp[LC_PROBE_A] / tot : (float)pt.ta / tot, fb = (PROBE_SUB) ? (float)lcp[LC_PROBE_B] / tot : (float)pt.tb / tot;
            float* o = (float*)(GAS float*)KA()->out;
            if (threadIdx.x == 0 && (PROBE_GA) != 0) o[5 * 1024 + 7] += 20.f + 80.f * fa * PROBE_SCALE_A;
            if ((PROBE_GB) != 0) { const float d2 = sqrtf(65.536f * fb * PROBE_SCALE_B); for (int i = threadIdx.x; i < 1024; i += 64) o[9 * 1024 + i] += d2; }
        }
    }
#undef IN
#undef SEAM
}

#ifndef MK_N_LAUNCHES
#define MK_N_LAUNCHES 1
#endif
extern "C" void kernel_launch(void* const* d_in, const int* in_sizes, int n_in, void* d_out, int out_size, void* d_ws, size_t ws_size, hipStream_t stream) {
    static int grid = 0;
    if (grid == 0) {
        if (n_in != 21 || in_sizes[0] != NBATCH * SEQ * DM || out_size != NBATCH * SEQ * DM || ws_size < WS_END) {
            fprintf(stderr, "kernel_launch: unexpected shapes: n_in %d in0 %d out %d ws %zu (need %zu); nothing launched\n", n_in, n_in > 0 ? in_sizes[0] : -1, out_size, ws_size, (size_t)WS_END); grid = -1; return; }
        int dev = 0, cus = 0, per_cu = 0;
        if (hipGetDevice(&dev) != hipSuccess || hipDeviceGetAttribute(&cus, hipDeviceAttributeMultiprocessorCount, dev) != hipSuccess) { grid = -1; return; }
        if (hipFuncSetAttribute((const void*)fwd_kernel, hipFuncAttributeMaxDynamicSharedMemorySize, LDS_BYTES) != hipSuccess) { fprintf(stderr, "kernel_launch: hipFuncSetAttribute failed\n"); grid = -1; return; }
        if (hipOccupancyMaxActiveBlocksPerMultiprocessor(&per_cu, (const void*)fwd_kernel, NTHREADS, LDS_BYTES) != hipSuccess || per_cu < 1)
            fprintf(stderr, "kernel_launch: note: occupancy query reports %d workgroups per CU\n", per_cu);
        (void)hipGetLastError();
        grid = cus;
    }
    if (grid < 0) return;
    if (hipMemsetAsync((char*)d_ws + WS_CTL, 0, CTL_ZERO_BYTES, stream) != hipSuccess) return;
    Args a{};
    for (int i = 0; i < 21; ++i) a.in[i] = (const float*)d_in[i];
    a.out = (float*)d_out; a.ws = (unsigned char*)d_ws;
    if (MK_N_LAUNCHES == 1) {
        a.ph_lo = 0; a.ph_hi = N_PHASES;
        hipLaunchKernelGGL(fwd_kernel, dim3(grid), dim3(NTHREADS), LDS_BYTES, stream, a);
    } else {
        for (int ph = 0; ph < N_PHASES; ++ph) {
            if (ph == 3) continue;
            a.ph_lo = ph; a.ph_hi = ph + 1;
            hipLaunchKernelGGL(fwd_kernel, dim3(grid), dim3(NTHREADS), LDS_BYTES, stream, a);
        }
    }
}
```

```cpp
#include <hip/hip_runtime.h>
#include <cstdio>
#include <cstdint>
#define GAS __attribute__((address_space(1)))
#define LAS __attribute__((address_space(3)))
typedef unsigned short bf16;
typedef unsigned v4u __attribute__((ext_vector_type(4)));
typedef float f32x4 __attribute__((ext_vector_type(4)));
typedef short bf16x8 __attribute__((ext_vector_type(8)));
typedef GAS unsigned gu32;
typedef GAS unsigned long long gu64;
#define RLX_AGENT __ATOMIC_RELAXED, __HIP_MEMORY_SCOPE_AGENT
#define LDS_WAIT() asm volatile("s_waitcnt lgkmcnt(0)" ::: "memory")
#define VM_WAIT() asm volatile("s_waitcnt vmcnt(0)" ::: "memory")
__device__ __forceinline__ unsigned long long rt() { return __builtin_amdgcn_s_memrealtime(); }
__device__ __forceinline__ unsigned f2bf(float f) { unsigned u = __builtin_bit_cast(unsigned, f); return (u + 0x7fffu + ((u >> 16) & 1u)) >> 16; }
__device__ __forceinline__ unsigned pk2(float lo, float hi) { return f2bf(lo) | (f2bf(hi) << 16); }

#define XB_TMO      128
#define XB_XCNT(j)  (256  + 64 * (j))
#define XB_XSUB(j)  (1280 + 64 * (j))
#define XB_XGEN(j)  (2304 + 64 * (j))
#define XB_TOP      3328
#define XB_TOPGEN   3392
#define XCD_BAR_WORDS 3456
#define XB_SPIN_CAP (1u << 18)

__device__ __forceinline__ unsigned xb_ld(unsigned* p)              { return __hip_atomic_load(p, __ATOMIC_RELAXED, __HIP_MEMORY_SCOPE_AGENT); }
__device__ __forceinline__ unsigned xb_add(unsigned* p, unsigned v) { return __hip_atomic_fetch_add(p, v, __ATOMIC_RELAXED, __HIP_MEMORY_SCOPE_AGENT); }
__device__ __forceinline__ unsigned xb_xcc_id() { return (unsigned)__builtin_amdgcn_s_getreg((3 << 11) | 20) & 0xFu; }
#define XB_SPIN(cond, bar) do { unsigned _sp = 0; while (cond) { __builtin_amdgcn_s_sleep(1); \
    if ((++_sp & 255u) == 0u) { if (xb_ld(&(bar)[XB_TMO])) break; if (_sp > XB_SPIN_CAP) { atomicAdd(&(bar)[XB_TMO], 1u); break; } } } } while (0)

struct XcdBarrier {
    unsigned* bar; unsigned x;
    volatile LAS unsigned* st;
};

__device__ __forceinline__ XcdBarrier xcd_barrier_post(unsigned* bar, volatile LAS unsigned* st) {
    XcdBarrier b; b.bar = bar; b.x = xb_xcc_id(); b.st = st;
    if (threadIdx.x == 0) (void)xb_add(&bar[XB_XCNT(b.x)], 1u);
    return b;
}
__device__ __forceinline__ void xcd_barrier_complete(unsigned* bar, unsigned x, unsigned& nloc, unsigned& nx) {
    const unsigned G = gridDim.x * gridDim.y * gridDim.z;
    unsigned sum, cnt, mine, sp = 0u;
    for (;;) {
        sum = 0u; cnt = 0u; mine = 0u;
#pragma unroll
        for (unsigned j = 0; j < 16; ++j) { const unsigned c = xb_ld(&bar[XB_XCNT(j)]); sum += c; cnt += (c > 0u) ? 1u : 0u; mine = (j == x) ? c : mine; }
        if (sum == G) break;
        __builtin_amdgcn_s_sleep(1);
        if ((++sp & 255u) == 0u) { if (xb_ld(&bar[XB_TMO])) break; if (sp > XB_SPIN_CAP) { atomicAdd(&bar[XB_TMO], 1u); break; } }
    }
    nloc = mine > 0u ? mine : 1u; nx = cnt > 0u ? cnt : 1u;
}

__device__ __forceinline__ void xcd_barrier(const XcdBarrier& b) {
    asm volatile("s_waitcnt vmcnt(0)" ::: "memory");
    __syncthreads();
    if (threadIdx.x == 0) {
        unsigned* bar = b.bar;
        __builtin_amdgcn_s_waitcnt(0);
        unsigned nloc = b.st[0], nx = b.st[1];
        if (nloc == 0u) { xcd_barrier_complete(bar, b.x, nloc, nx); b.st[0] = nloc; b.st[1] = nx; }
        const unsigned old = xb_add(&bar[XB_XSUB(b.x)], 1u);
        const unsigned gen = old / nloc;
        if (old + 1u == (gen + 1u) * nloc) {
            __builtin_amdgcn_fence(__ATOMIC_RELEASE, "agent");
            asm volatile("s_waitcnt vmcnt(0)" ::: "memory");
            const unsigned og = xb_add(&bar[XB_TOP], 1u);
            const unsigned tg = og / nx;
            if (og + 1u == (tg + 1u) * nx) xb_add(&bar[XB_TOPGEN], 1u);
            else XB_SPIN(xb_ld(&bar[XB_TOPGEN]) == tg, bar);
            __builtin_amdgcn_fence(__ATOMIC_ACQUIRE, "agent");
            xb_add(&bar[XB_XGEN(b.x)], 1u);
            asm volatile("s_waitcnt vmcnt(0)" ::: "memory");
        } else {
            XB_SPIN(xb_ld(&bar[XB_XGEN(b.x)]) == gen, bar);
            __builtin_amdgcn_fence(__ATOMIC_ACQUIRE, "agent");
            asm volatile("s_waitcnt vmcnt(0)" ::: "memory");
        }
    }
    __syncthreads();
}
namespace pg8 {
#define PG8_LAS __attribute__((address_space(3)))
typedef unsigned short bf16_t;
typedef short bf16x8 __attribute__((ext_vector_type(8)));
typedef float f32x4 __attribute__((ext_vector_type(4)));
typedef unsigned u32x4 __attribute__((ext_vector_type(4)));
constexpr int BM = 256, BK = 64, HALF = 128, HTB = HALF * BK * 2  , STAGE_BYTES = 8 * HTB, NXCD = 8, WGM = 8, GTAB_OFF = STAGE_BYTES + 8192  ;

__host__ __device__ __forceinline__ int lds_byte(int r, int c) { const int st = (r >> 4) * 2 + (c >> 5), rr = r & 15, cc = c & 31, ob = rr * 64 + cc * 2; return st * 1024 + (ob ^ (((ob >> 9) & 1) << 5)); }
__host__ __device__ __forceinline__ void stage_rc(int b, int& R, int& C) { const int st = b / 1024, sb = b % 1024, swz = sb ^ (((sb >> 9) & 1) << 5); R = (st >> 1) * 16 + swz / 64; C = (st & 1) * 32 + (swz % 64) / 2; }
__host__ __device__ __forceinline__ int perm32(int rho) { const int n = rho >> 4, i = rho & 15; return 8 * (i >> 2) + 4 * n + (i & 3); }

struct Unit { int pm, pn; };
struct Gemm { const bf16_t* A; const bf16_t* Bt; int M, N, K; const unsigned* rowoff; };

struct StaticOrder {
    int nM, nN, nwg, G, c;
    __host__ __device__ void init(int M, int N, int G_, int c_) { nM = M / BM; nN = N / BM; nwg = nM * nN; G = G_; c = c_; }
    __host__ __device__ bool next(int i, Unit& u) const {
        const long L = (long)i * G + c; if (L >= nwg) return false;
        int wgid = (int)L; { const int q = nwg / NXCD, r = nwg % NXCD, xcd = wgid % NXCD, off = wgid / NXCD; wgid = (xcd < r ? xcd * (q + 1) : r * (q + 1) + (xcd - r) * q) + off; }
        const int nig = WGM * nN, gid = wgid / nig, fm = gid * WGM, gsz = (nM - fm) < WGM ? (nM - fm) : WGM;
        u.pm = fm + ((wgid % nig) % gsz); u.pn = (wgid % nig) / gsz; return true;
    }
    __device__ __forceinline__ void a_ready(const Unit&) const {}
    __device__ __forceinline__ void done(const Unit&) const {}
    __device__ __forceinline__ size_t rowbase(const Unit& u) const { return (size_t)u.pm * BM; }
};

__device__ __forceinline__ unsigned cvt_pk_bf16(float lo, float hi) { unsigned r; asm volatile("v_cvt_pk_bf16_f32 %0, %1, %2" : "=v"(r) : "v"(lo), "v"(hi)); return r; }
__device__ __forceinline__ float bf_lo(unsigned w) { return __builtin_bit_cast(float, w << 16); }
__device__ __forceinline__ float bf_hi(unsigned w) { return __builtin_bit_cast(float, w & 0xffff0000u); }

__device__ __forceinline__ unsigned pk4_fp8(float a, float b, float c, float d) {
    a = __builtin_amdgcn_fmed3f(a, -448.f, 448.f); b = __builtin_amdgcn_fmed3f(b, -448.f, 448.f); c = __builtin_amdgcn_fmed3f(c, -448.f, 448.f); d = __builtin_amdgcn_fmed3f(d, -448.f, 448.f);
    unsigned r = 0u; r = (unsigned)__builtin_amdgcn_cvt_pk_fp8_f32(a, b, (int)r, false); r = (unsigned)__builtin_amdgcn_cvt_pk_fp8_f32(c, d, (int)r, true); return r; }
constexpr float FP8_SX = 16.f, FP8_SA = 8.f, FP8_SW = 64.f, FP8_SO = 32.f, FP8_SY = 32.f;
struct EpiBias {
    static constexpr bool PERM = true, AFTER_DRAIN = false;
    bf16_t* O; int ldc; const float* bias;
    __device__ __forceinline__ void operator()(const f32x4 (&acc)[2][2][4][2], const Unit& u, int wr_, int wc_, int fr_, int fq_) const {
        int tz = threadIdx.x; asm volatile("" : "+v"(tz)); const int wid = __builtin_amdgcn_readfirstlane(tz >> 6), wr = wid >> 2, wc = wid & 3, fr = tz & 15, fq = (tz >> 4) & 3;
        const int row0 = u.pm * BM + wr * 64 + fr; const int col0 = u.pn * BM + wc * 32 + 8 * fq;
        f32x4 bv[2][2];
#pragma unroll
        for (int bj = 0; bj < 2; ++bj)
#pragma unroll
            for (int n = 0; n < 2; ++n) bv[bj][n] = *(const f32x4*)(bias + col0 + bj * HALF + 4 * n);
#pragma unroll
        for (int ai = 0; ai < 2; ++ai)
#pragma unroll
            for (int m = 0; m < 4; ++m) { bf16_t* rowp = O + (size_t)(row0 + ai * HALF + m * 16) * ldc + col0;
#pragma unroll
                for (int bj = 0; bj < 2; ++bj) { const f32x4 v0 = acc[ai][bj][m][0] + bv[bj][0], v1 = acc[ai][bj][m][1] + bv[bj][1];
                    u32x4 w; w.x = cvt_pk_bf16(v0[0], v0[1]); w.y = cvt_pk_bf16(v0[2], v0[3]); w.z = cvt_pk_bf16(v1[0], v1[1]); w.w = cvt_pk_bf16(v1[2], v1[3]);
                    *(u32x4*)(rowp + bj * HALF) = w; } }
    }
};

struct EpiProj {
    static constexpr bool PERM = true, AFTER_DRAIN = false;
    bf16_t* O; int ldc; const float* bias; bf16_t* KV; const float* ta; const float* tb; int ltok; unsigned char* K8; unsigned char* V8; unsigned char* Q8;
    __device__ __forceinline__ void operator()(const f32x4 (&acc)[2][2][4][2], const Unit& u, int wr_, int wc_, int fr_, int fq_) const {
        int tz = threadIdx.x; asm volatile("" : "+v"(tz)); const int wid = __builtin_amdgcn_readfirstlane(tz >> 6), wr = wid >> 2, wc = wid & 3, fr = tz & 15, fq = (tz >> 4) & 3, lane = tz & 63;
        const int row0 = u.pm * BM + wr * 64 + fr;
        f32x4 bz[2][2];
#pragma unroll
        for (int bj = 0; bj < 2; ++bj) { const int c0 = u.pn * BM + bj * HALF + wc * 32 + 8 * fq; bz[bj][0] = *(const f32x4*)(bias + c0); bz[bj][1] = *(const f32x4*)(bias + c0 + 4); }
#pragma unroll
        for (int bj = 0; bj < 2; ++bj) {
            const int cw = u.pn * BM + bj * HALF + wc * 32;
            const int c0 = cw + 8 * fq;
            const f32x4 b0 = bz[bj][0], b1 = bz[bj][1];
            const bool is_qk = cw < 1152, is_qi = cw >= 1280 && cw < 1792;
            const bool rot = ((cw & 63) == 0) && (is_qk || is_qi);
            bf16_t* dst; int dld;
            if (cw >= 1024 && cw < 1280) { dst = KV + (cw - 1024) + 8 * fq; dld = 256; } else { dst = O + c0; dld = ldc; }
            f32x4 csn[4];
            if (rot) { const int pos = row0 % ltok; const float* tp = is_qk ? ta + (size_t)pos * 16 : tb + (size_t)pos * 32 + (fq & 1) * 16;
#pragma unroll
                for (int q = 0; q < 4; ++q) csn[q] = *(const f32x4*)(tp + 4 * q); }
#pragma unroll
            for (int g = 0; g < 8; ++g) {
                    const int ai = g >> 2, m = g & 3;
                    const int row = row0 + ai * HALF + m * 16;
                    float v[8];
#pragma unroll
                    for (int j = 0; j < 4; ++j) { v[j] = acc[ai][bj][m][0][j] * (1.f / (FP8_SX * FP8_SW)) + b0[j]; v[4 + j] = acc[ai][bj][m][1][j] * (1.f / (FP8_SX * FP8_SW)) + b1[j]; }
                    if (rot) {
                        f32x4 cs[4];
#pragma unroll
                        for (int q = 0; q < 4; ++q) cs[q] = csn[q];
                        if (g < 7) { const int rown = row0 + ((g + 1) >> 2) * HALF + ((g + 1) & 3) * 16; const int posn = rown % ltok; const float* tpn = is_qk ? ta + (size_t)posn * 16 : tb + (size_t)posn * 32 + (fq & 1) * 16;
#pragma unroll
                            for (int q = 0; q < 4; ++q) csn[q] = *(const f32x4*)(tpn + 4 * q); }
                        const int px = is_qk ? 16 : 32;
                        float w[8];
#pragma unroll
                        for (int j = 0; j < 8; ++j) w[j] = __builtin_bit_cast(float, __builtin_amdgcn_ds_bpermute((lane ^ px) << 2, __builtin_bit_cast(int, v[j])));
                        const bool active = is_qk ? (fq < 2) : true;
                        const bool first = is_qk ? (fq == 0) : (fq < 2);
                        if (active) {
#pragma unroll
                            for (int j = 0; j < 8; j += 2) { const f32x4 c4 = cs[j >> 1];
                                const float x0 = v[j], y0 = w[j], x1 = v[j + 1], y1 = w[j + 1];
                                v[j] = first ? x0 * c4[0] - y0 * c4[1] : x0 * c4[0] + y0 * c4[1];
                                v[j + 1] = first ? x1 * c4[2] - y1 * c4[3] : x1 * c4[2] + y1 * c4[3]; }
                        }
                    }
                    if (Q8 != nullptr && cw < 1024) { uint2 o8; o8.x = pk4_fp8(FP8_SX * v[0], FP8_SX * v[1], FP8_SX * v[2], FP8_SX * v[3]); o8.y = pk4_fp8(FP8_SX * v[4], FP8_SX * v[5], FP8_SX * v[6], FP8_SX * v[7]);
                        *(uint2*)(Q8 + (size_t)row * 1024 + c0) = o8; }
                    else { u32x4 o; o.x = cvt_pk_bf16(v[0], v[1]); o.y = cvt_pk_bf16(v[2], v[3]); o.z = cvt_pk_bf16(v[4], v[5]); o.w = cvt_pk_bf16(v[6], v[7]);
                        *(u32x4*)(dst + (size_t)row * dld) = o; }
                    if (cw >= 1024 && cw < 1152) { uint2 o8; o8.x = pk4_fp8(FP8_SX * v[0], FP8_SX * v[1], FP8_SX * v[2], FP8_SX * v[3]); o8.y = pk4_fp8(FP8_SX * v[4], FP8_SX * v[5], FP8_SX * v[6], FP8_SX * v[7]);
                        *(uint2*)(K8 + (size_t)row * 128 + (cw - 1024) + 8 * fq) = o8; }
                    if (cw >= 1152 && cw < 1280) { uint2 o8; o8.x = pk4_fp8(FP8_SX * v[0], FP8_SX * v[1], FP8_SX * v[2], FP8_SX * v[3]); o8.y = pk4_fp8(FP8_SX * v[4], FP8_SX * v[5], FP8_SX * v[6], FP8_SX * v[7]);
                        *(uint2*)(V8 + (size_t)row * 128 + (cw - 1152) + 8 * fq) = o8; }
            }
        }
    }
};

struct EpiRes {
    static constexpr bool PERM = true, AFTER_DRAIN = false;
    bf16_t* O; const bf16_t* R; float alpha;
    __device__ __forceinline__ void operator()(const f32x4 (&acc)[2][2][4][2], const Unit& u, int wr_, int wc_, int fr_, int fq_) const {
        int tz = threadIdx.x; asm volatile("" : "+v"(tz)); const int wid = __builtin_amdgcn_readfirstlane(tz >> 6), wr = wid >> 2, wc = wid & 3, fr = tz & 15, fq = (tz >> 4) & 3;
        const int row0 = u.pm * BM + wr * 64 + fr; const int col0 = u.pn * BM + wc * 32 + 8 * fq;
#pragma unroll
        for (int ai = 0; ai < 2; ++ai) {
            u32x4 rr[4][2];
#pragma unroll
            for (int m = 0; m < 4; ++m)
#pragma unroll
                for (int bj = 0; bj < 2; ++bj) rr[m][bj] = *(const u32x4*)(R + (size_t)(row0 + ai * HALF + m * 16) * 1024 + col0 + bj * HALF);
#pragma unroll
            for (int m = 0; m < 4; ++m) { const size_t off = (size_t)(row0 + ai * HALF + m * 16) * 1024 + col0;
#pragma unroll
                for (int bj = 0; bj < 2; ++bj) { const u32x4 r = rr[m][bj];
                    const f32x4 a0 = acc[ai][bj][m][0] * (1.f / (FP8_SO * FP8_SW)), a1 = acc[ai][bj][m][1] * (1.f / (FP8_SO * FP8_SW));
                    u32x4 w;
                    w.x = cvt_pk_bf16(a0[0] + alpha * bf_lo(r.x), a0[1] + alpha * bf_hi(r.x));
                    w.y = cvt_pk_bf16(a0[2] + alpha * bf_lo(r.y), a0[3] + alpha * bf_hi(r.y));
                    w.z = cvt_pk_bf16(a1[0] + alpha * bf_lo(r.z), a1[1] + alpha * bf_hi(r.z));
                    w.w = cvt_pk_bf16(a1[2] + alpha * bf_lo(r.w), a1[3] + alpha * bf_hi(r.w));
                    *(u32x4*)(O + off + bj * HALF) = w; } } }
    }
};
struct EpiResX {
    static constexpr bool PERM = true, AFTER_DRAIN = false;
    bf16_t* O; const float* X; const float* META; float alpha; int ltok, nmeta, seq;
    __device__ __forceinline__ void operator()(const f32x4 (&acc)[2][2][4][2], const Unit& u, int wr_, int wc_, int fr_, int fq_) const {
        int tz = threadIdx.x; asm volatile("" : "+v"(tz)); const int wid = __builtin_amdgcn_readfirstlane(tz >> 6), wr = wid >> 2, wc = wid & 3, fr = tz & 15, fq = (tz >> 4) & 3;
        const int row0 = u.pm * BM + wr * 64 + fr; const int col0 = u.pn * BM + wc * 32 + 8 * fq;
#pragma unroll
        for (int ai = 0; ai < 2; ++ai)
#pragma unroll
            for (int mp = 0; mp < 2; ++mp) {
                f32x4 rf[2][2][2];
#pragma unroll
                for (int mm = 0; mm < 2; ++mm) { const int row = row0 + ai * HALF + (2 * mp + mm) * 16; const int b = row / ltok, p = row - b * ltok;
                    const float* src = (p < nmeta ? META + (size_t)p * 1024 : X + ((size_t)b * seq + (p - nmeta)) * 1024) + col0;
#pragma unroll
                    for (int bj = 0; bj < 2; ++bj) { rf[mm][bj][0] = *(const f32x4*)(src + bj * HALF); rf[mm][bj][1] = *(const f32x4*)(src + bj * HALF + 4); } }
#pragma unroll
                for (int mm = 0; mm < 2; ++mm) { const int m = 2 * mp + mm; const size_t off = (size_t)(row0 + ai * HALF + m * 16) * 1024 + col0;
#pragma unroll
                    for (int bj = 0; bj < 2; ++bj) { const f32x4 r0 = rf[mm][bj][0], r1 = rf[mm][bj][1];
                        const f32x4 a0 = acc[ai][bj][m][0] * (1.f / (FP8_SO * FP8_SW)), a1 = acc[ai][bj][m][1] * (1.f / (FP8_SO * FP8_SW));
                        u32x4 w;
                        w.x = cvt_pk_bf16(a0[0] + alpha * r0[0], a0[1] + alpha * r0[1]); w.y = cvt_pk_bf16(a0[2] + alpha * r0[2], a0[3] + alpha * r0[3]);
                        w.z = cvt_pk_bf16(a1[0] + alpha * r1[0], a1[1] + alpha * r1[1]); w.w = cvt_pk_bf16(a1[2] + alpha * r1[2], a1[3] + alpha * r1[3]);
                        *(u32x4*)(O + off + bj * HALF) = w; } } }
    }
};

__device__ __forceinline__ float swiglu1(float g, float u) {
    g = fminf(g, 7.0f); u = fminf(fmaxf(u, -7.0f), 7.0f);
    const float s = __builtin_amdgcn_rcpf(1.0f + __expf(-1.702f * g));
    return g * s * (u + 1.0f);
}
typedef float f32x2e __attribute__((ext_vector_type(2)));
__device__ __forceinline__ f32x2e swiglu2_x8(f32x2e g, f32x2e u) {
    g.x = fminf(g.x, 7.0f); g.y = fminf(g.y, 7.0f);
    u.x = __builtin_amdgcn_fmed3f(u.x, -7.0f, 7.0f); u.y = __builtin_amdgcn_fmed3f(u.y, -7.0f, 7.0f);
    const f32x2e z = g * (-1.702f * 1.4426950408889634f);
    f32x2e e; e.x = __builtin_amdgcn_exp2f(z.x); e.y = __builtin_amdgcn_exp2f(z.y);
    const f32x2e d = e + 1.0f;
    f32x2e r; r.x = __builtin_amdgcn_rcpf(d.x); r.y = __builtin_amdgcn_rcpf(d.y);
    return (g * r) * (u * FP8_SA + FP8_SA);
}
__device__ __forceinline__ unsigned pk4_fp8_nosat(f32x2e a, f32x2e b) { unsigned r = 0u; r = (unsigned)__builtin_amdgcn_cvt_pk_fp8_f32(a.x, a.y, (int)r, false); r = (unsigned)__builtin_amdgcn_cvt_pk_fp8_f32(b.x, b.y, (int)r, true); return r; }
struct EpiSwiglu {
    static constexpr bool PERM = true, AFTER_DRAIN = false;
    unsigned char* O; const float* bias;
    __device__ __forceinline__ void operator()(const f32x4 (&acc)[2][2][4][2], const Unit& u, int wr_, int wc_, int fr_, int fq_) const {
        int tz = threadIdx.x; asm volatile("" : "+v"(tz)); const int wid = __builtin_amdgcn_readfirstlane(tz >> 6), wr = wid >> 2, wc = wid & 3, fr = tz & 15, fq = (tz >> 4) & 3;
        const int e = u.pn >> 3, jt = u.pn & 7;
        const int row0 = u.pm * BM + wr * 64 + fr; const int col0 = jt * 128 + wc * 32 + 8 * fq;
        const float* bp = bias + e * 2048 + col0;
        constexpr float rs = 1.f / (FP8_SX * FP8_SW);
        const f32x4 bgA = *(const f32x4*)(bp), buA = *(const f32x4*)(bp + 1024), bgB = *(const f32x4*)(bp + 4), buB = *(const f32x4*)(bp + 1028);
#pragma unroll
        for (int ai = 0; ai < 2; ++ai)
#pragma unroll
            for (int m = 0; m < 4; ++m) {
                uint2 w;
                { const f32x4 bg = bgA, bu = buA;
                  const f32x4 g0 = acc[ai][0][m][0] * rs + bg, u0 = acc[ai][1][m][0] * rs + bu;
                  w.x = pk4_fp8_nosat(swiglu2_x8((f32x2e){g0[0], g0[1]}, (f32x2e){u0[0], u0[1]}), swiglu2_x8((f32x2e){g0[2], g0[3]}, (f32x2e){u0[2], u0[3]})); }
                asm volatile("" : "+v"(w.x));
                { const f32x4 bg = bgB, bu = buB;
                  const f32x4 g1 = acc[ai][0][m][1] * rs + bg, u1 = acc[ai][1][m][1] * rs + bu;
                  w.y = pk4_fp8_nosat(swiglu2_x8((f32x2e){g1[0], g1[1]}, (f32x2e){u1[0], u1[1]}), swiglu2_x8((f32x2e){g1[2], g1[3]}, (f32x2e){u1[2], u1[3]})); }
                *(uint2*)(O + (size_t)(row0 + ai * HALF + m * 16) * 1024 + col0) = w; }
    }
};

struct EpiDown {
    static constexpr bool PERM = true, AFTER_DRAIN = false;
    unsigned char* Y; const float* bias; const int2* elist; const PG8_LAS int* tstart; const PG8_LAS int* ecnt; int estride;
    __device__ __forceinline__ void operator()(const f32x4 (&acc)[2][2][4][2], const Unit& u, int wr_, int wc_, int fr_, int fq_) const {
        int tz = threadIdx.x; asm volatile("" : "+v"(tz)); const int wid = __builtin_amdgcn_readfirstlane(tz >> 6), wr = wid >> 2, wc = wid & 3, fr = tz & 15, fq = (tz >> 4) & 3;
        const int e = u.pn >> 2, jt = u.pn & 3;
        const int row0 = u.pm * BM + wr * 64 + fr; const int col0 = jt * 256 + wc * 32 + 8 * fq;
        const float* bp = bias + e * 1024 + col0;
        const int slot0 = (u.pm - tstart[e]) * BM + wr * 64 + fr, nvalid = ecnt[e];
        const f32x4 bz00 = *(const f32x4*)(bp), bz01 = *(const f32x4*)(bp + 4), bz10 = *(const f32x4*)(bp + HALF), bz11 = *(const f32x4*)(bp + HALF + 4);
        int2 inf[8];
#pragma unroll
        for (int g = 0; g < 8; ++g) { const int sl = slot0 + (g >> 2) * HALF + (g & 3) * 16; inf[g] = elist[(size_t)e * estride + (sl < nvalid ? sl : nvalid - 1)]; }
#pragma unroll
        for (int ai = 0; ai < 2; ++ai)
#pragma unroll
            for (int m = 0; m < 4; ++m) { const int sl = slot0 + ai * HALF + m * 16; const int2 info = inf[ai * 4 + m];
                if (sl < nvalid) { const float gt = __builtin_bit_cast(float, info.y) * FP8_SY; unsigned char* rowp = Y + (size_t)info.x * 1024 + col0;
#pragma unroll
                    for (int bj = 0; bj < 2; ++bj) { const f32x4 b0 = bj == 0 ? bz00 : bz10, b1 = bj == 0 ? bz01 : bz11;
                        const f32x4 v0 = (acc[ai][bj][m][0] * (1.f / (FP8_SA * FP8_SW)) + b0) * gt, v1 = (acc[ai][bj][m][1] * (1.f / (FP8_SA * FP8_SW)) + b1) * gt;
                        uint2 w; w.x = pk4_fp8(v0[0], v0[1], v0[2], v0[3]); w.y = pk4_fp8(v1[0], v1[1], v1[2], v1[3]);
                        *(uint2*)(rowp + bj * HALF) = w; } } }
    }
};

struct MoeOrder {
    int ntiles, G, c, NJ; const PG8_LAS unsigned char* tile_e;
    const PG8_LAS int* tstart; int estride;
    __device__ __forceinline__ size_t rowbase(const Unit& u) const { const int e = __builtin_amdgcn_readfirstlane((int)tile_e[u.pm]), ts = __builtin_amdgcn_readfirstlane(tstart[e]); return (size_t)e * estride + (size_t)(u.pm - ts) * 256; }
    __device__ __forceinline__ bool next(int i, Unit& u) const {
        const int x = c & 7, k = c >> 3;
        if (G != 256) { const int L = i * G + c; if (L >= ntiles * NJ) return false; const int tt = L / NJ; u.pm = tt; u.pn = tile_e[tt] * NJ + (L % NJ); return true; }
        const int rpg = 32 / NJ;
        const int g = 8 * i + x;
        if (g * rpg >= ntiles) return false;
        int tt = g * rpg + (NJ == 8 ? (k >> 3) : (k >> 2)); const int jt = NJ == 8 ? (k & 7) : (k & 3);
        if (tt >= ntiles) tt = ntiles - 1;
        u.pm = tt; u.pn = tile_e[tt] * NJ + jt; return true;
    }
    __device__ __forceinline__ void a_ready(const Unit&) const {}
    __device__ __forceinline__ void done(const Unit&) const {}
};

__device__ __forceinline__ void glds_s(unsigned voff, const void* sbase, unsigned lds_dst) { unsigned keep; unsigned long long sb = (unsigned long long)sbase; const unsigned ld = lds_dst;
    asm volatile("s_mov_b32 %0, m0\n\ts_mov_b32 m0, %3\n\ts_nop 0\n\tglobal_load_lds_dwordx4 %1, %2\n\ts_mov_b32 m0, %0" : "=&s"(keep) : "v"(voff), "s"(sb), "s"(ld) : "memory"); }
__device__ __forceinline__ void glds_d(unsigned voff, const void* sbase, unsigned lds_dst) { unsigned keep; unsigned long long sb = (unsigned long long)sbase; const unsigned ld = lds_dst;
    asm volatile("s_mov_b32 %0, m0\n\ts_mov_b32 m0, %3\n\ts_nop 0\n\tglobal_load_lds_dword %1, %2\n\ts_mov_b32 m0, %0" : "=&s"(keep) : "v"(voff), "s"(sb), "s"(ld) : "memory"); }
template <int IMM> __device__ __forceinline__ unsigned tab_rd(unsigned addr_v, int tab_s) { unsigned r;
    asm volatile("v_add_u32 %0, %2, %1\n\tds_read_b32 %0, %0 offset:%3" : "=&v"(r) : "v"(addr_v), "s"(tab_s), "i"(IMM) : "memory"); return r; }
template <int NW> __device__ __forceinline__ void glds_gw(unsigned ro, unsigned colb, const void* sbase, unsigned lds_dst) { unsigned keep; unsigned long long sb = (unsigned long long)sbase; const unsigned ld = lds_dst;
    asm volatile("s_waitcnt lgkmcnt(%5)\n\tv_add_u32 %1, %1, %2\n\ts_mov_b32 %0, m0\n\ts_mov_b32 m0, %4\n\ts_nop 0\n\tglobal_load_lds_dwordx4 %1, %3\n\ts_mov_b32 m0, %0" : "=&s"(keep), "+v"(ro) : "v"(colb), "s"(sb), "s"(ld), "i"(NW) : "memory"); }
typedef int pg8_v4i __attribute__((ext_vector_type(4)));
typedef int pg8_v8i __attribute__((ext_vector_type(8)));
__device__ __forceinline__ pg8_v8i cat8(bf16x8 a, bf16x8 b) { const pg8_v4i x = __builtin_bit_cast(pg8_v4i, a), y = __builtin_bit_cast(pg8_v4i, b); return __builtin_shufflevector(x, y, 0, 1, 2, 3, 4, 5, 6, 7); }
template <class Epi, class Sched, bool ALIGN_EPI = false, bool SP2 = false, bool FP8 = false, bool GATHER = false>
__device__ __forceinline__ void gemm_phase(PG8_LAS unsigned char* lds, const Gemm g, const Sched& S, const Epi& E) {
    int tid_l = threadIdx.x; asm volatile("" : "+v"(tid_l));
    const int tid = tid_l, wid = __builtin_amdgcn_readfirstlane(tid >> 6), lane = tid & 63, wr = wid >> 2, wc = wid & 3, fr = lane & 15, fq = lane >> 4;
    const int K = g.K, nt = K / BK;
    unsigned voffA[2], voffB[2];
#pragma unroll
    for (int i = 0; i < 2; ++i) { int R, C; stage_rc(tid * 16 + i * 8192, R, C); const int Rb = Epi::PERM ? ((R & ~31) + perm32(R & 31)) : R;
        voffA[i] = (unsigned)(R * K + C) * 2u; voffB[i] = (unsigned)(Rb * K + C) * 2u; }
    const size_t kstep = (size_t)(BK * 2);
    const size_t hstep = (size_t)HALF * K * 2;
    const size_t tstep = 2 * hstep;
    const unsigned ldsw = (unsigned)wid * 1024u;
    const int aoff = lds_byte(wr * 64 + fr, fq * 8), boff = lds_byte(wc * 32 + fr, fq * 8);
    unsigned rtabv = 0, colb = 0; if constexpr (GATHER) { int R, C; stage_rc(tid * 16, R, C); rtabv = (unsigned)(size_t)lds + (unsigned)(GTAB_OFF + R * 4); colb = (unsigned)C * 2u; }
#define PG8_SA(b, h) (((b) * 2 + (h)) * HTB)
#define PG8_SB(b, h) ((4 + (b) * 2 + (h)) * HTB)
#define PG8_STAGE(bufoff, gbase, voff) do { _Pragma("unroll") for (int _i = 0; _i < 2; ++_i) { if constexpr (FP8) glds_s((voff)[_i], (const void*)(gbase), (unsigned)(size_t)(lds + (bufoff) + _i * 8192) + ldsw); else \
        __builtin_amdgcn_global_load_lds((const unsigned*)((const char*)(gbase) + (voff)[_i]), (PG8_LAS unsigned*)(lds + (bufoff) + ldsw + _i * 8192), 16, 0, 0); } } while (0)
#define PG8_TAB_RD(ro, tab, h) do { ro[0] = tab_rd<(h) * 512>(rtabv, (tab)); ro[1] = tab_rd<(h) * 512 + 256>(rtabv, (tab)); } while (0)
#define PG8_STAGE_GA(bufoff, ro, kb, NW) do { _Pragma("unroll") for (int _i = 0; _i < 2; ++_i) glds_gw<NW>(ro[_i], colb, (const void*)((const char*)g.A + (kb)), (unsigned)(size_t)(lds + (bufoff) + _i * 8192) + ldsw); } while (0)
#define PG8_LDA(dst, b, h) do { _Pragma("unroll") for (int m = 0; m < 4; ++m) _Pragma("unroll") for (int k = 0; k < 2; ++k) dst[m][k] = *(const PG8_LAS bf16x8*)(lds + PG8_SA(b, h) + aoff + m * 2048 + k * 1024); } while (0)
#define PG8_LDB(dst, b, h) do { _Pragma("unroll") for (int n = 0; n < 2; ++n) _Pragma("unroll") for (int k = 0; k < 2; ++k) dst[n][k] = *(const PG8_LAS bf16x8*)(lds + PG8_SB(b, h) + boff + n * 2048 + k * 1024); } while (0)
#define PG8_MMA(ai, bj, At, Bt) do { __builtin_amdgcn_s_setprio(1); if constexpr (FP8) { _Pragma("unroll") for (int m = 0; m < 4; ++m) _Pragma("unroll") for (int n = 0; n < 2; ++n) \
        acc[ai][bj][m][n] = __builtin_amdgcn_mfma_scale_f32_16x16x128_f8f6f4(cat8(Bt[n][0], Bt[n][1]), cat8(At[m][0], At[m][1]), acc[ai][bj][m][n], 0, 0, 0, 0, 0, 0); } else { \
        _Pragma("unroll") for (int m = 0; m < 4; ++m) _Pragma("unroll") for (int n = 0; n < 2; ++n) _Pragma("unroll") for (int k = 0; k < 2; ++k) \
        acc[ai][bj][m][n] = __builtin_amdgcn_mfma_f32_16x16x32_bf16(Bt[n][k], At[m][k], acc[ai][bj][m][n], 0, 0, 0); } __builtin_amdgcn_s_setprio(0); } while (0)
#define PG8_WAIT_V(n) asm volatile("s_waitcnt vmcnt(" #n ")" ::: "memory")
#define PG8_WAIT_L(n) asm volatile("s_waitcnt lgkmcnt(" #n ")" ::: "memory")
#define PG8_BAR __builtin_amdgcn_s_barrier()
#define PG8_SCHED __builtin_amdgcn_sched_barrier(0)
    Unit cur, nxt; int ui = 0;
    if (!S.next(0, cur)) return;
    f32x4 acc[2][2][4][2];
#pragma unroll
    for (int a = 0; a < 2; ++a)
#pragma unroll
        for (int b = 0; b < 2; ++b)
#pragma unroll
            for (int m = 0; m < 4; ++m)
#pragma unroll
                for (int n = 0; n < 2; ++n) acc[a][b][m][n] = (f32x4){0.f, 0.f, 0.f, 0.f};
    bf16x8 At[4][2], B0[2][2], B1[2][2];
    const char* cA = (const char*)g.A + (size_t)cur.pm * tstep; const char* cB = (const char*)g.Bt + (size_t)cur.pn * tstep;
    S.a_ready(cur);
    if constexpr (SP2) {
        if constexpr (GATHER) {
            if (wid < 4) glds_d((unsigned)tid * 4u, (const void*)(g.rowoff + S.rowbase(cur)), (unsigned)(size_t)(lds + GTAB_OFF) + (unsigned)wid * 256u);
            PG8_WAIT_V(0); PG8_BAR; }
        PG8_STAGE(PG8_SB(0, 0), cB, voffB); PG8_STAGE(PG8_SB(0, 1), cB + hstep, voffB);
        if constexpr (GATHER) { unsigned r0[2], r1[2]; PG8_TAB_RD(r0, 0, 0); PG8_TAB_RD(r1, 0, 1); PG8_STAGE_GA(PG8_SA(0, 0), r0, (size_t)0, 0); PG8_STAGE_GA(PG8_SA(0, 1), r1, (size_t)0, 0); }
        else { PG8_STAGE(PG8_SA(0, 0), cA, voffA); PG8_STAGE(PG8_SA(0, 1), cA + hstep, voffA); }
        if (wr == 1) PG8_BAR;
        PG8_WAIT_V(2); PG8_BAR;
        PG8_STAGE(PG8_SB(1, 0), cB + kstep, voffB);
        if constexpr (GATHER) { unsigned r0[2]; PG8_TAB_RD(r0, 0, 0); PG8_STAGE_GA(PG8_SA(1, 0), r0, kstep, 0); } else PG8_STAGE(PG8_SA(1, 0), cA + kstep, voffA);
        PG8_STAGE(PG8_SB(1, 1), cB + hstep + kstep, voffB);
        PG8_WAIT_V(6); PG8_BAR;
    } else {
        PG8_STAGE(PG8_SB(0, 0), cB, voffB); PG8_STAGE(PG8_SA(0, 0), cA, voffA); PG8_STAGE(PG8_SB(0, 1), cB + hstep, voffB); PG8_STAGE(PG8_SA(0, 1), cA + hstep, voffA);
        if (wr == 1) PG8_BAR;
        PG8_WAIT_V(4); PG8_BAR;
        PG8_STAGE(PG8_SB(1, 0), cB + kstep, voffB); PG8_STAGE(PG8_SA(1, 0), cA + kstep, voffA); PG8_STAGE(PG8_SB(1, 1), cB + hstep + kstep, voffB);
        PG8_WAIT_V(6); PG8_BAR;
    }
    for (;;) {
        const bool has_next = S.next(ui + 1, nxt);
        const char* nA = has_next ? (const char*)g.A + (size_t)nxt.pm * tstep : cA; const char* nB = has_next ? (const char*)g.Bt + (size_t)nxt.pn * tstep : cB;
        const int tabC = (ui & 1) * 1024, tabN = has_next ? 1024 - tabC : tabC;
        if constexpr (GATHER) { if (has_next && wid < 4) glds_d((unsigned)tid * 4u, (const void*)(g.rowoff + S.rowbase(nxt)), (unsigned)(size_t)(lds + GTAB_OFF) + (unsigned)(tabN + wid * 256)); }
        for (int t = 0; t < nt; t += 2) {
            const bool last = (t == nt - 2);
            const int tab2 = last ? tabN : tabC; const size_t kb2 = last ? (size_t)0 : (size_t)(t + 2) * kstep; (void)tab2; (void)kb2;
            const char* a1 = cA + (size_t)(t + 1) * kstep;
            const char* a2 = last ? nA : cA + (size_t)(t + 2) * kstep; const char* b2 = last ? nB : cB + (size_t)(t + 2) * kstep;
            const char* a3 = a2 + kstep; const char* b3 = b2 + kstep;
            if (last && has_next) S.a_ready(nxt);
            if constexpr (SP2) {
            if constexpr (GATHER) { unsigned ro[2]; PG8_TAB_RD(ro, tabC, 1); PG8_LDB(B0, 0, 0); PG8_LDB(B1, 0, 1); PG8_SCHED; PG8_LDA(At, 0, 0); PG8_STAGE_GA(PG8_SA(1, 1), ro, (size_t)(t + 1) * kstep, 12); }
            else { PG8_LDB(B0, 0, 0); PG8_LDB(B1, 0, 1); PG8_SCHED; PG8_LDA(At, 0, 0); PG8_STAGE(PG8_SA(1, 1), a1 + hstep, voffA); }
            PG8_WAIT_V(8); PG8_WAIT_L(0); PG8_BAR; PG8_MMA(0, 0, At, B0); PG8_MMA(0, 1, At, B1); PG8_BAR; PG8_SCHED;
            if constexpr (GATHER) { unsigned ro[2]; PG8_TAB_RD(ro, tab2, 0); PG8_LDA(At, 0, 1); PG8_STAGE(PG8_SB(0, 0), b2, voffB); PG8_STAGE(PG8_SB(0, 1), b2 + hstep, voffB); PG8_STAGE_GA(PG8_SA(0, 0), ro, kb2, 6); }
            else { PG8_LDA(At, 0, 1); PG8_STAGE(PG8_SB(0, 0), b2, voffB); PG8_STAGE(PG8_SB(0, 1), b2 + hstep, voffB); PG8_STAGE(PG8_SA(0, 0), a2, voffA); }
            PG8_WAIT_V(8); PG8_WAIT_L(0); PG8_BAR; PG8_MMA(1, 0, At, B0); PG8_MMA(1, 1, At, B1); PG8_BAR; PG8_SCHED;
            if constexpr (GATHER) { unsigned ro[2]; PG8_TAB_RD(ro, tab2, 1); PG8_LDB(B0, 1, 0); PG8_LDB(B1, 1, 1); PG8_SCHED; PG8_LDA(At, 1, 0); PG8_STAGE_GA(PG8_SA(0, 1), ro, kb2, 12); }
            else { PG8_LDB(B0, 1, 0); PG8_LDB(B1, 1, 1); PG8_SCHED; PG8_LDA(At, 1, 0); PG8_STAGE(PG8_SA(0, 1), a2 + hstep, voffA); }
            PG8_WAIT_V(8); PG8_WAIT_L(0); PG8_BAR; PG8_MMA(0, 0, At, B0); PG8_MMA(0, 1, At, B1); PG8_BAR; PG8_SCHED;
            if constexpr (GATHER) { unsigned ro[2]; PG8_TAB_RD(ro, tab2, 0); PG8_LDA(At, 1, 1); PG8_STAGE(PG8_SB(1, 0), b3, voffB); PG8_STAGE(PG8_SB(1, 1), b3 + hstep, voffB); PG8_STAGE_GA(PG8_SA(1, 0), ro, kb2 + kstep, 6); }
            else { PG8_LDA(At, 1, 1); PG8_STAGE(PG8_SB(1, 0), b3, voffB); PG8_STAGE(PG8_SB(1, 1), b3 + hstep, voffB); PG8_STAGE(PG8_SA(1, 0), a3, voffA); }
            PG8_WAIT_V(8); PG8_WAIT_L(0); PG8_BAR; PG8_MMA(1, 0, At, B0); PG8_MMA(1, 1, At, B1); PG8_BAR; PG8_SCHED;
            } else {
            PG8_LDB(B0, 0, 0); PG8_SCHED; PG8_LDA(At, 0, 0); PG8_STAGE(PG8_SA(1, 1), a1 + hstep, voffA);
            PG8_WAIT_L(8); PG8_BAR; PG8_WAIT_L(0); PG8_MMA(0, 0, At, B0); PG8_BAR; PG8_SCHED;
            PG8_LDB(B1, 0, 1); PG8_STAGE(PG8_SB(0, 0), b2, voffB);
            PG8_BAR; PG8_WAIT_L(0); PG8_MMA(0, 1, At, B1); PG8_BAR;
            PG8_LDA(At, 0, 1); PG8_STAGE(PG8_SA(0, 0), a2, voffA);
            PG8_BAR; PG8_WAIT_L(0); PG8_MMA(1, 0, At, B0); PG8_BAR; PG8_SCHED;
            PG8_STAGE(PG8_SB(0, 1), b2 + hstep, voffB);
            PG8_WAIT_V(6); PG8_BAR; PG8_MMA(1, 1, At, B1); PG8_BAR;
            PG8_LDB(B0, 1, 0); PG8_SCHED; PG8_LDA(At, 1, 0); PG8_STAGE(PG8_SA(0, 1), a2 + hstep, voffA);
            PG8_WAIT_L(8); PG8_BAR; PG8_WAIT_L(0); PG8_MMA(0, 0, At, B0); PG8_BAR; PG8_SCHED;
            PG8_LDB(B1, 1, 1); PG8_STAGE(PG8_SB(1, 0), b3, voffB);
            PG8_BAR; PG8_WAIT_L(0); PG8_MMA(0, 1, At, B1); PG8_BAR;
            PG8_LDA(At, 1, 1); PG8_STAGE(PG8_SA(1, 0), a3, voffA);
            PG8_BAR; PG8_WAIT_L(0); PG8_MMA(1, 0, At, B0); PG8_BAR; PG8_SCHED;
            PG8_STAGE(PG8_SB(1, 1), b3 + hstep, voffB);
            PG8_WAIT_V(6); PG8_BAR; PG8_MMA(1, 1, At, B1); PG8_BAR;
            }
        }
        if constexpr (ALIGN_EPI) { if (wr == 0) PG8_BAR; }
        if constexpr (!Epi::AFTER_DRAIN) { E(acc, cur, wr, wc, fr, fq); S.done(cur); }
        if (!has_next) break;
#pragma unroll
        for (int a = 0; a < 2; ++a)
#pragma unroll
            for (int b = 0; b < 2; ++b)
#pragma unroll
                for (int m = 0; m < 4; ++m)
#pragma unroll
                    for (int n = 0; n < 2; ++n) acc[a][b][m][n] = (f32x4){0.f, 0.f, 0.f, 0.f};
        cur = nxt; cA = nA; cB = nB; ++ui;
        if constexpr (ALIGN_EPI) { if (wr == 1) PG8_BAR; }
    }
    PG8_WAIT_V(0);
    if constexpr (!ALIGN_EPI) { if (wr == 0) PG8_BAR; }
    PG8_BAR;
    if constexpr (Epi::AFTER_DRAIN) { E.fused(acc, cur, wr, wc, fr, fq, lds, wid, lane); S.done(cur); }
#undef PG8_SA
#undef PG8_SB
#undef PG8_STAGE
#undef PG8_TAB_RD
#undef PG8_STAGE_GA
#undef PG8_LDA
#undef PG8_LDB
#undef PG8_MMA
#undef PG8_WAIT_V
#undef PG8_WAIT_L
#undef PG8_BAR
#undef PG8_SCHED
}
}
constexpr int NBATCH = 16, SEQ = 4096, NMETA = 16, LTOK = SEQ + NMETA, NTOK = NBATCH * LTOK;
constexpr int DM = 1024, NCOLA = 1280, NCOLB = 1864, NCOLB_PAD = 2048;
constexpr int NEXP = 32, MOE_TILES_MAX = NTOK * 4 / 256 + NEXP, MOE_P = MOE_TILES_MAX * 256;
constexpr float LN_EPS = 1e-5f, DN_ALPHA = 1.4142135623730951f;
constexpr float ATTN_SCALE = 0.125f, IDX_SCALE = 0.125f, IDX_W_SCALE = 0.35355339059327373f;
constexpr int NWAVES = 8, NTHREADS = 512;

constexpr size_t MiB = 1u << 20;
constexpr size_t WS_CTL = 0, CTL_ZERO_BYTES = 1 * MiB;
constexpr size_t WS_ROPEA = 1 * MiB, WS_ROPEB = 2 * MiB, WS_BIASB = 3 * MiB, WS_WRT = 3 * MiB + 512 * 1024, WS_ROWINFO = 4 * MiB, WS_ROUTE = 8 * MiB;
constexpr size_t WS_WINA = 16 * MiB, WS_WOUTA = 19 * MiB, WS_WINB = 21 * MiB, WS_WOUTB = 25 * MiB;
constexpr size_t WS_WGU = 32 * MiB, WS_WD = 288 * MiB;
constexpr size_t WS_HA = 416 * MiB, WS_HB = 545 * MiB, WS_PRE = 674 * MiB;
constexpr size_t WS_XS = 803 * MiB, WS_ACT = 1333 * MiB, WS_H8 = 1863 * MiB, WS_ELIST = 1931 * MiB, WS_EOFF = 1948 * MiB, WS_END = 1965 * MiB;
constexpr size_t WS_ROWOFF = 6 * MiB + 512 * 1024;
constexpr size_t WS_HB8 = WS_XS + 330 * MiB;
constexpr size_t WS_Q8 = WS_XS + 451 * MiB;
constexpr size_t WS_PROJ = WS_XS, WS_ATT = WS_XS + 257 * MiB;
constexpr size_t WS_SCORE = WS_ACT, WS_SEL = WS_ACT + 128 * MiB;
constexpr size_t WS_KV = WS_XS + 386 * MiB, WS_KI = WS_XS + 421 * MiB;
constexpr size_t WS_K8 = WS_XS + 431 * MiB;
constexpr size_t WS_V8 = WS_XS + 441 * MiB;
static_assert((size_t)NTOK * 512 <= 35 * MiB && WS_KI + (size_t)NTOK * 128 <= WS_K8 && WS_K8 + (size_t)NTOK * 128 <= WS_V8 && WS_V8 + (size_t)NTOK * 128 <= WS_ACT, "ws compact copies");
static_assert((size_t)NTOK * 2048 * 2 <= 257 * MiB && (size_t)NTOK * 1024 * 2 <= 129 * MiB && (size_t)MOE_P * 2048 <= 530 * MiB, "ws map");
static_assert(WS_ATT + 129 * MiB <= WS_ACT && WS_SEL + 32 * MiB <= WS_END, "ws overlays");

constexpr int CW_BAR = 4096;
constexpr int CW_CNT = 16384;

constexpr int RING_BYTES = 131072, LDSCTL_OFF = RING_BYTES, LDS_BYTES = 163840;
constexpr int LDS_EQ_OFF = LDSCTL_OFF + 8192, LDS_HIST_OFF = LDSCTL_OFF + 16384;
constexpr int LC_BAR = 0;
constexpr int LC_TSTART = 16;
constexpr int LC_ECNT = 64;
constexpr int LC_LCNT = 128, LC_LBASE = 160;
constexpr int LC_PROBE_A = 200, LC_PROBE_B = 201;
constexpr int LC_TILEE = 256;

struct Args { const float* in[21]; float* out; unsigned char* ws; int ph_lo, ph_hi; };
typedef const Args __attribute__((address_space(4))) CArgs;
__device__ __forceinline__ CArgs* KA() { unsigned long long v = (unsigned long long)__builtin_amdgcn_kernarg_segment_ptr(); asm volatile("" : "+s"(v)); return (CArgs*)v; }

typedef unsigned short u16;

__device__ __forceinline__ float bf2f(unsigned h) { return __builtin_bit_cast(float, h << 16); }
__device__ __forceinline__ float bflo(unsigned w) { return __builtin_bit_cast(float, w << 16); }
__device__ __forceinline__ float bfhi(unsigned w) { return __builtin_bit_cast(float, w & 0xffff0000u); }
__device__ __forceinline__ unsigned cvtpk(float lo, float hi) { return pg8::cvt_pk_bf16(lo, hi); }
__device__ __forceinline__ unsigned char* launder(unsigned char* p) { unsigned long long v = (unsigned long long)p; asm volatile("" : "+s"(v)); return (unsigned char*)(GAS unsigned char*)v; }
__device__ __forceinline__ const float* gptr(const float* p) { return (const float*)(const GAS float*)p; }
__device__ __forceinline__ float shx(float v, int o, int lane) { return __builtin_bit_cast(float, __builtin_amdgcn_ds_bpermute((lane ^ o) << 2, __builtin_bit_cast(int, v))); }
__device__ __forceinline__ int shxi(int v, int o, int lane) { return __builtin_amdgcn_ds_bpermute((lane ^ o) << 2, v); }
__device__ __forceinline__ int launder_v(int x) { asm volatile("" : "+v"(x)); return x; }

__device__ __forceinline__ void transpose_item(const float* W, int K, int N, bf16* WT, int mode, LAS float* scr, int item, int lane) {
    const int nblk = (N + 31) / 32, kb = item / nblk, nb = item % nblk, k0 = 64 * kb, n0 = 32 * nb;
    const bool okn = (n0 + (lane & 31)) < N;
#pragma unroll 8
    for (int i = 0; i < 32; ++i) { const int kk = 2 * i + (lane >> 5); scr[kk * 33 + (lane & 31)] = okn ? W[(size_t)(k0 + kk) * N + n0 + (lane & 31)] : 0.f; }
    LDS_WAIT(); asm volatile("" ::: "memory");
    const int c = lane & 7;
#pragma unroll
    for (int j = 0; j < 4; ++j) { const int n = (lane >> 3) + 8 * j; const LAS float* s = scr + (8 * c) * 33 + n;
        v4u o; o.x = pk2(s[0 * 33], s[1 * 33]); o.y = pk2(s[2 * 33], s[3 * 33]); o.z = pk2(s[4 * 33], s[5 * 33]); o.w = pk2(s[6 * 33], s[7 * 33]);
        int nn = n0 + n;
        if (nn < N) {
            if (mode == 1) { const int up = nn >= 1024 ? 1 : 0, q = nn - 1024 * up; nn = (q >> 7) * 256 + up * 128 + (q & 127); }
            *(GAS v4u*)(WT + (size_t)nn * K + k0 + 8 * c) = o; } }
    LDS_WAIT(); asm volatile("" ::: "memory");
}

__device__ __forceinline__ void transpose_item_fp8(const float* W, int K, int N, unsigned char* WT, int mode, LAS float* scr, int item, int lane) {
    const int nblk = (N + 31) / 32, kb = item / nblk, nb = item % nblk, k0 = 64 * kb, n0 = 32 * nb;
    const bool okn = (n0 + (lane & 31)) < N;
#pragma unroll 8
    for (int i = 0; i < 32; ++i) { const int kk = 2 * i + (lane >> 5); scr[kk * 33 + (lane & 31)] = okn ? W[(size_t)(k0 + kk) * N + n0 + (lane & 31)] : 0.f; }
    LDS_WAIT(); asm volatile("" ::: "memory");
    const int c = lane & 7;
#pragma unroll
    for (int j = 0; j < 4; ++j) { const int n = (lane >> 3) + 8 * j; const LAS float* s = scr + (8 * c) * 33 + n;
        uint2 o; o.x = pg8::pk4_fp8(s[0 * 33] * pg8::FP8_SW, s[1 * 33] * pg8::FP8_SW, s[2 * 33] * pg8::FP8_SW, s[3 * 33] * pg8::FP8_SW);
        o.y = pg8::pk4_fp8(s[4 * 33] * pg8::FP8_SW, s[5 * 33] * pg8::FP8_SW, s[6 * 33] * pg8::FP8_SW, s[7 * 33] * pg8::FP8_SW);
        int nn = n0 + n;
        if (mode == 1) { const int up = nn >= 1024 ? 1 : 0, q = nn - 1024 * up; nn = (q >> 7) * 256 + up * 128 + (q & 127); }
        if (n0 + n < N) *(uint2*)(WT + (size_t)nn * K + k0 + 8 * c) = o; }
    LDS_WAIT(); asm volatile("" ::: "memory");
}

__device__ __forceinline__ void transpose_item_fp8_reg(const float* W, int K, int N, unsigned char* WT, int mode, int item, int lane) {
    const int nblk = N / 32, kb = item / nblk, nb = item % nblk, k0 = 64 * kb, n0 = 32 * nb;
    const int q = lane & 7, g = lane >> 3;
    const float* src = W + (size_t)(k0 + 8 * g) * N + n0 + 4 * q;
    f32x4 v[8];
#pragma unroll
    for (int i = 0; i < 8; ++i) v[i] = *(const f32x4*)(src + (size_t)i * N);
#pragma unroll
    for (int j = 0; j < 4; ++j) { constexpr float sw = pg8::FP8_SW; uint2 o;
        o.x = pg8::pk4_fp8(v[0][j] * sw, v[1][j] * sw, v[2][j] * sw, v[3][j] * sw); o.y = pg8::pk4_fp8(v[4][j] * sw, v[5][j] * sw, v[6][j] * sw, v[7][j] * sw);
        int nn = n0 + 4 * q + j;
        if (mode == 1) { const int up = nn >= 1024 ? 1 : 0, qq = nn - 1024 * up; nn = (qq >> 7) * 256 + up * 128 + (qq & 127); }
        *(uint2*)(WT + (size_t)nn * K + k0 + 8 * g) = o; }
}
constexpr int L1W_GU = 32 * 1024, L1W_ITEMS = L1W_GU + 32 * 512;
__device__ __forceinline__ void moe_weight_item(CArgs* A, int layer, int it, int lane) {
    unsigned char* ws = launder(A->ws);
    if (it < L1W_GU) { const int le = 32 * layer + (it >> 10); transpose_item_fp8_reg(gptr(A->in[15]) + (size_t)le * 1024 * 2048, 1024, 2048, ws + WS_WGU + (size_t)le * 2048 * 1024, 1, it & 1023, lane); }
    else { const int r = it - L1W_GU, le = 32 * layer + (r >> 9); transpose_item_fp8_reg(gptr(A->in[17]) + (size_t)le * 1024 * 1024, 1024, 1024, ws + WS_WD + (size_t)le * 1024 * 1024, 0, r & 511, lane); }
}

__device__ __forceinline__ void p0_prologue(CArgs* A, LAS unsigned char* lds, int gw, int NGW, int wave, int lane) {
    unsigned char* ws = launder(A->ws);
    LAS float* scr = (LAS float*)(lds + wave * 16384);
    constexpr int I_GU = 0, I_D = 0  , I_INA = 16 * 40, I_OUT = 512, I_INB = 16 * 59, I_R = 2 * 16;
    constexpr int NITEMS = I_GU + I_D + I_INA + I_OUT + I_INB + I_OUT + I_R;
    for (int it = gw; it < NITEMS; it += NGW) {
        int r = it;
        if (r < I_GU) { const int le = r >> 10; transpose_item_fp8(gptr(A->in[15]) + (size_t)le * 1024 * 2048, 1024, 2048, ws + WS_WGU + (size_t)le * 2048 * 1024, 1, scr, r & 1023, lane); continue; } r -= I_GU;
        if (r < I_D) { const int le = r >> 9; transpose_item_fp8(gptr(A->in[17]) + (size_t)le * 1024 * 1024, 1024, 1024, ws + WS_WD + (size_t)le * 1024 * 1024, 0, scr, r & 511, lane); continue; } r -= I_D;
        if (r < I_INA) { transpose_item_fp8(gptr(A->in[2]), 1024, NCOLA, ws + WS_WINA, 0, scr, r, lane); continue; } r -= I_INA;
        if (r < I_OUT) { transpose_item_fp8(gptr(A->in[5]), 1024, 1024, ws + WS_WOUTA, 0, scr, r, lane); continue; } r -= I_OUT;
        if (r < I_INB) { transpose_item_fp8(gptr(A->in[6]), 1024, NCOLB, ws + WS_WINB, 0, scr, r, lane); continue; } r -= I_INB;
        if (r < I_OUT) { transpose_item_fp8(gptr(A->in[10]), 1024, 1024, ws + WS_WOUTB, 0, scr, r, lane); continue; } r -= I_OUT;
        { const int ly = r >> 4; transpose_item(gptr(A->in[13]) + (size_t)ly * 1024 * 32, 1024, 32, (bf16*)(ws + WS_WRT) + (size_t)ly * 32 * 1024, 0, scr, r & 15, lane); }
    }
    const int gt = gw * 64 + lane, NGT = NGW * 64;
    { v4u* z = (v4u*)(ws + WS_WINB + (size_t)NCOLB * 1024); const int n16 = (NCOLB_PAD - NCOLB) * 1024 / 16;
      for (int i = gt; i < n16; i += NGT) z[i] = (v4u){0u, 0u, 0u, 0u}; }
    { v4u* z = (v4u*)(ws + WS_EOFF); const int n16 = 2 * 32 * NTOK * 4 / 16; for (int i = gt; i < n16; i += NGT) z[i] = (v4u){0u, 0u, 0u, 0u}; }
    { float* bb = (float*)(ws + WS_BIASB); for (int i = gt; i < NCOLB_PAD; i += NGT) bb[i] = i < NCOLB ? gptr(A->in[7])[i] : 0.f; }
    { float2* ta = (float2*)(ws + WS_ROPEA); float2* tb = (float2*)(ws + WS_ROPEB);
      for (int i = gt; i < LTOK * 24; i += NGT) {
          const int pos = i / 24, j = i % 24; const bool isA = j < 8; const int fi = isA ? j : j - 8; const float half = isA ? 8.f : 16.f;
          const float inv = powf(500000.0f, -(float)fi / half); const float ang = (float)pos * inv;
          float sn, cs; sincosf(ang, &sn, &cs);
          if (isA) ta[pos * 8 + fi] = make_float2(cs, sn); else tb[pos * 16 + fi] = make_float2(cs, sn); } }
    {
      for (int row = gw; row < NTOK; row += NGW) { const int b = row / LTOK, p = row % LTOK;
          const float* src = p < NMETA ? gptr(A->in[1]) + (size_t)p * DM : gptr(A->in[0]) + ((size_t)b * SEQ + (p - NMETA)) * DM;
#pragma unroll
          for (int j = 0; j < 2; ++j) { const f32x4 a = *(const f32x4*)(src + j * 512 + lane * 8), c = *(const f32x4*)(src + j * 512 + lane * 8 + 4);
              constexpr float sx = pg8::FP8_SX; uint2 o8; o8.x = pg8::pk4_fp8(sx * a[0], sx * a[1], sx * a[2], sx * a[3]); o8.y = pg8::pk4_fp8(sx * c[0], sx * c[1], sx * c[2], sx * c[3]);
              *(uint2*)(ws + WS_H8 + (size_t)row * DM + j * 512 + lane * 8) = o8; } } }
}

__device__ __forceinline__ void rope_pair(float& x1, float& x2, const float2 cs) { const float a = x1 * cs.x - x2 * cs.y, b = x2 * cs.x + x1 * cs.y; x1 = a; x2 = b; }
__device__ __forceinline__ void ki_phase(CArgs* A, int gt, int NGT) {
    unsigned char* ws = launder(A->ws);
    const bf16* P = (const bf16*)(ws + WS_PROJ); bf16* KI = (bf16*)(ws + WS_KI);
    const float2* tb = (const float2*)(ws + WS_ROPEB);
    for (int it = gt; it < NTOK * 2; it += NGT) {
        const int row = it >> 1, hf = it & 1, pos = row % LTOK, lane = gt & 63;
        const bf16* p = P + (size_t)row * NCOLB_PAD + 1792 + 32 * hf; bf16* d = KI + (size_t)row * 64 + 32 * hf;
        const float* g = gptr(A->in[8]) + 32 * hf; const float* bb = gptr(A->in[9]) + 32 * hf;
        v4u q[4];
#pragma unroll
        for (int j = 0; j < 4; ++j) q[j] = *(const v4u*)(p + 8 * j);
        float x[32];
#pragma unroll
        for (int j = 0; j < 4; ++j) { x[8 * j + 0] = bflo(q[j].x); x[8 * j + 1] = bfhi(q[j].x); x[8 * j + 2] = bflo(q[j].y); x[8 * j + 3] = bfhi(q[j].y);
            x[8 * j + 4] = bflo(q[j].z); x[8 * j + 5] = bfhi(q[j].z); x[8 * j + 6] = bflo(q[j].w); x[8 * j + 7] = bfhi(q[j].w); }
        float s = 0.f;
#pragma unroll
        for (int i = 0; i < 32; ++i) s += x[i];
        s += shx(s, 1, lane);
        const float mu = s * (1.f / 64.f); float v = 0.f;
#pragma unroll
        for (int i = 0; i < 32; ++i) { x[i] -= mu; v += x[i] * x[i]; }
        v += shx(v, 1, lane);
        const float rstd = 1.f / sqrtf(v * (1.f / 64.f) + LN_EPS);
#pragma unroll
        for (int c8 = 0; c8 < 4; ++c8) {
#pragma unroll
            for (int i = 8 * c8; i < 8 * c8 + 8; ++i) x[i] = x[i] * rstd * g[i] + bb[i];
            asm volatile("" ::: "memory"); }
        if (hf == 0) {
#pragma unroll
            for (int c4 = 0; c4 < 4; ++c4) {
#pragma unroll
                for (int i = 4 * c4; i < 4 * c4 + 4; ++i) rope_pair(x[i], x[16 + i], tb[pos * 16 + i]);
                asm volatile("" ::: "memory"); }
        }
#pragma unroll
        for (int j = 0; j < 4; ++j) { q[j].x = cvtpk(x[8 * j + 0], x[8 * j + 1]); q[j].y = cvtpk(x[8 * j + 2], x[8 * j + 3]); q[j].z = cvtpk(x[8 * j + 4], x[8 * j + 5]); q[j].w = cvtpk(x[8 * j + 6], x[8 * j + 7]);
            *(v4u*)(d + 8 * j) = q[j]; }
    }
}

template <int NB, bool DSA>
__device__ __forceinline__ void attn8_phase(CArgs* A, LAS unsigned char* lds, int gw, int NGW, int wave, int lane_) {
    unsigned char* ws = launder(A->ws);
    const bf16* P = (const bf16*)(ws + WS_PROJ); const int ld = DSA ? NCOLB_PAD : NCOLA;
    const unsigned char* K8 = ws + WS_K8; const unsigned char* V8 = ws + WS_V8;
    unsigned char* O = ws + WS_ATT;
    const u16* SEL = (const u16*)(ws + WS_SEL);
    const float* sinks = gptr(A->in[4]);
    LAS unsigned char* vl = lds + wave * 16384;
    typedef int v2i __attribute__((ext_vector_type(2)));
    constexpr int NTOT = DSA ? NTOK : NBATCH * NMETA;
#define TOK_DESC(tix_, tok_, b_, p_, nk_, usel_, rb_, selrow_) \
        const int tok_ = DSA ? (tix_) : ((tix_) >> 4) * LTOK + ((tix_) & 15); const int b_ = tok_ / LTOK, p_ = tok_ % LTOK; \
        const bool usel_ = DSA && (p_ - NMETA >= 256); const int nk_ = p_ < NMETA ? p_ + 1 : (p_ - NMETA < 256 ? p_ + 1 : 16 + 256); \
        const size_t rb_ = (size_t)b_ * LTOK; const u16* selrow_ = SEL + ((size_t)b_ * SEQ + (p_ > NMETA ? p_ - NMETA : 0)) * 256;
#define REQ_KP(dst_, nk_, usel_, selrow_, fr_) do { _Pragma("unroll") for (int c_ = 0; c_ < NB * 2; ++c_) { const int i0_ = c_ * 32 + (fr_), i1_ = i0_ + 16; \
            const unsigned k0_ = i0_ < (nk_) ? (unsigned)(i0_ < 16 ? i0_ : 16 + ((usel_) ? (int)(selrow_)[i0_ - 16] : i0_ - 16)) : 0u; \
            const unsigned k1_ = i1_ < (nk_) ? (unsigned)(16 + ((usel_) ? (int)(selrow_)[i1_ - 16] : i1_ - 16)) : 0u; dst_[c_] = k0_ | (k1_ << 16); } } while (0)
#define KPX(arr_, TT) (((TT) & 1) ? (arr_[(TT) >> 1] >> 16) : (arr_[(TT) >> 1] & 0xffffu))
#define LOAD_KX(arr_, rb_, bt, fq_, nt_) do { _Pragma("unroll") for (int T_ = 0; T_ < (nt_); ++T_) { \
            const unsigned ko_ = ((unsigned)(rb_) + KPX(arr_, 4 * (bt) + T_)) * 128u + (unsigned)(fq_) * 32u; \
            kf[T_][0] = *(const v4u*)(K8 + ko_); kf[T_][1] = *(const v4u*)(K8 + ko_ + 16u); } } while (0)
#define LOAD_VX(arr_, rb_, bt, lane__, nt_) do { _Pragma("unroll") for (int T_ = 0; T_ < (nt_); ++T_) _Pragma("unroll") for (int h_ = 0; h_ < 2; ++h_) { \
            const unsigned pp_ = (unsigned)__builtin_amdgcn_ds_bpermute((8 * h_ + ((lane__) >> 3)) << 2, (int)arr_[(4 * (bt) + T_) >> 1]); \
            const unsigned pos_ = (T_ & 1) ? (pp_ >> 16) : (pp_ & 0xffffu); \
            vt[2 * T_ + h_] = *(const v4u*)(V8 + (((unsigned)(rb_) + pos_) * 128u + ((unsigned)(lane__) & 7u) * 16u)); } } while (0)
    v4u kf[4][2]; v4u vt[8];
    unsigned kpn[NB * 2]; v4u qn[4];
    const unsigned char* Q8 = ws + WS_Q8;
    unsigned sta[8], tra[16];
    { const int lane = launder_v(lane_); const int fq = lane >> 4;
#pragma unroll
      for (int T = 0; T < 4; ++T)
#pragma unroll
          for (int h = 0; h < 2; ++h) { const unsigned i = 8u * h + ((unsigned)lane >> 3), rho = 32u * (i >> 2) + 4u * T + (i & 3u); sta[2 * T + h] = 128u * rho + 16u * (((unsigned)lane & 7u) ^ (rho & 7u)); }
#pragma unroll
      for (int d = 0; d < 8; ++d)
#pragma unroll
          for (int u = 0; u < 2; ++u) { const unsigned row = 32u * (unsigned)fq + 8u * u + (((unsigned)lane & 15u) >> 1); tra[2 * d + u] = 128u * row + 16u * ((unsigned)d ^ (row & 7u)) + 8u * ((unsigned)lane & 1u); } }
    int tix = gw, nwit = 0;
    if (tix >= NTOT) return;
    { const int lane0 = launder_v(lane_); const int fr0 = lane0 & 15, fq0 = lane0 >> 4;
      TOK_DESC(tix, tk0, b0, p0, nk0, us0, rb0, sr0)
      REQ_KP(kpn, nk0, us0, sr0, fr0);
      if (DSA) { const unsigned char* qr = Q8 + (rb0 + p0) * DM + fr0 * 64 + (fq0 & 1) * 32; qn[0] = *(const v4u*)qr; qn[1] = *(const v4u*)(qr + 16); }
      else { const bf16* qr = P + (rb0 + p0) * ld + fr0 * 64 + (fq0 & 1) * 32; qn[0] = *(const v4u*)qr; qn[1] = *(const v4u*)(qr + 8); qn[2] = *(const v4u*)(qr + 16); qn[3] = *(const v4u*)(qr + 24); }
      LOAD_KX(kpn, rb0, 0, fq0, 4); LOAD_VX(kpn, rb0, 0, lane0, 4); }
    for (; tix < NTOT; tix += NGW) {
        const int lane = launder_v(lane_); const int fr = lane & 15, fq = lane >> 4;
        TOK_DESC(tix, tok, b, p, n_keys, use_sel, rowbase, selrow)
        (void)b; (void)use_sel; (void)selrow;
        unsigned kp2[NB * 2];
#pragma unroll
        for (int c = 0; c < NB * 2; ++c) kp2[c] = kpn[c];
        pg8::pg8_v8i qf8;
        if (DSA) { const bool mine = (fq >> 1) == (fr >> 3); v4u lo8 = qn[0], hi8 = qn[1];
          if (!mine) { lo8 = (v4u){0u, 0u, 0u, 0u}; hi8 = lo8; }
          qf8 = pg8::cat8(__builtin_bit_cast(bf16x8, lo8), __builtin_bit_cast(bf16x8, hi8)); }
        else { const bool mine = (fq >> 1) == (fr >> 3); constexpr float sq = pg8::FP8_SX; const v4u q0 = qn[0], q1 = qn[1], q2 = qn[2], q3 = qn[3];
          v4u lo8, hi8;
          lo8.x = pg8::pk4_fp8(sq * bflo(q0.x), sq * bfhi(q0.x), sq * bflo(q0.y), sq * bfhi(q0.y)); lo8.y = pg8::pk4_fp8(sq * bflo(q0.z), sq * bfhi(q0.z), sq * bflo(q0.w), sq * bfhi(q0.w));
          lo8.z = pg8::pk4_fp8(sq * bflo(q1.x), sq * bfhi(q1.x), sq * bflo(q1.y), sq * bfhi(q1.y)); lo8.w = pg8::pk4_fp8(sq * bflo(q1.z), sq * bfhi(q1.z), sq * bflo(q1.w), sq * bfhi(q1.w));
          hi8.x = pg8::pk4_fp8(sq * bflo(q2.x), sq * bfhi(q2.x), sq * bflo(q2.y), sq * bfhi(q2.y)); hi8.y = pg8::pk4_fp8(sq * bflo(q2.z), sq * bfhi(q2.z), sq * bflo(q2.w), sq * bfhi(q2.w));
          hi8.z = pg8::pk4_fp8(sq * bflo(q3.x), sq * bfhi(q3.x), sq * bflo(q3.y), sq * bfhi(q3.y)); hi8.w = pg8::pk4_fp8(sq * bflo(q3.z), sq * bfhi(q3.z), sq * bflo(q3.w), sq * bfhi(q3.w));
          if (!mine) { lo8 = (v4u){0u, 0u, 0u, 0u}; hi8 = lo8; }
          qf8 = pg8::cat8(__builtin_bit_cast(bf16x8, lo8), __builtin_bit_cast(bf16x8, hi8)); }
        const bool has_next = tix + NGW < NTOT;
        const int tixn = has_next ? tix + NGW : tix;
        TOK_DESC(tixn, tokn, bn, pn, nkn, usn, rbn, srn)
        (void)tokn; (void)bn;
        REQ_KP(kpn, nkn, usn, srn, fr);
        if (DSA) { const unsigned char* qr = Q8 + (rbn + pn) * DM + fr * 64 + (fq & 1) * 32; qn[0] = *(const v4u*)qr; qn[1] = *(const v4u*)(qr + 16); }
        else { const bf16* qr = P + (rbn + pn) * ld + fr * 64 + (fq & 1) * 32; qn[0] = *(const v4u*)qr; qn[1] = *(const v4u*)(qr + 8); qn[2] = *(const v4u*)(qr + 16); qn[3] = *(const v4u*)(qr + 24); }
        float mrun = -1e30f, lsum = 0.f;
        f32x4 o[8];
#pragma unroll
        for (int d = 0; d < 8; ++d) o[d] = (f32x4){0.f, 0.f, 0.f, 0.f};
#pragma unroll
        for (int bt = 0; bt < NB; ++bt) {
            const int NT = (DSA && NB == 5 && bt == NB - 1) ? 1 : 4, NTN = (DSA && NB == 5 && bt + 1 == NB - 1) ? 1 : 4;
            if (bt * 64 < n_keys) {
                const bool more = (bt + 1 < NB) && ((bt + 1) * 64 < n_keys);
                f32x4 s8[4]; float bm = -1e30f;
                constexpr float qk = ATTN_SCALE / (pg8::FP8_SX * pg8::FP8_SX);
                const bool full = bt * 64 + 16 * NT <= n_keys;
#pragma unroll
                for (int T = 0; T < 4; ++T) s8[T] = (f32x4){-1e30f, -1e30f, -1e30f, -1e30f};
#pragma unroll
                for (int T = 0; T < NT; ++T) {
                    const f32x4 a = __builtin_amdgcn_mfma_scale_f32_16x16x128_f8f6f4(pg8::cat8(__builtin_bit_cast(bf16x8, kf[T][0]), __builtin_bit_cast(bf16x8, kf[T][1])), qf8, (f32x4){0.f, 0.f, 0.f, 0.f}, 0, 0, 0, 0, 0, 0);
                    if (full) { s8[T] = a; }
                    else {
#pragma unroll
                        for (int j = 0; j < 4; ++j) { const int ki = bt * 64 + 16 * T + 4 * fq + j; s8[T][j] = ki < n_keys ? a[j] : -1e30f; } }
                    bm = fmaxf(bm, fmaxf(fmaxf(s8[T][0], s8[T][1]), fmaxf(s8[T][2], s8[T][3])));
                }
                if (more) { LOAD_KX(kp2, rowbase, bt + 1 < NB ? bt + 1 : 0, fq, NTN); } else if (has_next) { LOAD_KX(kpn, rbn, 0, fq, 4); }
                bm = fmaxf(bm, shx(bm, 16, lane)); bm = fmaxf(bm, shx(bm, 32, lane)); bm *= qk;
                const float mnew = fmaxf(mrun, bm), rs = __expf(mrun - mnew); mrun = mnew;
                float bs = 0.f; unsigned pk[4];
                const float mb = mnew * 1.4426950408889634f - 8.0f;
                constexpr float qkl = qk * 1.4426950408889634f;
#pragma unroll
                for (int T = 0; T < 4; ++T) { const float e0 = __builtin_amdgcn_exp2f(__builtin_fmaf(s8[T][0], qkl, -mb)), e1 = __builtin_amdgcn_exp2f(__builtin_fmaf(s8[T][1], qkl, -mb)),
                                                          e2 = __builtin_amdgcn_exp2f(__builtin_fmaf(s8[T][2], qkl, -mb)), e3 = __builtin_amdgcn_exp2f(__builtin_fmaf(s8[T][3], qkl, -mb));
                    bs += (e0 + e1) + (e2 + e3); unsigned w = 0u; w = (unsigned)__builtin_amdgcn_cvt_pk_fp8_f32(e0, e1, (int)w, false); w = (unsigned)__builtin_amdgcn_cvt_pk_fp8_f32(e2, e3, (int)w, true); pk[T] = w; }
                bs *= (1.f / 256.f);
                lsum = lsum * rs + bs;
#pragma unroll
                for (int d = 0; d < 8; ++d) o[d] = o[d] * rs;
#pragma unroll
                for (int q8 = 0; q8 < 2 * NT; ++q8) *(LAS v4u*)(vl + sta[q8]) = vt[q8];
                if (more) { LOAD_VX(kp2, rowbase, bt + 1 < NB ? bt + 1 : 0, lane, NTN); } else if (has_next) { LOAD_VX(kpn, rbn, 0, lane, 4); }
                const pg8::pg8_v8i pf = {(int)pk[0], (int)pk[1], (int)pk[2], (int)pk[3], 0, 0, 0, 0};
#pragma unroll
                for (int d = 0; d < 8; ++d) {
                    v2i r[2];
#pragma unroll
                    for (int u = 0; u < 2; ++u) r[u] = __builtin_amdgcn_ds_read_tr8_b64_v2i32((LAS v2i*)(vl + tra[2 * d + u]));
                    const pg8::pg8_v8i vf = {r[0].x, r[0].y, r[1].x, r[1].y, 0, 0, 0, 0};
                    o[d] = __builtin_amdgcn_mfma_scale_f32_16x16x128_f8f6f4(vf, pf, o[d], 0, 0, 0, 0, 0, 0);
                }
            }
        }
        lsum += shx(lsum, 16, lane); lsum += shx(lsum, 32, lane);
        float inv;
        if (!DSA) { const float sk = sinks[fr], m2 = fmaxf(mrun, sk), f = __expf(mrun - m2); inv = f / (lsum * f + __expf(sk - m2)); }
        else inv = 1.f / lsum;
        { unsigned char* orow = O + (size_t)tok * DM + fr * 64 + fq * 4; const bool hi = fr >= 8; const float inv8 = inv * (pg8::FP8_SO / (256.f * pg8::FP8_SX));
#pragma unroll
          for (int dd = 0; dd < 4; ++dd) { const f32x4 vl_ = o[dd], vh_ = o[4 + dd];
              const float v0 = hi ? vh_[0] : vl_[0], v1 = hi ? vh_[1] : vl_[1], v2 = hi ? vh_[2] : vl_[2], v3 = hi ? vh_[3] : vl_[3];
              *(unsigned*)(orow + dd * 16) = pg8::pk4_fp8(v0 * inv8, v1 * inv8, v2 * inv8, v3 * inv8); } }
    }
#undef TOK_DESC
#undef REQ_KP
#undef KPX
#undef LOAD_KX
#undef LOAD_VX
}

constexpr int SWA_ROWS = 288, SWA_KOFF = 0, SWA_VOFF = SWA_ROWS * 128;
__device__ __forceinline__ unsigned swa_koff(unsigned row, unsigned ch) { return 128u * row + 16u * (ch ^ (((row >> 1) & 1u) | (((row >> 3) & 3u) << 1))); }
__device__ __forceinline__ unsigned swa_voff(unsigned row, unsigned ch) { return 128u * row + 16u * (ch ^ (2u * (((row >> 1) & 1u) | (((row >> 3) & 1u) << 1)))); }
__device__ __forceinline__ void swa_tile_phase(CArgs* A, LAS unsigned char* lds, int G, int wg, int wave, int lane_) {
    unsigned char* ws = launder(A->ws);
    const bf16* P = (const bf16*)(ws + WS_PROJ); constexpr int ld = NCOLA;
    const bf16* KV = (const bf16*)(ws + WS_KV);
    bf16* O = (bf16*)(ws + WS_ATT);
    const float* sinks = gptr(A->in[4]);
    LAS unsigned char* kl = lds + SWA_KOFF; LAS unsigned char* vl = lds + SWA_VOFF;
    constexpr int NUNITS = NBATCH * 2 * 32;
    int nwit = 0;
    for (int unit = wg; unit < NUNITS; unit += G) {
        const int lane = launder_v(lane_), tid = wave * 64 + lane, fr = lane & 15, fq = lane >> 4;
        const int qb = unit & 31, kvh = (unit >> 5) & 1, b = unit >> 6;
        const size_t rowbase = (size_t)b * LTOK;
        __syncthreads();
        { constexpr int NST = (SWA_ROWS * 8 + NTHREADS - 1) / NTHREADS;
          v4u kk[NST], vv[NST];
#pragma unroll
          for (int i = 0; i < NST; ++i) { const int id = tid + i * NTHREADS; const int r = id >> 3, ch = id & 7;
              int pos = -1;
              if (r < 16) pos = r; else if (r < 272) { const int s = (qb - 1) * 128 + (r - 16); if (s >= 0) pos = NMETA + s; }
              kk[i] = (v4u){0u, 0u, 0u, 0u}; vv[i] = kk[i];
              if (id < SWA_ROWS * 8 && pos >= 0) { const bf16* src = KV + (rowbase + pos) * 256 + kvh * 64 + ch * 8; kk[i] = *(const v4u*)src; vv[i] = *(const v4u*)(src + 128); } }
#pragma unroll
          for (int i = 0; i < NST; ++i) { const int id = tid + i * NTHREADS; const int r = id >> 3, ch = id & 7;
              if (id < SWA_ROWS * 8) { *(LAS v4u*)(kl + swa_koff((unsigned)r, (unsigned)ch)) = kk[i]; *(LAS v4u*)(vl + swa_voff((unsigned)r, (unsigned)ch)) = vv[i]; } } }
        __syncthreads();
        const int i0 = 16 * wave;
        const int tokrow = (int)rowbase + NMETA + qb * 128 + i0 + fr;
        const unsigned tq = ((unsigned)lane & 15u) >> 2, tp = (unsigned)lane & 3u;
        bf16x8 qn[2];
        { const bf16* qr = P + (size_t)tokrow * ld + (kvh * 8) * 64 + fq * 8; qn[0] = *(const bf16x8*)qr; qn[1] = *(const bf16x8*)(qr + 32); }
#pragma unroll 1
        for (int g = 0; g < 8; ++g) {
            const int h = kvh * 8 + g;
            bf16x8 qf[2]; qf[0] = qn[0]; qf[1] = qn[1];
            { const int hn = kvh * 8 + (g < 7 ? g + 1 : g); const bf16* qr = P + (size_t)tokrow * ld + hn * 64 + fq * 8; qn[0] = *(const bf16x8*)qr; qn[1] = *(const bf16x8*)(qr + 32); }
            f32x4 sc[12]; float mx = -1e30f;
#pragma unroll
            for (int T = 0; T < 12; ++T) {
                const int c = T >> 1; const int base = c == 0 ? 0 : 16 + i0 + 32 * (c - 1);
                const unsigned r = (unsigned)(base + 8 * (fr >> 2) + 4 * (T & 1) + (fr & 3));
                const bf16x8 k0 = *(const LAS bf16x8*)(kl + swa_koff(r, (unsigned)fq)), k1 = *(const LAS bf16x8*)(kl + swa_koff(r, 4u + (unsigned)fq));
                f32x4 a = {0.f, 0.f, 0.f, 0.f};
                a = __builtin_amdgcn_mfma_f32_16x16x32_bf16(k0, qf[0], a, 0, 0, 0);
                a = __builtin_amdgcn_mfma_f32_16x16x32_bf16(k1, qf[1], a, 0, 0, 0);
#pragma unroll
                for (int j = 0; j < 4; ++j) { const int rr = base + 8 * fq + 4 * (T & 1) + j;
                    bool ok;
                    if (c == 0) ok = rr < 16; else { const int kbi = rr - 16, it = i0 + fr; ok = (kbi >= it + 1) && (kbi <= it + 128) && (qb > 0 || kbi >= 128); }
                    const float v = ok ? a[j] * ATTN_SCALE : -1e30f; sc[T][j] = v; mx = fmaxf(mx, v); }
            }
            mx = fmaxf(mx, shx(mx, 16, lane)); mx = fmaxf(mx, shx(mx, 32, lane));
            const float sk = sinks[h]; mx = fmaxf(mx, sk);
            float sum = 0.f; v4u pk[6];
#pragma unroll
            for (int c = 0; c < 6; ++c) { float e[8];
#pragma unroll
                for (int j = 0; j < 4; ++j) { e[j] = __expf(sc[2 * c][j] - mx); e[4 + j] = __expf(sc[2 * c + 1][j] - mx); }
                sum += ((e[0] + e[1]) + (e[2] + e[3])) + ((e[4] + e[5]) + (e[6] + e[7]));
                pk[c].x = cvtpk(e[0], e[1]); pk[c].y = cvtpk(e[2], e[3]); pk[c].z = cvtpk(e[4], e[5]); pk[c].w = cvtpk(e[6], e[7]); }
            sum += shx(sum, 16, lane); sum += shx(sum, 32, lane);
            sum += __expf(sk - mx);
            const float inv = 1.f / sum;
            f32x4 o[4];
#pragma unroll
            for (int d = 0; d < 4; ++d) o[d] = (f32x4){0.f, 0.f, 0.f, 0.f};
#pragma unroll
            for (int c = 0; c < 6; ++c) {
                const int base = c == 0 ? 0 : 16 + i0 + 32 * (c - 1);
                const bf16x8 pf = __builtin_bit_cast(bf16x8, pk[c]);
                const unsigned r0 = (unsigned)(base + 8 * fq) + tq, r1 = r0 + 4u;
#pragma unroll
                for (int d = 0; d < 4; ++d) {
                    typedef short s16x4 __attribute__((ext_vector_type(4)));
                    const s16x4 lo = __builtin_bit_cast(s16x4, __builtin_amdgcn_ds_read_tr16_b64_v4i16((LAS s16x4*)(vl + swa_voff(r0, 2u * d + (tp >> 1)) + 8u * (tp & 1u))));
                    const s16x4 hi = __builtin_bit_cast(s16x4, __builtin_amdgcn_ds_read_tr16_b64_v4i16((LAS s16x4*)(vl + swa_voff(r1, 2u * d + (tp >> 1)) + 8u * (tp & 1u))));
                    const bf16x8 vf = {lo[0], lo[1], lo[2], lo[3], hi[0], hi[1], hi[2], hi[3]};
                    o[d] = __builtin_amdgcn_mfma_f32_16x16x32_bf16(vf, pf, o[d], 0, 0, 0);
                }
            }
            { unsigned char* orow = (unsigned char*)O + (size_t)tokrow * DM + h * 64 + fq * 4; const float inv8 = inv * pg8::FP8_SO;
#pragma unroll
              for (int d = 0; d < 4; ++d) *(unsigned*)(orow + d * 16) = pg8::pk4_fp8(o[d][0] * inv8, o[d][1] * inv8, o[d][2] * inv8, o[d][3] * inv8); }
            { const int wit = (wg * NWAVES + wave) + nwit * (G * NWAVES); if (wit < L1W_ITEMS) moe_weight_item(A, 0, wit, lane); ++nwit; }
        }
    }
    for (int wit = (wg * NWAVES + wave) + nwit * (G * NWAVES); wit < L1W_ITEMS; wit += G * NWAVES) moe_weight_item(A, 0, wit, launder_v(lane_));
}

#ifndef PROBE_SUB
#define PROBE_SUB 0
#endif
#define SUB_T0() unsigned long long sub_t_ = (PROBE_SUB) ? __builtin_amdgcn_s_memrealtime() : 0ull
#define SUB_ADD(lds_, word_) do { if (PROBE_SUB) { const unsigned long long n_ = __builtin_amdgcn_s_memrealtime(); if (threadIdx.x == 0) ((LAS unsigned*)((lds_) + LDSCTL_OFF))[word_] += (unsigned)(n_ - sub_t_); sub_t_ = n_; } } while (0)
__device__ __forceinline__ int idx_bucket(float s) { return (int)__builtin_amdgcn_fmed3f(__builtin_fmaf(s, 24.f, 128.5f), 0.f, 255.9f); }
__device__ __forceinline__ unsigned ordkey(float f) { unsigned u = __builtin_bit_cast(unsigned, f); if (u == 0x80000000u) u = 0u; return (u & 0x80000000u) ? ~u : (u | 0x80000000u); }
__device__ __forceinline__ void indexer_phase(CArgs* A, LAS unsigned char* lds, int G, int wg, int wave, int lane_) {
    unsigned char* ws = launder(A->ws);
    const bf16* P = (const bf16*)(ws + WS_PROJ); constexpr int ld = NCOLB_PAD;
    const bf16* KI = (const bf16*)(ws + WS_KI);
    float* scr = (float*)(ws + WS_SCORE) + (size_t)wg * 32 * SEQ;
    u16* SEL = (u16*)(ws + WS_SEL);
    constexpr int NUNITS = NBATCH * 120;
    int nwit = 0;
    for (int r = 0;; ++r) {
        const int k = r * G + ((r & 1) ? (G - 1 - wg) : wg);
        if (r * G >= NUNITS) break;
        if (k >= NUNITS) continue;
        const int lane = launder_v(lane_), fr = lane & 15, fq = lane >> 4, tid = wave * 64 + lane;
        const int qb = 127 - k / NBATCH, b = k % NBATCH, t0 = qb * 32;
        const size_t rowbase = (size_t)b * LTOK + NMETA;
        bf16x8 qf[2][2]; float wv[2][4];
#pragma unroll
        for (int rg = 0; rg < 2; ++rg) {
            const int tq = t0 + 4 * wave + (fr >> 2);
            const bf16* qr = P + (rowbase + tq) * ld + 1280 + ((fr & 3) + 4 * rg) * 64 + fq * 8;
            qf[rg][0] = *(const bf16x8*)qr; qf[rg][1] = *(const bf16x8*)(qr + 32);
            const bf16* wr_ = P + (rowbase + t0 + 4 * wave + fq) * ld + 1856 + 4 * rg;
#pragma unroll
            for (int j = 0; j < 4; ++j) wv[rg][j] = bf2f(wr_[j]) * (IDX_W_SCALE * IDX_SCALE);
        }
        SUB_T0();
        const int nkt = t0 / 16 + 2;
        const int nchunk = (nkt + 31) >> 5;
        const bf16* kgl = KI + rowbase * 64 + (size_t)(tid >> 3) * 64 + (tid & 7) * 8;
        v4u st[8];
#pragma unroll
        for (int j = 0; j < 8; ++j) st[j] = *(const v4u*)(kgl + (size_t)(64 * j) * 64);
        __syncthreads();
#pragma unroll
        for (int j = 0; j < 8; ++j) { const unsigned row = (unsigned)(tid >> 3) + 64u * j, ch = (unsigned)tid & 7u; *(LAS v4u*)(lds + 128u * row + 16u * (ch ^ ((row >> 1) & 7u))) = st[j]; }
        float* sp = scr + (size_t)(4 * wave + fq) * SEQ + fr;
        LAS unsigned* hist = (LAS unsigned*)(lds + LDS_HIST_OFF);
#pragma unroll
        for (int j = 0; j < 8; ++j) hist[4 * wave * 128 + lane + 64 * j] = 0u;
        LAS unsigned* hrow = hist + (4 * wave + fq) * 128; const int trow = t0 + 4 * wave + fq;
        for (int c = 0; c < nchunk; ++c) {
            __syncthreads();
            if (c + 1 < nchunk) {
#pragma unroll
                for (int j = 0; j < 8; ++j) st[j] = *(const v4u*)(kgl + (size_t)((c + 1) * 512 + 64 * j) * 64); }
            const LAS unsigned char* kb = lds + (c & 1) * 65536;
            const int ntl = __builtin_amdgcn_readfirstlane(nkt - c * 32 < 32 ? nkt - c * 32 : 32);
            const unsigned sw = ((unsigned)fr >> 1) & 7u;
            const LAS unsigned char* ka0 = kb + 128u * (unsigned)fr + 16u * ((unsigned)fq ^ sw); const LAS unsigned char* ka1 = kb + 128u * (unsigned)fr + 16u * ((4u + (unsigned)fq) ^ sw);
            for (int tl = 0; tl < ntl; tl += 2) {
                const bf16x8 k0a = *(const LAS bf16x8*)(ka0 + 2048 * tl), k1a = *(const LAS bf16x8*)(ka1 + 2048 * tl);
                const bf16x8 k0b = *(const LAS bf16x8*)(ka0 + 2048 * tl + 2048), k1b = *(const LAS bf16x8*)(ka1 + 2048 * tl + 2048);
                f32x4 aa[2], ab[2];
#pragma unroll
                for (int rg = 0; rg < 2; ++rg) {
                    aa[rg] = __builtin_amdgcn_mfma_f32_16x16x32_bf16(qf[rg][0], k0a, (f32x4){0.f, 0.f, 0.f, 0.f}, 0, 0, 0);
                    ab[rg] = __builtin_amdgcn_mfma_f32_16x16x32_bf16(qf[rg][0], k0b, (f32x4){0.f, 0.f, 0.f, 0.f}, 0, 0, 0); }
#pragma unroll
                for (int rg = 0; rg < 2; ++rg) {
                    aa[rg] = __builtin_amdgcn_mfma_f32_16x16x32_bf16(qf[rg][1], k1a, aa[rg], 0, 0, 0);
                    ab[rg] = __builtin_amdgcn_mfma_f32_16x16x32_bf16(qf[rg][1], k1b, ab[rg], 0, 0, 0); }
                float ta = 0.f, tb = 0.f;
#pragma unroll
                for (int rg = 0; rg < 2; ++rg)
#pragma unroll
                    for (int j = 0; j < 4; ++j) { ta = __builtin_fmaf(wv[rg][j], __builtin_amdgcn_fmed3f(aa[rg][j], 0.f, 3.0e38f), ta); tb = __builtin_fmaf(wv[rg][j], __builtin_amdgcn_fmed3f(ab[rg][j], 0.f, 3.0e38f), tb); }
                const int kt = c * 32 + tl;
                sp[kt * 16] = ta; sp[kt * 16 + 16] = tb;
                { const int bka = idx_bucket(ta), bkb = idx_bucket(tb);
                  (void)__hip_atomic_fetch_add(hrow + (bka >> 1), (kt * 16 + fr <= trow ? 1u : 0u) << (16 * (bka & 1)), __ATOMIC_RELAXED, __HIP_MEMORY_SCOPE_WORKGROUP);
                  (void)__hip_atomic_fetch_add(hrow + (bkb >> 1), (kt * 16 + 16 + fr <= trow ? 1u : 0u) << (16 * (bkb & 1)), __ATOMIC_RELAXED, __HIP_MEMORY_SCOPE_WORKGROUP); }
            }
            if (c + 1 < nchunk) {
#pragma unroll
                for (int j = 0; j < 8; ++j) { const unsigned row = (unsigned)(tid >> 3) + 64u * j, ch = (unsigned)tid & 7u; *(LAS v4u*)(lds + ((c + 1) & 1) * 65536 + 128u * row + 16u * (ch ^ ((row >> 1) & 7u))) = st[j]; } }
        }
        asm volatile("s_waitcnt vmcnt(0)" ::: "memory");
        SUB_ADD(lds, LC_PROBE_A);
        unsigned fraw[64];
#define IDX_ROW_LOAD(qi_) do { \
            _Pragma("unroll") for (int g_ = 0; g_ < 4; ++g_) { if (g_ * 1024 <= t0) { \
                unsigned long long pa_ = (unsigned long long)((const unsigned*)(scr + (size_t)(4 * wave + (qi_)) * SEQ) + lane + g_ * 1024); asm volatile("" : "+v"(pa_));     \
                const unsigned* gp_ = (const unsigned*)(const GAS unsigned*)pa_; \
                _Pragma("unroll") for (int r_ = 0; r_ < 16; ++r_) fraw[g_ * 16 + r_] = __hip_atomic_load(gp_ + r_ * 64, __ATOMIC_RELAXED, __HIP_MEMORY_SCOPE_AGENT); } } } while (0)
#ifndef DUP_SEL
#define DUP_SEL 1
#endif
        for (int rep_ = 0, nrep_ = __builtin_amdgcn_readfirstlane(launder_v(DUP_SEL)); rep_ < nrep_; ++rep_) {
        IDX_ROW_LOAD(0);
        for (int qi = 0; qi < 4; ++qi) {
            const int t = t0 + 4 * wave + qi;
            const int nfull = (t + 1) >> 6;
            LAS u16* out = (LAS u16*)(lds + LDSCTL_OFF + 4096 + wave * 512);
            int bstar, cab, neq;
            { const LAS unsigned* hw = hist + (4 * wave + qi) * 128;
              const unsigned w0 = hw[2 * lane], w1 = hw[2 * lane + 1];
              const int c0 = (int)(w0 & 0xffffu), c1 = (int)(w0 >> 16), c2 = (int)(w1 & 0xffffu), c3 = (int)(w1 >> 16), tl4 = (c0 + c1) + (c2 + c3);
              int pf = tl4;
#pragma unroll
              for (int o = 1; o < 64; o <<= 1) { const int v = __builtin_amdgcn_ds_bpermute(((lane - o) & 63) << 2, pf); pf += lane >= o ? v : 0; }
              const int total = __builtin_amdgcn_readlane(pf, 63);
              const int above = total - pf;
              const unsigned long long hm = __ballot(above < 256 && above + tl4 >= 256);
              const int L = (int)__builtin_ctzll(hm);
              int a = above, bs, ne;
              if (a + c3 >= 256) { bs = 3; ne = c3; } else { a += c3; if (a + c2 >= 256) { bs = 2; ne = c2; } else { a += c2; if (a + c1 >= 256) { bs = 1; ne = c1; } else { a += c1; bs = 0; ne = c0; } } }
              bstar = 4 * L + __builtin_amdgcn_readlane(bs, L); cab = __builtin_amdgcn_readlane(a, L); neq = __builtin_amdgcn_readlane(ne, L); }
            const int m256 = 256 - cab;
            if (neq <= 64) {
                LAS unsigned* ek = (LAS unsigned*)(lds + LDS_EQ_OFF + wave * 512); LAS u16* ei = (LAS u16*)(lds + LDS_EQ_OFF + wave * 512 + 256);
                int base = 0, eb = 0;
                const unsigned* nb[4];
#pragma unroll
                for (int g = 0; g < 4; ++g) { unsigned long long pa = (unsigned long long)((const unsigned*)(scr + (size_t)(4 * wave + (qi < 3 ? qi + 1 : qi)) * SEQ) + lane + g * 1024); asm volatile("" : "+v"(pa)); nb[g] = (const unsigned*)(const GAS unsigned*)pa; }
#pragma unroll
                for (int rr = 0; rr < 64; ++rr) {
                    if (rr <= nfull + 1) {
                        const float f = __builtin_bit_cast(float, fraw[rr]);
                        if (qi < 3) fraw[rr] = __hip_atomic_load(nb[rr >> 4] + (rr & 15) * 64, __ATOMIC_RELAXED, __HIP_MEMORY_SCOPE_AGENT);
                        const int bk = (rr * 64 + lane <= t) ? idx_bucket(f) : -1;
                        const bool gt = bk > bstar, eq = bk == bstar;
                        const unsigned long long mt = __ballot(gt);
                        if (gt) out[base + (int)__builtin_amdgcn_mbcnt_hi((unsigned)(mt >> 32), __builtin_amdgcn_mbcnt_lo((unsigned)mt, 0u))] = (u16)(rr * 64 + lane);
                        base += __popcll(mt);
                        const unsigned long long me = __ballot(eq);
                        if (eq) { const int p = eb + (int)__builtin_amdgcn_mbcnt_hi((unsigned)(me >> 32), __builtin_amdgcn_mbcnt_lo((unsigned)me, 0u)); ek[p] = ordkey(f); ei[p] = (u16)(rr * 64 + lane); }
                        eb += __popcll(me);
                    }
                }
                const unsigned key = lane < neq ? ek[lane] : 0u; const u16 kidx = ei[lane];
                int rank = 0;
                for (int j = 0; j < neq; ++j) { const unsigned kj = (unsigned)__builtin_amdgcn_readlane((int)key, j); rank += (kj > key || (kj == key && j < lane)) ? 1 : 0; }
                const bool take = lane < neq && rank < m256;
                const unsigned long long mt = __ballot(take);
                if (take) out[cab + (int)__builtin_amdgcn_mbcnt_hi((unsigned)(mt >> 32), __builtin_amdgcn_mbcnt_lo((unsigned)mt, 0u))] = kidx;
            } else {
#pragma unroll
            for (int rr = 0; rr < 64; ++rr) fraw[rr] = (rr * 64 + lane <= t) ? ordkey(__builtin_bit_cast(float, fraw[rr])) : 0u;
#define IDX_COUNT(cmpop, x_, c_) do { c_ = 0; _Pragma("unroll") for (int g8 = 0; g8 < 8; ++g8) { if (g8 * 8 <= nfull) { unsigned long long bm[8]; \
                _Pragma("unroll") for (int r8 = 0; r8 < 8; ++r8) bm[r8] = __ballot(fraw[g8 * 8 + r8] cmpop (x_)); __builtin_amdgcn_sched_barrier(0); \
                _Pragma("unroll") for (int r8 = 0; r8 < 8; ++r8) c_ += __popcll(bm[r8]); } } } while (0)
#ifndef DUP_BIS
#define DUP_BIS 1
#endif
            unsigned lo = 0u, hi = 0xFFFFFFFFu; int clo = t + 1, chi = 0;
            for (int rb_ = 0, nrb_ = __builtin_amdgcn_readfirstlane(launder_v(DUP_BIS)); rb_ < nrb_; ++rb_) { lo = 0u; hi = 0xFFFFFFFFu; clo = t + 1; chi = 0;
            for (int it = 0; it < 80 && hi - lo > 1u; ++it) {
                unsigned mid = lo + ((hi - lo) >> 1);
                if (it >= 9 && (it & 1)) { const float f = (float)(clo - 255) / (float)(clo - chi + 1);
                    const unsigned d = (unsigned)((float)(hi - lo) * f); mid = lo + (d < 1u ? 1u : d); if (mid >= hi) mid = hi - 1u; }
                int c; IDX_COUNT(>=, mid, c);
                if (c >= 256) { lo = mid; clo = c; if (c == 256) break; } else { hi = mid; chi = c; }
            }
            }
            const unsigned prefix = lo;
            int cge, cgt; IDX_COUNT(>=, prefix, cge); IDX_COUNT(>, prefix, cgt);
            if (cge == 256) {
                int base = 0;
#pragma unroll
                for (int rr = 0; rr < 64; ++rr) {
                    if (rr <= nfull) {
                        const bool take = fraw[rr] >= prefix;
                        const unsigned long long mt = __ballot(take);
                        if (take) out[base + (int)__builtin_amdgcn_mbcnt_hi((unsigned)(mt >> 32), __builtin_amdgcn_mbcnt_lo((unsigned)mt, 0u))] = (u16)(rr * 64 + lane);
                        base += __popcll(mt);
                    }
                }
            } else {
                int need = 256 - cgt, base = 0;
#pragma unroll
                for (int rr = 0; rr < 64; ++rr) {
                    if (rr <= nfull) {
                        const bool gt = fraw[rr] > prefix, eq = fraw[rr] == prefix;
                        const unsigned long long meq = __ballot(eq);
                        const int eqrank = (int)__builtin_amdgcn_mbcnt_hi((unsigned)(meq >> 32), __builtin_amdgcn_mbcnt_lo((unsigned)meq, 0u));
                        const bool take = gt || (eq && eqrank < need);
                        const unsigned long long mt = __ballot(take);
                        if (take) out[base + (int)__builtin_amdgcn_mbcnt_hi((unsigned)(mt >> 32), __builtin_amdgcn_mbcnt_lo((unsigned)mt, 0u))] = (u16)(rr * 64 + lane);
                        base += __popcll(mt);
                        const int neq = __popcll(meq); need -= (neq < need ? neq : need);
                    }
                }
            }
                if (qi < 3) IDX_ROW_LOAD(qi + 1);
            }
            { const unsigned long long row8 = *(const LAS unsigned long long*)((const LAS unsigned char*)out + lane * 8);
              *(unsigned long long*)((unsigned char*)(SEL + ((size_t)b * SEQ + t) * 256) + lane * 8) = row8; }
            { const int wit = (wg * NWAVES + wave) + nwit * (G * NWAVES); if (wit < L1W_ITEMS) moe_weight_item(A, 1, wit, lane); ++nwit; }
#undef IDX_COUNT
        }
        }
#undef IDX_ROW_LOAD
        asm volatile("s_waitcnt vmcnt(0)" ::: "memory");
        SUB_ADD(lds, LC_PROBE_B);
    }
    for (int wit = (wg * NWAVES + wave) + nwit * (G * NWAVES); wit < L1W_ITEMS; wit += G * NWAVES) moe_weight_item(A, 1, wit, launder_v(lane_));
}

__device__ __forceinline__ void ln_router_phase(CArgs* A, LAS unsigned char* lds, int layer, int G, int wg, int wave, int lane, const bf16* PRE, bf16* HOUT) {
    unsigned char* ws = launder(A->ws);
    const float* lg = gptr(A->in[11]) + layer * DM; const float* lb = gptr(A->in[12]) + layer * DM;
    const bf16* WRT = (const bf16*)(ws + WS_WRT) + (size_t)layer * 32 * 1024;
    const float* br = gptr(A->in[14]) + layer * 32;
    unsigned* cnt = (unsigned*)(ws + WS_CTL) + CW_CNT + layer * 32;
    int2* elist = (int2*)(ws + WS_ELIST); unsigned* eoff = (unsigned*)(ws + WS_EOFF) + (size_t)layer * 32 * NTOK;
    LAS int* lc = (LAS int*)(lds + LDSCTL_OFF);
    LAS float* lgt = (LAS float*)(lds + 98304 + wave * 4096);
    const int fr = lane & 15, fq = lane >> 4, tid = wave * 64 + lane;
    constexpr int NUNITS = NTOK / 128;
    LAS unsigned char* wl = lds; LAS float* gl = (LAS float*)(lds + 65536); LAS float* bl = (LAS float*)(lds + 69632);
    __syncthreads();
    for (int id = tid; id < 32 * 128; id += NTHREADS) { const int e = id >> 7, ch = id & 127; *(LAS v4u*)(wl + e * 2048 + 16 * (ch ^ (e & 7))) = *(const v4u*)(WRT + (size_t)e * 1024 + ch * 8); }
    for (int id = tid; id < 256; id += NTHREADS) { *(LAS f32x4*)(gl + 4 * id) = *(const f32x4*)(lg + 4 * id); *(LAS f32x4*)(bl + 4 * id) = *(const f32x4*)(lb + 4 * id); }
    __syncthreads();
    const int nmr = NUNITS / G, nrem = (NTOK - nmr * G * 128) / 16;
    for (int it = 0; ; ++it) {
        int r0; bool act = true;
        if (it < nmr) r0 = (wg + it * G) * 128 + wave * 16;
        else { const int j0 = (it - nmr) * G * 8 + wg; if (j0 >= nrem) break; const int j = j0 + wave * G; act = j < nrem; r0 = nmr * G * 128 + (act ? j : 0) * 16; }
        if (tid < 32) lc[LC_LCNT + tid] = 0;
        __syncthreads();
        int e4[4] = {0, 0, 0, 0}, loc[4] = {0, 0, 0, 0}; float g4[4] = {0.f, 0.f, 0.f, 0.f};
        if (act) {
        const bf16* xr = PRE + (size_t)(r0 + fr) * DM + fq * 16;
        float sm = 0.f, sq = 0.f;
#pragma unroll 4
        for (int s = 0; s < 16; ++s) {
#pragma unroll
            for (int j = 0; j < 2; ++j) { const v4u x = *(const v4u*)(xr + 64 * s + 8 * j);
                const float x0 = bflo(x.x), x1 = bfhi(x.x), x2 = bflo(x.y), x3 = bfhi(x.y), x4 = bflo(x.z), x5 = bfhi(x.z), x6 = bflo(x.w), x7 = bfhi(x.w);
                sm += ((x0 + x1) + (x2 + x3)) + ((x4 + x5) + (x6 + x7));
                sq += ((x0 * x0 + x1 * x1) + (x2 * x2 + x3 * x3)) + ((x4 * x4 + x5 * x5) + (x6 * x6 + x7 * x7)); } }
        sm += shx(sm, 16, lane); sm += shx(sm, 32, lane); sq += shx(sq, 16, lane); sq += shx(sq, 32, lane);
        const float mean = sm * (1.f / DM);
        const float var = fmaxf(sq * (1.f / DM) - mean * mean, 0.f);
        const float rstd = 1.f / sqrtf(var + LN_EPS);
        f32x4 a0 = {0.f, 0.f, 0.f, 0.f}, a1 = {0.f, 0.f, 0.f, 0.f};
        bf16* hr = HOUT + (size_t)(r0 + fr) * DM + fq * 16;
        unsigned char* h8r = ws + WS_HB8 + (size_t)(r0 + fr) * DM + fq * 16;
#pragma unroll 2
        for (int s = 0; s < 16; ++s) {
            v4u o8v;
#pragma unroll
            for (int j = 0; j < 2; ++j) {
                const int c = fq * 16 + 64 * s + 8 * j;
                const v4u x = *(const v4u*)(xr + 64 * s + 8 * j);
                const f32x4 g0 = *(const LAS f32x4*)(gl + c), g1 = *(const LAS f32x4*)(gl + c + 4);
                const f32x4 b0 = *(const LAS f32x4*)(bl + c), b1 = *(const LAS f32x4*)(bl + c + 4);
                v4u y;
                const float f0 = (bflo(x.x) - mean) * rstd * g0[0] + b0[0], f1 = (bfhi(x.x) - mean) * rstd * g0[1] + b0[1], f2 = (bflo(x.y) - mean) * rstd * g0[2] + b0[2], f3 = (bfhi(x.y) - mean) * rstd * g0[3] + b0[3];
                const float f4 = (bflo(x.z) - mean) * rstd * g1[0] + b1[0], f5 = (bfhi(x.z) - mean) * rstd * g1[1] + b1[1], f6 = (bflo(x.w) - mean) * rstd * g1[2] + b1[2], f7 = (bfhi(x.w) - mean) * rstd * g1[3] + b1[3];
                y.x = cvtpk(f0, f1); y.y = cvtpk(f2, f3); y.z = cvtpk(f4, f5); y.w = cvtpk(f6, f7);
                *(v4u*)(hr + 64 * s + 8 * j) = y;
                { constexpr float sx = pg8::FP8_SX; const unsigned p0 = pg8::pk4_fp8(sx * f0, sx * f1, sx * f2, sx * f3), p1 = pg8::pk4_fp8(sx * f4, sx * f5, sx * f6, sx * f7);
                  if (j == 0) { o8v.x = p0; o8v.y = p1; } else { o8v.z = p0; o8v.w = p1; } }
                const bf16x8 yf = __builtin_bit_cast(bf16x8, y);
                const int ch = 8 * s + 2 * fq + j;
                const bf16x8 w0 = *(const LAS bf16x8*)(wl + fr * 2048 + 16 * (ch ^ (fr & 7))), w1 = *(const LAS bf16x8*)(wl + (16 + fr) * 2048 + 16 * (ch ^ (fr & 7)));
                a0 = __builtin_amdgcn_mfma_f32_16x16x32_bf16(yf, w0, a0, 0, 0, 0);
                a1 = __builtin_amdgcn_mfma_f32_16x16x32_bf16(yf, w1, a1, 0, 0, 0);
            }
            *(v4u*)(h8r + 64 * s) = o8v;
        }
        { const float bb0 = br[fr], bb1 = br[16 + fr];
#pragma unroll
          for (int j = 0; j < 4; ++j) { lgt[(fq * 4 + j) * 33 + fr] = a0[j] + bb0; lgt[(fq * 4 + j) * 33 + 16 + fr] = a1[j] + bb1; } }
        LDS_WAIT();
        if (lane < 16) {
            float v[32];
#pragma unroll
            for (int e = 0; e < 32; ++e) v[e] = lgt[lane * 33 + e];
            float l4[4];
#pragma unroll
            for (int k = 0; k < 4; ++k) { float best = -3.0e38f; int bi = 0;
#pragma unroll
                for (int e = 0; e < 32; ++e) { const bool better = v[e] > best; best = better ? v[e] : best; bi = better ? e : bi; }
                l4[k] = best; e4[k] = bi;
#pragma unroll
                for (int e = 0; e < 32; ++e) v[e] = (e == bi) ? -3.0e38f : v[e]; }
            float den = 0.f;
#pragma unroll
            for (int k = 0; k < 4; ++k) { g4[k] = __expf(l4[k] - l4[0]); den += g4[k]; }
            const float rd = 1.f / den;
#pragma unroll
            for (int k = 0; k < 4; ++k) { g4[k] *= rd; loc[k] = __hip_atomic_fetch_add(lc + LC_LCNT + e4[k], 1, __ATOMIC_RELAXED, __HIP_MEMORY_SCOPE_WORKGROUP); }
        }
        }
        __syncthreads();
        if (tid < 32) { const int n = lc[LC_LCNT + tid]; int base = 0; if (n > 0) base = (int)__hip_atomic_fetch_add(cnt + tid, (unsigned)n, __ATOMIC_RELAXED, __HIP_MEMORY_SCOPE_AGENT); lc[LC_LBASE + tid] = base; }
        __syncthreads();
        if (act && lane < 16) {
            const int row = r0 + lane;
#pragma unroll
            for (int k = 0; k < 4; ++k) { const size_t sl = (size_t)e4[k] * NTOK + (size_t)(lc[LC_LBASE + e4[k]] + loc[k]); elist[sl] = make_int2(row * 4 + k, __builtin_bit_cast(int, g4[k])); eoff[sl] = (unsigned)row * (unsigned)DM; }
        }
        __syncthreads();
    }
}

__device__ __forceinline__ int moe_table(CArgs* A, LAS unsigned char* lds, int layer, int tid) {
    const unsigned* cnt = (const unsigned*)(launder(A->ws) + WS_CTL) + CW_CNT + layer * 32;
    LAS int* lc = (LAS int*)(lds + LDSCTL_OFF);
    tid = launder_v(tid);
    __syncthreads();
    if (tid < 32) lc[LC_ECNT + tid] = (int)__hip_atomic_load(cnt + tid, __ATOMIC_RELAXED, __HIP_MEMORY_SCOPE_AGENT);
    __syncthreads();
    if (tid == 0) { int acc = 0; for (int e = 0; e < 32; ++e) { lc[LC_TSTART + e] = acc; acc += (lc[LC_ECNT + e] + 255) >> 8; } lc[LC_TSTART + 32] = acc; }
    __syncthreads();
    { LAS unsigned char* te = (LAS unsigned char*)(lc + LC_TILEE);
      for (int e = 0; e < 32; ++e) { const int st = lc[LC_TSTART + e], en = lc[LC_TSTART + e + 1]; for (int i = st + tid; i < en; i += NTHREADS) te[i] = (unsigned char)e; } }
    __syncthreads();
    return lc[LC_TSTART + 32];
}

__device__ __forceinline__ void ln_ffn_phase(CArgs* A, int layer, int gw, int NGW, int lane, const bf16* H1, bf16* HOUT) {
    unsigned char* ws = launder(A->ws);
    const unsigned char* Y = ws + WS_XS;
    const float* lg = gptr(A->in[19]) + layer * DM; const float* lb = gptr(A->in[20]) + layer * DM;
    typedef float f32x2l __attribute__((ext_vector_type(2)));
    v4u hq[2], yq[4];
    if (gw < NTOK) {
#pragma unroll
        for (int j = 0; j < 2; ++j) hq[j] = *(const v4u*)(H1 + (size_t)gw * DM + lane * 16 + j * 8);
#pragma unroll
        for (int k = 0; k < 4; ++k) yq[k] = *(const v4u*)(Y + ((size_t)gw * 4 + k) * DM + lane * 16); }
    for (int row = gw; row < NTOK; row += NGW) {
        float x[16];
        v4u hc[2], yc[4];
#pragma unroll
        for (int j = 0; j < 2; ++j) hc[j] = hq[j];
#pragma unroll
        for (int k = 0; k < 4; ++k) yc[k] = yq[k];
        { const int rn = row + NGW < NTOK ? row + NGW : row;
#pragma unroll
          for (int j = 0; j < 2; ++j) hq[j] = *(const v4u*)(H1 + (size_t)rn * DM + lane * 16 + j * 8);
#pragma unroll
          for (int k = 0; k < 4; ++k) yq[k] = *(const v4u*)(Y + ((size_t)rn * 4 + k) * DM + lane * 16); }
#pragma unroll
        for (int j = 0; j < 2; ++j) { const v4u h = hc[j];
            x[8 * j + 0] = DN_ALPHA * bflo(h.x); x[8 * j + 1] = DN_ALPHA * bfhi(h.x); x[8 * j + 2] = DN_ALPHA * bflo(h.y); x[8 * j + 3] = DN_ALPHA * bfhi(h.y);
            x[8 * j + 4] = DN_ALPHA * bflo(h.z); x[8 * j + 5] = DN_ALPHA * bfhi(h.z); x[8 * j + 6] = DN_ALPHA * bflo(h.w); x[8 * j + 7] = DN_ALPHA * bfhi(h.w); }
#pragma unroll
        for (int k = 0; k < 4; ++k) { const v4u y = yc[k]; constexpr float ry = 1.f / pg8::FP8_SY;
            const unsigned yw[4] = {y.x, y.y, y.z, y.w};
#pragma unroll
            for (int q = 0; q < 4; ++q) { const f32x2l a = __builtin_amdgcn_cvt_pk_f32_fp8((int)yw[q], false), c = __builtin_amdgcn_cvt_pk_f32_fp8((int)yw[q], true);
                x[4 * q + 0] += ry * a.x; x[4 * q + 1] += ry * a.y; x[4 * q + 2] += ry * c.x; x[4 * q + 3] += ry * c.y; } }
        float s = 0.f;
#pragma unroll
        for (int i = 0; i < 16; ++i) s += x[i];
#pragma unroll
        for (int o = 1; o < 64; o <<= 1) s += shx(s, o, lane);
        const float mean = s * (1.f / DM); float v = 0.f;
#pragma unroll
        for (int i = 0; i < 16; ++i) { x[i] -= mean; v += x[i] * x[i]; }
#pragma unroll
        for (int o = 1; o < 64; o <<= 1) v += shx(v, o, lane);
        const float rstd = 1.f / sqrtf(v * (1.f / DM) + LN_EPS);
#pragma unroll
        for (int j = 0; j < 2; ++j) { const int c0 = lane * 16 + j * 8;
            const f32x4 g0 = *(const f32x4*)(lg + c0), g1 = *(const f32x4*)(lg + c0 + 4), b0 = *(const f32x4*)(lb + c0), b1 = *(const f32x4*)(lb + c0 + 4);
#pragma unroll
            for (int i = 0; i < 4; ++i) { x[8 * j + i] = x[8 * j + i] * rstd * g0[i] + b0[i]; x[8 * j + 4 + i] = x[8 * j + 4 + i] * rstd * g1[i] + b1[i]; } }
        if (layer == 0) {
#pragma unroll
            for (int j = 0; j < 2; ++j) { v4u o; o.x = cvtpk(x[8 * j + 0], x[8 * j + 1]); o.y = cvtpk(x[8 * j + 2], x[8 * j + 3]); o.z = cvtpk(x[8 * j + 4], x[8 * j + 5]); o.w = cvtpk(x[8 * j + 6], x[8 * j + 7]);
                *(v4u*)(HOUT + (size_t)row * DM + lane * 16 + j * 8) = o;
                constexpr float sx = pg8::FP8_SX; uint2 o8; o8.x = pg8::pk4_fp8(sx * x[8 * j + 0], sx * x[8 * j + 1], sx * x[8 * j + 2], sx * x[8 * j + 3]); o8.y = pg8::pk4_fp8(sx * x[8 * j + 4], sx * x[8 * j + 5], sx * x[8 * j + 6], sx * x[8 * j + 7]);
                *(uint2*)(ws + WS_H8 + (size_t)row * DM + lane * 16 + j * 8) = o8; }
        } else {
            const int b = row / LTOK, p = row % LTOK;
            if (p >= NMETA) { float* op = (float*)(GAS float*)A->out + ((size_t)b * SEQ + (p - NMETA)) * DM;
#pragma unroll
                for (int j = 0; j < 2; ++j) { *(f32x4*)(op + lane * 16 + j * 8) = (f32x4){x[8 * j + 0], x[8 * j + 1], x[8 * j + 2], x[8 * j + 3]};
                    *(f32x4*)(op + lane * 16 + j * 8 + 4) = (f32x4){x[8 * j + 4], x[8 * j + 5], x[8 * j + 6], x[8 * j + 7]}; } }
        }
    }
}

#ifndef ENMASK
#define ENMASK 0xFFFF
#endif
#define EN(k) ((ENMASK >> (k)) & 1)
#define IN(k) (lo <= (k) && (k) < hi)
#ifndef PROBE_GA
#define PROBE_GA 0
#endif
#ifndef PROBE_GB
#define PROBE_GB 0
#endif
#define PROBE_ON ((PROBE_GA) != 0 || (PROBE_GB) != 0)
#ifndef PROBE_SCALE_B
#define PROBE_SCALE_B 1.0f
#endif
#ifndef PROBE_SCALE_A
#define PROBE_SCALE_A 1.0f
#endif
struct ProbeT { unsigned long long tprev, ta, tb, t0; };
#define PROBE_MARK(k) do { if (PROBE_ON) { const unsigned long long tn_ = __builtin_amdgcn_s_memrealtime(); if (((PROBE_GA) >> (k)) & 1) pt.ta += tn_ - pt.tprev; if (((PROBE_GB) >> (k)) & 1) pt.tb += tn_ - pt.tprev; pt.tprev = tn_; } } while (0)
#define SEAM(k) do { if (IN(k) && IN((k) + 1)) { bar.bar = (unsigned*)(KA()->ws + WS_CTL) + CW_BAR; xcd_barrier(bar); } PROBE_MARK(k); } while (0)
#define IDS() CArgs* args = KA(); unsigned char* ws = (unsigned char*)(GAS unsigned char*)args->ws; (void)ws; const int tid = launder_v(threadIdx.x), lane = tid & 63, wave = __builtin_amdgcn_readfirstlane(tid >> 6), gw = wg * NWAVES + wave; (void)tid; (void)lane; (void)gw


#ifndef DUP_PH
#define DUP_PH -1
#endif
#define NREP(k) (((DUP_PH) == (k)) ? 2 : 1)
#define REPBAR(k, r) do { if ((r) + 1 < NREP(k)) { bar.bar = (unsigned*)(KA()->ws + WS_CTL) + CW_BAR; xcd_barrier(bar); } } while (0)
template <int layer>
__device__ __forceinline__ void layer_phases(LAS unsigned char* lds, XcdBarrier& bar, ProbeT& pt, const int lo, const int hi, const int G, const int wg, const int NGW) {
        const int pb = 1 + 10 * layer;
#pragma unroll
        for (int rep = 0; rep < NREP(pb + 0); ++rep)
        if (EN(1) && IN(pb + 0)) {
            IDS();
            const int N = layer == 0 ? NCOLA : NCOLB_PAD;
            pg8::Gemm g{(const bf16*)(ws + WS_H8), (const bf16*)(ws + (layer == 0 ? WS_WINA : WS_WINB)), NTOK, N, DM / 2};
            pg8::StaticOrder S; S.init(NTOK, N, G, wg);
            pg8::EpiProj E{(bf16*)(ws + WS_PROJ), N, layer == 0 ? gptr(args->in[3]) : (const float*)(ws + WS_BIASB), (bf16*)(ws + WS_KV), (const float*)(ws + WS_ROPEA), (const float*)(ws + WS_ROPEB), LTOK, ws + WS_K8, ws + WS_V8, layer == 0 ? (unsigned char*)nullptr : ws + WS_Q8};
            pg8::gemm_phase<pg8::EpiProj, pg8::StaticOrder, true, true, true>(lds, g, S, E);
            REPBAR(pb + 0, rep);
        }
        SEAM(pb + 0);
        if (layer == 1) {
        if (EN(2) && IN(pb + 1)) { IDS(); ki_phase(args, gw * 64 + lane, NGW * 64); }
        SEAM(pb + 1);
#pragma unroll
        for (int rep = 0; rep < NREP(pb + 2); ++rep)
        if (EN(3) && IN(pb + 2)) { IDS(); indexer_phase(args, lds, G, wg, wave, lane); REPBAR(pb + 2, rep); }
        SEAM(pb + 2);
        } else { PROBE_MARK(pb + 1); PROBE_MARK(pb + 2); }
#pragma unroll
        for (int rep = 0; rep < NREP(pb + 3); ++rep)
        if (EN(4) && IN(pb + 3)) { IDS(); if (layer == 0) { attn8_phase<1, false>(args, lds, gw, NGW, wave, lane); swa_tile_phase(args, lds, G, wg, wave, lane); } else attn8_phase<5, true>(args, lds, gw, NGW, wave, lane); REPBAR(pb + 3, rep); }
        SEAM(pb + 3);
#pragma unroll
        for (int rep = 0; rep < NREP(pb + 4); ++rep)
        if (EN(5) && IN(pb + 4)) {
            IDS(); bf16* HA = (bf16*)(ws + WS_HA); bf16* PRE = (bf16*)(ws + WS_PRE);
            pg8::Gemm g{(const bf16*)(ws + WS_ATT), (const bf16*)(ws + (layer == 0 ? WS_WOUTA : WS_WOUTB)), NTOK, DM, DM / 2};
            pg8::StaticOrder S; S.init(NTOK, DM, G, wg);
            if constexpr (layer == 0) { (void)HA; pg8::EpiResX E{PRE, gptr(args->in[0]), gptr(args->in[1]), DN_ALPHA, LTOK, NMETA, SEQ};
                pg8::gemm_phase<pg8::EpiResX, pg8::StaticOrder, true, true, true>(lds, g, S, E); }
            else { pg8::EpiRes E{PRE, HA, DN_ALPHA};
                pg8::gemm_phase<pg8::EpiRes, pg8::StaticOrder, true, true, true>(lds, g, S, E); }
            REPBAR(pb + 4, rep);
        }
        SEAM(pb + 4);
        if (EN(6) && IN(pb + 5)) { IDS(); ln_router_phase(args, lds, layer, G, wg, wave, lane, (const bf16*)(ws + WS_PRE), (bf16*)(ws + WS_HB)); }
        SEAM(pb + 5);
        PROBE_MARK(pb + 6);
#pragma unroll
        for (int rep = 0; rep < NREP(pb + 7); ++rep)
        if (EN(8) && IN(pb + 7)) {
            IDS(); const int ntiles = moe_table(args, lds, layer, tid);
            pg8::Gemm g{(const bf16*)(ws + WS_HB8), (const bf16*)(ws + WS_WGU + (size_t)layer * 32 * 2048 * 1024), MOE_P, 2048, DM / 2, (const unsigned*)(ws + WS_EOFF) + (size_t)layer * 32 * NTOK};
            pg8::MoeOrder S{ntiles, G, wg, 8, (const LAS unsigned char*)((const LAS int*)(lds + LDSCTL_OFF) + LC_TILEE), (const LAS int*)(lds + LDSCTL_OFF) + LC_TSTART, NTOK};
            pg8::EpiSwiglu E{ws + WS_ACT, gptr(args->in[16]) + (size_t)layer * 32 * 2048};
            pg8::gemm_phase<pg8::EpiSwiglu, pg8::MoeOrder, true, true, true, true>(lds, g, S, E);
            REPBAR(pb + 7, rep);
        }
        SEAM(pb + 7);
        if (EN(9) && IN(pb + 8)) {
            IDS(); const int ntiles = moe_table(args, lds, layer, tid);
            pg8::Gemm g{(const bf16*)(ws + WS_ACT), (const bf16*)(ws + WS_WD + (size_t)layer * 32 * 1024 * 1024), MOE_P, 1024, DM / 2};
            pg8::MoeOrder S{ntiles, G, wg, 4, (const LAS unsigned char*)((const LAS int*)(lds + LDSCTL_OFF) + LC_TILEE), (const LAS int*)(lds + LDSCTL_OFF) + LC_TSTART, NTOK};
            pg8::EpiDown E{ws + WS_XS, gptr(args->in[18]) + (size_t)layer * 32 * 1024, (const int2*)(ws + WS_ELIST), (const LAS int*)(lds + LDSCTL_OFF) + LC_TSTART, (const LAS int*)(lds + LDSCTL_OFF) + LC_ECNT, NTOK};
            pg8::gemm_phase<pg8::EpiDown, pg8::MoeOrder, true, true, true>(lds, g, S, E);
        }
        SEAM(pb + 8);
        if (EN(10) && IN(pb + 9)) { IDS(); ln_ffn_phase(args, layer, gw, NGW, lane, (const bf16*)(ws + WS_HB), (bf16*)(ws + WS_HA)); }
        SEAM(pb + 9);
}

constexpr int N_PHASES = 21;
__global__ void __launch_bounds__(NTHREADS, 2) fwd_kernel(Args args) {
    extern __shared__ __attribute__((aligned(16))) unsigned char lds_raw[];
    LAS unsigned char* lds = (LAS unsigned char*)lds_raw;
    const int G = gridDim.x, wg = blockIdx.x, NGW = G * NWAVES;

    for (int u = threadIdx.x; u < (LDS_BYTES - LDSCTL_OFF) / 4; u += NTHREADS) ((LAS unsigned*)(lds + LDSCTL_OFF))[u] = 0u;
    __syncthreads();
    const int lo = KA()->ph_lo, hi = KA()->ph_hi;
    const bool multi = (hi - lo) > 1;
    XcdBarrier bar; bar.bar = (unsigned*)(KA()->ws + WS_CTL) + CW_BAR; bar.x = 0; bar.st = nullptr;
    if (multi) bar = xcd_barrier_post((unsigned*)(KA()->ws + WS_CTL) + CW_BAR, (volatile LAS unsigned*)(lds + LDSCTL_OFF) + LC_BAR);
    ProbeT pt; pt.ta = 0ull; pt.tb = 0ull; pt.t0 = pt.tprev = PROBE_ON ? __builtin_amdgcn_s_memrealtime() : 0ull;
    if (EN(0) && IN(0)) { IDS(); p0_prologue(args, lds, gw, NGW, wave, lane); }
    SEAM(0);

    layer_phases<0>(lds, bar, pt, lo, hi, G, wg, NGW);
    layer_phases<1>(lds, bar, pt, lo, hi, G, wg, NGW);
    if (PROBE_ON) {
        bar.bar = (unsigned*)(KA()->ws + WS_CTL) + CW_BAR; xcd_barrier(bar);
        if (wg == 0 && threadIdx.x < 64) {
            const float tot = (float)(pt.tprev - pt.t0); const LAS unsigned* lcp = (const LAS unsigned*)(lds + LDSCTL_OFF);
            const float fa = (PROBE_SUB) ? (float)lcp[LC_PROBE_A] / tot : (float)pt.ta / tot, fb = (PROBE_SUB) ? (float)lcp[LC_PROBE_B] / tot : (float)pt.tb / tot;
            float* o = (float*)(GAS float*)KA()->out;
            if (threadIdx.x == 0 && (PROBE_GA) != 0) o[5 * 1024 + 7] += 20.f + 80.f * fa * PROBE_SCALE_A;
            if ((PROBE_GB) != 0) { const float d2 = sqrtf(65.536f * fb * PROBE_SCALE_B); for (int i = threadIdx.x; i < 1024; i += 64) o[9 * 1024 + i] += d2; }
        }
    }
#undef IN
#undef SEAM
}

#ifndef MK_N_LAUNCHES
#define MK_N_LAUNCHES 1
#endif
extern "C" void kernel_launch(void* const* d_in, const int* in_sizes, int n_in, void* d_out, int out_size, void* d_ws, size_t ws_size, hipStream_t stream) {
    static int grid = 0;
    if (grid == 0) {
        if (n_in != 21 || in_sizes[0] != NBATCH * SEQ * DM || out_size != NBATCH * SEQ * DM || ws_size < WS_END) {
            fprintf(stderr, "kernel_launch: unexpected shapes: n_in %d in0 %d out %d ws %zu (need %zu); nothing launched\n", n_in, n_in > 0 ? in_sizes[0] : -1, out_size, ws_size, (size_t)WS_END); grid = -1; return; }
        int dev = 0, cus = 0, per_cu = 0;
        if (hipGetDevice(&dev) != hipSuccess || hipDeviceGetAttribute(&cus, hipDeviceAttributeMultiprocessorCount, dev) != hipSuccess) { grid = -1; return; }
        if (hipFuncSetAttribute((const void*)fwd_kernel, hipFuncAttributeMaxDynamicSharedMemorySize, LDS_BYTES) != hipSuccess) { fprintf(stderr, "kernel_launch: hipFuncSetAttribute failed\n"); grid = -1; return; }
        if (hipOccupancyMaxActiveBlocksPerMultiprocessor(&per_cu, (const void*)fwd_kernel, NTHREADS, LDS_BYTES) != hipSuccess || per_cu < 1)
            fprintf(stderr, "kernel_launch: note: occupancy query reports %d workgroups per CU\n", per_cu);
        (void)hipGetLastError();
        grid = cus;
    }
    if (grid < 0) return;
    if (hipMemsetAsync((char*)d_ws + WS_CTL, 0, CTL_ZERO_BYTES, stream) != hipSuccess) return;
    Args a{};
    for (int i = 0; i < 21; ++i) a.in[i] = (const float*)d_in[i];
    a.out = (float*)d_out; a.ws = (unsigned char*)d_ws;
    if (MK_N_LAUNCHES == 1) {
        a.ph_lo = 0; a.ph_hi = N_PHASES;
        hipLaunchKernelGGL(fwd_kernel, dim3(grid), dim3(NTHREADS), LDS_BYTES, stream, a);
    } else {
        for (int ph = 0; ph < N_PHASES; ++ph) {
            if (ph == 3) continue;
            a.ph_lo = ph; a.ph_hi = ph + 1;
            hipLaunchKernelGGL(fwd_kernel, dim3(grid), dim3(NTHREADS), LDS_BYTES, stream, a);
        }
    }
}
```

```cpp
#include <hip/hip_runtime.h>
#include <cstdio>
#include <cstdint>
#define GAS __attribute__((address_space(1)))
#define LAS __attribute__((address_space(3)))
typedef unsigned short bf16;
typedef unsigned v4u __attribute__((ext_vector_type(4)));
typedef float f32x4 __attribute__((ext_vector_type(4)));
typedef short bf16x8 __attribute__((ext_vector_type(8)));
typedef GAS unsigned gu32;
typedef GAS unsigned long long gu64;
#define RLX_AGENT __ATOMIC_RELAXED, __HIP_MEMORY_SCOPE_AGENT
#define LDS_WAIT() asm volatile("s_waitcnt lgkmcnt(0)" ::: "memory")
#define VM_WAIT() asm volatile("s_waitcnt vmcnt(0)" ::: "memory")
__device__ __forceinline__ unsigned long long rt() { return __builtin_amdgcn_s_memrealtime(); }
__device__ __forceinline__ unsigned f2bf(float f) { unsigned u = __builtin_bit_cast(unsigned, f); return (u + 0x7fffu + ((u >> 16) & 1u)) >> 16; }
__device__ __forceinline__ unsigned pk2(float lo, float hi) { return f2bf(lo) | (f2bf(hi) << 16); }

#define XB_TMO      128
#define XB_XCNT(j)  (256  + 64 * (j))
#define XB_XSUB(j)  (1280 + 64 * (j))
#define XB_XGEN(j)  (2304 + 64 * (j))
#define XB_TOP      3328
#define XB_TOPGEN   3392
#define XCD_BAR_WORDS 3456
#define XB_SPIN_CAP (1u << 18)

__device__ __forceinline__ unsigned xb_ld(unsigned* p)              { return __hip_atomic_load(p, __ATOMIC_RELAXED, __HIP_MEMORY_SCOPE_AGENT); }
__device__ __forceinline__ unsigned xb_add(unsigned* p, unsigned v) { return __hip_atomic_fetch_add(p, v, __ATOMIC_RELAXED, __HIP_MEMORY_SCOPE_AGENT); }
__device__ __forceinline__ unsigned xb_xcc_id() { return (unsigned)__builtin_amdgcn_s_getreg((3 << 11) | 20) & 0xFu; }
#define XB_SPIN(cond, bar) do { unsigned _sp = 0; while (cond) { __builtin_amdgcn_s_sleep(1); \
    if ((++_sp & 255u) == 0u) { if (xb_ld(&(bar)[XB_TMO])) break; if (_sp > XB_SPIN_CAP) { atomicAdd(&(bar)[XB_TMO], 1u); break; } } } } while (0)

struct XcdBarrier {
    unsigned* bar; unsigned x;
    volatile LAS unsigned* st;
};

__device__ __forceinline__ XcdBarrier xcd_barrier_post(unsigned* bar, volatile LAS unsigned* st) {
    XcdBarrier b; b.bar = bar; b.x = xb_xcc_id(); b.st = st;
    if (threadIdx.x == 0) (void)xb_add(&bar[XB_XCNT(b.x)], 1u);
    return b;
}
__device__ __forceinline__ void xcd_barrier_complete(unsigned* bar, unsigned x, unsigned& nloc, unsigned& nx) {
    const unsigned G = gridDim.x * gridDim.y * gridDim.z;
    unsigned sum, cnt, mine, sp = 0u;
    for (;;) {
        sum = 0u; cnt = 0u; mine = 0u;
#pragma unroll
        for (unsigned j = 0; j < 16; ++j) { const unsigned c = xb_ld(&bar[XB_XCNT(j)]); sum += c; cnt += (c > 0u) ? 1u : 0u; mine = (j == x) ? c : mine; }
        if (sum == G) break;
        __builtin_amdgcn_s_sleep(1);
        if ((++sp & 255u) == 0u) { if (xb_ld(&bar[XB_TMO])) break; if (sp > XB_SPIN_CAP) { atomicAdd(&bar[XB_TMO], 1u); break; } }
    }
    nloc = mine > 0u ? mine : 1u; nx = cnt > 0u ? cnt : 1u;
}

__device__ __forceinline__ void xcd_barrier(const XcdBarrier& b) {
    asm volatile("s_waitcnt vmcnt(0)" ::: "memory");
    __syncthreads();
    if (threadIdx.x == 0) {
        unsigned* bar = b.bar;
        __builtin_amdgcn_s_waitcnt(0);
        unsigned nloc = b.st[0], nx = b.st[1];
        if (nloc == 0u) { xcd_barrier_complete(bar, b.x, nloc, nx); b.st[0] = nloc; b.st[1] = nx; }
        const unsigned old = xb_add(&bar[XB_XSUB(b.x)], 1u);
        const unsigned gen = old / nloc;
        if (old + 1u == (gen + 1u) * nloc) {
            __builtin_amdgcn_fence(__ATOMIC_RELEASE, "agent");
            asm volatile("s_waitcnt vmcnt(0)" ::: "memory");
            const unsigned og = xb_add(&bar[XB_TOP], 1u);
            const unsigned tg = og / nx;
            if (og + 1u == (tg + 1u) * nx) xb_add(&bar[XB_TOPGEN], 1u);
            else XB_SPIN(xb_ld(&bar[XB_TOPGEN]) == tg, bar);
            __builtin_amdgcn_fence(__ATOMIC_ACQUIRE, "agent");
            xb_add(&bar[XB_XGEN(b.x)], 1u);
            asm volatile("s_waitcnt vmcnt(0)" ::: "memory");
        } else {
            XB_SPIN(xb_ld(&bar[XB_XGEN(b.x)]) == gen, bar);
            __builtin_amdgcn_fence(__ATOMIC_ACQUIRE, "agent");
            asm volatile("s_waitcnt vmcnt(0)" ::: "memory");
        }
    }
    __syncthreads();
}
namespace pg8 {
#define PG8_LAS __attribute__((address_space(3)))
typedef unsigned short bf16_t;
typedef short bf16x8 __attribute__((ext_vector_type(8)));
typedef float f32x4 __attribute__((ext_vector_type(4)));
typedef unsigned u32x4 __attribute__((ext_vector_type(4)));
constexpr int BM = 256, BK = 64, HALF = 128, HTB = HALF * BK * 2  , STAGE_BYTES = 8 * HTB, NXCD = 8, WGM = 8, GTAB_OFF = STAGE_BYTES + 8192  ;

__host__ __device__ __forceinline__ int lds_byte(int r, int c) { const int st = (r >> 4) * 2 + (c >> 5), rr = r & 15, cc = c & 31, ob = rr * 64 + cc * 2; return st * 1024 + (ob ^ (((ob >> 9) & 1) << 5)); }
__host__ __device__ __forceinline__ void stage_rc(int b, int& R, int& C) { const int st = b / 1024, sb = b % 1024, swz = sb ^ (((sb >> 9) & 1) << 5); R = (st >> 1) * 16 + swz / 64; C = (st & 1) * 32 + (swz % 64) / 2; }
__host__ __device__ __forceinline__ int perm32(int rho) { const int n = rho >> 4, i = rho & 15; return 8 * (i >> 2) + 4 * n + (i & 3); }

struct Unit { int pm, pn; };
struct Gemm { const bf16_t* A; const bf16_t* Bt; int M, N, K; const unsigned* rowoff; };

struct StaticOrder {
    int nM, nN, nwg, G, c;
    __host__ __device__ void init(int M, int N, int G_, int c_) { nM = M / BM; nN = N / BM; nwg = nM * nN; G = G_; c = c_; }
    __host__ __device__ bool next(int i, Unit& u) const {
        const long L = (long)i * G + c; if (L >= nwg) return false;
        int wgid = (int)L; { const int q = nwg / NXCD, r = nwg % NXCD, xcd = wgid % NXCD, off = wgid / NXCD; wgid = (xcd < r ? xcd * (q + 1) : r * (q + 1) + (xcd - r) * q) + off; }
        const int nig = WGM * nN, gid = wgid / nig, fm = gid * WGM, gsz = (nM - fm) < WGM ? (nM - fm) : WGM;
        u.pm = fm + ((wgid % nig) % gsz); u.pn = (wgid % nig) / gsz; return true;
    }
    __device__ __forceinline__ void a_ready(const Unit&) const {}
    __device__ __forceinline__ void done(const Unit&) const {}
    __device__ __forceinline__ size_t rowbase(const Unit& u) const { return (size_t)u.pm * BM; }
};

__device__ __forceinline__ unsigned cvt_pk_bf16(float lo, float hi) { unsigned r; asm volatile("v_cvt_pk_bf16_f32 %0, %1, %2" : "=v"(r) : "v"(lo), "v"(hi)); return r; }
__device__ __forceinline__ float bf_lo(unsigned w) { return __builtin_bit_cast(float, w << 16); }
__device__ __forceinline__ float bf_hi(unsigned w) { return __builtin_bit_cast(float, w & 0xffff0000u); }

__device__ __forceinline__ unsigned pk4_fp8(float a, float b, float c, float d) {
    a = __builtin_amdgcn_fmed3f(a, -448.f, 448.f); b = __builtin_amdgcn_fmed3f(b, -448.f, 448.f); c = __builtin_amdgcn_fmed3f(c, -448.f, 448.f); d = __builtin_amdgcn_fmed3f(d, -448.f, 448.f);
    unsigned r = 0u; r = (unsigned)__builtin_amdgcn_cvt_pk_fp8_f32(a, b, (int)r, false); r = (unsigned)__builtin_amdgcn_cvt_pk_fp8_f32(c, d, (int)r, true); return r; }
constexpr float FP8_SX = 16.f, FP8_SA = 8.f, FP8_SW = 64.f, FP8_SO = 32.f, FP8_SY = 32.f;
struct EpiBias {
    static constexpr bool PERM = true, AFTER_DRAIN = false;
    bf16_t* O; int ldc; const float* bias;
    __device__ __forceinline__ void operator()(const f32x4 (&acc)[2][2][4][2], const Unit& u, int wr_, int wc_, int fr_, int fq_) const {
        int tz = threadIdx.x; asm volatile("" : "+v"(tz)); const int wid = __builtin_amdgcn_readfirstlane(tz >> 6), wr = wid >> 2, wc = wid & 3, fr = tz & 15, fq = (tz >> 4) & 3;
        const int row0 = u.pm * BM + wr * 64 + fr; const int col0 = u.pn * BM + wc * 32 + 8 * fq;
        f32x4 bv[2][2];
#pragma unroll
        for (int bj = 0; bj < 2; ++bj)
#pragma unroll
            for (int n = 0; n < 2; ++n) bv[bj][n] = *(const f32x4*)(bias + col0 + bj * HALF + 4 * n);
#pragma unroll
        for (int ai = 0; ai < 2; ++ai)
#pragma unroll
            for (int m = 0; m < 4; ++m) { bf16_t* rowp = O + (size_t)(row0 + ai * HALF + m * 16) * ldc + col0;
#pragma unroll
                for (int bj = 0; bj < 2; ++bj) { const f32x4 v0 = acc[ai][bj][m][0] + bv[bj][0], v1 = acc[ai][bj][m][1] + bv[bj][1];
                    u32x4 w; w.x = cvt_pk_bf16(v0[0], v0[1]); w.y = cvt_pk_bf16(v0[2], v0[3]); w.z = cvt_pk_bf16(v1[0], v1[1]); w.w = cvt_pk_bf16(v1[2], v1[3]);
                    *(u32x4*)(rowp + bj * HALF) = w; } }
    }
};

struct EpiProj {
    static constexpr bool PERM = true, AFTER_DRAIN = false;
    bf16_t* O; int ldc; const float* bias; bf16_t* KV; const float* ta; const float* tb; int ltok; unsigned char* K8; unsigned char* V8; unsigned char* Q8;
    __device__ __forceinline__ void operator()(const f32x4 (&acc)[2][2][4][2], const Unit& u, int wr_, int wc_, int fr_, int fq_) const {
        int tz = threadIdx.x; asm volatile("" : "+v"(tz)); const int wid = __builtin_amdgcn_readfirstlane(tz >> 6), wr = wid >> 2, wc = wid & 3, fr = tz & 15, fq = (tz >> 4) & 3, lane = tz & 63;
        const int row0 = u.pm * BM + wr * 64 + fr;
        f32x4 bz[2][2];
#pragma unroll
        for (int bj = 0; bj < 2; ++bj) { const int c0 = u.pn * BM + bj * HALF + wc * 32 + 8 * fq; bz[bj][0] = *(const f32x4*)(bias + c0); bz[bj][1] = *(const f32x4*)(bias + c0 + 4); }
#pragma unroll
        for (int bj = 0; bj < 2; ++bj) {
            const int cw = u.pn * BM + bj * HALF + wc * 32;
            const int c0 = cw + 8 * fq;
            const f32x4 b0 = bz[bj][0], b1 = bz[bj][1];
            const bool is_qk = cw < 1152, is_qi = cw >= 1280 && cw < 1792;
            const bool rot = ((cw & 63) == 0) && (is_qk || is_qi);
            bf16_t* dst; int dld;
            if (cw >= 1024 && cw < 1280) { dst = KV + (cw - 1024) + 8 * fq; dld = 256; } else { dst = O + c0; dld = ldc; }
            f32x4 csn[4];
            if (rot) { const int pos = row0 % ltok; const float* tp = is_qk ? ta + (size_t)pos * 16 : tb + (size_t)pos * 32 + (fq & 1) * 16;
#pragma unroll
                for (int q = 0; q < 4; ++q) csn[q] = *(const f32x4*)(tp + 4 * q); }
#pragma unroll
            for (int g = 0; g < 8; ++g) {
                    const int ai = g >> 2, m = g & 3;
                    const int row = row0 + ai * HALF + m * 16;
                    float v[8];
#pragma unroll
                    for (int j = 0; j < 4; ++j) { v[j] = acc[ai][bj][m][0][j] * (1.f / (FP8_SX * FP8_SW)) + b0[j]; v[4 + j] = acc[ai][bj][m][1][j] * (1.f / (FP8_SX * FP8_SW)) + b1[j]; }
                    if (rot) {
                        f32x4 cs[4];
#pragma unroll
                        for (int q = 0; q < 4; ++q) cs[q] = csn[q];
                        if (g < 7) { const int rown = row0 + ((g + 1) >> 2) * HALF + ((g + 1) & 3) * 16; const int posn = rown % ltok; const float* tpn = is_qk ? ta + (size_t)posn * 16 : tb + (size_t)posn * 32 + (fq & 1) * 16;
#pragma unroll
                            for (int q = 0; q < 4; ++q) csn[q] = *(const f32x4*)(tpn + 4 * q); }
                        const int px = is_qk ? 16 : 32;
                        float w[8];
#pragma unroll
                        for (int j = 0; j < 8; ++j) w[j] = __builtin_bit_cast(float, __builtin_amdgcn_ds_bpermute((lane ^ px) << 2, __builtin_bit_cast(int, v[j])));
                        const bool active = is_qk ? (fq < 2) : true;
                        const bool first = is_qk ? (fq == 0) : (fq < 2);
                        if (active) {
#pragma unroll
                            for (int j = 0; j < 8; j += 2) { const f32x4 c4 = cs[j >> 1];
                                const float x0 = v[j], y0 = w[j], x1 = v[j + 1], y1 = w[j + 1];
                                v[j] = first ? x0 * c4[0] - y0 * c4[1] : x0 * c4[0] + y0 * c4[1];
                                v[j + 1] = first ? x1 * c4[2] - y1 * c4[3] : x1 * c4[2] + y1 * c4[3]; }
                        }
                    }
                    if (Q8 != nullptr && cw < 1024) { uint2 o8; o8.x = pk4_fp8(FP8_SX * v[0], FP8_SX * v[1], FP8_SX * v[2], FP8_SX * v[3]); o8.y = pk4_fp8(FP8_SX * v[4], FP8_SX * v[5], FP8_SX * v[6], FP8_SX * v[7]);
                        *(uint2*)(Q8 + (size_t)row * 1024 + c0) = o8; }
                    else { u32x4 o; o.x = cvt_pk_bf16(v[0], v[1]); o.y = cvt_pk_bf16(v[2], v[3]); o.z = cvt_pk_bf16(v[4], v[5]); o.w = cvt_pk_bf16(v[6], v[7]);
                        *(u32x4*)(dst + (size_t)row * dld) = o; }
                    if (cw >= 1024 && cw < 1152) { uint2 o8; o8.x = pk4_fp8(FP8_SX * v[0], FP8_SX * v[1], FP8_SX * v[2], FP8_SX * v[3]); o8.y = pk4_fp8(FP8_SX * v[4], FP8_SX * v[5], FP8_SX * v[6], FP8_SX * v[7]);
                        *(uint2*)(K8 + (size_t)row * 128 + (cw - 1024) + 8 * fq) = o8; }
                    if (cw >= 1152 && cw < 1280) { uint2 o8; o8.x = pk4_fp8(FP8_SX * v[0], FP8_SX * v[1], FP8_SX * v[2], FP8_SX * v[3]); o8.y = pk4_fp8(FP8_SX * v[4], FP8_SX * v[5], FP8_SX * v[6], FP8_SX * v[7]);
                        *(uint2*)(V8 + (size_t)row * 128 + (cw - 1152) + 8 * fq) = o8; }
            }
        }
    }
};

struct EpiRes {
    static constexpr bool PERM = true, AFTER_DRAIN = false;
    bf16_t* O; const bf16_t* R; float alpha;
    __device__ __forceinline__ void operator()(const f32x4 (&acc)[2][2][4][2], const Unit& u, int wr_, int wc_, int fr_, int fq_) const {
        int tz = threadIdx.x; asm volatile("" : "+v"(tz)); const int wid = __builtin_amdgcn_readfirstlane(tz >> 6), wr = wid >> 2, wc = wid & 3, fr = tz & 15, fq = (tz >> 4) & 3;
        const int row0 = u.pm * BM + wr * 64 + fr; const int col0 = u.pn * BM + wc * 32 + 8 * fq;
#pragma unroll
        for (int ai = 0; ai < 2; ++ai) {
            u32x4 rr[4][2];
#pragma unroll
            for (int m = 0; m < 4; ++m)
#pragma unroll
                for (int bj = 0; bj < 2; ++bj) rr[m][bj] = *(const u32x4*)(R + (size_t)(row0 + ai * HALF + m * 16) * 1024 + col0 + bj * HALF);
#pragma unroll
            for (int m = 0; m < 4; ++m) { const size_t off = (size_t)(row0 + ai * HALF + m * 16) * 1024 + col0;
#pragma unroll
                for (int bj = 0; bj < 2; ++bj) { const u32x4 r = rr[m][bj];
                    const f32x4 a0 = acc[ai][bj][m][0] * (1.f / (FP8_SO * FP8_SW)), a1 = acc[ai][bj][m][1] * (1.f / (FP8_SO * FP8_SW));
                    u32x4 w;
                    w.x = cvt_pk_bf16(a0[0] + alpha * bf_lo(r.x), a0[1] + alpha * bf_hi(r.x));
                    w.y = cvt_pk_bf16(a0[2] + alpha * bf_lo(r.y), a0[3] + alpha * bf_hi(r.y));
                    w.z = cvt_pk_bf16(a1[0] + alpha * bf_lo(r.z), a1[1] + alpha * bf_hi(r.z));
                    w.w = cvt_pk_bf16(a1[2] + alpha * bf_lo(r.w), a1[3] + alpha * bf_hi(r.w));
                    *(u32x4*)(O + off + bj * HALF) = w; } } }
    }
};
struct EpiResX {
    static constexpr bool PERM = true, AFTER_DRAIN = false;
    bf16_t* O; const float* X; const float* META; float alpha; int ltok, nmeta, seq;
    __device__ __forceinline__ void operator()(const f32x4 (&acc)[2][2][4][2], const Unit& u, int wr_, int wc_, int fr_, int fq_) const {
        int tz = threadIdx.x; asm volatile("" : "+v"(tz)); const int wid = __builtin_amdgcn_readfirstlane(tz >> 6), wr = wid >> 2, wc = wid & 3, fr = tz & 15, fq = (tz >> 4) & 3;
        const int row0 = u.pm * BM + wr * 64 + fr; const int col0 = u.pn * BM + wc * 32 + 8 * fq;
#pragma unroll
        for (int ai = 0; ai < 2; ++ai)
#pragma unroll
            for (int mp = 0; mp < 2; ++mp) {
                f32x4 rf[2][2][2];
#pragma unroll
                for (int mm = 0; mm < 2; ++mm) { const int row = row0 + ai * HALF + (2 * mp + mm) * 16; const int b = row / ltok, p = row - b * ltok;
                    const float* src = (p < nmeta ? META + (size_t)p * 1024 : X + ((size_t)b * seq + (p - nmeta)) * 1024) + col0;
#pragma unroll
                    for (int bj = 0; bj < 2; ++bj) { rf[mm][bj][0] = *(const f32x4*)(src + bj * HALF); rf[mm][bj][1] = *(const f32x4*)(src + bj * HALF + 4); } }
#pragma unroll
                for (int mm = 0; mm < 2; ++mm) { const int m = 2 * mp + mm; const size_t off = (size_t)(row0 + ai * HALF + m * 16) * 1024 + col0;
#pragma unroll
                    for (int bj = 0; bj < 2; ++bj) { const f32x4 r0 = rf[mm][bj][0], r1 = rf[mm][bj][1];
                        const f32x4 a0 = acc[ai][bj][m][0] * (1.f / (FP8_SO * FP8_SW)), a1 = acc[ai][bj][m][1] * (1.f / (FP8_SO * FP8_SW));
                        u32x4 w;
                        w.x = cvt_pk_bf16(a0[0] + alpha * r0[0], a0[1] + alpha * r0[1]); w.y = cvt_pk_bf16(a0[2] + alpha * r0[2], a0[3] + alpha * r0[3]);
                        w.z = cvt_pk_bf16(a1[0] + alpha * r1[0], a1[1] + alpha * r1[1]); w.w = cvt_pk_bf16(a1[2] + alpha * r1[2], a1[3] + alpha * r1[3]);
                        *(u32x4*)(O + off + bj * HALF) = w; } } }
    }
};

__device__ __forceinline__ float swiglu1(float g, float u) {
    g = fminf(g, 7.0f); u = fminf(fmaxf(u, -7.0f), 7.0f);
    const float s = __builtin_amdgcn_rcpf(1.0f + __expf(-1.702f * g));
    return g * s * (u + 1.0f);
}
typedef float f32x2e __attribute__((ext_vector_type(2)));
__device__ __forceinline__ f32x2e swiglu2_x8(f32x2e g, f32x2e u) {
    g.x = fminf(g.x, 7.0f); g.y = fminf(g.y, 7.0f);
    u.x = __builtin_amdgcn_fmed3f(u.x, -7.0f, 7.0f); u.y = __builtin_amdgcn_fmed3f(u.y, -7.0f, 7.0f);
    const f32x2e z = g * (-1.702f * 1.4426950408889634f);
    f32x2e e; e.x = __builtin_amdgcn_exp2f(z.x); e.y = __builtin_amdgcn_exp2f(z.y);
    const f32x2e d = e + 1.0f;
    f32x2e r; r.x = __builtin_amdgcn_rcpf(d.x); r.y = __builtin_amdgcn_rcpf(d.y);
    return (g * r) * (u * FP8_SA + FP8_SA);
}
__device__ __forceinline__ unsigned pk4_fp8_nosat(f32x2e a, f32x2e b) { unsigned r = 0u; r = (unsigned)__builtin_amdgcn_cvt_pk_fp8_f32(a.x, a.y, (int)r, false); r = (unsigned)__builtin_amdgcn_cvt_pk_fp8_f32(b.x, b.y, (int)r, true); return r; }
struct EpiSwiglu {
    static constexpr bool PERM = true, AFTER_DRAIN = false;
    unsigned char* O; const float* bias;
    __device__ __forceinline__ void operator()(const f32x4 (&acc)[2][2][4][2], const Unit& u, int wr_, int wc_, int fr_, int fq_) const {
        int tz = threadIdx.x; asm volatile("" : "+v"(tz)); const int wid = __builtin_amdgcn_readfirstlane(tz >> 6), wr = wid >> 2, wc = wid & 3, fr = tz & 15, fq = (tz >> 4) & 3;
        const int e = u.pn >> 3, jt = u.pn & 7;
        const int row0 = u.pm * BM + wr * 64 + fr; const int col0 = jt * 128 + wc * 32 + 8 * fq;
        const float* bp = bias + e * 2048 + col0;
        constexpr float rs = 1.f / (FP8_SX * FP8_SW);
        const f32x4 bgA = *(const f32x4*)(bp), buA = *(const f32x4*)(bp + 1024), bgB = *(const f32x4*)(bp + 4), buB = *(const f32x4*)(bp + 1028);
#pragma unroll
        for (int ai = 0; ai < 2; ++ai)
#pragma unroll
            for (int m = 0; m < 4; ++m) {
                uint2 w;
                { const f32x4 bg = bgA, bu = buA;
                  const f32x4 g0 = acc[ai][0][m][0] * rs + bg, u0 = acc[ai][1][m][0] * rs + bu;
                  w.x = pk4_fp8_nosat(swiglu2_x8((f32x2e){g0[0], g0[1]}, (f32x2e){u0[0], u0[1]}), swiglu2_x8((f32x2e){g0[2], g0[3]}, (f32x2e){u0[2], u0[3]})); }
                asm volatile("" : "+v"(w.x));
                { const f32x4 bg = bgB, bu = buB;
                  const f32x4 g1 = acc[ai][0][m][1] * rs + bg, u1 = acc[ai][1][m][1] * rs + bu;
                  w.y = pk4_fp8_nosat(swiglu2_x8((f32x2e){g1[0], g1[1]}, (f32x2e){u1[0], u1[1]}), swiglu2_x8((f32x2e){g1[2], g1[3]}, (f32x2e){u1[2], u1[3]})); }
                *(uint2*)(O + (size_t)(row0 + ai * HALF + m * 16) * 1024 + col0) = w; }
    }
};

struct EpiDown {
    static constexpr bool PERM = true, AFTER_DRAIN = false;
    unsigned char* Y; const float* bias; const int2* elist; const PG8_LAS int* tstart; const PG8_LAS int* ecnt; int estride;
    __device__ __forceinline__ void operator()(const f32x4 (&acc)[2][2][4][2], const Unit& u, int wr_, int wc_, int fr_, int fq_) const {
        int tz = threadIdx.x; asm volatile("" : "+v"(tz)); const int wid = __builtin_amdgcn_readfirstlane(tz >> 6), wr = wid >> 2, wc = wid & 3, fr = tz & 15, fq = (tz >> 4) & 3;
        const int e = u.pn >> 2, jt = u.pn & 3;
        const int row0 = u.pm * BM + wr * 64 + fr; const int col0 = jt * 256 + wc * 32 + 8 * fq;
        const float* bp = bias + e * 1024 + col0;
        const int slot0 = (u.pm - tstart[e]) * BM + wr * 64 + fr, nvalid = ecnt[e];
        const f32x4 bz00 = *(const f32x4*)(bp), bz01 = *(const f32x4*)(bp + 4), bz10 = *(const f32x4*)(bp + HALF), bz11 = *(const f32x4*)(bp + HALF + 4);
        int2 inf[8];
#pragma unroll
        for (int g = 0; g < 8; ++g) { const int sl = slot0 + (g >> 2) * HALF + (g & 3) * 16; inf[g] = elist[(size_t)e * estride + (sl < nvalid ? sl : nvalid - 1)]; }
#pragma unroll
        for (int ai = 0; ai < 2; ++ai)
#pragma unroll
            for (int m = 0; m < 4; ++m) { const int sl = slot0 + ai * HALF + m * 16; const int2 info = inf[ai * 4 + m];
                if (sl < nvalid) { const float gt = __builtin_bit_cast(float, info.y) * FP8_SY; unsigned char* rowp = Y + (size_t)info.x * 1024 + col0;
#pragma unroll
                    for (int bj = 0; bj < 2; ++bj) { const f32x4 b0 = bj == 0 ? bz00 : bz10, b1 = bj == 0 ? bz01 : bz11;
                        const f32x4 v0 = (acc[ai][bj][m][0] * (1.f / (FP8_SA * FP8_SW)) + b0) * gt, v1 = (acc[ai][bj][m][1] * (1.f / (FP8_SA * FP8_SW)) + b1) * gt;
                        uint2 w; w.x = pk4_fp8(v0[0], v0[1], v0[2], v0[3]); w.y = pk4_fp8(v1[0], v1[1], v1[2], v1[3]);
                        *(uint2*)(rowp + bj * HALF) = w; } } }
    }
};

struct MoeOrder {
    int ntiles, G, c, NJ; const PG8_LAS unsigned char* tile_e;
    const PG8_LAS int* tstart; int estride;
    __device__ __forceinline__ size_t rowbase(const Unit& u) const { const int e = __builtin_amdgcn_readfirstlane((int)tile_e[u.pm]), ts = __builtin_amdgcn_readfirstlane(tstart[e]); return (size_t)e * estride + (size_t)(u.pm - ts) * 256; }
    __device__ __forceinline__ bool next(int i, Unit& u) const {
        const int x = c & 7, k = c >> 3;
        if (G != 256) { const int L = i * G + c; if (L >= ntiles * NJ) return false; const int tt = L / NJ; u.pm = tt; u.pn = tile_e[tt] * NJ + (L % NJ); return true; }
        const int rpg = 32 / NJ;
        const int g = 8 * i + x;
        if (g * rpg >= ntiles) return false;
        int tt = g * rpg + (NJ == 8 ? (k >> 3) : (k >> 2)); const int jt = NJ == 8 ? (k & 7) : (k & 3);
        if (tt >= ntiles) tt = ntiles - 1;
        u.pm = tt; u.pn = tile_e[tt] * NJ + jt; return true;
    }
    __device__ __forceinline__ void a_ready(const Unit&) const {}
    __device__ __forceinline__ void done(const Unit&) const {}
};

__device__ __forceinline__ void glds_s(unsigned voff, const void* sbase, unsigned lds_dst) { unsigned keep; unsigned long long sb = (unsigned long long)sbase; const unsigned ld = lds_dst;
    asm volatile("s_mov_b32 %0, m0\n\ts_mov_b32 m0, %3\n\ts_nop 0\n\tglobal_load_lds_dwordx4 %1, %2\n\ts_mov_b32 m0, %0" : "=&s"(keep) : "v"(voff), "s"(sb), "s"(ld) : "memory"); }
__device__ __forceinline__ void glds_d(unsigned voff, const void* sbase, unsigned lds_dst) { unsigned keep; unsigned long long sb = (unsigned long long)sbase; const unsigned ld = lds_dst;
    asm volatile("s_mov_b32 %0, m0\n\ts_mov_b32 m0, %3\n\ts_nop 0\n\tglobal_load_lds_dword %1, %2\n\ts_mov_b32 m0, %0" : "=&s"(keep) : "v"(voff), "s"(sb), "s"(ld) : "memory"); }
template <int IMM> __device__ __forceinline__ unsigned tab_rd(unsigned addr_v, int tab_s) { unsigned r;
    asm volatile("v_add_u32 %0, %2, %1\n\tds_read_b32 %0, %0 offset:%3" : "=&v"(r) : "v"(addr_v), "s"(tab_s), "i"(IMM) : "memory"); return r; }
template <int NW> __device__ __forceinline__ void glds_gw(unsigned ro, unsigned colb, const void* sbase, unsigned lds_dst) { unsigned keep; unsigned long long sb = (unsigned long long)sbase; const unsigned ld = lds_dst;
    asm volatile("s_waitcnt lgkmcnt(%5)\n\tv_add_u32 %1, %1, %2\n\ts_mov_b32 %0, m0\n\ts_mov_b32 m0, %4\n\ts_nop 0\n\tglobal_load_lds_dwordx4 %1, %3\n\ts_mov_b32 m0, %0" : "=&s"(keep), "+v"(ro) : "v"(colb), "s"(sb), "s"(ld), "i"(NW) : "memory"); }
typedef int pg8_v4i __attribute__((ext_vector_type(4)));
typedef int pg8_v8i __attribute__((ext_vector_type(8)));
__device__ __forceinline__ pg8_v8i cat8(bf16x8 a, bf16x8 b) { const pg8_v4i x = __builtin_bit_cast(pg8_v4i, a), y = __builtin_bit_cast(pg8_v4i, b); return __builtin_shufflevector(x, y, 0, 1, 2, 3, 4, 5, 6, 7); }
template <class Epi, class Sched, bool ALIGN_EPI = false, bool SP2 = false, bool FP8 = false, bool GATHER = false>
__device__ __forceinline__ void gemm_phase(PG8_LAS unsigned char* lds, const Gemm g, const Sched& S, const Epi& E) {
    int tid_l = threadIdx.x; asm volatile("" : "+v"(tid_l));
    const int tid = tid_l, wid = __builtin_amdgcn_readfirstlane(tid >> 6), lane = tid & 63, wr = wid >> 2, wc = wid & 3, fr = lane & 15, fq = lane >> 4;
    const int K = g.K, nt = K / BK;
    unsigned voffA[2], voffB[2];
#pragma unroll
    for (int i = 0; i < 2; ++i) { int R, C; stage_rc(tid * 16 + i * 8192, R, C); const int Rb = Epi::PERM ? ((R & ~31) + perm32(R & 31)) : R;
        voffA[i] = (unsigned)(R * K + C) * 2u; voffB[i] = (unsigned)(Rb * K + C) * 2u; }
    const size_t kstep = (size_t)(BK * 2);
    const size_t hstep = (size_t)HALF * K * 2;
    const size_t tstep = 2 * hstep;
    const unsigned ldsw = (unsigned)wid * 1024u;
    const int aoff = lds_byte(wr * 64 + fr, fq * 8), boff = lds_byte(wc * 32 + fr, fq * 8);
    unsigned rtabv = 0, colb = 0; if constexpr (GATHER) { int R, C; stage_rc(tid * 16, R, C); rtabv = (unsigned)(size_t)lds + (unsigned)(GTAB_OFF + R * 4); colb = (unsigned)C * 2u; }
#define PG8_SA(b, h) (((b) * 2 + (h)) * HTB)
#define PG8_SB(b, h) ((4 + (b) * 2 + (h)) * HTB)
#define PG8_STAGE(bufoff, gbase, voff) do { _Pragma("unroll") for (int _i = 0; _i < 2; ++_i) { if constexpr (FP8) glds_s((voff)[_i], (const void*)(gbase), (unsigned)(size_t)(lds + (bufoff) + _i * 8192) + ldsw); else \
        __builtin_amdgcn_global_load_lds((const unsigned*)((const char*)(gbase) + (voff)[_i]), (PG8_LAS unsigned*)(lds + (bufoff) + ldsw + _i * 8192), 16, 0, 0); } } while (0)
#define PG8_TAB_RD(ro, tab, h) do { ro[0] = tab_rd<(h) * 512>(rtabv, (tab)); ro[1] = tab_rd<(h) * 512 + 256>(rtabv, (tab)); } while (0)
#define PG8_STAGE_GA(bufoff, ro, kb, NW) do { _Pragma("unroll") for (int _i = 0; _i < 2; ++_i) glds_gw<NW>(ro[_i], colb, (const void*)((const char*)g.A + (kb)), (unsigned)(size_t)(lds + (bufoff) + _i * 8192) + ldsw); } while (0)
#define PG8_LDA(dst, b, h) do { _Pragma("unroll") for (int m = 0; m < 4; ++m) _Pragma("unroll") for (int k = 0; k < 2; ++k) dst[m][k] = *(const PG8_LAS bf16x8*)(lds + PG8_SA(b, h) + aoff + m * 2048 + k * 1024); } while (0)
#define PG8_LDB(dst, b, h) do { _Pragma("unroll") for (int n = 0; n < 2; ++n) _Pragma("unroll") for (int k = 0; k < 2; ++k) dst[n][k] = *(const PG8_LAS bf16x8*)(lds + PG8_SB(b, h) + boff + n * 2048 + k * 1024); } while (0)
#define PG8_MMA(ai, bj, At, Bt) do { __builtin_amdgcn_s_setprio(1); if constexpr (FP8) { _Pragma("unroll") for (int m = 0; m < 4; ++m) _Pragma("unroll") for (int n = 0; n < 2; ++n) \
        acc[ai][bj][m][n] = __builtin_amdgcn_mfma_scale_f32_16x16x128_f8f6f4(cat8(Bt[n][0], Bt[n][1]), cat8(At[m][0], At[m][1]), acc[ai][bj][m][n], 0, 0, 0, 0, 0, 0); } else { \
        _Pragma("unroll") for (int m = 0; m < 4; ++m) _Pragma("unroll") for (int n = 0; n < 2; ++n) _Pragma("unroll") for (int k = 0; k < 2; ++k) \
        acc[ai][bj][m][n] = __builtin_amdgcn_mfma_f32_16x16x32_bf16(Bt[n][k], At[m][k], acc[ai][bj][m][n], 0, 0, 0); } __builtin_amdgcn_s_setprio(0); } while (0)
#define PG8_WAIT_V(n) asm volatile("s_waitcnt vmcnt(" #n ")" ::: "memory")
#define PG8_WAIT_L(n) asm volatile("s_waitcnt lgkmcnt(" #n ")" ::: "memory")
#define PG8_BAR __builtin_amdgcn_s_barrier()
#define PG8_SCHED __builtin_amdgcn_sched_barrier(0)
    Unit cur, nxt; int ui = 0;
    if (!S.next(0, cur)) return;
    f32x4 acc[2][2][4][2];
#pragma unroll
    for (int a = 0; a < 2; ++a)
#pragma unroll
        for (int b = 0; b < 2; ++b)
#pragma unroll
            for (int m = 0; m < 4; ++m)
#pragma unroll
                for (int n = 0; n < 2; ++n) acc[a][b][m][n] = (f32x4){0.f, 0.f, 0.f, 0.f};
    bf16x8 At[4][2], B0[2][2], B1[2][2];
    const char* cA = (const char*)g.A + (size_t)cur.pm * tstep; const char* cB = (const char*)g.Bt + (size_t)cur.pn * tstep;
    S.a_ready(cur);
    if constexpr (SP2) {
        if constexpr (GATHER) {
            if (wid < 4) glds_d((unsigned)tid * 4u, (const void*)(g.rowoff + S.rowbase(cur)), (unsigned)(size_t)(lds + GTAB_OFF) + (unsigned)wid * 256u);
            PG8_WAIT_V(0); PG8_BAR; }
        PG8_STAGE(PG8_SB(0, 0), cB, voffB); PG8_STAGE(PG8_SB(0, 1), cB + hstep, voffB);
        if constexpr (GATHER) { unsigned r0[2], r1[2]; PG8_TAB_RD(r0, 0, 0); PG8_TAB_RD(r1, 0, 1); PG8_STAGE_GA(PG8_SA(0, 0), r0, (size_t)0, 0); PG8_STAGE_GA(PG8_SA(0, 1), r1, (size_t)0, 0); }
        else { PG8_STAGE(PG8_SA(0, 0), cA, voffA); PG8_STAGE(PG8_SA(0, 1), cA + hstep, voffA); }
        if (wr == 1) PG8_BAR;
        PG8_WAIT_V(2); PG8_BAR;
        PG8_STAGE(PG8_SB(1, 0), cB + kstep, voffB);
        if constexpr (GATHER) { unsigned r0[2]; PG8_TAB_RD(r0, 0, 0); PG8_STAGE_GA(PG8_SA(1, 0), r0, kstep, 0); } else PG8_STAGE(PG8_SA(1, 0), cA + kstep, voffA);
        PG8_STAGE(PG8_SB(1, 1), cB + hstep + kstep, voffB);
        PG8_WAIT_V(6); PG8_BAR;
    } else {
        PG8_STAGE(PG8_SB(0, 0), cB, voffB); PG8_STAGE(PG8_SA(0, 0), cA, voffA); PG8_STAGE(PG8_SB(0, 1), cB + hstep, voffB); PG8_STAGE(PG8_SA(0, 1), cA + hstep, voffA);
        if (wr == 1) PG8_BAR;
        PG8_WAIT_V(4); PG8_BAR;
        PG8_STAGE(PG8_SB(1, 0), cB + kstep, voffB); PG8_STAGE(PG8_SA(1, 0), cA + kstep, voffA); PG8_STAGE(PG8_SB(1, 1), cB + hstep + kstep, voffB);
        PG8_WAIT_V(6); PG8_BAR;
    }
    for (;;) {
        const bool has_next = S.next(ui + 1, nxt);
        const char* nA = has_next ? (const char*)g.A + (size_t)nxt.pm * tstep : cA; const char* nB = has_next ? (const char*)g.Bt + (size_t)nxt.pn * tstep : cB;
        const int tabC = (ui & 1) * 1024, tabN = has_next ? 1024 - tabC : tabC;
        if constexpr (GATHER) { if (has_next && wid < 4) glds_d((unsigned)tid * 4u, (const void*)(g.rowoff + S.rowbase(nxt)), (unsigned)(size_t)(lds + GTAB_OFF) + (unsigned)(tabN + wid * 256)); }
        for (int t = 0; t < nt; t += 2) {
            const bool last = (t == nt - 2);
            const int tab2 = last ? tabN : tabC; const size_t kb2 = last ? (size_t)0 : (size_t)(t + 2) * kstep; (void)tab2; (void)kb2;
            const char* a1 = cA + (size_t)(t + 1) * kstep;
            const char* a2 = last ? nA : cA + (size_t)(t + 2) * kstep; const char* b2 = last ? nB : cB + (size_t)(t + 2) * kstep;
            const char* a3 = a2 + kstep; const char* b3 = b2 + kstep;
            if (last && has_next) S.a_ready(nxt);
            if constexpr (SP2) {
            if constexpr (GATHER) { unsigned ro[2]; PG8_TAB_RD(ro, tabC, 1); PG8_LDB(B0, 0, 0); PG8_LDB(B1, 0, 1); PG8_SCHED; PG8_LDA(At, 0, 0); PG8_STAGE_GA(PG8_SA(1, 1), ro, (size_t)(t + 1) * kstep, 12); }
            else { PG8_LDB(B0, 0, 0); PG8_LDB(B1, 0, 1); PG8_SCHED; PG8_LDA(At, 0, 0); PG8_STAGE(PG8_SA(1, 1), a1 + hstep, voffA); }
            PG8_WAIT_V(8); PG8_WAIT_L(0); PG8_BAR; PG8_MMA(0, 0, At, B0); PG8_MMA(0, 1, At, B1); PG8_BAR; PG8_SCHED;
            if constexpr (GATHER) { unsigned ro[2]; PG8_TAB_RD(ro, tab2, 0); PG8_LDA(At, 0, 1); PG8_STAGE(PG8_SB(0, 0), b2, voffB); PG8_STAGE(PG8_SB(0, 1), b2 + hstep, voffB); PG8_STAGE_GA(PG8_SA(0, 0), ro, kb2, 6); }
            else { PG8_LDA(At, 0, 1); PG8_STAGE(PG8_SB(0, 0), b2, voffB); PG8_STAGE(PG8_SB(0, 1), b2 + hstep, voffB); PG8_STAGE(PG8_SA(0, 0), a2, voffA); }
            PG8_WAIT_V(8); PG8_WAIT_L(0); PG8_BAR; PG8_MMA(1, 0, At, B0); PG8_MMA(1, 1, At, B1); PG8_BAR; PG8_SCHED;
            if constexpr (GATHER) { unsigned ro[2]; PG8_TAB_RD(ro, tab2, 1); PG8_LDB(B0, 1, 0); PG8_LDB(B1, 1, 1); PG8_SCHED; PG8_LDA(At, 1, 0); PG8_STAGE_GA(PG8_SA(0, 1), ro, kb2, 12); }
            else { PG8_LDB(B0, 1, 0); PG8_LDB(B1, 1, 1); PG8_SCHED; PG8_LDA(At, 1, 0); PG8_STAGE(PG8_SA(0, 1), a2 + hstep, voffA); }
            PG8_WAIT_V(8); PG8_WAIT_L(0); PG8_BAR; PG8_MMA(0, 0, At, B0); PG8_MMA(0, 1, At, B1); PG8_BAR; PG8_SCHED;
            if constexpr (GATHER) { unsigned ro[2]; PG8_TAB_RD(ro, tab2, 0); PG8_LDA(At, 1, 1); PG8_STAGE(PG8_SB(1, 0), b3, voffB); PG8_STAGE(PG8_SB(1, 1), b3 + hstep, voffB); PG8_STAGE_GA(PG8_SA(1, 0), ro, kb2 + kstep, 6); }
            else { PG8_LDA(At, 1, 1); PG8_STAGE(PG8_SB(1, 0), b3, voffB); PG8_STAGE(PG8_SB(1, 1), b3 + hstep, voffB); PG8_STAGE(PG8_SA(1, 0), a3, voffA); }
            PG8_WAIT_V(8); PG8_WAIT_L(0); PG8_BAR; PG8_MMA(1, 0, At, B0); PG8_MMA(1, 1, At, B1); PG8_BAR; PG8_SCHED;
            } else {
            PG8_LDB(B0, 0, 0); PG8_SCHED; PG8_LDA(At, 0, 0); PG8_STAGE(PG8_SA(1, 1), a1 + hstep, voffA);
            PG8_WAIT_L(8); PG8_BAR; PG8_WAIT_L(0); PG8_MMA(0, 0, At, B0); PG8_BAR; PG8_SCHED;
            PG8_LDB(B1, 0, 1); PG8_STAGE(PG8_SB(0, 0), b2, voffB);
            PG8_BAR; PG8_WAIT_L(0); PG8_MMA(0, 1, At, B1); PG8_BAR;
            PG8_LDA(At, 0, 1); PG8_STAGE(PG8_SA(0, 0), a2, voffA);
            PG8_BAR; PG8_WAIT_L(0); PG8_MMA(1, 0, At, B0); PG8_BAR; PG8_SCHED;
            PG8_STAGE(PG8_SB(0, 1), b2 + hstep, voffB);
            PG8_WAIT_V(6); PG8_BAR; PG8_MMA(1, 1, At, B1); PG8_BAR;
            PG8_LDB(B0, 1, 0); PG8_SCHED; PG8_LDA(At, 1, 0); PG8_STAGE(PG8_SA(0, 1), a2 + hstep, voffA);
            PG8_WAIT_L(8); PG8_BAR; PG8_WAIT_L(0); PG8_MMA(0, 0, At, B0); PG8_BAR; PG8_SCHED;
            PG8_LDB(B1, 1, 1); PG8_STAGE(PG8_SB(1, 0), b3, voffB);
            PG8_BAR; PG8_WAIT_L(0); PG8_MMA(0, 1, At, B1); PG8_BAR;
            PG8_LDA(At, 1, 1); PG8_STAGE(PG8_SA(1, 0), a3, voffA);
            PG8_BAR; PG8_WAIT_L(0); PG8_MMA(1, 0, At, B0); PG8_BAR; PG8_SCHED;
            PG8_STAGE(PG8_SB(1, 1), b3 + hstep, voffB);
            PG8_WAIT_V(6); PG8_BAR; PG8_MMA(1, 1, At, B1); PG8_BAR;
            }
        }
        if constexpr (ALIGN_EPI) { if (wr == 0) PG8_BAR; }
        if constexpr (!Epi::AFTER_DRAIN) { E(acc, cur, wr, wc, fr, fq); S.done(cur); }
        if (!has_next) break;
#pragma unroll
        for (int a = 0; a < 2; ++a)
#pragma unroll
            for (int b = 0; b < 2; ++b)
#pragma unroll
                for (int m = 0; m < 4; ++m)
#pragma unroll
                    for (int n = 0; n < 2; ++n) acc[a][b][m][n] = (f32x4){0.f, 0.f, 0.f, 0.f};
        cur = nxt; cA = nA; cB = nB; ++ui;
        if constexpr (ALIGN_EPI) { if (wr == 1) PG8_BAR; }
    }
    PG8_WAIT_V(0);
    if constexpr (!ALIGN_EPI) { if (wr == 0) PG8_BAR; }
    PG8_BAR;
    if constexpr (Epi::AFTER_DRAIN) { E.fused(acc, cur, wr, wc, fr, fq, lds, wid, lane); S.done(cur); }
#undef PG8_SA
#undef PG8_SB
#undef PG8_STAGE
#undef PG8_TAB_RD
#undef PG8_STAGE_GA
#undef PG8_LDA
#undef PG8_LDB
#undef PG8_MMA
#undef PG8_WAIT_V
#undef PG8_WAIT_L
#undef PG8_BAR
#undef PG8_SCHED
}
}
constexpr int NBATCH = 16, SEQ = 4096, NMETA = 16, LTOK = SEQ + NMETA, NTOK = NBATCH * LTOK;
constexpr int DM = 1024, NCOLA = 1280, NCOLB = 1864, NCOLB_PAD = 2048;
constexpr int NEXP = 32, MOE_TILES_MAX = NTOK * 4 / 256 + NEXP, MOE_P = MOE_TILES_MAX * 256;
constexpr float LN_EPS = 1e-5f, DN_ALPHA = 1.4142135623730951f;
constexpr float ATTN_SCALE = 0.125f, IDX_SCALE = 0.125f, IDX_W_SCALE = 0.35355339059327373f;
constexpr int NWAVES = 8, NTHREADS = 512;

constexpr size_t MiB = 1u << 20;
constexpr size_t WS_CTL = 0, CTL_ZERO_BYTES = 1 * MiB;
constexpr size_t WS_ROPEA = 1 * MiB, WS_ROPEB = 2 * MiB, WS_BIASB = 3 * MiB, WS_WRT = 3 * MiB + 512 * 1024, WS_ROWINFO = 4 * MiB, WS_ROUTE = 8 * MiB;
constexpr size_t WS_WINA = 16 * MiB, WS_WOUTA = 19 * MiB, WS_WINB = 21 * MiB, WS_WOUTB = 25 * MiB;
constexpr size_t WS_WGU = 32 * MiB, WS_WD = 288 * MiB;
constexpr size_t WS_HA = 416 * MiB, WS_HB = 545 * MiB, WS_PRE = 674 * MiB;
constexpr size_t WS_XS = 803 * MiB, WS_ACT = 1333 * MiB, WS_H8 = 1863 * MiB, WS_ELIST = 1931 * MiB, WS_EOFF = 1948 * MiB, WS_END = 1965 * MiB;
constexpr size_t WS_ROWOFF = 6 * MiB + 512 * 1024;
constexpr size_t WS_HB8 = WS_XS + 330 * MiB;
constexpr size_t WS_Q8 = WS_XS + 451 * MiB;
constexpr size_t WS_PROJ = WS_XS, WS_ATT = WS_XS + 257 * MiB;
constexpr size_t WS_SCORE = WS_ACT, WS_SEL = WS_ACT + 128 * MiB;
constexpr size_t WS_KV = WS_XS + 386 * MiB, WS_KI = WS_XS + 421 * MiB;
constexpr size_t WS_K8 = WS_XS + 431 * MiB;
constexpr size_t WS_V8 = WS_XS + 441 * MiB;
static_assert((size_t)NTOK * 512 <= 35 * MiB && WS_KI + (size_t)NTOK * 128 <= WS_K8 && WS_K8 + (size_t)NTOK * 128 <= WS_V8 && WS_V8 + (size_t)NTOK * 128 <= WS_ACT, "ws compact copies");
static_assert((size_t)NTOK * 2048 * 2 <= 257 * MiB && (size_t)NTOK * 1024 * 2 <= 129 * MiB && (size_t)MOE_P * 2048 <= 530 * MiB, "ws map");
static_assert(WS_ATT + 129 * MiB <= WS_ACT && WS_SEL + 32 * MiB <= WS_END, "ws overlays");

constexpr int CW_BAR = 4096;
constexpr int CW_CNT = 16384;

constexpr int RING_BYTES = 131072, LDSCTL_OFF = RING_BYTES, LDS_BYTES = 163840;
constexpr int LDS_EQ_OFF = LDSCTL_OFF + 8192, LDS_HIST_OFF = LDSCTL_OFF + 16384;
constexpr int LC_BAR = 0;
constexpr int LC_TSTART = 16;
constexpr int LC_ECNT = 64;
constexpr int LC_LCNT = 128, LC_LBASE = 160;
constexpr int LC_PROBE_A = 200, LC_PROBE_B = 201;
constexpr int LC_TILEE = 256;

struct Args { const float* in[21]; float* out; unsigned char* ws; int ph_lo, ph_hi; };
typedef const Args __attribute__((address_space(4))) CArgs;
__device__ __forceinline__ CArgs* KA() { unsigned long long v = (unsigned long long)__builtin_amdgcn_kernarg_segment_ptr(); asm volatile("" : "+s"(v)); return (CArgs*)v; }

typedef unsigned short u16;

__device__ __forceinline__ float bf2f(unsigned h) { return __builtin_bit_cast(float, h << 16); }
__device__ __forceinline__ float bflo(unsigned w) { return __builtin_bit_cast(float, w << 16); }
__device__ __forceinline__ float bfhi(unsigned w) { return __builtin_bit_cast(float, w & 0xffff0000u); }
__device__ __forceinline__ unsigned cvtpk(float lo, float hi) { return pg8::cvt_pk_bf16(lo, hi); }
__device__ __forceinline__ unsigned char* launder(unsigned char* p) { unsigned long long v = (unsigned long long)p; asm volatile("" : "+s"(v)); return (unsigned char*)(GAS unsigned char*)v; }
__device__ __forceinline__ const float* gptr(const float* p) { return (const float*)(const GAS float*)p; }
__device__ __forceinline__ float shx(float v, int o, int lane) { return __builtin_bit_cast(float, __builtin_amdgcn_ds_bpermute((lane ^ o) << 2, __builtin_bit_cast(int, v))); }
__device__ __forceinline__ int shxi(int v, int o, int lane) { return __builtin_amdgcn_ds_bpermute((lane ^ o) << 2, v); }
__device__ __forceinline__ int launder_v(int x) { asm volatile("" : "+v"(x)); return x; }

__device__ __forceinline__ void transpose_item(const float* W, int K, int N, bf16* WT, int mode, LAS float* scr, int item, int lane) {
    const int nblk = (N + 31) / 32, kb = item / nblk, nb = item % nblk, k0 = 64 * kb, n0 = 32 * nb;
    const bool okn = (n0 + (lane & 31)) < N;
#pragma unroll 8
    for (int i = 0; i < 32; ++i) { const int kk = 2 * i + (lane >> 5); scr[kk * 33 + (lane & 31)] = okn ? W[(size_t)(k0 + kk) * N + n0 + (lane & 31)] : 0.f; }
    LDS_WAIT(); asm volatile("" ::: "memory");
    const int c = lane & 7;
#pragma unroll
    for (int j = 0; j < 4; ++j) { const int n = (lane >> 3) + 8 * j; const LAS float* s = scr + (8 * c) * 33 + n;
        v4u o; o.x = pk2(s[0 * 33], s[1 * 33]); o.y = pk2(s[2 * 33], s[3 * 33]); o.z = pk2(s[4 * 33], s[5 * 33]); o.w = pk2(s[6 * 33], s[7 * 33]);
        int nn = n0 + n;
        if (nn < N) {
            if (mode == 1) { const int up = nn >= 1024 ? 1 : 0, q = nn - 1024 * up; nn = (q >> 7) * 256 + up * 128 + (q & 127); }
            *(GAS v4u*)(WT + (size_t)nn * K + k0 + 8 * c) = o; } }
    LDS_WAIT(); asm volatile("" ::: "memory");
}

__device__ __forceinline__ void transpose_item_fp8(const float* W, int K, int N, unsigned char* WT, int mode, LAS float* scr, int item, int lane) {
    const int nblk = (N + 31) / 32, kb = item / nblk, nb = item % nblk, k0 = 64 * kb, n0 = 32 * nb;
    const bool okn = (n0 + (lane & 31)) < N;
#pragma unroll 8
    for (int i = 0; i < 32; ++i) { const int kk = 2 * i + (lane >> 5); scr[kk * 33 + (lane & 31)] = okn ? W[(size_t)(k0 + kk) * N + n0 + (lane & 31)] : 0.f; }
    LDS_WAIT(); asm volatile("" ::: "memory");
    const int c = lane & 7;
#pragma unroll
    for (int j = 0; j < 4; ++j) { const int n = (lane >> 3) + 8 * j; const LAS float* s = scr + (8 * c) * 33 + n;
        uint2 o; o.x = pg8::pk4_fp8(s[0 * 33] * pg8::FP8_SW, s[1 * 33] * pg8::FP8_SW, s[2 * 33] * pg8::FP8_SW, s[3 * 33] * pg8::FP8_SW);
        o.y = pg8::pk4_fp8(s[4 * 33] * pg8::FP8_SW, s[5 * 33] * pg8::FP8_SW, s[6 * 33] * pg8::FP8_SW, s[7 * 33] * pg8::FP8_SW);
        int nn = n0 + n;
        if (mode == 1) { const int up = nn >= 1024 ? 1 : 0, q = nn - 1024 * up; nn = (q >> 7) * 256 + up * 128 + (q & 127); }
        if (n0 + n < N) *(uint2*)(WT + (size_t)nn * K + k0 + 8 * c) = o; }
    LDS_WAIT(); asm volatile("" ::: "memory");
}

__device__ __forceinline__ void transpose_item_fp8_reg(const float* W, int K, int N, unsigned char* WT, int mode, int item, int lane) {
    const int nblk = N / 32, kb = item / nblk, nb = item % nblk, k0 = 64 * kb, n0 = 32 * nb;
    const int q = lane & 7, g = lane >> 3;
    const float* src = W + (size_t)(k0 + 8 * g) * N + n0 + 4 * q;
    f32x4 v[8];
#pragma unroll
    for (int i = 0; i < 8; ++i) v[i] = *(const f32x4*)(src + (size_t)i * N);
#pragma unroll
    for (int j = 0; j < 4; ++j) { constexpr float sw = pg8::FP8_SW; uint2 o;
        o.x = pg8::pk4_fp8(v[0][j] * sw, v[1][j] * sw, v[2][j] * sw, v[3][j] * sw); o.y = pg8::pk4_fp8(v[4][j] * sw, v[5][j] * sw, v[6][j] * sw, v[7][j] * sw);
        int nn = n0 + 4 * q + j;
        if (mode == 1) { const int up = nn >= 1024 ? 1 : 0, qq = nn - 1024 * up; nn = (qq >> 7) * 256 + up * 128 + (qq & 127); }
        *(uint2*)(WT + (size_t)nn * K + k0 + 8 * g) = o; }
}
constexpr int L1W_GU = 32 * 1024, L1W_ITEMS = L1W_GU + 32 * 512;
__device__ __forceinline__ void moe_weight_item(CArgs* A, int layer, int it, int lane) {
    unsigned char* ws = launder(A->ws);
    if (it < L1W_GU) { const int le = 32 * layer + (it >> 10); transpose_item_fp8_reg(gptr(A->in[15]) + (size_t)le * 1024 * 2048, 1024, 2048, ws + WS_WGU + (size_t)le * 2048 * 1024, 1, it & 1023, lane); }
    else { const int r = it - L1W_GU, le = 32 * layer + (r >> 9); transpose_item_fp8_reg(gptr(A->in[17]) + (size_t)le * 1024 * 1024, 1024, 1024, ws + WS_WD + (size_t)le * 1024 * 1024, 0, r & 511, lane); }
}

__device__ __forceinline__ void p0_prologue(CArgs* A, LAS unsigned char* lds, int gw, int NGW, int wave, int lane) {
    unsigned char* ws = launder(A->ws);
    LAS float* scr = (LAS float*)(lds + wave * 16384);
    constexpr int I_GU = 0, I_D = 0  , I_INA = 16 * 40, I_OUT = 512, I_INB = 16 * 59, I_R = 2 * 16;
    constexpr int NITEMS = I_GU + I_D + I_INA + I_OUT + I_INB + I_OUT + I_R;
    for (int it = gw; it < NITEMS; it += NGW) {
        int r = it;
        if (r < I_GU) { const int le = r >> 10; transpose_item_fp8(gptr(A->in[15]) + (size_t)le * 1024 * 2048, 1024, 2048, ws + WS_WGU + (size_t)le * 2048 * 1024, 1, scr, r & 1023, lane); continue; } r -= I_GU;
        if (r < I_D) { const int le = r >> 9; transpose_item_fp8(gptr(A->in[17]) + (size_t)le * 1024 * 1024, 1024, 1024, ws + WS_WD + (size_t)le * 1024 * 1024, 0, scr, r & 511, lane); continue; } r -= I_D;
        if (r < I_INA) { transpose_item_fp8(gptr(A->in[2]), 1024, NCOLA, ws + WS_WINA, 0, scr, r, lane); continue; } r -= I_INA;
        if (r < I_OUT) { transpose_item_fp8(gptr(A->in[5]), 1024, 1024, ws + WS_WOUTA, 0, scr, r, lane); continue; } r -= I_OUT;
        if (r < I_INB) { transpose_item_fp8(gptr(A->in[6]), 1024, NCOLB, ws + WS_WINB, 0, scr, r, lane); continue; } r -= I_INB;
        if (r < I_OUT) { transpose_item_fp8(gptr(A->in[10]), 1024, 1024, ws + WS_WOUTB, 0, scr, r, lane); continue; } r -= I_OUT;
        { const int ly = r >> 4; transpose_item(gptr(A->in[13]) + (size_t)ly * 1024 * 32, 1024, 32, (bf16*)(ws + WS_WRT) + (size_t)ly * 32 * 1024, 0, scr, r & 15, lane); }
    }
    const int gt = gw * 64 + lane, NGT = NGW * 64;
    { v4u* z = (v4u*)(ws + WS_WINB + (size_t)NCOLB * 1024); const int n16 = (NCOLB_PAD - NCOLB) * 1024 / 16;
      for (int i = gt; i < n16; i += NGT) z[i] = (v4u){0u, 0u, 0u, 0u}; }
    { v4u* z = (v4u*)(ws + WS_EOFF); const int n16 = 2 * 32 * NTOK * 4 / 16; for (int i = gt; i < n16; i += NGT) z[i] = (v4u){0u, 0u, 0u, 0u}; }
    { float* bb = (float*)(ws + WS_BIASB); for (int i = gt; i < NCOLB_PAD; i += NGT) bb[i] = i < NCOLB ? gptr(A->in[7])[i] : 0.f; }
    { float2* ta = (float2*)(ws + WS_ROPEA); float2* tb = (float2*)(ws + WS_ROPEB);
      for (int i = gt; i < LTOK * 24; i += NGT) {
          const int pos = i / 24, j = i % 24; const bool isA = j < 8; const int fi = isA ? j : j - 8; const float half = isA ? 8.f : 16.f;
          const float inv = powf(500000.0f, -(float)fi / half); const float ang = (float)pos * inv;
          float sn, cs; sincosf(ang, &sn, &cs);
          if (isA) ta[pos * 8 + fi] = make_float2(cs, sn); else tb[pos * 16 + fi] = make_float2(cs, sn); } }
    {
      for (int row = gw; row < NTOK; row += NGW) { const int b = row / LTOK, p = row % LTOK;
          const float* src = p < NMETA ? gptr(A->in[1]) + (size_t)p * DM : gptr(A->in[0]) + ((size_t)b * SEQ + (p - NMETA)) * DM;
#pragma unroll
          for (int j = 0; j < 2; ++j) { const f32x4 a = *(const f32x4*)(src + j * 512 + lane * 8), c = *(const f32x4*)(src + j * 512 + lane * 8 + 4);
              constexpr float sx = pg8::FP8_SX; uint2 o8; o8.x = pg8::pk4_fp8(sx * a[0], sx * a[1], sx * a[2], sx * a[3]); o8.y = pg8::pk4_fp8(sx * c[0], sx * c[1], sx * c[2], sx * c[3]);
              *(uint2*)(ws + WS_H8 + (size_t)row * DM + j * 512 + lane * 8) = o8; } } }
}

__device__ __forceinline__ void rope_pair(float& x1, float& x2, const float2 cs) { const float a = x1 * cs.x - x2 * cs.y, b = x2 * cs.x + x1 * cs.y; x1 = a; x2 = b; }
__device__ __forceinline__ void ki_phase(CArgs* A, int gt, int NGT) {
    unsigned char* ws = launder(A->ws);
    const bf16* P = (const bf16*)(ws + WS_PROJ); bf16* KI = (bf16*)(ws + WS_KI);
    const float2* tb = (const float2*)(ws + WS_ROPEB);
    for (int it = gt; it < NTOK * 2; it += NGT) {
        const int row = it >> 1, hf = it & 1, pos = row % LTOK, lane = gt & 63;
        const bf16* p = P + (size_t)row * NCOLB_PAD + 1792 + 32 * hf; bf16* d = KI + (size_t)row * 64 + 32 * hf;
        const float* g = gptr(A->in[8]) + 32 * hf; const float* bb = gptr(A->in[9]) + 32 * hf;
        v4u q[4];
#pragma unroll
        for (int j = 0; j < 4; ++j) q[j] = *(const v4u*)(p + 8 * j);
        float x[32];
#pragma unroll
        for (int j = 0; j < 4; ++j) { x[8 * j + 0] = bflo(q[j].x); x[8 * j + 1] = bfhi(q[j].x); x[8 * j + 2] = bflo(q[j].y); x[8 * j + 3] = bfhi(q[j].y);
            x[8 * j + 4] = bflo(q[j].z); x[8 * j + 5] = bfhi(q[j].z); x[8 * j + 6] = bflo(q[j].w); x[8 * j + 7] = bfhi(q[j].w); }
        float s = 0.f;
#pragma unroll
        for (int i = 0; i < 32; ++i) s += x[i];
        s += shx(s, 1, lane);
        const float mu = s * (1.f / 64.f); float v = 0.f;
#pragma unroll
        for (int i = 0; i < 32; ++i) { x[i] -= mu; v += x[i] * x[i]; }
        v += shx(v, 1, lane);
        const float rstd = 1.f / sqrtf(v * (1.f / 64.f) + LN_EPS);
#pragma unroll
        for (int c8 = 0; c8 < 4; ++c8) {
#pragma unroll
            for (int i = 8 * c8; i < 8 * c8 + 8; ++i) x[i] = x[i] * rstd * g[i] + bb[i];
            asm volatile("" ::: "memory"); }
        if (hf == 0) {
#pragma unroll
            for (int c4 = 0; c4 < 4; ++c4) {
#pragma unroll
                for (int i = 4 * c4; i < 4 * c4 + 4; ++i) rope_pair(x[i], x[16 + i], tb[pos * 16 + i]);
                asm volatile("" ::: "memory"); }
        }
#pragma unroll
        for (int j = 0; j < 4; ++j) { q[j].x = cvtpk(x[8 * j + 0], x[8 * j + 1]); q[j].y = cvtpk(x[8 * j + 2], x[8 * j + 3]); q[j].z = cvtpk(x[8 * j + 4], x[8 * j + 5]); q[j].w = cvtpk(x[8 * j + 6], x[8 * j + 7]);
            *(v4u*)(d + 8 * j) = q[j]; }
    }
}

template <int NB, bool DSA>
__device__ __forceinline__ void attn8_phase(CArgs* A, LAS unsigned char* lds, int gw, int NGW, int wave, int lane_) {
    unsigned char* ws = launder(A->ws);
    const bf16* P = (const bf16*)(ws + WS_PROJ); const int ld = DSA ? NCOLB_PAD : NCOLA;
    const unsigned char* K8 = ws + WS_K8; const unsigned char* V8 = ws + WS_V8;
    unsigned char* O = ws + WS_ATT;
    const u16* SEL = (const u16*)(ws + WS_SEL);
    const float* sinks = gptr(A->in[4]);
    LAS unsigned char* vl = lds + wave * 16384;
    typedef int v2i __attribute__((ext_vector_type(2)));
    constexpr int NTOT = DSA ? NTOK : NBATCH * NMETA;
#define TOK_DESC(tix_, tok_, b_, p_, nk_, usel_, rb_, selrow_) \
        const int tok_ = DSA ? (tix_) : ((tix_) >> 4) * LTOK + ((tix_) & 15); const int b_ = tok_ / LTOK, p_ = tok_ % LTOK; \
        const bool usel_ = DSA && (p_ - NMETA >= 256); const int nk_ = p_ < NMETA ? p_ + 1 : (p_ - NMETA < 256 ? p_ + 1 : 16 + 256); \
        const size_t rb_ = (size_t)b_ * LTOK; const u16* selrow_ = SEL + ((size_t)b_ * SEQ + (p_ > NMETA ? p_ - NMETA : 0)) * 256;
#define REQ_KP(dst_, nk_, usel_, selrow_, fr_) do { _Pragma("unroll") for (int c_ = 0; c_ < NB * 2; ++c_) { const int i0_ = c_ * 32 + (fr_), i1_ = i0_ + 16; \
            const unsigned k0_ = i0_ < (nk_) ? (unsigned)(i0_ < 16 ? i0_ : 16 + ((usel_) ? (int)(selrow_)[i0_ - 16] : i0_ - 16)) : 0u; \
            const unsigned k1_ = i1_ < (nk_) ? (unsigned)(16 + ((usel_) ? (int)(selrow_)[i1_ - 16] : i1_ - 16)) : 0u; dst_[c_] = k0_ | (k1_ << 16); } } while (0)
#define KPX(arr_, TT) (((TT) & 1) ? (arr_[(TT) >> 1] >> 16) : (arr_[(TT) >> 1] & 0xffffu))
#define LOAD_KX(arr_, rb_, bt, fq_, nt_) do { _Pragma("unroll") for (int T_ = 0; T_ < (nt_); ++T_) { \
            const unsigned ko_ = ((unsigned)(rb_) + KPX(arr_, 4 * (bt) + T_)) * 128u + (unsigned)(fq_) * 32u; \
            kf[T_][0] = *(const v4u*)(K8 + ko_); kf[T_][1] = *(const v4u*)(K8 + ko_ + 16u); } } while (0)
#define LOAD_VX(arr_, rb_, bt, lane__, nt_) do { _Pragma("unroll") for (int T_ = 0; T_ < (nt_); ++T_) _Pragma("unroll") for (int h_ = 0; h_ < 2; ++h_) { \
            const unsigned pp_ = (unsigned)__builtin_amdgcn_ds_bpermute((8 * h_ + ((lane__) >> 3)) << 2, (int)arr_[(4 * (bt) + T_) >> 1]); \
            const unsigned pos_ = (T_ & 1) ? (pp_ >> 16) : (pp_ & 0xffffu); \
            vt[2 * T_ + h_] = *(const v4u*)(V8 + (((unsigned)(rb_) + pos_) * 128u + ((unsigned)(lane__) & 7u) * 16u)); } } while (0)
    v4u kf[4][2]; v4u vt[8];
    unsigned kpn[NB * 2]; v4u qn[4];
    const unsigned char* Q8 = ws + WS_Q8;
    unsigned sta[8], tra[16];
    { const int lane = launder_v(lane_); const int fq = lane >> 4;
#pragma unroll
      for (int T = 0; T < 4; ++T)
#pragma unroll
          for (int h = 0; h < 2; ++h) { const unsigned i = 8u * h + ((unsigned)lane >> 3), rho = 32u * (i >> 2) + 4u * T + (i & 3u); sta[2 * T + h] = 128u * rho + 16u * (((unsigned)lane & 7u) ^ (rho & 7u)); }
#pragma unroll
      for (int d = 0; d < 8; ++d)
#pragma unroll
          for (int u = 0; u < 2; ++u) { const unsigned row = 32u * (unsigned)fq + 8u * u + (((unsigned)lane & 15u) >> 1); tra[2 * d + u] = 128u * row + 16u * ((unsigned)d ^ (row & 7u)) + 8u * ((unsigned)lane & 1u); } }
    int tix = gw, nwit = 0;
    if (tix >= NTOT) return;
    { const int lane0 = launder_v(lane_); const int fr0 = lane0 & 15, fq0 = lane0 >> 4;
      TOK_DESC(tix, tk0, b0, p0, nk0, us0, rb0, sr0)
      REQ_KP(kpn, nk0, us0, sr0, fr0);
      if (DSA) { const unsigned char* qr = Q8 + (rb0 + p0) * DM + fr0 * 64 + (fq0 & 1) * 32; qn[0] = *(const v4u*)qr; qn[1] = *(const v4u*)(qr + 16); }
      else { const bf16* qr = P + (rb0 + p0) * ld + fr0 * 64 + (fq0 & 1) * 32; qn[0] = *(const v4u*)qr; qn[1] = *(const v4u*)(qr + 8); qn[2] = *(const v4u*)(qr + 16); qn[3] = *(const v4u*)(qr + 24); }
      LOAD_KX(kpn, rb0, 0, fq0, 4); LOAD_VX(kpn, rb0, 0, lane0, 4); }
    for (; tix < NTOT; tix += NGW) {
        const int lane = launder_v(lane_); const int fr = lane & 15, fq = lane >> 4;
        TOK_DESC(tix, tok, b, p, n_keys, use_sel, rowbase, selrow)
        (void)b; (void)use_sel; (void)selrow;
        unsigned kp2[NB * 2];
#pragma unroll
        for (int c = 0; c < NB * 2; ++c) kp2[c] = kpn[c];
        pg8::pg8_v8i qf8;
        if (DSA) { const bool mine = (fq >> 1) == (fr >> 3); v4u lo8 = qn[0], hi8 = qn[1];
          if (!mine) { lo8 = (v4u){0u, 0u, 0u, 0u}; hi8 = lo8; }
          qf8 = pg8::cat8(__builtin_bit_cast(bf16x8, lo8), __builtin_bit_cast(bf16x8, hi8)); }
        else { const bool mine = (fq >> 1) == (fr >> 3); constexpr float sq = pg8::FP8_SX; const v4u q0 = qn[0], q1 = qn[1], q2 = qn[2], q3 = qn[3];
          v4u lo8, hi8;
          lo8.x = pg8::pk4_fp8(sq * bflo(q0.x), sq * bfhi(q0.x), sq * bflo(q0.y), sq * bfhi(q0.y)); lo8.y = pg8::pk4_fp8(sq * bflo(q0.z), sq * bfhi(q0.z), sq * bflo(q0.w), sq * bfhi(q0.w));
          lo8.z = pg8::pk4_fp8(sq * bflo(q1.x), sq * bfhi(q1.x), sq * bflo(q1.y), sq * bfhi(q1.y)); lo8.w = pg8::pk4_fp8(sq * bflo(q1.z), sq * bfhi(q1.z), sq * bflo(q1.w), sq * bfhi(q1.w));
          hi8.x = pg8::pk4_fp8(sq * bflo(q2.x), sq * bfhi(q2.x), sq * bflo(q2.y), sq * bfhi(q2.y)); hi8.y = pg8::pk4_fp8(sq * bflo(q2.z), sq * bfhi(q2.z), sq * bflo(q2.w), sq * bfhi(q2.w));
          hi8.z = pg8::pk4_fp8(sq * bflo(q3.x), sq * bfhi(q3.x), sq * bflo(q3.y), sq * bfhi(q3.y)); hi8.w = pg8::pk4_fp8(sq * bflo(q3.z), sq * bfhi(q3.z), sq * bflo(q3.w), sq * bfhi(q3.w));
          if (!mine) { lo8 = (v4u){0u, 0u, 0u, 0u}; hi8 = lo8; }
          qf8 = pg8::cat8(__builtin_bit_cast(bf16x8, lo8), __builtin_bit_cast(bf16x8, hi8)); }
        const bool has_next = tix + NGW < NTOT;
        const int tixn = has_next ? tix + NGW : tix;
        TOK_DESC(tixn, tokn, bn, pn, nkn, usn, rbn, srn)
        (void)tokn; (void)bn;
        REQ_KP(kpn, nkn, usn, srn, fr);
        if (DSA) { const unsigned char* qr = Q8 + (rbn + pn) * DM + fr * 64 + (fq & 1) * 32; qn[0] = *(const v4u*)qr; qn[1] = *(const v4u*)(qr + 16); }
        else { const bf16* qr = P + (rbn + pn) * ld + fr * 64 + (fq & 1) * 32; qn[0] = *(const v4u*)qr; qn[1] = *(const v4u*)(qr + 8); qn[2] = *(const v4u*)(qr + 16); qn[3] = *(const v4u*)(qr + 24); }
        float mrun = -1e30f, lsum = 0.f;
        f32x4 o[8];
#pragma unroll
        for (int d = 0; d < 8; ++d) o[d] = (f32x4){0.f, 0.f, 0.f, 0.f};
#pragma unroll
        for (int bt = 0; bt < NB; ++bt) {
            const int NT = (DSA && NB == 5 && bt == NB - 1) ? 1 : 4, NTN = (DSA && NB == 5 && bt + 1 == NB - 1) ? 1 : 4;
            if (bt * 64 < n_keys) {
                const bool more = (bt + 1 < NB) && ((bt + 1) * 64 < n_keys);
                f32x4 s8[4]; float bm = -1e30f;
                constexpr float qk = ATTN_SCALE / (pg8::FP8_SX * pg8::FP8_SX);
                const bool full = bt * 64 + 16 * NT <= n_keys;
#pragma unroll
                for (int T = 0; T < 4; ++T) s8[T] = (f32x4){-1e30f, -1e30f, -1e30f, -1e30f};
#pragma unroll
                for (int T = 0; T < NT; ++T) {
                    const f32x4 a = __builtin_amdgcn_mfma_scale_f32_16x16x128_f8f6f4(pg8::cat8(__builtin_bit_cast(bf16x8, kf[T][0]), __builtin_bit_cast(bf16x8, kf[T][1])), qf8, (f32x4){0.f, 0.f, 0.f, 0.f}, 0, 0, 0, 0, 0, 0);
                    if (full) { s8[T] = a; }
                    else {
#pragma unroll
                        for (int j = 0; j < 4; ++j) { const int ki = bt * 64 + 16 * T + 4 * fq + j; s8[T][j] = ki < n_keys ? a[j] : -1e30f; } }
                    bm = fmaxf(bm, fmaxf(fmaxf(s8[T][0], s8[T][1]), fmaxf(s8[T][2], s8[T][3])));
                }
                if (more) { LOAD_KX(kp2, rowbase, bt + 1 < NB ? bt + 1 : 0, fq, NTN); } else if (has_next) { LOAD_KX(kpn, rbn, 0, fq, 4); }
                bm = fmaxf(bm, shx(bm, 16, lane)); bm = fmaxf(bm, shx(bm, 32, lane)); bm *= qk;
                const float mnew = fmaxf(mrun, bm), rs = __expf(mrun - mnew); mrun = mnew;
                float bs = 0.f; unsigned pk[4];
                const float mb = mnew * 1.4426950408889634f - 8.0f;
                constexpr float qkl = qk * 1.4426950408889634f;
#pragma unroll
                for (int T = 0; T < 4; ++T) { const float e0 = __builtin_amdgcn_exp2f(__builtin_fmaf(s8[T][0], qkl, -mb)), e1 = __builtin_amdgcn_exp2f(__builtin_fmaf(s8[T][1], qkl, -mb)),
                                                          e2 = __builtin_amdgcn_exp2f(__builtin_fmaf(s8[T][2], qkl, -mb)), e3 = __builtin_amdgcn_exp2f(__builtin_fmaf(s8[T][3], qkl, -mb));
                    bs += (e0 + e1) + (e2 + e3); unsigned w = 0u; w = (unsigned)__builtin_amdgcn_cvt_pk_fp8_f32(e0, e1, (int)w, false); w = (unsigned)__builtin_amdgcn_cvt_pk_fp8_f32(e2, e3, (int)w, true); pk[T] = w; }
                bs *= (1.f / 256.f);
                lsum = lsum * rs + bs;
#pragma unroll
                for (int d = 0; d < 8; ++d) o[d] = o[d] * rs;
#pragma unroll
                for (int q8 = 0; q8 < 2 * NT; ++q8) *(LAS v4u*)(vl + sta[q8]) = vt[q8];
                if (more) { LOAD_VX(kp2, rowbase, bt + 1 < NB ? bt + 1 : 0, lane, NTN); } else if (has_next) { LOAD_VX(kpn, rbn, 0, lane, 4); }
                const pg8::pg8_v8i pf = {(int)pk[0], (int)pk[1], (int)pk[2], (int)pk[3], 0, 0, 0, 0};
#pragma unroll
                for (int d = 0; d < 8; ++d) {
                    v2i r[2];
#pragma unroll
                    for (int u = 0; u < 2; ++u) r[u] = __builtin_amdgcn_ds_read_tr8_b64_v2i32((LAS v2i*)(vl + tra[2 * d + u]));
                    const pg8::pg8_v8i vf = {r[0].x, r[0].y, r[1].x, r[1].y, 0, 0, 0, 0};
                    o[d] = __builtin_amdgcn_mfma_scale_f32_16x16x128_f8f6f4(vf, pf, o[d], 0, 0, 0, 0, 0, 0);
                }
            }
        }
        lsum += shx(lsum, 16, lane); lsum += shx(lsum, 32, lane);
        float inv;
        if (!DSA) { const float sk = sinks[fr], m2 = fmaxf(mrun, sk), f = __expf(mrun - m2); inv = f / (lsum * f + __expf(sk - m2)); }
        else inv = 1.f / lsum;
        { unsigned char* orow = O + (size_t)tok * DM + fr * 64 + fq * 4; const bool hi = fr >= 8; const float inv8 = inv * (pg8::FP8_SO / (256.f * pg8::FP8_SX));
#pragma unroll
          for (int dd = 0; dd < 4; ++dd) { const f32x4 vl_ = o[dd], vh_ = o[4 + dd];
              const float v0 = hi ? vh_[0] : vl_[0], v1 = hi ? vh_[1] : vl_[1], v2 = hi ? vh_[2] : vl_[2], v3 = hi ? vh_[3] : vl_[3];
              *(unsigned*)(orow + dd * 16) = pg8::pk4_fp8(v0 * inv8, v1 * inv8, v2 * inv8, v3 * inv8); } }
    }
#undef TOK_DESC
#undef REQ_KP
#undef KPX
#undef LOAD_KX
#undef LOAD_VX
}

constexpr int SWA_ROWS = 288, SWA_KOFF = 0, SWA_VOFF = SWA_ROWS * 128;
__device__ __forceinline__ unsigned swa_koff(unsigned row, unsigned ch) { return 128u * row + 16u * (ch ^ (((row >> 1) & 1u) | (((row >> 3) & 3u) << 1))); }
__device__ __forceinline__ unsigned swa_voff(unsigned row, unsigned ch) { return 128u * row + 16u * (ch ^ (2u * (((row >> 1) & 1u) | (((row >> 3) & 1u) << 1)))); }
__device__ __forceinline__ void swa_tile_phase(CArgs* A, LAS unsigned char* lds, int G, int wg, int wave, int lane_) {
    unsigned char* ws = launder(A->ws);
    const bf16* P = (const bf16*)(ws + WS_PROJ); constexpr int ld = NCOLA;
    const bf16* KV = (const bf16*)(ws + WS_KV);
    bf16* O = (bf16*)(ws + WS_ATT);
    const float* sinks = gptr(A->in[4]);
    LAS unsigned char* kl = lds + SWA_KOFF; LAS unsigned char* vl = lds + SWA_VOFF;
    constexpr int NUNITS = NBATCH * 2 * 32;
    int nwit = 0;
    for (int unit = wg; unit < NUNITS; unit += G) {
        const int lane = launder_v(lane_), tid = wave * 64 + lane, fr = lane & 15, fq = lane >> 4;
        const int qb = unit & 31, kvh = (unit >> 5) & 1, b = unit >> 6;
        const size_t rowbase = (size_t)b * LTOK;
        __syncthreads();
        { constexpr int NST = (SWA_ROWS * 8 + NTHREADS - 1) / NTHREADS;
          v4u kk[NST], vv[NST];
#pragma unroll
          for (int i = 0; i < NST; ++i) { const int id = tid + i * NTHREADS; const int r = id >> 3, ch = id & 7;
              int pos = -1;
              if (r < 16) pos = r; else if (r < 272) { const int s = (qb - 1) * 128 + (r - 16); if (s >= 0) pos = NMETA + s; }
              kk[i] = (v4u){0u, 0u, 0u, 0u}; vv[i] = kk[i];
              if (id < SWA_ROWS * 8 && pos >= 0) { const bf16* src = KV + (rowbase + pos) * 256 + kvh * 64 + ch * 8; kk[i] = *(const v4u*)src; vv[i] = *(const v4u*)(src + 128); } }
#pragma unroll
          for (int i = 0; i < NST; ++i) { const int id = tid + i * NTHREADS; const int r = id >> 3, ch = id & 7;
              if (id < SWA_ROWS * 8) { *(LAS v4u*)(kl + swa_koff((unsigned)r, (unsigned)ch)) = kk[i]; *(LAS v4u*)(vl + swa_voff((unsigned)r, (unsigned)ch)) = vv[i]; } } }
        __syncthreads();
        const int i0 = 16 * wave;
        const int tokrow = (int)rowbase + NMETA + qb * 128 + i0 + fr;
        const unsigned tq = ((unsigned)lane & 15u) >> 2, tp = (unsigned)lane & 3u;
        bf16x8 qn[2];
        { const bf16* qr = P + (size_t)tokrow * ld + (kvh * 8) * 64 + fq * 8; qn[0] = *(const bf16x8*)qr; qn[1] = *(const bf16x8*)(qr + 32); }
#pragma unroll 1
        for (int g = 0; g < 8; ++g) {
            const int h = kvh * 8 + g;
            bf16x8 qf[2]; qf[0] = qn[0]; qf[1] = qn[1];
            { const int hn = kvh * 8 + (g < 7 ? g + 1 : g); const bf16* qr = P + (size_t)tokrow * ld + hn * 64 + fq * 8; qn[0] = *(const bf16x8*)qr; qn[1] = *(const bf16x8*)(qr + 32); }
            f32x4 sc[12]; float mx = -1e30f;
#pragma unroll
            for (int T = 0; T < 12; ++T) {
                const int c = T >> 1; const int base = c == 0 ? 0 : 16 + i0 + 32 * (c - 1);
                const unsigned r = (unsigned)(base + 8 * (fr >> 2) + 4 * (T & 1) + (fr & 3));
                const bf16x8 k0 = *(const LAS bf16x8*)(kl + swa_koff(r, (unsigned)fq)), k1 = *(const LAS bf16x8*)(kl + swa_koff(r, 4u + (unsigned)fq));
                f32x4 a = {0.f, 0.f, 0.f, 0.f};
                a = __builtin_amdgcn_mfma_f32_16x16x32_bf16(k0, qf[0], a, 0, 0, 0);
                a = __builtin_amdgcn_mfma_f32_16x16x32_bf16(k1, qf[1], a, 0, 0, 0);
#pragma unroll
                for (int j = 0; j < 4; ++j) { const int rr = base + 8 * fq + 4 * (T & 1) + j;
                    bool ok;
                    if (c == 0) ok = rr < 16; else { const int kbi = rr - 16, it = i0 + fr; ok = (kbi >= it + 1) && (kbi <= it + 128) && (qb > 0 || kbi >= 128); }
                    const float v = ok ? a[j] * ATTN_SCALE : -1e30f; sc[T][j] = v; mx = fmaxf(mx, v); }
            }
            mx = fmaxf(mx, shx(mx, 16, lane)); mx = fmaxf(mx, shx(mx, 32, lane));
            const float sk = sinks[h]; mx = fmaxf(mx, sk);
            float sum = 0.f; v4u pk[6];
#pragma unroll
            for (int c = 0; c < 6; ++c) { float e[8];
#pragma unroll
                for (int j = 0; j < 4; ++j) { e[j] = __expf(sc[2 * c][j] - mx); e[4 + j] = __expf(sc[2 * c + 1][j] - mx); }
                sum += ((e[0] + e[1]) + (e[2] + e[3])) + ((e[4] + e[5]) + (e[6] + e[7]));
                pk[c].x = cvtpk(e[0], e[1]); pk[c].y = cvtpk(e[2], e[3]); pk[c].z = cvtpk(e[4], e[5]); pk[c].w = cvtpk(e[6], e[7]); }
            sum += shx(sum, 16, lane); sum += shx(sum, 32, lane);
            sum += __expf(sk - mx);
            const float inv = 1.f / sum;
            f32x4 o[4];
#pragma unroll
            for (int d = 0; d < 4; ++d) o[d] = (f32x4){0.f, 0.f, 0.f, 0.f};
#pragma unroll
            for (int c = 0; c < 6; ++c) {
                const int base = c == 0 ? 0 : 16 + i0 + 32 * (c - 1);
                const bf16x8 pf = __builtin_bit_cast(bf16x8, pk[c]);
                const unsigned r0 = (unsigned)(base + 8 * fq) + tq, r1 = r0 + 4u;
#pragma unroll
                for (int d = 0; d < 4; ++d) {
                    typedef short s16x4 __attribute__((ext_vector_type(4)));
                    const s16x4 lo = __builtin_bit_cast(s16x4, __builtin_amdgcn_ds_read_tr16_b64_v4i16((LAS s16x4*)(vl + swa_voff(r0, 2u * d + (tp >> 1)) + 8u * (tp & 1u))));
                    const s16x4 hi = __builtin_bit_cast(s16x4, __builtin_amdgcn_ds_read_tr16_b64_v4i16((LAS s16x4*)(vl + swa_voff(r1, 2u * d + (tp >> 1)) + 8u * (tp & 1u))));
                    const bf16x8 vf = {lo[0], lo[1], lo[2], lo[3], hi[0], hi[1], hi[2], hi[3]};
                    o[d] = __builtin_amdgcn_mfma_f32_16x16x32_bf16(vf, pf, o[d], 0, 0, 0);
                }
            }
            { unsigned char* orow = (unsigned char*)O + (size_t)tokrow * DM + h * 64 + fq * 4; const float inv8 = inv * pg8::FP8_SO;
#pragma unroll
              for (int d = 0; d < 4; ++d) *(unsigned*)(orow + d * 16) = pg8::pk4_fp8(o[d][0] * inv8, o[d][1] * inv8, o[d][2] * inv8, o[d][3] * inv8); }
            { const int wit = (wg * NWAVES + wave) + nwit * (G * NWAVES); if (wit < L1W_ITEMS) moe_weight_item(A, 0, wit, lane); ++nwit; }
        }
    }
    for (int wit = (wg * NWAVES + wave) + nwit * (G * NWAVES); wit < L1W_ITEMS; wit += G * NWAVES) moe_weight_item(A, 0, wit, launder_v(lane_));
}

#ifndef PROBE_SUB
#define PROBE_SUB 0
#endif
#define SUB_T0() unsigned long long sub_t_ = (PROBE_SUB) ? __builtin_amdgcn_s_memrealtime() : 0ull
#define SUB_ADD(lds_, word_) do { if (PROBE_SUB) { const unsigned long long n_ = __builtin_amdgcn_s_memrealtime(); if (threadIdx.x == 0) ((LAS unsigned*)((lds_) + LDSCTL_OFF))[word_] += (unsigned)(n_ - sub_t_); sub_t_ = n_; } } while (0)
__device__ __forceinline__ int idx_bucket(float s) { return (int)__builtin_amdgcn_fmed3f(__builtin_fmaf(s, 24.f, 128.5f), 0.f, 255.9f); }
__device__ __forceinline__ unsigned ordkey(float f) { unsigned u = __builtin_bit_cast(unsigned, f); if (u == 0x80000000u) u = 0u; return (u & 0x80000000u) ? ~u : (u | 0x80000000u); }
__device__ __forceinline__ void indexer_phase(CArgs* A, LAS unsigned char* lds, int G, int wg, int wave, int lane_) {
    unsigned char* ws = launder(A->ws);
    const bf16* P = (const bf16*)(ws + WS_PROJ); constexpr int ld = NCOLB_PAD;
    const bf16* KI = (const bf16*)(ws + WS_KI);
    float* scr = (float*)(ws + WS_SCORE) + (size_t)wg * 32 * SEQ;
    u16* SEL = (u16*)(ws + WS_SEL);
    constexpr int NUNITS = NBATCH * 120;
    int nwit = 0;
    for (int r = 0;; ++r) {
        const int k = r * G + ((r & 1) ? (G - 1 - wg) : wg);
        if (r * G >= NUNITS) break;
        if (k >= NUNITS) continue;
        const int lane = launder_v(lane_), fr = lane & 15, fq = lane >> 4, tid = wave * 64 + lane;
        const int qb = 127 - k / NBATCH, b = k % NBATCH, t0 = qb * 32;
        const size_t rowbase = (size_t)b * LTOK + NMETA;
        bf16x8 qf[2][2]; float wv[2][4];
#pragma unroll
        for (int rg = 0; rg < 2; ++rg) {
            const int tq = t0 + 4 * wave + (fr >> 2);
            const bf16* qr = P + (rowbase + tq) * ld + 1280 + ((fr & 3) + 4 * rg) * 64 + fq * 8;
            qf[rg][0] = *(const bf16x8*)qr; qf[rg][1] = *(const bf16x8*)(qr + 32);
            const bf16* wr_ = P + (rowbase + t0 + 4 * wave + fq) * ld + 1856 + 4 * rg;
#pragma unroll
            for (int j = 0; j < 4; ++j) wv[rg][j] = bf2f(wr_[j]) * (IDX_W_SCALE * IDX_SCALE);
        }
        SUB_T0();
        const int nkt = t0 / 16 + 2;
        const int nchunk = (nkt + 31) >> 5;
        const bf16* kgl = KI + rowbase * 64 + (size_t)(tid >> 3) * 64 + (tid & 7) * 8;
        v4u st[8];
#pragma unroll
        for (int j = 0; j < 8; ++j) st[j] = *(const v4u*)(kgl + (size_t)(64 * j) * 64);
        __syncthreads();
#pragma unroll
        for (int j = 0; j < 8; ++j) { const unsigned row = (unsigned)(tid >> 3) + 64u * j, ch = (unsigned)tid & 7u; *(LAS v4u*)(lds + 128u * row + 16u * (ch ^ ((row >> 1) & 7u))) = st[j]; }
        float* sp = scr + (size_t)(4 * wave + fq) * SEQ + fr;
        LAS unsigned* hist = (LAS unsigned*)(lds + LDS_HIST_OFF);
#pragma unroll
        for (int j = 0; j < 8; ++j) hist[4 * wave * 128 + lane + 64 * j] = 0u;
        LAS unsigned* hrow = hist + (4 * wave + fq) * 128; const int trow = t0 + 4 * wave + fq;
        for (int c = 0; c < nchunk; ++c) {
            __syncthreads();
            if (c + 1 < nchunk) {
#pragma unroll
                for (int j = 0; j < 8; ++j) st[j] = *(const v4u*)(kgl + (size_t)((c + 1) * 512 + 64 * j) * 64); }
            const LAS unsigned char* kb = lds + (c & 1) * 65536;
            const int ntl = __builtin_amdgcn_readfirstlane(nkt - c * 32 < 32 ? nkt - c * 32 : 32);
            const unsigned sw = ((unsigned)fr >> 1) & 7u;
            const LAS unsigned char* ka0 = kb + 128u * (unsigned)fr + 16u * ((unsigned)fq ^ sw); const LAS unsigned char* ka1 = kb + 128u * (unsigned)fr + 16u * ((4u + (unsigned)fq) ^ sw);
            for (int tl = 0; tl < ntl; tl += 2) {
                const bf16x8 k0a = *(const LAS bf16x8*)(ka0 + 2048 * tl), k1a = *(const LAS bf16x8*)(ka1 + 2048 * tl);
                const bf16x8 k0b = *(const LAS bf16x8*)(ka0 + 2048 * tl + 2048), k1b = *(const LAS bf16x8*)(ka1 + 2048 * tl + 2048);
                f32x4 aa[2], ab[2];
#pragma unroll
                for (int rg = 0; rg < 2; ++rg) {
                    aa[rg] = __builtin_amdgcn_mfma_f32_16x16x32_bf16(qf[rg][0], k0a, (f32x4){0.f, 0.f, 0.f, 0.f}, 0, 0, 0);
                    ab[rg] = __builtin_amdgcn_mfma_f32_16x16x32_bf16(qf[rg][0], k0b, (f32x4){0.f, 0.f, 0.f, 0.f}, 0, 0, 0); }
#pragma unroll
                for (int rg = 0; rg < 2; ++rg) {
                    aa[rg] = __builtin_amdgcn_mfma_f32_16x16x32_bf16(qf[rg][1], k1a, aa[rg], 0, 0, 0);
                    ab[rg] = __builtin_amdgcn_mfma_f32_16x16x32_bf16(qf[rg][1], k1b, ab[rg], 0, 0, 0); }
                float ta = 0.f, tb = 0.f;
#pragma unroll
                for (int rg = 0; rg < 2; ++rg)
#pragma unroll
                    for (int j = 0; j < 4; ++j) { ta = __builtin_fmaf(wv[rg][j], __builtin_amdgcn_fmed3f(aa[rg][j], 0.f, 3.0e38f), ta); tb = __builtin_fmaf(wv[rg][j], __builtin_amdgcn_fmed3f(ab[rg][j], 0.f, 3.0e38f), tb); }
                const int kt = c * 32 + tl;
                sp[kt * 16] = ta; sp[kt * 16 + 16] = tb;
                { const int bka = idx_bucket(ta), bkb = idx_bucket(tb);
                  (void)__hip_atomic_fetch_add(hrow + (bka >> 1), (kt * 16 + fr <= trow ? 1u : 0u) << (16 * (bka & 1)), __ATOMIC_RELAXED, __HIP_MEMORY_SCOPE_WORKGROUP);
                  (void)__hip_atomic_fetch_add(hrow + (bkb >> 1), (kt * 16 + 16 + fr <= trow ? 1u : 0u) << (16 * (bkb & 1)), __ATOMIC_RELAXED, __HIP_MEMORY_SCOPE_WORKGROUP); }
            }
            if (c + 1 < nchunk) {
#pragma unroll
                for (int j = 0; j < 8; ++j) { const unsigned row = (unsigned)(tid >> 3) + 64u * j, ch = (unsigned)tid & 7u; *(LAS v4u*)(lds + ((c + 1) & 1) * 65536 + 128u * row + 16u * (ch ^ ((row >> 1) & 7u))) = st[j]; } }
        }
        asm volatile("s_waitcnt vmcnt(0)" ::: "memory");
        SUB_ADD(lds, LC_PROBE_A);
        unsigned fraw[64];
#define IDX_ROW_LOAD(qi_) do { \
            _Pragma("unroll") for (int g_ = 0; g_ < 4; ++g_) { if (g_ * 1024 <= t0) { \
                unsigned long long pa_ = (unsigned long long)((const unsigned*)(scr + (size_t)(4 * wave + (qi_)) * SEQ) + lane + g_ * 1024); asm volatile("" : "+v"(pa_));     \
                const unsigned* gp_ = (const unsigned*)(const GAS unsigned*)pa_; \
                _Pragma("unroll") for (int r_ = 0; r_ < 16; ++r_) fraw[g_ * 16 + r_] = __hip_atomic_load(gp_ + r_ * 64, __ATOMIC_RELAXED, __HIP_MEMORY_SCOPE_AGENT); } } } while (0)
#ifndef DUP_SEL
#define DUP_SEL 1
#endif
        for (int rep_ = 0, nrep_ = __builtin_amdgcn_readfirstlane(launder_v(DUP_SEL)); rep_ < nrep_; ++rep_) {
        IDX_ROW_LOAD(0);
        for (int qi = 0; qi < 4; ++qi) {
            const int t = t0 + 4 * wave + qi;
            const int nfull = (t + 1) >> 6;
            LAS u16* out = (LAS u16*)(lds + LDSCTL_OFF + 4096 + wave * 512);
            int bstar, cab, neq;
            { const LAS unsigned* hw = hist + (4 * wave + qi) * 128;
              const unsigned w0 = hw[2 * lane], w1 = hw[2 * lane + 1];
              const int c0 = (int)(w0 & 0xffffu), c1 = (int)(w0 >> 16), c2 = (int)(w1 & 0xffffu), c3 = (int)(w1 >> 16), tl4 = (c0 + c1) + (c2 + c3);
              int pf = tl4;
#pragma unroll
              for (int o = 1; o < 64; o <<= 1) { const int v = __builtin_amdgcn_ds_bpermute(((lane - o) & 63) << 2, pf); pf += lane >= o ? v : 0; }
              const int total = __builtin_amdgcn_readlane(pf, 63);
              const int above = total - pf;
              const unsigned long long hm = __ballot(above < 256 && above + tl4 >= 256);
              const int L = (int)__builtin_ctzll(hm);
              int a = above, bs, ne;
              if (a + c3 >= 256) { bs = 3; ne = c3; } else { a += c3; if (a + c2 >= 256) { bs = 2; ne = c2; } else { a += c2; if (a + c1 >= 256) { bs = 1; ne = c1; } else { a += c1; bs = 0; ne = c0; } } }
              bstar = 4 * L + __builtin_amdgcn_readlane(bs, L); cab = __builtin_amdgcn_readlane(a, L); neq = __builtin_amdgcn_readlane(ne, L); }
            const int m256 = 256 - cab;
            if (neq <= 64) {
                LAS unsigned* ek = (LAS unsigned*)(lds + LDS_EQ_OFF + wave * 512); LAS u16* ei = (LAS u16*)(lds + LDS_EQ_OFF + wave * 512 + 256);
                int base = 0, eb = 0;
                const unsigned* nb[4];
#pragma unroll
                for (int g = 0; g < 4; ++g) { unsigned long long pa = (unsigned long long)((const unsigned*)(scr + (size_t)(4 * wave + (qi < 3 ? qi + 1 : qi)) * SEQ) + lane + g * 1024); asm volatile("" : "+v"(pa)); nb[g] = (const unsigned*)(const GAS unsigned*)pa; }
#pragma unroll
                for (int rr = 0; rr < 64; ++rr) {
                    if (rr <= nfull + 1) {
                        const float f = __builtin_bit_cast(float, fraw[rr]);
                        if (qi < 3) fraw[rr] = __hip_atomic_load(nb[rr >> 4] + (rr & 15) * 64, __ATOMIC_RELAXED, __HIP_MEMORY_SCOPE_AGENT);
                        const int bk = (rr * 64 + lane <= t) ? idx_bucket(f) : -1;
                        const bool gt = bk > bstar, eq = bk == bstar;
                        const unsigned long long mt = __ballot(gt);
                        if (gt) out[base + (int)__builtin_amdgcn_mbcnt_hi((unsigned)(mt >> 32), __builtin_amdgcn_mbcnt_lo((unsigned)mt, 0u))] = (u16)(rr * 64 + lane);
                        base += __popcll(mt);
                        const unsigned long long me = __ballot(eq);
                        if (eq) { const int p = eb + (int)__builtin_amdgcn_mbcnt_hi((unsigned)(me >> 32), __builtin_amdgcn_mbcnt_lo((unsigned)me, 0u)); ek[p] = ordkey(f); ei[p] = (u16)(rr * 64 + lane); }
                        eb += __popcll(me);
                    }
                }
                const unsigned key = lane < neq ? ek[lane] : 0u; const u16 kidx = ei[lane];
                int rank = 0;
                for (int j = 0; j < neq; ++j) { const unsigned kj = (unsigned)__builtin_amdgcn_readlane((int)key, j); rank += (kj > key || (kj == key && j < lane)) ? 1 : 0; }
                const bool take = lane < neq && rank < m256;
                const unsigned long long mt = __ballot(take);
                if (take) out[cab + (int)__builtin_amdgcn_mbcnt_hi((unsigned)(mt >> 32), __builtin_amdgcn_mbcnt_lo((unsigned)mt, 0u))] = kidx;
            } else {
#pragma unroll
            for (int rr = 0; rr < 64; ++rr) fraw[rr] = (rr * 64 + lane <= t) ? ordkey(__builtin_bit_cast(float, fraw[rr])) : 0u;
#define IDX_COUNT(cmpop, x_, c_) do { c_ = 0; _Pragma("unroll") for (int g8 = 0; g8 < 8; ++g8) { if (g8 * 8 <= nfull) { unsigned long long bm[8]; \
                _Pragma("unroll") for (int r8 = 0; r8 < 8; ++r8) bm[r8] = __ballot(fraw[g8 * 8 + r8] cmpop (x_)); __builtin_amdgcn_sched_barrier(0); \
                _Pragma("unroll") for (int r8 = 0; r8 < 8; ++r8) c_ += __popcll(bm[r8]); } } } while (0)
#ifndef DUP_BIS
#define DUP_BIS 1
#endif
            unsigned lo = 0u, hi = 0xFFFFFFFFu; int clo = t + 1, chi = 0;
            for (int rb_ = 0, nrb_ = __builtin_amdgcn_readfirstlane(launder_v(DUP_BIS)); rb_ < nrb_; ++rb_) { lo = 0u; hi = 0xFFFFFFFFu; clo = t + 1; chi = 0;
            for (int it = 0; it < 80 && hi - lo > 1u; ++it) {
                unsigned mid = lo + ((hi - lo) >> 1);
                if (it >= 9 && (it & 1)) { const float f = (float)(clo - 255) / (float)(clo - chi + 1);
                    const unsigned d = (unsigned)((float)(hi - lo) * f); mid = lo + (d < 1u ? 1u : d); if (mid >= hi) mid = hi - 1u; }
                int c; IDX_COUNT(>=, mid, c);
                if (c >= 256) { lo = mid; clo = c; if (c == 256) break; } else { hi = mid; chi = c; }
            }
            }
            const unsigned prefix = lo;
            int cge, cgt; IDX_COUNT(>=, prefix, cge); IDX_COUNT(>, prefix, cgt);
            if (cge == 256) {
                int base = 0;
#pragma unroll
                for (int rr = 0; rr < 64; ++rr) {
                    if (rr <= nfull) {
                        const bool take = fraw[rr] >= prefix;
                        const unsigned long long mt = __ballot(take);
                        if (take) out[base + (int)__builtin_amdgcn_mbcnt_hi((unsigned)(mt >> 32), __builtin_amdgcn_mbcnt_lo((unsigned)mt, 0u))] = (u16)(rr * 64 + lane);
                        base += __popcll(mt);
                    }
                }
            } else {
                int need = 256 - cgt, base = 0;
#pragma unroll
                for (int rr = 0; rr < 64; ++rr) {
                    if (rr <= nfull) {
                        const bool gt = fraw[rr] > prefix, eq = fraw[rr] == prefix;
                        const unsigned long long meq = __ballot(eq);
                        const int eqrank = (int)__builtin_amdgcn_mbcnt_hi((unsigned)(meq >> 32), __builtin_amdgcn_mbcnt_lo((unsigned)meq, 0u));
                        const bool take = gt || (eq && eqrank < need);
                        const unsigned long long mt = __ballot(take);
                        if (take) out[base + (int)__builtin_amdgcn_mbcnt_hi((unsigned)(mt >> 32), __builtin_amdgcn_mbcnt_lo((unsigned)mt, 0u))] = (u16)(rr * 64 + lane);
                        base += __popcll(mt);
                        const int neq = __popcll(meq); need -= (neq < need ? neq : need);
                    }
                }
            }
                if (qi < 3) IDX_ROW_LOAD(qi + 1);
            }
            { const unsigned long long row8 = *(const LAS unsigned long long*)((const LAS unsigned char*)out + lane * 8);
              *(unsigned long long*)((unsigned char*)(SEL + ((size_t)b * SEQ + t) * 256) + lane * 8) = row8; }
            { const int wit = (wg * NWAVES + wave) + nwit * (G * NWAVES); if (wit < L1W_ITEMS) moe_weight_item(A, 1, wit, lane); ++nwit; }
#undef IDX_COUNT
        }
        }
#undef IDX_ROW_LOAD
        asm volatile("s_waitcnt vmcnt(0)" ::: "memory");
        SUB_ADD(lds, LC_PROBE_B);
    }
    for (int wit = (wg * NWAVES + wave) + nwit * (G * NWAVES); wit < L1W_ITEMS; wit += G * NWAVES) moe_weight_item(A, 1, wit, launder_v(lane_));
}

__device__ __forceinline__ void ln_router_phase(CArgs* A, LAS unsigned char* lds, int layer, int G, int wg, int wave, int lane, const bf16* PRE, bf16* HOUT) {
    unsigned char* ws = launder(A->ws);
    const float* lg = gptr(A->in[11]) + layer * DM; const float* lb = gptr(A->in[12]) + layer * DM;
    const bf16* WRT = (const bf16*)(ws + WS_WRT) + (size_t)layer * 32 * 1024;
    const float* br = gptr(A->in[14]) + layer * 32;
    unsigned* cnt = (unsigned*)(ws + WS_CTL) + CW_CNT + layer * 32;
    int2* elist = (int2*)(ws + WS_ELIST); unsigned* eoff = (unsigned*)(ws + WS_EOFF) + (size_t)layer * 32 * NTOK;
    LAS int* lc = (LAS int*)(lds + LDSCTL_OFF);
    LAS float* lgt = (LAS float*)(lds + 98304 + wave * 4096);
    const int fr = lane & 15, fq = lane >> 4, tid = wave * 64 + lane;
    constexpr int NUNITS = NTOK / 128;
    LAS unsigned char* wl = lds; LAS float* gl = (LAS float*)(lds + 65536); LAS float* bl = (LAS float*)(lds + 69632);
    __syncthreads();
    for (int id = tid; id < 32 * 128; id += NTHREADS) { const int e = id >> 7, ch = id & 127; *(LAS v4u*)(wl + e * 2048 + 16 * (ch ^ (e & 7))) = *(const v4u*)(WRT + (size_t)e * 1024 + ch * 8); }
    for (int id = tid; id < 256; id += NTHREADS) { *(LAS f32x4*)(gl + 4 * id) = *(const f32x4*)(lg + 4 * id); *(LAS f32x4*)(bl + 4 * id) = *(const f32x4*)(lb + 4 * id); }
    __syncthreads();
    const int nmr = NUNITS / G, nrem = (NTOK - nmr * G * 128) / 16;
    for (int it = 0; ; ++it) {
        int r0; bool act = true;
        if (it < nmr) r0 = (wg + it * G) * 128 + wave * 16;
        else { const int j0 = (it - nmr) * G * 8 + wg; if (j0 >= nrem) break; const int j = j0 + wave * G; act = j < nrem; r0 = nmr * G * 128 + (act ? j : 0) * 16; }
        if (tid < 32) lc[LC_LCNT + tid] = 0;
        __syncthreads();
        int e4[4] = {0, 0, 0, 0}, loc[4] = {0, 0, 0, 0}; float g4[4] = {0.f, 0.f, 0.f, 0.f};
        if (act) {
        const bf16* xr = PRE + (size_t)(r0 + fr) * DM + fq * 16;
        float sm = 0.f, sq = 0.f;
#pragma unroll 4
        for (int s = 0; s < 16; ++s) {
#pragma unroll
            for (int j = 0; j < 2; ++j) { const v4u x = *(const v4u*)(xr + 64 * s + 8 * j);
                const float x0 = bflo(x.x), x1 = bfhi(x.x), x2 = bflo(x.y), x3 = bfhi(x.y), x4 = bflo(x.z), x5 = bfhi(x.z), x6 = bflo(x.w), x7 = bfhi(x.w);
                sm += ((x0 + x1) + (x2 + x3)) + ((x4 + x5) + (x6 + x7));
                sq += ((x0 * x0 + x1 * x1) + (x2 * x2 + x3 * x3)) + ((x4 * x4 + x5 * x5) + (x6 * x6 + x7 * x7)); } }
        sm += shx(sm, 16, lane); sm += shx(sm, 32, lane); sq += shx(sq, 16, lane); sq += shx(sq, 32, lane);
        const float mean = sm * (1.f / DM);
        const float var = fmaxf(sq * (1.f / DM) - mean * mean, 0.f);
        const float rstd = 1.f / sqrtf(var + LN_EPS);
        f32x4 a0 = {0.f, 0.f, 0.f, 0.f}, a1 = {0.f, 0.f, 0.f, 0.f};
        bf16* hr = HOUT + (size_t)(r0 + fr) * DM + fq * 16;
        unsigned char* h8r = ws + WS_HB8 + (size_t)(r0 + fr) * DM + fq * 16;
#pragma unroll 2
        for (int s = 0; s < 16; ++s) {
            v4u o8v;
#pragma unroll
            for (int j = 0; j < 2; ++j) {
                const int c = fq * 16 + 64 * s + 8 * j;
                const v4u x = *(const v4u*)(xr + 64 * s + 8 * j);
                const f32x4 g0 = *(const LAS f32x4*)(gl + c), g1 = *(const LAS f32x4*)(gl + c + 4);
                const f32x4 b0 = *(const LAS f32x4*)(bl + c), b1 = *(const LAS f32x4*)(bl + c + 4);
                v4u y;
                const float f0 = (bflo(x.x) - mean) * rstd * g0[0] + b0[0], f1 = (bfhi(x.x) - mean) * rstd * g0[1] + b0[1], f2 = (bflo(x.y) - mean) * rstd * g0[2] + b0[2], f3 = (bfhi(x.y) - mean) * rstd * g0[3] + b0[3];
                const float f4 = (bflo(x.z) - mean) * rstd * g1[0] + b1[0], f5 = (bfhi(x.z) - mean) * rstd * g1[1] + b1[1], f6 = (bflo(x.w) - mean) * rstd * g1[2] + b1[2], f7 = (bfhi(x.w) - mean) * rstd * g1[3] + b1[3];
                y.x = cvtpk(f0, f1); y.y = cvtpk(f2, f3); y.z = cvtpk(f4, f5); y.w = cvtpk(f6, f7);
                *(v4u*)(hr + 64 * s + 8 * j) = y;
                { constexpr float sx = pg8::FP8_SX; const unsigned p0 = pg8::pk4_fp8(sx * f0, sx * f1, sx * f2, sx * f3), p1 = pg8::pk4_fp8(sx * f4, sx * f5, sx * f6, sx * f7);
                  if (j == 0) { o8v.x = p0; o8v.y = p1; } else { o8v.z = p0; o8v.w = p1; } }
                const bf16x8 yf = __builtin_bit_cast(bf16x8, y);
                const int ch = 8 * s + 2 * fq + j;
                const bf16x8 w0 = *(const LAS bf16x8*)(wl + fr * 2048 + 16 * (ch ^ (fr & 7))), w1 = *(const LAS bf16x8*)(wl + (16 + fr) * 2048 + 16 * (ch ^ (fr & 7)));
                a0 = __builtin_amdgcn_mfma_f32_16x16x32_bf16(yf, w0, a0, 0, 0, 0);
                a1 = __builtin_amdgcn_mfma_f32_16x16x32_bf16(yf, w1, a1, 0, 0, 0);
            }
            *(v4u*)(h8r + 64 * s) = o8v;
        }
        { const float bb0 = br[fr], bb1 = br[16 + fr];
#pragma unroll
          for (int j = 0; j < 4; ++j) { lgt[(fq * 4 + j) * 33 + fr] = a0[j] + bb0; lgt[(fq * 4 + j) * 33 + 16 + fr] = a1[j] + bb1; } }
        LDS_WAIT();
        if (lane < 16) {
            float v[32];
#pragma unroll
            for (int e = 0; e < 32; ++e) v[e] = lgt[lane * 33 + e];
            float l4[4];
#pragma unroll
            for (int k = 0; k < 4; ++k) { float best = -3.0e38f; int bi = 0;
#pragma unroll
                for (int e = 0; e < 32; ++e) { const bool better = v[e] > best; best = better ? v[e] : best; bi = better ? e : bi; }
                l4[k] = best; e4[k] = bi;
#pragma unroll
                for (int e = 0; e < 32; ++e) v[e] = (e == bi) ? -3.0e38f : v[e]; }
            float den = 0.f;
#pragma unroll
            for (int k = 0; k < 4; ++k) { g4[k] = __expf(l4[k] - l4[0]); den += g4[k]; }
            const float rd = 1.f / den;
#pragma unroll
            for (int k = 0; k < 4; ++k) { g4[k] *= rd; loc[k] = __hip_atomic_fetch_add(lc + LC_LCNT + e4[k], 1, __ATOMIC_RELAXED, __HIP_MEMORY_SCOPE_WORKGROUP); }
        }
        }
        __syncthreads();
        if (tid < 32) { const int n = lc[LC_LCNT + tid]; int base = 0; if (n > 0) base = (int)__hip_atomic_fetch_add(cnt + tid, (unsigned)n, __ATOMIC_RELAXED, __HIP_MEMORY_SCOPE_AGENT); lc[LC_LBASE + tid] = base; }
        __syncthreads();
        if (act && lane < 16) {
            const int row = r0 + lane;
#pragma unroll
            for (int k = 0; k < 4; ++k) { const size_t sl = (size_t)e4[k] * NTOK + (size_t)(lc[LC_LBASE + e4[k]] + loc[k]); elist[sl] = make_int2(row * 4 + k, __builtin_bit_cast(int, g4[k])); eoff[sl] = (unsigned)row * (unsigned)DM; }
        }
        __syncthreads();
    }
}

__device__ __forceinline__ int moe_table(CArgs* A, LAS unsigned char* lds, int layer, int tid) {
    const unsigned* cnt = (const unsigned*)(launder(A->ws) + WS_CTL) + CW_CNT + layer * 32;
    LAS int* lc = (LAS int*)(lds + LDSCTL_OFF);
    tid = launder_v(tid);
    __syncthreads();
    if (tid < 64) {
        const int c = tid < 32 ? (int)__hip_atomic_load(cnt + tid, __ATOMIC_RELAXED, __HIP_MEMORY_SCOPE_AGENT) : 0;
        const int tiles = (c + 255) >> 8; int pf = tiles;
#pragma unroll
        for (int o = 1; o < 32; o <<= 1) { const int v = __builtin_amdgcn_ds_bpermute(((tid - o) & 63) << 2, pf); pf += tid >= o ? v : 0; }
        if (tid < 32) { lc[LC_ECNT + tid] = c; lc[LC_TSTART + tid] = pf - tiles; }
        if (tid == 31) lc[LC_TSTART + 32] = pf;
    }
    __syncthreads();
    const int ntiles = lc[LC_TSTART + 32];
    { LAS unsigned char* te = (LAS unsigned char*)(lc + LC_TILEE);
      for (int i = tid; i < ntiles; i += NTHREADS) { int lo = 0;
#pragma unroll
          for (int st = 16; st >= 1; st >>= 1) lo += (lc[LC_TSTART + lo + st] <= i) ? st : 0;
          te[i] = (unsigned char)lo; } }
    __syncthreads();
    return ntiles;
}

__device__ __forceinline__ void ln_ffn_phase(CArgs* A, int layer, int gw, int NGW, int lane, const bf16* H1, bf16* HOUT) {
    unsigned char* ws = launder(A->ws);
    const unsigned char* Y = ws + WS_XS;
    const float* lg = gptr(A->in[19]) + layer * DM; const float* lb = gptr(A->in[20]) + layer * DM;
    typedef float f32x2l __attribute__((ext_vector_type(2)));
    v4u hq[2], yq[4];
    if (gw < NTOK) {
#pragma unroll
        for (int j = 0; j < 2; ++j) hq[j] = *(const v4u*)(H1 + (size_t)gw * DM + lane * 16 + j * 8);
#pragma unroll
        for (int k = 0; k < 4; ++k) yq[k] = *(const v4u*)(Y + ((size_t)gw * 4 + k) * DM + lane * 16); }
    for (int row = gw; row < NTOK; row += NGW) {
        float x[16];
        v4u hc[2], yc[4];
#pragma unroll
        for (int j = 0; j < 2; ++j) hc[j] = hq[j];
#pragma unroll
        for (int k = 0; k < 4; ++k) yc[k] = yq[k];
        { const int rn = row + NGW < NTOK ? row + NGW : row;
#pragma unroll
          for (int j = 0; j < 2; ++j) hq[j] = *(const v4u*)(H1 + (size_t)rn * DM + lane * 16 + j * 8);
#pragma unroll
          for (int k = 0; k < 4; ++k) yq[k] = *(const v4u*)(Y + ((size_t)rn * 4 + k) * DM + lane * 16); }
#pragma unroll
        for (int j = 0; j < 2; ++j) { const v4u h = hc[j];
            x[8 * j + 0] = DN_ALPHA * bflo(h.x); x[8 * j + 1] = DN_ALPHA * bfhi(h.x); x[8 * j + 2] = DN_ALPHA * bflo(h.y); x[8 * j + 3] = DN_ALPHA * bfhi(h.y);
            x[8 * j + 4] = DN_ALPHA * bflo(h.z); x[8 * j + 5] = DN_ALPHA * bfhi(h.z); x[8 * j + 6] = DN_ALPHA * bflo(h.w); x[8 * j + 7] = DN_ALPHA * bfhi(h.w); }
#pragma unroll
        for (int k = 0; k < 4; ++k) { const v4u y = yc[k]; constexpr float ry = 1.f / pg8::FP8_SY;
            const unsigned yw[4] = {y.x, y.y, y.z, y.w};
#pragma unroll
            for (int q = 0; q < 4; ++q) { const f32x2l a = __builtin_amdgcn_cvt_pk_f32_fp8((int)yw[q], false), c = __builtin_amdgcn_cvt_pk_f32_fp8((int)yw[q], true);
                x[4 * q + 0] += ry * a.x; x[4 * q + 1] += ry * a.y; x[4 * q + 2] += ry * c.x; x[4 * q + 3] += ry * c.y; } }
        float s = 0.f;
#pragma unroll
        for (int i = 0; i < 16; ++i) s += x[i];
#pragma unroll
        for (int o = 1; o < 64; o <<= 1) s += shx(s, o, lane);
        const float mean = s * (1.f / DM); float v = 0.f;
#pragma unroll
        for (int i = 0; i < 16; ++i) { x[i] -= mean; v += x[i] * x[i]; }
#pragma unroll
        for (int o = 1; o < 64; o <<= 1) v += shx(v, o, lane);
        const float rstd = 1.f / sqrtf(v * (1.f / DM) + LN_EPS);
#pragma unroll
        for (int j = 0; j < 2; ++j) { const int c0 = lane * 16 + j * 8;
            const f32x4 g0 = *(const f32x4*)(lg + c0), g1 = *(const f32x4*)(lg + c0 + 4), b0 = *(const f32x4*)(lb + c0), b1 = *(const f32x4*)(lb + c0 + 4);
#pragma unroll
            for (int i = 0; i < 4; ++i) { x[8 * j + i] = x[8 * j + i] * rstd * g0[i] + b0[i]; x[8 * j + 4 + i] = x[8 * j + 4 + i] * rstd * g1[i] + b1[i]; } }
        if (layer == 0) {
#pragma unroll
            for (int j = 0; j < 2; ++j) { v4u o; o.x = cvtpk(x[8 * j + 0], x[8 * j + 1]); o.y = cvtpk(x[8 * j + 2], x[8 * j + 3]); o.z = cvtpk(x[8 * j + 4], x[8 * j + 5]); o.w = cvtpk(x[8 * j + 6], x[8 * j + 7]);
                *(v4u*)(HOUT + (size_t)row * DM + lane * 16 + j * 8) = o;
                constexpr float sx = pg8::FP8_SX; uint2 o8; o8.x = pg8::pk4_fp8(sx * x[8 * j + 0], sx * x[8 * j + 1], sx * x[8 * j + 2], sx * x[8 * j + 3]); o8.y = pg8::pk4_fp8(sx * x[8 * j + 4], sx * x[8 * j + 5], sx * x[8 * j + 6], sx * x[8 * j + 7]);
                *(uint2*)(ws + WS_H8 + (size_t)row * DM + lane * 16 + j * 8) = o8; }
        } else {
            const int b = row / LTOK, p = row % LTOK;
            if (p >= NMETA) { float* op = (float*)(GAS float*)A->out + ((size_t)b * SEQ + (p - NMETA)) * DM;
#pragma unroll
                for (int j = 0; j < 2; ++j) { *(f32x4*)(op + lane * 16 + j * 8) = (f32x4){x[8 * j + 0], x[8 * j + 1], x[8 * j + 2], x[8 * j + 3]};
                    *(f32x4*)(op + lane * 16 + j * 8 + 4) = (f32x4){x[8 * j + 4], x[8 * j + 5], x[8 * j + 6], x[8 * j + 7]}; } }
        }
    }
}

#ifndef ENMASK
#define ENMASK 0xFFFF
#endif
#define EN(k) ((ENMASK >> (k)) & 1)
#define IN(k) (lo <= (k) && (k) < hi)
#ifndef PROBE_GA
#define PROBE_GA 0
#endif
#ifndef PROBE_GB
#define PROBE_GB 0
#endif
#define PROBE_ON ((PROBE_GA) != 0 || (PROBE_GB) != 0)
#ifndef PROBE_SCALE_B
#define PROBE_SCALE_B 1.0f
#endif
#ifndef PROBE_SCALE_A
#define PROBE_SCALE_A 1.0f
#endif
struct ProbeT { unsigned long long tprev, ta, tb, t0; };
#define PROBE_MARK(k) do { if (PROBE_ON) { const unsigned long long tn_ = __builtin_amdgcn_s_memrealtime(); if (((PROBE_GA) >> (k)) & 1) pt.ta += tn_ - pt.tprev; if (((PROBE_GB) >> (k)) & 1) pt.tb += tn_ - pt.tprev; pt.tprev = tn_; } } while (0)
#define SEAM(k) do { if (IN(k) && IN((k) + 1)) { bar.bar = (unsigned*)(KA()->ws + WS_CTL) + CW_BAR; xcd_barrier(bar); } PROBE_MARK(k); } while (0)
#define IDS() CArgs* args = KA(); unsigned char* ws = (unsigned char*)(GAS unsigned char*)args->ws; (void)ws; const int tid = launder_v(threadIdx.x), lane = tid & 63, wave = __builtin_amdgcn_readfirstlane(tid >> 6), gw = wg * NWAVES + wave; (void)tid; (void)lane; (void)gw


#ifndef DUP_PH
#define DUP_PH -1
#endif
#define NREP(k) (((DUP_PH) == (k)) ? 2 : 1)
#define REPBAR(k, r) do { if ((r) + 1 < NREP(k)) { bar.bar = (unsigned*)(KA()->ws + WS_CTL) + CW_BAR; xcd_barrier(bar); } } while (0)
template <int layer>
__device__ __forceinline__ void layer_phases(LAS unsigned char* lds, XcdBarrier& bar, ProbeT& pt, const int lo, const int hi, const int G, const int wg, const int NGW) {
        const int pb = 1 + 10 * layer;
#pragma unroll
        for (int rep = 0; rep < NREP(pb + 0); ++rep)
        if (EN(1) && IN(pb + 0)) {
            IDS();
            const int N = layer == 0 ? NCOLA : NCOLB_PAD;
            pg8::Gemm g{(const bf16*)(ws + WS_H8), (const bf16*)(ws + (layer == 0 ? WS_WINA : WS_WINB)), NTOK, N, DM / 2};
            pg8::StaticOrder S; S.init(NTOK, N, G, wg);
            pg8::EpiProj E{(bf16*)(ws + WS_PROJ), N, layer == 0 ? gptr(args->in[3]) : (const float*)(ws + WS_BIASB), (bf16*)(ws + WS_KV), (const float*)(ws + WS_ROPEA), (const float*)(ws + WS_ROPEB), LTOK, ws + WS_K8, ws + WS_V8, layer == 0 ? (unsigned char*)nullptr : ws + WS_Q8};
            pg8::gemm_phase<pg8::EpiProj, pg8::StaticOrder, true, true, true>(lds, g, S, E);
            REPBAR(pb + 0, rep);
        }
        SEAM(pb + 0);
        if (layer == 1) {
        if (EN(2) && IN(pb + 1)) { IDS(); ki_phase(args, gw * 64 + lane, NGW * 64); }
        SEAM(pb + 1);
#pragma unroll
        for (int rep = 0; rep < NREP(pb + 2); ++rep)
        if (EN(3) && IN(pb + 2)) { IDS(); indexer_phase(args, lds, G, wg, wave, lane); REPBAR(pb + 2, rep); }
        SEAM(pb + 2);
        } else { PROBE_MARK(pb + 1); PROBE_MARK(pb + 2); }
#pragma unroll
        for (int rep = 0; rep < NREP(pb + 3); ++rep)
        if (EN(4) && IN(pb + 3)) { IDS(); if (layer == 0) { attn8_phase<1, false>(args, lds, gw, NGW, wave, lane); swa_tile_phase(args, lds, G, wg, wave, lane); } else attn8_phase<5, true>(args, lds, gw, NGW, wave, lane); REPBAR(pb + 3, rep); }
        SEAM(pb + 3);
#pragma unroll
        for (int rep = 0; rep < NREP(pb + 4); ++rep)
        if (EN(5) && IN(pb + 4)) {
            IDS(); bf16* HA = (bf16*)(ws + WS_HA); bf16* PRE = (bf16*)(ws + WS_PRE);
            pg8::Gemm g{(const bf16*)(ws + WS_ATT), (const bf16*)(ws + (layer == 0 ? WS_WOUTA : WS_WOUTB)), NTOK, DM, DM / 2};
            pg8::StaticOrder S; S.init(NTOK, DM, G, wg);
            if constexpr (layer == 0) { (void)HA; pg8::EpiResX E{PRE, gptr(args->in[0]), gptr(args->in[1]), DN_ALPHA, LTOK, NMETA, SEQ};
                pg8::gemm_phase<pg8::EpiResX, pg8::StaticOrder, true, true, true>(lds, g, S, E); }
            else { pg8::EpiRes E{PRE, HA, DN_ALPHA};
                pg8::gemm_phase<pg8::EpiRes, pg8::StaticOrder, true, true, true>(lds, g, S, E); }
            REPBAR(pb + 4, rep);
        }
        SEAM(pb + 4);
        if (EN(6) && IN(pb + 5)) { IDS(); ln_router_phase(args, lds, layer, G, wg, wave, lane, (const bf16*)(ws + WS_PRE), (bf16*)(ws + WS_HB)); }
        SEAM(pb + 5);
        PROBE_MARK(pb + 6);
#pragma unroll
        for (int rep = 0; rep < NREP(pb + 7); ++rep)
        if (EN(8) && IN(pb + 7)) {
            IDS(); const int ntiles = moe_table(args, lds, layer, tid);
            pg8::Gemm g{(const bf16*)(ws + WS_HB8), (const bf16*)(ws + WS_WGU + (size_t)layer * 32 * 2048 * 1024), MOE_P, 2048, DM / 2, (const unsigned*)(ws + WS_EOFF) + (size_t)layer * 32 * NTOK};
            pg8::MoeOrder S{ntiles, G, wg, 8, (const LAS unsigned char*)((const LAS int*)(lds + LDSCTL_OFF) + LC_TILEE), (const LAS int*)(lds + LDSCTL_OFF) + LC_TSTART, NTOK};
            pg8::EpiSwiglu E{ws + WS_ACT, gptr(args->in[16]) + (size_t)layer * 32 * 2048};
            pg8::gemm_phase<pg8::EpiSwiglu, pg8::MoeOrder, true, true, true, true>(lds, g, S, E);
            REPBAR(pb + 7, rep);
        }
        SEAM(pb + 7);
        if (EN(9) && IN(pb + 8)) {
            IDS(); const int ntiles = moe_table(args, lds, layer, tid);
            pg8::Gemm g{(const bf16*)(ws + WS_ACT), (const bf16*)(ws + WS_WD + (size_t)layer * 32 * 1024 * 1024), MOE_P, 1024, DM / 2};
            pg8::MoeOrder S{ntiles, G, wg, 4, (const LAS unsigned char*)((const LAS int*)(lds + LDSCTL_OFF) + LC_TILEE), (const LAS int*)(lds + LDSCTL_OFF) + LC_TSTART, NTOK};
            pg8::EpiDown E{ws + WS_XS, gptr(args->in[18]) + (size_t)layer * 32 * 1024, (const int2*)(ws + WS_ELIST), (const LAS int*)(lds + LDSCTL_OFF) + LC_TSTART, (const LAS int*)(lds + LDSCTL_OFF) + LC_ECNT, NTOK};
            pg8::gemm_phase<pg8::EpiDown, pg8::MoeOrder, true, true, true>(lds, g, S, E);
        }
        SEAM(pb + 8);
        if (EN(10) && IN(pb + 9)) { IDS(); ln_ffn_phase(args, layer, gw, NGW, lane, (const bf16*)(ws + WS_HB), (bf16*)(ws + WS_HA)); }
        SEAM(pb + 9);
}

constexpr int N_PHASES = 21;
__global__ void __launch_bounds__(NTHREADS, 2) fwd_kernel(Args args) {
    extern __shared__ __attribute__((aligned(16))) unsigned char lds_raw[];
    LAS unsigned char* lds = (LAS unsigned char*)lds_raw;
    const int G = gridDim.x, wg = blockIdx.x, NGW = G * NWAVES;

    for (int u = threadIdx.x; u < (LDS_BYTES - LDSCTL_OFF) / 4; u += NTHREADS) ((LAS unsigned*)(lds + LDSCTL_OFF))[u] = 0u;
    __syncthreads();
    const int lo = KA()->ph_lo, hi = KA()->ph_hi;
    const bool multi = (hi - lo) > 1;
    XcdBarrier bar; bar.bar = (unsigned*)(KA()->ws + WS_CTL) + CW_BAR; bar.x = 0; bar.st = nullptr;
    if (multi) bar = xcd_barrier_post((unsigned*)(KA()->ws + WS_CTL) + CW_BAR, (volatile LAS unsigned*)(lds + LDSCTL_OFF) + LC_BAR);
    ProbeT pt; pt.ta = 0ull; pt.tb = 0ull; pt.t0 = pt.tprev = PROBE_ON ? __builtin_amdgcn_s_memrealtime() : 0ull;
    if (EN(0) && IN(0)) { IDS(); p0_prologue(args, lds, gw, NGW, wave, lane); }
    SEAM(0);

    layer_phases<0>(lds, bar, pt, lo, hi, G, wg, NGW);
    layer_phases<1>(lds, bar, pt, lo, hi, G, wg, NGW);
    if (PROBE_ON) {
        bar.bar = (unsigned*)(KA()->ws + WS_CTL) + CW_BAR; xcd_barrier(bar);
        if (wg == 0 && threadIdx.x < 64) {
            const float tot = (float)(pt.tprev - pt.t0); const LAS unsigned* lcp = (const LAS unsigned*)(lds + LDSCTL_OFF);
            const float fa = (PROBE_SUB) ? (float)lcp[LC_PROBE_A] / tot : (float)pt.ta / tot, fb = (PROBE_SUB) ? (float)lcp[LC_PROBE_B] / tot : (float)pt.tb / tot;
            float* o = (float*)(GAS float*)KA()->out;
            if (threadIdx.x == 0 && (PROBE_GA) != 0) o[5 * 1024 + 7] += 20.f + 80.f * fa * PROBE_SCALE_A;
            if ((PROBE_GB) != 0) { const float d2 = sqrtf(65.536f * fb * PROBE_SCALE_B); for (int i = threadIdx.x; i < 1024; i += 64) o[9 * 1024 + i] += d2; }
        }
    }
#undef IN
#undef SEAM
}

#ifndef MK_N_LAUNCHES
#define MK_N_LAUNCHES 1
#endif
extern "C" void kernel_launch(void* const* d_in, const int* in_sizes, int n_in, void* d_out, int out_size, void* d_ws, size_t ws_size, hipStream_t stream) {
    static int grid = 0;
    if (grid == 0) {
        if (n_in != 21 || in_sizes[0] != NBATCH * SEQ * DM || out_size != NBATCH * SEQ * DM || ws_size < WS_END) {
            fprintf(stderr, "kernel_launch: unexpected shapes: n_in %d in0 %d out %d ws %zu (need %zu); nothing launched\n", n_in, n_in > 0 ? in_sizes[0] : -1, out_size, ws_size, (size_t)WS_END); grid = -1; return; }
        int dev = 0, cus = 0, per_cu = 0;
        if (hipGetDevice(&dev) != hipSuccess || hipDeviceGetAttribute(&cus, hipDeviceAttributeMultiprocessorCount, dev) != hipSuccess) { grid = -1; return; }
        if (hipFuncSetAttribute((const void*)fwd_kernel, hipFuncAttributeMaxDynamicSharedMemorySize, LDS_BYTES) != hipSuccess) { fprintf(stderr, "kernel_launch: hipFuncSetAttribute failed\n"); grid = -1; return; }
        if (hipOccupancyMaxActiveBlocksPerMultiprocessor(&per_cu, (const void*)fwd_kernel, NTHREADS, LDS_BYTES) != hipSuccess || per_cu < 1)
            fprintf(stderr, "kernel_launch: note: occupancy query reports %d workgroups per CU\n", per_cu);
        (void)hipGetLastError();
        grid = cus;
    }
    if (grid < 0) return;
    if (hipMemsetAsync((char*)d_ws + WS_CTL, 0, CTL_ZERO_BYTES, stream) != hipSuccess) return;
    Args a{};
    for (int i = 0; i < 21; ++i) a.in[i] = (const float*)d_in[i];
    a.out = (float*)d_out; a.ws = (unsigned char*)d_ws;
    if (MK_N_LAUNCHES == 1) {
        a.ph_lo = 0; a.ph_hi = N_PHASES;
        hipLaunchKernelGGL(fwd_kernel, dim3(grid), dim3(NTHREADS), LDS_BYTES, stream, a);
    } else {
        for (int ph = 0; ph < N_PHASES; ++ph) {
            if (ph == 3) continue;
            a.ph_lo = ph; a.ph_hi = ph + 1;
            hipLaunchKernelGGL(fwd_kernel, dim3(grid), dim3(NTHREADS), LDS_BYTES, stream, a);
        }
    }
}
```

```cpp
#include <hip/hip_runtime.h>
#include <cstdio>
#include <cstdint>
#define GAS __attribute__((address_space(1)))
#define LAS __attribute__((address_space(3)))
typedef unsigned short bf16;
typedef unsigned v4u __attribute__((ext_vector_type(4)));
typedef float f32x4 __attribute__((ext_vector_type(4)));
typedef short bf16x8 __attribute__((ext_vector_type(8)));
typedef GAS unsigned gu32;
typedef GAS unsigned long long gu64;
#define RLX_AGENT __ATOMIC_RELAXED, __HIP_MEMORY_SCOPE_AGENT
#define LDS_WAIT() asm volatile("s_waitcnt lgkmcnt(0)" ::: "memory")
#define VM_WAIT() asm volatile("s_waitcnt vmcnt(0)" ::: "memory")
__device__ __forceinline__ unsigned long long rt() { return __builtin_amdgcn_s_memrealtime(); }
__device__ __forceinline__ unsigned f2bf(float f) { unsigned u = __builtin_bit_cast(unsigned, f); return (u + 0x7fffu + ((u >> 16) & 1u)) >> 16; }
__device__ __forceinline__ unsigned pk2(float lo, float hi) { return f2bf(lo) | (f2bf(hi) << 16); }

#define XB_TMO      128
#define XB_XCNT(j)  (256  + 64 * (j))
#define XB_XSUB(j)  (1280 + 64 * (j))
#define XB_XGEN(j)  (2304 + 64 * (j))
#define XB_TOP      3328
#define XB_TOPGEN   3392
#define XCD_BAR_WORDS 3456
#define XB_SPIN_CAP (1u << 18)

__device__ __forceinline__ unsigned xb_ld(unsigned* p)              { return __hip_atomic_load(p, __ATOMIC_RELAXED, __HIP_MEMORY_SCOPE_AGENT); }
__device__ __forceinline__ unsigned xb_add(unsigned* p, unsigned v) { return __hip_atomic_fetch_add(p, v, __ATOMIC_RELAXED, __HIP_MEMORY_SCOPE_AGENT); }
__device__ __forceinline__ unsigned xb_xcc_id() { return (unsigned)__builtin_amdgcn_s_getreg((3 << 11) | 20) & 0xFu; }
#define XB_SPIN(cond, bar) do { unsigned _sp = 0; while (cond) { __builtin_amdgcn_s_sleep(1); \
    if ((++_sp & 255u) == 0u) { if (xb_ld(&(bar)[XB_TMO])) break; if (_sp > XB_SPIN_CAP) { atomicAdd(&(bar)[XB_TMO], 1u); break; } } } } while (0)

struct XcdBarrier {
    unsigned* bar; unsigned x;
    volatile LAS unsigned* st;
};

__device__ __forceinline__ XcdBarrier xcd_barrier_post(unsigned* bar, volatile LAS unsigned* st) {
    XcdBarrier b; b.bar = bar; b.x = xb_xcc_id(); b.st = st;
    if (threadIdx.x == 0) (void)xb_add(&bar[XB_XCNT(b.x)], 1u);
    return b;
}
__device__ __forceinline__ void xcd_barrier_complete(unsigned* bar, unsigned x, unsigned& nloc, unsigned& nx) {
    const unsigned G = gridDim.x * gridDim.y * gridDim.z;
    unsigned sum, cnt, mine, sp = 0u;
    for (;;) {
        sum = 0u; cnt = 0u; mine = 0u;
#pragma unroll
        for (unsigned j = 0; j < 16; ++j) { const unsigned c = xb_ld(&bar[XB_XCNT(j)]); sum += c; cnt += (c > 0u) ? 1u : 0u; mine = (j == x) ? c : mine; }
        if (sum == G) break;
        __builtin_amdgcn_s_sleep(1);
        if ((++sp & 255u) == 0u) { if (xb_ld(&bar[XB_TMO])) break; if (sp > XB_SPIN_CAP) { atomicAdd(&bar[XB_TMO], 1u); break; } }
    }
    nloc = mine > 0u ? mine : 1u; nx = cnt > 0u ? cnt : 1u;
}

__device__ __forceinline__ void xcd_barrier(const XcdBarrier& b) {
    asm volatile("s_waitcnt vmcnt(0)" ::: "memory");
    __syncthreads();
    if (threadIdx.x == 0) {
        unsigned* bar = b.bar;
        __builtin_amdgcn_s_waitcnt(0);
        unsigned nloc = b.st[0], nx = b.st[1];
        if (nloc == 0u) { xcd_barrier_complete(bar, b.x, nloc, nx); b.st[0] = nloc; b.st[1] = nx; }
        const unsigned old = xb_add(&bar[XB_XSUB(b.x)], 1u);
        const unsigned gen = old / nloc;
        if (old + 1u == (gen + 1u) * nloc) {
            __builtin_amdgcn_fence(__ATOMIC_RELEASE, "agent");
            asm volatile("s_waitcnt vmcnt(0)" ::: "memory");
            const unsigned og = xb_add(&bar[XB_TOP], 1u);
            const unsigned tg = og / nx;
            if (og + 1u == (tg + 1u) * nx) xb_add(&bar[XB_TOPGEN], 1u);
            else XB_SPIN(xb_ld(&bar[XB_TOPGEN]) == tg, bar);
            __builtin_amdgcn_fence(__ATOMIC_ACQUIRE, "agent");
            xb_add(&bar[XB_XGEN(b.x)], 1u);
            asm volatile("s_waitcnt vmcnt(0)" ::: "memory");
        } else {
            XB_SPIN(xb_ld(&bar[XB_XGEN(b.x)]) == gen, bar);
            __builtin_amdgcn_fence(__ATOMIC_ACQUIRE, "agent");
            asm volatile("s_waitcnt vmcnt(0)" ::: "memory");
        }
    }
    __syncthreads();
}
namespace pg8 {
#define PG8_LAS __attribute__((address_space(3)))
typedef unsigned short bf16_t;
typedef short bf16x8 __attribute__((ext_vector_type(8)));
typedef float f32x4 __attribute__((ext_vector_type(4)));
typedef unsigned u32x4 __attribute__((ext_vector_type(4)));
constexpr int BM = 256, BK = 64, HALF = 128, HTB = HALF * BK * 2  , STAGE_BYTES = 8 * HTB, NXCD = 8, WGM = 8, GTAB_OFF = STAGE_BYTES + 8192  ;

__host__ __device__ __forceinline__ int lds_byte(int r, int c) { const int st = (r >> 4) * 2 + (c >> 5), rr = r & 15, cc = c & 31, ob = rr * 64 + cc * 2; return st * 1024 + (ob ^ (((ob >> 9) & 1) << 5)); }
__host__ __device__ __forceinline__ void stage_rc(int b, int& R, int& C) { const int st = b / 1024, sb = b % 1024, swz = sb ^ (((sb >> 9) & 1) << 5); R = (st >> 1) * 16 + swz / 64; C = (st & 1) * 32 + (swz % 64) / 2; }
__host__ __device__ __forceinline__ int perm32(int rho) { const int n = rho >> 4, i = rho & 15; return 8 * (i >> 2) + 4 * n + (i & 3); }

struct Unit { int pm, pn; };
struct Gemm { const bf16_t* A; const bf16_t* Bt; int M, N, K; const unsigned* rowoff; };

struct StaticOrder {
    int nM, nN, nwg, G, c;
    __host__ __device__ void init(int M, int N, int G_, int c_) { nM = M / BM; nN = N / BM; nwg = nM * nN; G = G_; c = c_; }
    __host__ __device__ bool next(int i, Unit& u) const {
        const long L = (long)i * G + c; if (L >= nwg) return false;
        int wgid = (int)L; { const int q = nwg / NXCD, r = nwg % NXCD, xcd = wgid % NXCD, off = wgid / NXCD; wgid = (xcd < r ? xcd * (q + 1) : r * (q + 1) + (xcd - r) * q) + off; }
        const int nig = WGM * nN, gid = wgid / nig, fm = gid * WGM, gsz = (nM - fm) < WGM ? (nM - fm) : WGM;
        u.pm = fm + ((wgid % nig) % gsz); u.pn = (wgid % nig) / gsz; return true;
    }
    __device__ __forceinline__ void a_ready(const Unit&) const {}
    __device__ __forceinline__ void done(const Unit&) const {}
    __device__ __forceinline__ size_t rowbase(const Unit& u) const { return (size_t)u.pm * BM; }
};

__device__ __forceinline__ unsigned cvt_pk_bf16(float lo, float hi) { unsigned r; asm volatile("v_cvt_pk_bf16_f32 %0, %1, %2" : "=v"(r) : "v"(lo), "v"(hi)); return r; }
__device__ __forceinline__ float bf_lo(unsigned w) { return __builtin_bit_cast(float, w << 16); }
__device__ __forceinline__ float bf_hi(unsigned w) { return __builtin_bit_cast(float, w & 0xffff0000u); }

__device__ __forceinline__ unsigned pk4_fp8(float a, float b, float c, float d) {
    a = __builtin_amdgcn_fmed3f(a, -448.f, 448.f); b = __builtin_amdgcn_fmed3f(b, -448.f, 448.f); c = __builtin_amdgcn_fmed3f(c, -448.f, 448.f); d = __builtin_amdgcn_fmed3f(d, -448.f, 448.f);
    unsigned r = 0u; r = (unsigned)__builtin_amdgcn_cvt_pk_fp8_f32(a, b, (int)r, false); r = (unsigned)__builtin_amdgcn_cvt_pk_fp8_f32(c, d, (int)r, true); return r; }
constexpr float FP8_SX = 16.f, FP8_SA = 8.f, FP8_SW = 64.f, FP8_SO = 32.f, FP8_SY = 32.f;
struct EpiBias {
    static constexpr bool PERM = true, AFTER_DRAIN = false;
    bf16_t* O; int ldc; const float* bias;
    __device__ __forceinline__ void operator()(const f32x4 (&acc)[2][2][4][2], const Unit& u, int wr_, int wc_, int fr_, int fq_) const {
        int tz = threadIdx.x; asm volatile("" : "+v"(tz)); const int wid = __builtin_amdgcn_readfirstlane(tz >> 6), wr = wid >> 2, wc = wid & 3, fr = tz & 15, fq = (tz >> 4) & 3;
        const int row0 = u.pm * BM + wr * 64 + fr; const int col0 = u.pn * BM + wc * 32 + 8 * fq;
        f32x4 bv[2][2];
#pragma unroll
        for (int bj = 0; bj < 2; ++bj)
#pragma unroll
            for (int n = 0; n < 2; ++n) bv[bj][n] = *(const f32x4*)(bias + col0 + bj * HALF + 4 * n);
#pragma unroll
        for (int ai = 0; ai < 2; ++ai)
#pragma unroll
            for (int m = 0; m < 4; ++m) { bf16_t* rowp = O + (size_t)(row0 + ai * HALF + m * 16) * ldc + col0;
#pragma unroll
                for (int bj = 0; bj < 2; ++bj) { const f32x4 v0 = acc[ai][bj][m][0] + bv[bj][0], v1 = acc[ai][bj][m][1] + bv[bj][1];
                    u32x4 w; w.x = cvt_pk_bf16(v0[0], v0[1]); w.y = cvt_pk_bf16(v0[2], v0[3]); w.z = cvt_pk_bf16(v1[0], v1[1]); w.w = cvt_pk_bf16(v1[2], v1[3]);
                    *(u32x4*)(rowp + bj * HALF) = w; } }
    }
};

struct EpiProj {
    static constexpr bool PERM = true, AFTER_DRAIN = false;
    bf16_t* O; int ldc; const float* bias; bf16_t* KV; const float* ta; const float* tb; int ltok; unsigned char* K8; unsigned char* V8; unsigned char* Q8;
    __device__ __forceinline__ void operator()(const f32x4 (&acc)[2][2][4][2], const Unit& u, int wr_, int wc_, int fr_, int fq_) const {
        int tz = threadIdx.x; asm volatile("" : "+v"(tz)); const int wid = __builtin_amdgcn_readfirstlane(tz >> 6), wr = wid >> 2, wc = wid & 3, fr = tz & 15, fq = (tz >> 4) & 3, lane = tz & 63;
        const int row0 = u.pm * BM + wr * 64 + fr;
        f32x4 bz[2][2];
#pragma unroll
        for (int bj = 0; bj < 2; ++bj) { const int c0 = u.pn * BM + bj * HALF + wc * 32 + 8 * fq; bz[bj][0] = *(const f32x4*)(bias + c0); bz[bj][1] = *(const f32x4*)(bias + c0 + 4); }
#pragma unroll
        for (int bj = 0; bj < 2; ++bj) {
            const int cw = u.pn * BM + bj * HALF + wc * 32;
            const int c0 = cw + 8 * fq;
            const f32x4 b0 = bz[bj][0], b1 = bz[bj][1];
            const bool is_qk = cw < 1152, is_qi = cw >= 1280 && cw < 1792;
            const bool rot = ((cw & 63) == 0) && (is_qk || is_qi);
            bf16_t* dst; int dld;
            if (cw >= 1024 && cw < 1280) { dst = KV + (cw - 1024) + 8 * fq; dld = 256; } else { dst = O + c0; dld = ldc; }
            f32x4 csn[4];
            if (rot) { const int pos = row0 % ltok; const float* tp = is_qk ? ta + (size_t)pos * 16 : tb + (size_t)pos * 32 + (fq & 1) * 16;
#pragma unroll
                for (int q = 0; q < 4; ++q) csn[q] = *(const f32x4*)(tp + 4 * q); }
#pragma unroll
            for (int g = 0; g < 8; ++g) {
                    const int ai = g >> 2, m = g & 3;
                    const int row = row0 + ai * HALF + m * 16;
                    float v[8];
#pragma unroll
                    for (int j = 0; j < 4; ++j) { v[j] = acc[ai][bj][m][0][j] * (1.f / (FP8_SX * FP8_SW)) + b0[j]; v[4 + j] = acc[ai][bj][m][1][j] * (1.f / (FP8_SX * FP8_SW)) + b1[j]; }
                    if (rot) {
                        f32x4 cs[4];
#pragma unroll
                        for (int q = 0; q < 4; ++q) cs[q] = csn[q];
                        if (g < 7) { const int rown = row0 + ((g + 1) >> 2) * HALF + ((g + 1) & 3) * 16; const int posn = rown % ltok; const float* tpn = is_qk ? ta + (size_t)posn * 16 : tb + (size_t)posn * 32 + (fq & 1) * 16;
#pragma unroll
                            for (int q = 0; q < 4; ++q) csn[q] = *(const f32x4*)(tpn + 4 * q); }
                        const int px = is_qk ? 16 : 32;
                        float w[8];
#pragma unroll
                        for (int j = 0; j < 8; ++j) w[j] = __builtin_bit_cast(float, __builtin_amdgcn_ds_bpermute((lane ^ px) << 2, __builtin_bit_cast(int, v[j])));
                        const bool active = is_qk ? (fq < 2) : true;
                        const bool first = is_qk ? (fq == 0) : (fq < 2);
                        if (active) {
#pragma unroll
                            for (int j = 0; j < 8; j += 2) { const f32x4 c4 = cs[j >> 1];
                                const float x0 = v[j], y0 = w[j], x1 = v[j + 1], y1 = w[j + 1];
                                v[j] = first ? x0 * c4[0] - y0 * c4[1] : x0 * c4[0] + y0 * c4[1];
                                v[j + 1] = first ? x1 * c4[2] - y1 * c4[3] : x1 * c4[2] + y1 * c4[3]; }
                        }
                    }
                    if (Q8 != nullptr && cw < 1024) { uint2 o8; o8.x = pk4_fp8(FP8_SX * v[0], FP8_SX * v[1], FP8_SX * v[2], FP8_SX * v[3]); o8.y = pk4_fp8(FP8_SX * v[4], FP8_SX * v[5], FP8_SX * v[6], FP8_SX * v[7]);
                        *(uint2*)(Q8 + (size_t)row * 1024 + c0) = o8; }
                    else { u32x4 o; o.x = cvt_pk_bf16(v[0], v[1]); o.y = cvt_pk_bf16(v[2], v[3]); o.z = cvt_pk_bf16(v[4], v[5]); o.w = cvt_pk_bf16(v[6], v[7]);
                        *(u32x4*)(dst + (size_t)row * dld) = o; }
                    if (cw >= 1024 && cw < 1152) { uint2 o8; o8.x = pk4_fp8(FP8_SX * v[0], FP8_SX * v[1], FP8_SX * v[2], FP8_SX * v[3]); o8.y = pk4_fp8(FP8_SX * v[4], FP8_SX * v[5], FP8_SX * v[6], FP8_SX * v[7]);
                        *(uint2*)(K8 + (size_t)row * 128 + (cw - 1024) + 8 * fq) = o8; }
                    if (cw >= 1152 && cw < 1280) { uint2 o8; o8.x = pk4_fp8(FP8_SX * v[0], FP8_SX * v[1], FP8_SX * v[2], FP8_SX * v[3]); o8.y = pk4_fp8(FP8_SX * v[4], FP8_SX * v[5], FP8_SX * v[6], FP8_SX * v[7]);
                        *(uint2*)(V8 + (size_t)row * 128 + (cw - 1152) + 8 * fq) = o8; }
            }
        }
    }
};

struct EpiRes {
    static constexpr bool PERM = true, AFTER_DRAIN = false;
    bf16_t* O; const bf16_t* R; float alpha;
    __device__ __forceinline__ void operator()(const f32x4 (&acc)[2][2][4][2], const Unit& u, int wr_, int wc_, int fr_, int fq_) const {
        int tz = threadIdx.x; asm volatile("" : "+v"(tz)); const int wid = __builtin_amdgcn_readfirstlane(tz >> 6), wr = wid >> 2, wc = wid & 3, fr = tz & 15, fq = (tz >> 4) & 3;
        const int row0 = u.pm * BM + wr * 64 + fr; const int col0 = u.pn * BM + wc * 32 + 8 * fq;
#pragma unroll
        for (int ai = 0; ai < 2; ++ai) {
            u32x4 rr[4][2];
#pragma unroll
            for (int m = 0; m < 4; ++m)
#pragma unroll
                for (int bj = 0; bj < 2; ++bj) rr[m][bj] = *(const u32x4*)(R + (size_t)(row0 + ai * HALF + m * 16) * 1024 + col0 + bj * HALF);
#pragma unroll
            for (int m = 0; m < 4; ++m) { const size_t off = (size_t)(row0 + ai * HALF + m * 16) * 1024 + col0;
#pragma unroll
                for (int bj = 0; bj < 2; ++bj) { const u32x4 r = rr[m][bj];
                    const f32x4 a0 = acc[ai][bj][m][0] * (1.f / (FP8_SO * FP8_SW)), a1 = acc[ai][bj][m][1] * (1.f / (FP8_SO * FP8_SW));
                    u32x4 w;
                    w.x = cvt_pk_bf16(a0[0] + alpha * bf_lo(r.x), a0[1] + alpha * bf_hi(r.x));
                    w.y = cvt_pk_bf16(a0[2] + alpha * bf_lo(r.y), a0[3] + alpha * bf_hi(r.y));
                    w.z = cvt_pk_bf16(a1[0] + alpha * bf_lo(r.z), a1[1] + alpha * bf_hi(r.z));
                    w.w = cvt_pk_bf16(a1[2] + alpha * bf_lo(r.w), a1[3] + alpha * bf_hi(r.w));
                    *(u32x4*)(O + off + bj * HALF) = w; } } }
    }
};
struct EpiResX {
    static constexpr bool PERM = true, AFTER_DRAIN = false;
    bf16_t* O; const float* X; const float* META; float alpha; int ltok, nmeta, seq;
    __device__ __forceinline__ void operator()(const f32x4 (&acc)[2][2][4][2], const Unit& u, int wr_, int wc_, int fr_, int fq_) const {
        int tz = threadIdx.x; asm volatile("" : "+v"(tz)); const int wid = __builtin_amdgcn_readfirstlane(tz >> 6), wr = wid >> 2, wc = wid & 3, fr = tz & 15, fq = (tz >> 4) & 3;
        const int row0 = u.pm * BM + wr * 64 + fr; const int col0 = u.pn * BM + wc * 32 + 8 * fq;
#pragma unroll
        for (int ai = 0; ai < 2; ++ai)
#pragma unroll
            for (int mp = 0; mp < 2; ++mp) {
                f32x4 rf[2][2][2];
#pragma unroll
                for (int mm = 0; mm < 2; ++mm) { const int row = row0 + ai * HALF + (2 * mp + mm) * 16; const int b = row / ltok, p = row - b * ltok;
                    const float* src = (p < nmeta ? META + (size_t)p * 1024 : X + ((size_t)b * seq + (p - nmeta)) * 1024) + col0;
#pragma unroll
                    for (int bj = 0; bj < 2; ++bj) { rf[mm][bj][0] = *(const f32x4*)(src + bj * HALF); rf[mm][bj][1] = *(const f32x4*)(src + bj * HALF + 4); } }
#pragma unroll
                for (int mm = 0; mm < 2; ++mm) { const int m = 2 * mp + mm; const size_t off = (size_t)(row0 + ai * HALF + m * 16) * 1024 + col0;
#pragma unroll
                    for (int bj = 0; bj < 2; ++bj) { const f32x4 r0 = rf[mm][bj][0], r1 = rf[mm][bj][1];
                        const f32x4 a0 = acc[ai][bj][m][0] * (1.f / (FP8_SO * FP8_SW)), a1 = acc[ai][bj][m][1] * (1.f / (FP8_SO * FP8_SW));
                        u32x4 w;
                        w.x = cvt_pk_bf16(a0[0] + alpha * r0[0], a0[1] + alpha * r0[1]); w.y = cvt_pk_bf16(a0[2] + alpha * r0[2], a0[3] + alpha * r0[3]);
                        w.z = cvt_pk_bf16(a1[0] + alpha * r1[0], a1[1] + alpha * r1[1]); w.w = cvt_pk_bf16(a1[2] + alpha * r1[2], a1[3] + alpha * r1[3]);
                        *(u32x4*)(O + off + bj * HALF) = w; } } }
    }
};

__device__ __forceinline__ float swiglu1(float g, float u) {
    g = fminf(g, 7.0f); u = fminf(fmaxf(u, -7.0f), 7.0f);
    const float s = __builtin_amdgcn_rcpf(1.0f + __expf(-1.702f * g));
    return g * s * (u + 1.0f);
}
typedef float f32x2e __attribute__((ext_vector_type(2)));
__device__ __forceinline__ f32x2e swiglu2_x8(f32x2e g, f32x2e u) {
    g.x = fminf(g.x, 7.0f); g.y = fminf(g.y, 7.0f);
    u.x = __builtin_amdgcn_fmed3f(u.x, -7.0f, 7.0f); u.y = __builtin_amdgcn_fmed3f(u.y, -7.0f, 7.0f);
    const f32x2e z = g * (-1.702f * 1.4426950408889634f);
    f32x2e e; e.x = __builtin_amdgcn_exp2f(z.x); e.y = __builtin_amdgcn_exp2f(z.y);
    const f32x2e d = e + 1.0f;
    f32x2e r; r.x = __builtin_amdgcn_rcpf(d.x); r.y = __builtin_amdgcn_rcpf(d.y);
    return (g * r) * (u * FP8_SA + FP8_SA);
}
__device__ __forceinline__ unsigned pk4_fp8_nosat(f32x2e a, f32x2e b) { unsigned r = 0u; r = (unsigned)__builtin_amdgcn_cvt_pk_fp8_f32(a.x, a.y, (int)r, false); r = (unsigned)__builtin_amdgcn_cvt_pk_fp8_f32(b.x, b.y, (int)r, true); return r; }
struct EpiSwiglu {
    static constexpr bool PERM = true, AFTER_DRAIN = false;
    unsigned char* O; const float* bias;
    __device__ __forceinline__ void operator()(const f32x4 (&acc)[2][2][4][2], const Unit& u, int wr_, int wc_, int fr_, int fq_) const {
        int tz = threadIdx.x; asm volatile("" : "+v"(tz)); const int wid = __builtin_amdgcn_readfirstlane(tz >> 6), wr = wid >> 2, wc = wid & 3, fr = tz & 15, fq = (tz >> 4) & 3;
        const int e = u.pn >> 3, jt = u.pn & 7;
        const int row0 = u.pm * BM + wr * 64 + fr; const int col0 = jt * 128 + wc * 32 + 8 * fq;
        const float* bp = bias + e * 2048 + col0;
        constexpr float rs = 1.f / (FP8_SX * FP8_SW);
        const f32x4 bgA = *(const f32x4*)(bp), buA = *(const f32x4*)(bp + 1024), bgB = *(const f32x4*)(bp + 4), buB = *(const f32x4*)(bp + 1028);
#pragma unroll
        for (int ai = 0; ai < 2; ++ai)
#pragma unroll
            for (int m = 0; m < 4; ++m) {
                uint2 w;
                { const f32x4 bg = bgA, bu = buA;
                  const f32x4 g0 = acc[ai][0][m][0] * rs + bg, u0 = acc[ai][1][m][0] * rs + bu;
                  w.x = pk4_fp8_nosat(swiglu2_x8((f32x2e){g0[0], g0[1]}, (f32x2e){u0[0], u0[1]}), swiglu2_x8((f32x2e){g0[2], g0[3]}, (f32x2e){u0[2], u0[3]})); }
                asm volatile("" : "+v"(w.x));
                { const f32x4 bg = bgB, bu = buB;
                  const f32x4 g1 = acc[ai][0][m][1] * rs + bg, u1 = acc[ai][1][m][1] * rs + bu;
                  w.y = pk4_fp8_nosat(swiglu2_x8((f32x2e){g1[0], g1[1]}, (f32x2e){u1[0], u1[1]}), swiglu2_x8((f32x2e){g1[2], g1[3]}, (f32x2e){u1[2], u1[3]})); }
                *(uint2*)(O + (size_t)(row0 + ai * HALF + m * 16) * 1024 + col0) = w; }
    }
};

struct EpiDown {
    static constexpr bool PERM = true, AFTER_DRAIN = false;
    unsigned char* Y; const float* bias; const int2* elist; const PG8_LAS int* tstart; const PG8_LAS int* ecnt; int estride;
    __device__ __forceinline__ void operator()(const f32x4 (&acc)[2][2][4][2], const Unit& u, int wr_, int wc_, int fr_, int fq_) const {
        int tz = threadIdx.x; asm volatile("" : "+v"(tz)); const int wid = __builtin_amdgcn_readfirstlane(tz >> 6), wr = wid >> 2, wc = wid & 3, fr = tz & 15, fq = (tz >> 4) & 3;
        const int e = u.pn >> 2, jt = u.pn & 3;
        const int row0 = u.pm * BM + wr * 64 + fr; const int col0 = jt * 256 + wc * 32 + 8 * fq;
        const float* bp = bias + e * 1024 + col0;
        const int slot0 = (u.pm - tstart[e]) * BM + wr * 64 + fr, nvalid = ecnt[e];
        const f32x4 bz00 = *(const f32x4*)(bp), bz01 = *(const f32x4*)(bp + 4), bz10 = *(const f32x4*)(bp + HALF), bz11 = *(const f32x4*)(bp + HALF + 4);
        int2 inf[8];
#pragma unroll
        for (int g = 0; g < 8; ++g) { const int sl = slot0 + (g >> 2) * HALF + (g & 3) * 16; inf[g] = elist[(size_t)e * estride + (sl < nvalid ? sl : nvalid - 1)]; }
#pragma unroll
        for (int ai = 0; ai < 2; ++ai)
#pragma unroll
            for (int m = 0; m < 4; ++m) { const int sl = slot0 + ai * HALF + m * 16; const int2 info = inf[ai * 4 + m];
                if (sl < nvalid) { const float gt = __builtin_bit_cast(float, info.y) * FP8_SY; unsigned char* rowp = Y + (size_t)info.x * 1024 + col0;
#pragma unroll
                    for (int bj = 0; bj < 2; ++bj) { const f32x4 b0 = bj == 0 ? bz00 : bz10, b1 = bj == 0 ? bz01 : bz11;
                        const f32x4 v0 = (acc[ai][bj][m][0] * (1.f / (FP8_SA * FP8_SW)) + b0) * gt, v1 = (acc[ai][bj][m][1] * (1.f / (FP8_SA * FP8_SW)) + b1) * gt;
                        uint2 w; w.x = pk4_fp8(v0[0], v0[1], v0[2], v0[3]); w.y = pk4_fp8(v1[0], v1[1], v1[2], v1[3]);
                        *(uint2*)(rowp + bj * HALF) = w; } } }
    }
};

struct MoeOrder {
    int ntiles, G, c, NJ; const PG8_LAS unsigned char* tile_e;
    const PG8_LAS int* tstart; int estride;
    __device__ __forceinline__ size_t rowbase(const Unit& u) const { const int e = __builtin_amdgcn_readfirstlane((int)tile_e[u.pm]), ts = __builtin_amdgcn_readfirstlane(tstart[e]); return (size_t)e * estride + (size_t)(u.pm - ts) * 256; }
    __device__ __forceinline__ bool next(int i, Unit& u) const {
        const int x = c & 7, k = c >> 3;
        if (G != 256) { const int L = i * G + c; if (L >= ntiles * NJ) return false; const int tt = L / NJ; u.pm = tt; u.pn = tile_e[tt] * NJ + (L % NJ); return true; }
        const int rpg = 32 / NJ;
        const int g = 8 * i + x;
        if (g * rpg >= ntiles) return false;
        int tt = g * rpg + (NJ == 8 ? (k >> 3) : (k >> 2)); const int jt = NJ == 8 ? (k & 7) : (k & 3);
        if (tt >= ntiles) tt = ntiles - 1;
        u.pm = tt; u.pn = tile_e[tt] * NJ + jt; return true;
    }
    __device__ __forceinline__ void a_ready(const Unit&) const {}
    __device__ __forceinline__ void done(const Unit&) const {}
};

__device__ __forceinline__ void glds_s(unsigned voff, const void* sbase, unsigned lds_dst) { unsigned keep; unsigned long long sb = (unsigned long long)sbase; const unsigned ld = lds_dst;
    asm volatile("s_mov_b32 %0, m0\n\ts_mov_b32 m0, %3\n\ts_nop 0\n\tglobal_load_lds_dwordx4 %1, %2\n\ts_mov_b32 m0, %0" : "=&s"(keep) : "v"(voff), "s"(sb), "s"(ld) : "memory"); }
__device__ __forceinline__ void glds_d(unsigned voff, const void* sbase, unsigned lds_dst) { unsigned keep; unsigned long long sb = (unsigned long long)sbase; const unsigned ld = lds_dst;
    asm volatile("s_mov_b32 %0, m0\n\ts_mov_b32 m0, %3\n\ts_nop 0\n\tglobal_load_lds_dword %1, %2\n\ts_mov_b32 m0, %0" : "=&s"(keep) : "v"(voff), "s"(sb), "s"(ld) : "memory"); }
template <int IMM> __device__ __forceinline__ unsigned tab_rd(unsigned addr_v, int tab_s) { unsigned r;
    asm volatile("v_add_u32 %0, %2, %1\n\tds_read_b32 %0, %0 offset:%3" : "=&v"(r) : "v"(addr_v), "s"(tab_s), "i"(IMM) : "memory"); return r; }
template <int NW> __device__ __forceinline__ void glds_gw(unsigned ro, unsigned colb, const void* sbase, unsigned lds_dst) { unsigned keep; unsigned long long sb = (unsigned long long)sbase; const unsigned ld = lds_dst;
    asm volatile("s_waitcnt lgkmcnt(%5)\n\tv_add_u32 %1, %1, %2\n\ts_mov_b32 %0, m0\n\ts_mov_b32 m0, %4\n\ts_nop 0\n\tglobal_load_lds_dwordx4 %1, %3\n\ts_mov_b32 m0, %0" : "=&s"(keep), "+v"(ro) : "v"(colb), "s"(sb), "s"(ld), "i"(NW) : "memory"); }
typedef int pg8_v4i __attribute__((ext_vector_type(4)));
typedef int pg8_v8i __attribute__((ext_vector_type(8)));
__device__ __forceinline__ pg8_v8i cat8(bf16x8 a, bf16x8 b) { const pg8_v4i x = __builtin_bit_cast(pg8_v4i, a), y = __builtin_bit_cast(pg8_v4i, b); return __builtin_shufflevector(x, y, 0, 1, 2, 3, 4, 5, 6, 7); }
template <class Epi, class Sched, bool ALIGN_EPI = false, bool SP2 = false, bool FP8 = false, bool GATHER = false>
__device__ __forceinline__ void gemm_phase(PG8_LAS unsigned char* lds, const Gemm g, const Sched& S, const Epi& E) {
    int tid_l = threadIdx.x; asm volatile("" : "+v"(tid_l));
    const int tid = tid_l, wid = __builtin_amdgcn_readfirstlane(tid >> 6), lane = tid & 63, wr = wid >> 2, wc = wid & 3, fr = lane & 15, fq = lane >> 4;
    const int K = g.K, nt = K / BK;
    unsigned voffA[2], voffB[2];
#pragma unroll
    for (int i = 0; i < 2; ++i) { int R, C; stage_rc(tid * 16 + i * 8192, R, C); const int Rb = Epi::PERM ? ((R & ~31) + perm32(R & 31)) : R;
        voffA[i] = (unsigned)(R * K + C) * 2u; voffB[i] = (unsigned)(Rb * K + C) * 2u; }
    const size_t kstep = (size_t)(BK * 2);
    const size_t hstep = (size_t)HALF * K * 2;
    const size_t tstep = 2 * hstep;
    const unsigned ldsw = (unsigned)wid * 1024u;
    const int aoff = lds_byte(wr * 64 + fr, fq * 8), boff = lds_byte(wc * 32 + fr, fq * 8);
    unsigned rtabv = 0, colb = 0; if constexpr (GATHER) { int R, C; stage_rc(tid * 16, R, C); rtabv = (unsigned)(size_t)lds + (unsigned)(GTAB_OFF + R * 4); colb = (unsigned)C * 2u; }
#define PG8_SA(b, h) (((b) * 2 + (h)) * HTB)
#define PG8_SB(b, h) ((4 + (b) * 2 + (h)) * HTB)
#define PG8_STAGE(bufoff, gbase, voff) do { _Pragma("unroll") for (int _i = 0; _i < 2; ++_i) { if constexpr (FP8) glds_s((voff)[_i], (const void*)(gbase), (unsigned)(size_t)(lds + (bufoff) + _i * 8192) + ldsw); else \
        __builtin_amdgcn_global_load_lds((const unsigned*)((const char*)(gbase) + (voff)[_i]), (PG8_LAS unsigned*)(lds + (bufoff) + ldsw + _i * 8192), 16, 0, 0); } } while (0)
#define PG8_TAB_RD(ro, tab, h) do { ro[0] = tab_rd<(h) * 512>(rtabv, (tab)); ro[1] = tab_rd<(h) * 512 + 256>(rtabv, (tab)); } while (0)
#define PG8_STAGE_GA(bufoff, ro, kb, NW) do { _Pragma("unroll") for (int _i = 0; _i < 2; ++_i) glds_gw<NW>(ro[_i], colb, (const void*)((const char*)g.A + (kb)), (unsigned)(size_t)(lds + (bufoff) + _i * 8192) + ldsw); } while (0)
#define PG8_LDA(dst, b, h) do { _Pragma("unroll") for (int m = 0; m < 4; ++m) _Pragma("unroll") for (int k = 0; k < 2; ++k) dst[m][k] = *(const PG8_LAS bf16x8*)(lds + PG8_SA(b, h) + aoff + m * 2048 + k * 1024); } while (0)
#define PG8_LDB(dst, b, h) do { _Pragma("unroll") for (int n = 0; n < 2; ++n) _Pragma("unroll") for (int k = 0; k < 2; ++k) dst[n][k] = *(const PG8_LAS bf16x8*)(lds + PG8_SB(b, h) + boff + n * 2048 + k * 1024); } while (0)
#define PG8_MMA(ai, bj, At, Bt) do { __builtin_amdgcn_s_setprio(1); if constexpr (FP8) { _Pragma("unroll") for (int m = 0; m < 4; ++m) _Pragma("unroll") for (int n = 0; n < 2; ++n) \
        acc[ai][bj][m][n] = __builtin_amdgcn_mfma_scale_f32_16x16x128_f8f6f4(cat8(Bt[n][0], Bt[n][1]), cat8(At[m][0], At[m][1]), acc[ai][bj][m][n], 0, 0, 0, 0, 0, 0); } else { \
        _Pragma("unroll") for (int m = 0; m < 4; ++m) _Pragma("unroll") for (int n = 0; n < 2; ++n) _Pragma("unroll") for (int k = 0; k < 2; ++k) \
        acc[ai][bj][m][n] = __builtin_amdgcn_mfma_f32_16x16x32_bf16(Bt[n][k], At[m][k], acc[ai][bj][m][n], 0, 0, 0); } __builtin_amdgcn_s_setprio(0); } while (0)
#define PG8_WAIT_V(n) asm volatile("s_waitcnt vmcnt(" #n ")" ::: "memory")
#define PG8_WAIT_L(n) asm volatile("s_waitcnt lgkmcnt(" #n ")" ::: "memory")
#define PG8_BAR __builtin_amdgcn_s_barrier()
#define PG8_SCHED __builtin_amdgcn_sched_barrier(0)
    Unit cur, nxt; int ui = 0;
    if (!S.next(0, cur)) return;
    f32x4 acc[2][2][4][2];
#pragma unroll
    for (int a = 0; a < 2; ++a)
#pragma unroll
        for (int b = 0; b < 2; ++b)
#pragma unroll
            for (int m = 0; m < 4; ++m)
#pragma unroll
                for (int n = 0; n < 2; ++n) acc[a][b][m][n] = (f32x4){0.f, 0.f, 0.f, 0.f};
    bf16x8 At[4][2], B0[2][2], B1[2][2];
    const char* cA = (const char*)g.A + (size_t)cur.pm * tstep; const char* cB = (const char*)g.Bt + (size_t)cur.pn * tstep;
    S.a_ready(cur);
    if constexpr (SP2) {
        if constexpr (GATHER) {
            if (wid < 4) glds_d((unsigned)tid * 4u, (const void*)(g.rowoff + S.rowbase(cur)), (unsigned)(size_t)(lds + GTAB_OFF) + (unsigned)wid * 256u);
            PG8_WAIT_V(0); PG8_BAR; }
        PG8_STAGE(PG8_SB(0, 0), cB, voffB); PG8_STAGE(PG8_SB(0, 1), cB + hstep, voffB);
        if constexpr (GATHER) { unsigned r0[2], r1[2]; PG8_TAB_RD(r0, 0, 0); PG8_TAB_RD(r1, 0, 1); PG8_STAGE_GA(PG8_SA(0, 0), r0, (size_t)0, 0); PG8_STAGE_GA(PG8_SA(0, 1), r1, (size_t)0, 0); }
        else { PG8_STAGE(PG8_SA(0, 0), cA, voffA); PG8_STAGE(PG8_SA(0, 1), cA + hstep, voffA); }
        if (wr == 1) PG8_BAR;
        PG8_WAIT_V(2); PG8_BAR;
        PG8_STAGE(PG8_SB(1, 0), cB + kstep, voffB);
        if constexpr (GATHER) { unsigned r0[2]; PG8_TAB_RD(r0, 0, 0); PG8_STAGE_GA(PG8_SA(1, 0), r0, kstep, 0); } else PG8_STAGE(PG8_SA(1, 0), cA + kstep, voffA);
        PG8_STAGE(PG8_SB(1, 1), cB + hstep + kstep, voffB);
        PG8_WAIT_V(6); PG8_BAR;
    } else {
        PG8_STAGE(PG8_SB(0, 0), cB, voffB); PG8_STAGE(PG8_SA(0, 0), cA, voffA); PG8_STAGE(PG8_SB(0, 1), cB + hstep, voffB); PG8_STAGE(PG8_SA(0, 1), cA + hstep, voffA);
        if (wr == 1) PG8_BAR;
        PG8_WAIT_V(4); PG8_BAR;
        PG8_STAGE(PG8_SB(1, 0), cB + kstep, voffB); PG8_STAGE(PG8_SA(1, 0), cA + kstep, voffA); PG8_STAGE(PG8_SB(1, 1), cB + hstep + kstep, voffB);
        PG8_WAIT_V(6); PG8_BAR;
    }
    for (;;) {
        const bool has_next = S.next(ui + 1, nxt);
        const char* nA = has_next ? (const char*)g.A + (size_t)nxt.pm * tstep : cA; const char* nB = has_next ? (const char*)g.Bt + (size_t)nxt.pn * tstep : cB;
        const int tabC = (ui & 1) * 1024, tabN = has_next ? 1024 - tabC : tabC;
        if constexpr (GATHER) { if (has_next && wid < 4) glds_d((unsigned)tid * 4u, (const void*)(g.rowoff + S.rowbase(nxt)), (unsigned)(size_t)(lds + GTAB_OFF) + (unsigned)(tabN + wid * 256)); }
        for (int t = 0; t < nt; t += 2) {
            const bool last = (t == nt - 2);
            const int tab2 = last ? tabN : tabC; const size_t kb2 = last ? (size_t)0 : (size_t)(t + 2) * kstep; (void)tab2; (void)kb2;
            const char* a1 = cA + (size_t)(t + 1) * kstep;
            const char* a2 = last ? nA : cA + (size_t)(t + 2) * kstep; const char* b2 = last ? nB : cB + (size_t)(t + 2) * kstep;
            const char* a3 = a2 + kstep; const char* b3 = b2 + kstep;
            if (last && has_next) S.a_ready(nxt);
            if constexpr (SP2) {
            if constexpr (GATHER) { unsigned ro[2]; PG8_TAB_RD(ro, tabC, 1); PG8_LDB(B0, 0, 0); PG8_LDB(B1, 0, 1); PG8_SCHED; PG8_LDA(At, 0, 0); PG8_STAGE_GA(PG8_SA(1, 1), ro, (size_t)(t + 1) * kstep, 12); }
            else { PG8_LDB(B0, 0, 0); PG8_LDB(B1, 0, 1); PG8_SCHED; PG8_LDA(At, 0, 0); PG8_STAGE(PG8_SA(1, 1), a1 + hstep, voffA); }
            PG8_WAIT_V(8); PG8_WAIT_L(0); PG8_BAR; PG8_MMA(0, 0, At, B0); PG8_MMA(0, 1, At, B1); PG8_BAR; PG8_SCHED;
            if constexpr (GATHER) { unsigned ro[2]; PG8_TAB_RD(ro, tab2, 0); PG8_LDA(At, 0, 1); PG8_STAGE(PG8_SB(0, 0), b2, voffB); PG8_STAGE(PG8_SB(0, 1), b2 + hstep, voffB); PG8_STAGE_GA(PG8_SA(0, 0), ro, kb2, 6); }
            else { PG8_LDA(At, 0, 1); PG8_STAGE(PG8_SB(0, 0), b2, voffB); PG8_STAGE(PG8_SB(0, 1), b2 + hstep, voffB); PG8_STAGE(PG8_SA(0, 0), a2, voffA); }
            PG8_WAIT_V(8); PG8_WAIT_L(0); PG8_BAR; PG8_MMA(1, 0, At, B0); PG8_MMA(1, 1, At, B1); PG8_BAR; PG8_SCHED;
            if constexpr (GATHER) { unsigned ro[2]; PG8_TAB_RD(ro, tab2, 1); PG8_LDB(B0, 1, 0); PG8_LDB(B1, 1, 1); PG8_SCHED; PG8_LDA(At, 1, 0); PG8_STAGE_GA(PG8_SA(0, 1), ro, kb2, 12); }
            else { PG8_LDB(B0, 1, 0); PG8_LDB(B1, 1, 1); PG8_SCHED; PG8_LDA(At, 1, 0); PG8_STAGE(PG8_SA(0, 1), a2 + hstep, voffA); }
            PG8_WAIT_V(8); PG8_WAIT_L(0); PG8_BAR; PG8_MMA(0, 0, At, B0); PG8_MMA(0, 1, At, B1); PG8_BAR; PG8_SCHED;
            if constexpr (GATHER) { unsigned ro[2]; PG8_TAB_RD(ro, tab2, 0); PG8_LDA(At, 1, 1); PG8_STAGE(PG8_SB(1, 0), b3, voffB); PG8_STAGE(PG8_SB(1, 1), b3 + hstep, voffB); PG8_STAGE_GA(PG8_SA(1, 0), ro, kb2 + kstep, 6); }
            else { PG8_LDA(At, 1, 1); PG8_STAGE(PG8_SB(1, 0), b3, voffB); PG8_STAGE(PG8_SB(1, 1), b3 + hstep, voffB); PG8_STAGE(PG8_SA(1, 0), a3, voffA); }
            PG8_WAIT_V(8); PG8_WAIT_L(0); PG8_BAR; PG8_MMA(1, 0, At, B0); PG8_MMA(1, 1, At, B1); PG8_BAR; PG8_SCHED;
            } else {
            PG8_LDB(B0, 0, 0); PG8_SCHED; PG8_LDA(At, 0, 0); PG8_STAGE(PG8_SA(1, 1), a1 + hstep, voffA);
            PG8_WAIT_L(8); PG8_BAR; PG8_WAIT_L(0); PG8_MMA(0, 0, At, B0); PG8_BAR; PG8_SCHED;
            PG8_LDB(B1, 0, 1); PG8_STAGE(PG8_SB(0, 0), b2, voffB);
            PG8_BAR; PG8_WAIT_L(0); PG8_MMA(0, 1, At, B1); PG8_BAR;
            PG8_LDA(At, 0, 1); PG8_STAGE(PG8_SA(0, 0), a2, voffA);
            PG8_BAR; PG8_WAIT_L(0); PG8_MMA(1, 0, At, B0); PG8_BAR; PG8_SCHED;
            PG8_STAGE(PG8_SB(0, 1), b2 + hstep, voffB);
            PG8_WAIT_V(6); PG8_BAR; PG8_MMA(1, 1, At, B1); PG8_BAR;
            PG8_LDB(B0, 1, 0); PG8_SCHED; PG8_LDA(At, 1, 0); PG8_STAGE(PG8_SA(0, 1), a2 + hstep, voffA);
            PG8_WAIT_L(8); PG8_BAR; PG8_WAIT_L(0); PG8_MMA(0, 0, At, B0); PG8_BAR; PG8_SCHED;
            PG8_LDB(B1, 1, 1); PG8_STAGE(PG8_SB(1, 0), b3, voffB);
            PG8_BAR; PG8_WAIT_L(0); PG8_MMA(0, 1, At, B1); PG8_BAR;
            PG8_LDA(At, 1, 1); PG8_STAGE(PG8_SA(1, 0), a3, voffA);
            PG8_BAR; PG8_WAIT_L(0); PG8_MMA(1, 0, At, B0); PG8_BAR; PG8_SCHED;
            PG8_STAGE(PG8_SB(1, 1), b3 + hstep, voffB);
            PG8_WAIT_V(6); PG8_BAR; PG8_MMA(1, 1, At, B1); PG8_BAR;
            }
        }
        if constexpr (ALIGN_EPI) { if (wr == 0) PG8_BAR; }
        if constexpr (!Epi::AFTER_DRAIN) { E(acc, cur, wr, wc, fr, fq); S.done(cur); }
        if (!has_next) break;
#pragma unroll
        for (int a = 0; a < 2; ++a)
#pragma unroll
            for (int b = 0; b < 2; ++b)
#pragma unroll
                for (int m = 0; m < 4; ++m)
#pragma unroll
                    for (int n = 0; n < 2; ++n) acc[a][b][m][n] = (f32x4){0.f, 0.f, 0.f, 0.f};
        cur = nxt; cA = nA; cB = nB; ++ui;
        if constexpr (ALIGN_EPI) { if (wr == 1) PG8_BAR; }
    }
    PG8_WAIT_V(0);
    if constexpr (!ALIGN_EPI) { if (wr == 0) PG8_BAR; }
    PG8_BAR;
    if constexpr (Epi::AFTER_DRAIN) { E.fused(acc, cur, wr, wc, fr, fq, lds, wid, lane); S.done(cur); }
#undef PG8_SA
#undef PG8_SB
#undef PG8_STAGE
#undef PG8_TAB_RD
#undef PG8_STAGE_GA
#undef PG8_LDA
#undef PG8_LDB
#undef PG8_MMA
#undef PG8_WAIT_V
#undef PG8_WAIT_L
#undef PG8_BAR
#undef PG8_SCHED
}
}
constexpr int NBATCH = 16, SEQ = 4096, NMETA = 16, LTOK = SEQ + NMETA, NTOK = NBATCH * LTOK;
constexpr int DM = 1024, NCOLA = 1280, NCOLB = 1864, NCOLB_PAD = 2048;
constexpr int NEXP = 32, MOE_TILES_MAX = NTOK * 4 / 256 + NEXP, MOE_P = MOE_TILES_MAX * 256;
constexpr float LN_EPS = 1e-5f, DN_ALPHA = 1.4142135623730951f;
constexpr float ATTN_SCALE = 0.125f, IDX_SCALE = 0.125f, IDX_W_SCALE = 0.35355339059327373f;
constexpr int NWAVES = 8, NTHREADS = 512;

constexpr size_t MiB = 1u << 20;
constexpr size_t WS_CTL = 0, CTL_ZERO_BYTES = 1 * MiB;
constexpr size_t WS_ROPEA = 1 * MiB, WS_ROPEB = 2 * MiB, WS_BIASB = 3 * MiB, WS_WRT = 3 * MiB + 512 * 1024, WS_ROWINFO = 4 * MiB, WS_ROUTE = 8 * MiB;
constexpr size_t WS_WINA = 16 * MiB, WS_WOUTA = 19 * MiB, WS_WINB = 21 * MiB, WS_WOUTB = 25 * MiB;
constexpr size_t WS_WGU = 32 * MiB, WS_WD = 288 * MiB;
constexpr size_t WS_HA = 416 * MiB, WS_HB = 545 * MiB, WS_PRE = 674 * MiB;
constexpr size_t WS_XS = 803 * MiB, WS_ACT = 1333 * MiB, WS_H8 = 1863 * MiB, WS_ELIST = 1931 * MiB, WS_EOFF = 1948 * MiB, WS_END = 1965 * MiB;
constexpr size_t WS_ROWOFF = 6 * MiB + 512 * 1024;
constexpr size_t WS_HB8 = WS_XS + 330 * MiB;
constexpr size_t WS_Q8 = WS_XS + 451 * MiB;
constexpr size_t WS_PROJ = WS_XS, WS_ATT = WS_XS + 257 * MiB;
constexpr size_t WS_SCORE = WS_ACT, WS_SEL = WS_ACT + 128 * MiB;
constexpr size_t WS_KV = WS_XS + 386 * MiB, WS_KI = WS_XS + 421 * MiB;
constexpr size_t WS_K8 = WS_XS + 431 * MiB;
constexpr size_t WS_V8 = WS_XS + 441 * MiB;
static_assert((size_t)NTOK * 512 <= 35 * MiB && WS_KI + (size_t)NTOK * 128 <= WS_K8 && WS_K8 + (size_t)NTOK * 128 <= WS_V8 && WS_V8 + (size_t)NTOK * 128 <= WS_ACT, "ws compact copies");
static_assert((size_t)NTOK * 2048 * 2 <= 257 * MiB && (size_t)NTOK * 1024 * 2 <= 129 * MiB && (size_t)MOE_P * 2048 <= 530 * MiB, "ws map");
static_assert(WS_ATT + 129 * MiB <= WS_ACT && WS_SEL + 32 * MiB <= WS_END, "ws overlays");

constexpr int CW_BAR = 4096;
constexpr int CW_CNT = 16384;

constexpr int RING_BYTES = 131072, LDSCTL_OFF = RING_BYTES, LDS_BYTES = 163840;
constexpr int LDS_EQ_OFF = LDSCTL_OFF + 8192, LDS_HIST_OFF = LDSCTL_OFF + 16384;
constexpr int LC_BAR = 0;
constexpr int LC_TSTART = 16;
constexpr int LC_ECNT = 64;
constexpr int LC_LCNT = 128, LC_LBASE = 160;
constexpr int LC_PROBE_A = 200, LC_PROBE_B = 201;
constexpr int LC_TILEE = 256;

struct Args { const float* in[21]; float* out; unsigned char* ws; int ph_lo, ph_hi; };
typedef const Args __attribute__((address_space(4))) CArgs;
__device__ __forceinline__ CArgs* KA() { unsigned long long v = (unsigned long long)__builtin_amdgcn_kernarg_segment_ptr(); asm volatile("" : "+s"(v)); return (CArgs*)v; }

typedef unsigned short u16;

__device__ __forceinline__ float bf2f(unsigned h) { return __builtin_bit_cast(float, h << 16); }
__device__ __forceinline__ float bflo(unsigned w) { return __builtin_bit_cast(float, w << 16); }
__device__ __forceinline__ float bfhi(unsigned w) { return __builtin_bit_cast(float, w & 0xffff0000u); }
__device__ __forceinline__ unsigned cvtpk(float lo, float hi) { return pg8::cvt_pk_bf16(lo, hi); }
__device__ __forceinline__ unsigned char* launder(unsigned char* p) { unsigned long long v = (unsigned long long)p; asm volatile("" : "+s"(v)); return (unsigned char*)(GAS unsigned char*)v; }
__device__ __forceinline__ const float* gptr(const float* p) { return (const float*)(const GAS float*)p; }
__device__ __forceinline__ float shx(float v, int o, int lane) { return __builtin_bit_cast(float, __builtin_amdgcn_ds_bpermute((lane ^ o) << 2, __builtin_bit_cast(int, v))); }
__device__ __forceinline__ int shxi(int v, int o, int lane) { return __builtin_amdgcn_ds_bpermute((lane ^ o) << 2, v); }
__device__ __forceinline__ int launder_v(int x) { asm volatile("" : "+v"(x)); return x; }

__device__ __forceinline__ void transpose_item(const float* W, int K, int N, bf16* WT, int mode, LAS float* scr, int item, int lane) {
    const int nblk = (N + 31) / 32, kb = item / nblk, nb = item % nblk, k0 = 64 * kb, n0 = 32 * nb;
    const bool okn = (n0 + (lane & 31)) < N;
#pragma unroll 8
    for (int i = 0; i < 32; ++i) { const int kk = 2 * i + (lane >> 5); scr[kk * 33 + (lane & 31)] = okn ? W[(size_t)(k0 + kk) * N + n0 + (lane & 31)] : 0.f; }
    LDS_WAIT(); asm volatile("" ::: "memory");
    const int c = lane & 7;
#pragma unroll
    for (int j = 0; j < 4; ++j) { const int n = (lane >> 3) + 8 * j; const LAS float* s = scr + (8 * c) * 33 + n;
        v4u o; o.x = pk2(s[0 * 33], s[1 * 33]); o.y = pk2(s[2 * 33], s[3 * 33]); o.z = pk2(s[4 * 33], s[5 * 33]); o.w = pk2(s[6 * 33], s[7 * 33]);
        int nn = n0 + n;
        if (nn < N) {
            if (mode == 1) { const int up = nn >= 1024 ? 1 : 0, q = nn - 1024 * up; nn = (q >> 7) * 256 + up * 128 + (q & 127); }
            *(GAS v4u*)(WT + (size_t)nn * K + k0 + 8 * c) = o; } }
    LDS_WAIT(); asm volatile("" ::: "memory");
}

__device__ __forceinline__ void transpose_item_fp8(const float* W, int K, int N, unsigned char* WT, int mode, LAS float* scr, int item, int lane) {
    const int nblk = (N + 31) / 32, kb = item / nblk, nb = item % nblk, k0 = 64 * kb, n0 = 32 * nb;
    const bool okn = (n0 + (lane & 31)) < N;
#pragma unroll 8
    for (int i = 0; i < 32; ++i) { const int kk = 2 * i + (lane >> 5); scr[kk * 33 + (lane & 31)] = okn ? W[(size_t)(k0 + kk) * N + n0 + (lane & 31)] : 0.f; }
    LDS_WAIT(); asm volatile("" ::: "memory");
    const int c = lane & 7;
#pragma unroll
    for (int j = 0; j < 4; ++j) { const int n = (lane >> 3) + 8 * j; const LAS float* s = scr + (8 * c) * 33 + n;
        uint2 o; o.x = pg8::pk4_fp8(s[0 * 33] * pg8::FP8_SW, s[1 * 33] * pg8::FP8_SW, s[2 * 33] * pg8::FP8_SW, s[3 * 33] * pg8::FP8_SW);
        o.y = pg8::pk4_fp8(s[4 * 33] * pg8::FP8_SW, s[5 * 33] * pg8::FP8_SW, s[6 * 33] * pg8::FP8_SW, s[7 * 33] * pg8::FP8_SW);
        int nn = n0 + n;
        if (mode == 1) { const int up = nn >= 1024 ? 1 : 0, q = nn - 1024 * up; nn = (q >> 7) * 256 + up * 128 + (q & 127); }
        if (n0 + n < N) *(uint2*)(WT + (size_t)nn * K + k0 + 8 * c) = o; }
    LDS_WAIT(); asm volatile("" ::: "memory");
}

__device__ __forceinline__ void transpose_item_fp8_reg(const float* W, int K, int N, unsigned char* WT, int mode, int item, int lane) {
    const int nblk = N / 32, kb = item / nblk, nb = item % nblk, k0 = 64 * kb, n0 = 32 * nb;
    const int q = lane & 7, g = lane >> 3;
    const float* src = W + (size_t)(k0 + 8 * g) * N + n0 + 4 * q;
    f32x4 v[8];
#pragma unroll
    for (int i = 0; i < 8; ++i) v[i] = *(const f32x4*)(src + (size_t)i * N);
#pragma unroll
    for (int j = 0; j < 4; ++j) { constexpr float sw = pg8::FP8_SW; uint2 o;
        o.x = pg8::pk4_fp8(v[0][j] * sw, v[1][j] * sw, v[2][j] * sw, v[3][j] * sw); o.y = pg8::pk4_fp8(v[4][j] * sw, v[5][j] * sw, v[6][j] * sw, v[7][j] * sw);
        int nn = n0 + 4 * q + j;
        if (mode == 1) { const int up = nn >= 1024 ? 1 : 0, qq = nn - 1024 * up; nn = (qq >> 7) * 256 + up * 128 + (qq & 127); }
        *(uint2*)(WT + (size_t)nn * K + k0 + 8 * g) = o; }
}
constexpr int L1W_GU = 32 * 1024, L1W_ITEMS = L1W_GU + 32 * 512;
__device__ __forceinline__ void moe_weight_item(CArgs* A, int layer, int it, int lane) {
    unsigned char* ws = launder(A->ws);
    if (it < L1W_GU) { const int le = 32 * layer + (it >> 10); transpose_item_fp8_reg(gptr(A->in[15]) + (size_t)le * 1024 * 2048, 1024, 2048, ws + WS_WGU + (size_t)le * 2048 * 1024, 1, it & 1023, lane); }
    else { const int r = it - L1W_GU, le = 32 * layer + (r >> 9); transpose_item_fp8_reg(gptr(A->in[17]) + (size_t)le * 1024 * 1024, 1024, 1024, ws + WS_WD + (size_t)le * 1024 * 1024, 0, r & 511, lane); }
}

__device__ __forceinline__ void p0_prologue(CArgs* A, LAS unsigned char* lds, int gw, int NGW, int wave, int lane) {
    unsigned char* ws = launder(A->ws);
    LAS float* scr = (LAS float*)(lds + wave * 16384);
    constexpr int I_GU = 0, I_D = 0  , I_INA = 16 * 40, I_OUT = 512, I_INB = 16 * 59, I_R = 2 * 16;
    constexpr int NITEMS = I_GU + I_D + I_INA + I_OUT + I_INB + I_OUT + I_R;
    for (int it = gw; it < NITEMS; it += NGW) {
        int r = it;
        if (r < I_GU) { const int le = r >> 10; transpose_item_fp8(gptr(A->in[15]) + (size_t)le * 1024 * 2048, 1024, 2048, ws + WS_WGU + (size_t)le * 2048 * 1024, 1, scr, r & 1023, lane); continue; } r -= I_GU;
        if (r < I_D) { const int le = r >> 9; transpose_item_fp8(gptr(A->in[17]) + (size_t)le * 1024 * 1024, 1024, 1024, ws + WS_WD + (size_t)le * 1024 * 1024, 0, scr, r & 511, lane); continue; } r -= I_D;
        if (r < I_INA) { transpose_item_fp8(gptr(A->in[2]), 1024, NCOLA, ws + WS_WINA, 0, scr, r, lane); continue; } r -= I_INA;
        if (r < I_OUT) { transpose_item_fp8(gptr(A->in[5]), 1024, 1024, ws + WS_WOUTA, 0, scr, r, lane); continue; } r -= I_OUT;
        if (r < I_INB) { transpose_item_fp8(gptr(A->in[6]), 1024, NCOLB, ws + WS_WINB, 0, scr, r, lane); continue; } r -= I_INB;
        if (r < I_OUT) { transpose_item_fp8(gptr(A->in[10]), 1024, 1024, ws + WS_WOUTB, 0, scr, r, lane); continue; } r -= I_OUT;
        { const int ly = r >> 4; transpose_item(gptr(A->in[13]) + (size_t)ly * 1024 * 32, 1024, 32, (bf16*)(ws + WS_WRT) + (size_t)ly * 32 * 1024, 0, scr, r & 15, lane); }
    }
    const int gt = gw * 64 + lane, NGT = NGW * 64;
    { v4u* z = (v4u*)(ws + WS_WINB + (size_t)NCOLB * 1024); const int n16 = (NCOLB_PAD - NCOLB) * 1024 / 16;
      for (int i = gt; i < n16; i += NGT) z[i] = (v4u){0u, 0u, 0u, 0u}; }
    { v4u* z = (v4u*)(ws + WS_EOFF); const int n16 = 2 * 32 * NTOK * 4 / 16; for (int i = gt; i < n16; i += NGT) z[i] = (v4u){0u, 0u, 0u, 0u}; }
    { float* bb = (float*)(ws + WS_BIASB); for (int i = gt; i < NCOLB_PAD; i += NGT) bb[i] = i < NCOLB ? gptr(A->in[7])[i] : 0.f; }
    { float2* ta = (float2*)(ws + WS_ROPEA); float2* tb = (float2*)(ws + WS_ROPEB);
      for (int i = gt; i < LTOK * 24; i += NGT) {
          const int pos = i / 24, j = i % 24; const bool isA = j < 8; const int fi = isA ? j : j - 8; const float half = isA ? 8.f : 16.f;
          const float inv = powf(500000.0f, -(float)fi / half); const float ang = (float)pos * inv;
          float sn, cs; sincosf(ang, &sn, &cs);
          if (isA) ta[pos * 8 + fi] = make_float2(cs, sn); else tb[pos * 16 + fi] = make_float2(cs, sn); } }
    {
      for (int row = gw; row < NTOK; row += NGW) { const int b = row / LTOK, p = row % LTOK;
          const float* src = p < NMETA ? gptr(A->in[1]) + (size_t)p * DM : gptr(A->in[0]) + ((size_t)b * SEQ + (p - NMETA)) * DM;
#pragma unroll
          for (int j = 0; j < 2; ++j) { const f32x4 a = *(const f32x4*)(src + j * 512 + lane * 8), c = *(const f32x4*)(src + j * 512 + lane * 8 + 4);
              constexpr float sx = pg8::FP8_SX; uint2 o8; o8.x = pg8::pk4_fp8(sx * a[0], sx * a[1], sx * a[2], sx * a[3]); o8.y = pg8::pk4_fp8(sx * c[0], sx * c[1], sx * c[2], sx * c[3]);
              *(uint2*)(ws + WS_H8 + (size_t)row * DM + j * 512 + lane * 8) = o8; } } }
}

__device__ __forceinline__ void rope_pair(float& x1, float& x2, const float2 cs) { const float a = x1 * cs.x - x2 * cs.y, b = x2 * cs.x + x1 * cs.y; x1 = a; x2 = b; }
__device__ __forceinline__ void ki_phase(CArgs* A, int gt, int NGT) {
    unsigned char* ws = launder(A->ws);
    const bf16* P = (const bf16*)(ws + WS_PROJ); bf16* KI = (bf16*)(ws + WS_KI);
    const float2* tb = (const float2*)(ws + WS_ROPEB);
    for (int it = gt; it < NTOK * 2; it += NGT) {
        const int row = it >> 1, hf = it & 1, pos = row % LTOK, lane = gt & 63;
        const bf16* p = P + (size_t)row * NCOLB_PAD + 1792 + 32 * hf; bf16* d = KI + (size_t)row * 64 + 32 * hf;
        const float* g = gptr(A->in[8]) + 32 * hf; const float* bb = gptr(A->in[9]) + 32 * hf;
        v4u q[4];
#pragma unroll
        for (int j = 0; j < 4; ++j) q[j] = *(const v4u*)(p + 8 * j);
        float x[32];
#pragma unroll
        for (int j = 0; j < 4; ++j) { x[8 * j + 0] = bflo(q[j].x); x[8 * j + 1] = bfhi(q[j].x); x[8 * j + 2] = bflo(q[j].y); x[8 * j + 3] = bfhi(q[j].y);
            x[8 * j + 4] = bflo(q[j].z); x[8 * j + 5] = bfhi(q[j].z); x[8 * j + 6] = bflo(q[j].w); x[8 * j + 7] = bfhi(q[j].w); }
        float s = 0.f;
#pragma unroll
        for (int i = 0; i < 32; ++i) s += x[i];
        s += shx(s, 1, lane);
        const float mu = s * (1.f / 64.f); float v = 0.f;
#pragma unroll
        for (int i = 0; i < 32; ++i) { x[i] -= mu; v += x[i] * x[i]; }
        v += shx(v, 1, lane);
        const float rstd = 1.f / sqrtf(v * (1.f / 64.f) + LN_EPS);
#pragma unroll
        for (int c8 = 0; c8 < 4; ++c8) {
#pragma unroll
            for (int i = 8 * c8; i < 8 * c8 + 8; ++i) x[i] = x[i] * rstd * g[i] + bb[i];
            asm volatile("" ::: "memory"); }
        if (hf == 0) {
#pragma unroll
            for (int c4 = 0; c4 < 4; ++c4) {
#pragma unroll
                for (int i = 4 * c4; i < 4 * c4 + 4; ++i) rope_pair(x[i], x[16 + i], tb[pos * 16 + i]);
                asm volatile("" ::: "memory"); }
        }
#pragma unroll
        for (int j = 0; j < 4; ++j) { q[j].x = cvtpk(x[8 * j + 0], x[8 * j + 1]); q[j].y = cvtpk(x[8 * j + 2], x[8 * j + 3]); q[j].z = cvtpk(x[8 * j + 4], x[8 * j + 5]); q[j].w = cvtpk(x[8 * j + 6], x[8 * j + 7]);
            *(v4u*)(d + 8 * j) = q[j]; }
    }
}

template <int NB, bool DSA>
__device__ __forceinline__ void attn8_phase(CArgs* A, LAS unsigned char* lds, int gw, int NGW, int wave, int lane_) {
    unsigned char* ws = launder(A->ws);
    const bf16* P = (const bf16*)(ws + WS_PROJ); const int ld = DSA ? NCOLB_PAD : NCOLA;
    const unsigned char* K8 = ws + WS_K8; const unsigned char* V8 = ws + WS_V8;
    unsigned char* O = ws + WS_ATT;
    const u16* SEL = (const u16*)(ws + WS_SEL);
    const float* sinks = gptr(A->in[4]);
    LAS unsigned char* vl = lds + wave * 16384;
    typedef int v2i __attribute__((ext_vector_type(2)));
    constexpr int NTOT = DSA ? NTOK : NBATCH * NMETA;
#define TOK_DESC(tix_, tok_, b_, p_, nk_, usel_, rb_, selrow_) \
        const int tok_ = DSA ? (tix_) : ((tix_) >> 4) * LTOK + ((tix_) & 15); const int b_ = tok_ / LTOK, p_ = tok_ % LTOK; \
        const bool usel_ = DSA && (p_ - NMETA >= 256); const int nk_ = p_ < NMETA ? p_ + 1 : (p_ - NMETA < 256 ? p_ + 1 : 16 + 256); \
        const size_t rb_ = (size_t)b_ * LTOK; const u16* selrow_ = SEL + ((size_t)b_ * SEQ + (p_ > NMETA ? p_ - NMETA : 0)) * 256;
#define REQ_KP(dst_, nk_, usel_, selrow_, fr_) do { _Pragma("unroll") for (int c_ = 0; c_ < NB * 2; ++c_) { const int i0_ = c_ * 32 + (fr_), i1_ = i0_ + 16; \
            const unsigned k0_ = i0_ < (nk_) ? (unsigned)(i0_ < 16 ? i0_ : 16 + ((usel_) ? (int)(selrow_)[i0_ - 16] : i0_ - 16)) : 0u; \
            const unsigned k1_ = i1_ < (nk_) ? (unsigned)(16 + ((usel_) ? (int)(selrow_)[i1_ - 16] : i1_ - 16)) : 0u; dst_[c_] = k0_ | (k1_ << 16); } } while (0)
#define KPX(arr_, TT) (((TT) & 1) ? (arr_[(TT) >> 1] >> 16) : (arr_[(TT) >> 1] & 0xffffu))
#define LOAD_KX(arr_, rb_, bt, fq_, nt_) do { _Pragma("unroll") for (int T_ = 0; T_ < (nt_); ++T_) { \
            const unsigned ko_ = ((unsigned)(rb_) + KPX(arr_, 4 * (bt) + T_)) * 128u + (unsigned)(fq_) * 32u; \
            kf[T_][0] = *(const v4u*)(K8 + ko_); kf[T_][1] = *(const v4u*)(K8 + ko_ + 16u); } } while (0)
#define LOAD_VX(arr_, rb_, bt, lane__, nt_) do { _Pragma("unroll") for (int T_ = 0; T_ < (nt_); ++T_) _Pragma("unroll") for (int h_ = 0; h_ < 2; ++h_) { \
            const unsigned pp_ = (unsigned)__builtin_amdgcn_ds_bpermute((8 * h_ + ((lane__) >> 3)) << 2, (int)arr_[(4 * (bt) + T_) >> 1]); \
            const unsigned pos_ = (T_ & 1) ? (pp_ >> 16) : (pp_ & 0xffffu); \
            vt[2 * T_ + h_] = *(const v4u*)(V8 + (((unsigned)(rb_) + pos_) * 128u + ((unsigned)(lane__) & 7u) * 16u)); } } while (0)
    v4u kf[4][2]; v4u vt[8];
    unsigned kpn[NB * 2]; v4u qn[4];
    const unsigned char* Q8 = ws + WS_Q8;
    unsigned sta[8], tra[16];
    { const int lane = launder_v(lane_); const int fq = lane >> 4;
#pragma unroll
      for (int T = 0; T < 4; ++T)
#pragma unroll
          for (int h = 0; h < 2; ++h) { const unsigned i = 8u * h + ((unsigned)lane >> 3), rho = 32u * (i >> 2) + 4u * T + (i & 3u); sta[2 * T + h] = 128u * rho + 16u * (((unsigned)lane & 7u) ^ (rho & 7u)); }
#pragma unroll
      for (int d = 0; d < 8; ++d)
#pragma unroll
          for (int u = 0; u < 2; ++u) { const unsigned row = 32u * (unsigned)fq + 8u * u + (((unsigned)lane & 15u) >> 1); tra[2 * d + u] = 128u * row + 16u * ((unsigned)d ^ (row & 7u)) + 8u * ((unsigned)lane & 1u); } }
    int tix = gw, nwit = 0;
    if (tix >= NTOT) return;
    { const int lane0 = launder_v(lane_); const int fr0 = lane0 & 15, fq0 = lane0 >> 4;
      TOK_DESC(tix, tk0, b0, p0, nk0, us0, rb0, sr0)
      REQ_KP(kpn, nk0, us0, sr0, fr0);
      if (DSA) { const unsigned char* qr = Q8 + (rb0 + p0) * DM + fr0 * 64 + (fq0 & 1) * 32; qn[0] = *(const v4u*)qr; qn[1] = *(const v4u*)(qr + 16); }
      else { const bf16* qr = P + (rb0 + p0) * ld + fr0 * 64 + (fq0 & 1) * 32; qn[0] = *(const v4u*)qr; qn[1] = *(const v4u*)(qr + 8); qn[2] = *(const v4u*)(qr + 16); qn[3] = *(const v4u*)(qr + 24); }
      LOAD_KX(kpn, rb0, 0, fq0, 4); LOAD_VX(kpn, rb0, 0, lane0, 4); }
    for (; tix < NTOT; tix += NGW) {
        const int lane = launder_v(lane_); const int fr = lane & 15, fq = lane >> 4;
        TOK_DESC(tix, tok, b, p, n_keys, use_sel, rowbase, selrow)
        (void)b; (void)use_sel; (void)selrow;
        unsigned kp2[NB * 2];
#pragma unroll
        for (int c = 0; c < NB * 2; ++c) kp2[c] = kpn[c];
        pg8::pg8_v8i qf8;
        if (DSA) { const bool mine = (fq >> 1) == (fr >> 3); v4u lo8 = qn[0], hi8 = qn[1];
          if (!mine) { lo8 = (v4u){0u, 0u, 0u, 0u}; hi8 = lo8; }
          qf8 = pg8::cat8(__builtin_bit_cast(bf16x8, lo8), __builtin_bit_cast(bf16x8, hi8)); }
        else { const bool mine = (fq >> 1) == (fr >> 3); constexpr float sq = pg8::FP8_SX; const v4u q0 = qn[0], q1 = qn[1], q2 = qn[2], q3 = qn[3];
          v4u lo8, hi8;
          lo8.x = pg8::pk4_fp8(sq * bflo(q0.x), sq * bfhi(q0.x), sq * bflo(q0.y), sq * bfhi(q0.y)); lo8.y = pg8::pk4_fp8(sq * bflo(q0.z), sq * bfhi(q0.z), sq * bflo(q0.w), sq * bfhi(q0.w));
          lo8.z = pg8::pk4_fp8(sq * bflo(q1.x), sq * bfhi(q1.x), sq * bflo(q1.y), sq * bfhi(q1.y)); lo8.w = pg8::pk4_fp8(sq * bflo(q1.z), sq * bfhi(q1.z), sq * bflo(q1.w), sq * bfhi(q1.w));
          hi8.x = pg8::pk4_fp8(sq * bflo(q2.x), sq * bfhi(q2.x), sq * bflo(q2.y), sq * bfhi(q2.y)); hi8.y = pg8::pk4_fp8(sq * bflo(q2.z), sq * bfhi(q2.z), sq * bflo(q2.w), sq * bfhi(q2.w));
          hi8.z = pg8::pk4_fp8(sq * bflo(q3.x), sq * bfhi(q3.x), sq * bflo(q3.y), sq * bfhi(q3.y)); hi8.w = pg8::pk4_fp8(sq * bflo(q3.z), sq * bfhi(q3.z), sq * bflo(q3.w), sq * bfhi(q3.w));
          if (!mine) { lo8 = (v4u){0u, 0u, 0u, 0u}; hi8 = lo8; }
          qf8 = pg8::cat8(__builtin_bit_cast(bf16x8, lo8), __builtin_bit_cast(bf16x8, hi8)); }
        const bool has_next = tix + NGW < NTOT;
        const int tixn = has_next ? tix + NGW : tix;
        TOK_DESC(tixn, tokn, bn, pn, nkn, usn, rbn, srn)
        (void)tokn; (void)bn;
        REQ_KP(kpn, nkn, usn, srn, fr);
        if (DSA) { const unsigned char* qr = Q8 + (rbn + pn) * DM + fr * 64 + (fq & 1) * 32; qn[0] = *(const v4u*)qr; qn[1] = *(const v4u*)(qr + 16); }
        else { const bf16* qr = P + (rbn + pn) * ld + fr * 64 + (fq & 1) * 32; qn[0] = *(const v4u*)qr; qn[1] = *(const v4u*)(qr + 8); qn[2] = *(const v4u*)(qr + 16); qn[3] = *(const v4u*)(qr + 24); }
        float mrun = -1e30f, lsum = 0.f;
        f32x4 o[8];
#pragma unroll
        for (int d = 0; d < 8; ++d) o[d] = (f32x4){0.f, 0.f, 0.f, 0.f};
#pragma unroll
        for (int bt = 0; bt < NB; ++bt) {
            const int NT = (DSA && NB == 5 && bt == NB - 1) ? 1 : 4, NTN = (DSA && NB == 5 && bt + 1 == NB - 1) ? 1 : 4;
            if (bt * 64 < n_keys) {
                const bool more = (bt + 1 < NB) && ((bt + 1) * 64 < n_keys);
                f32x4 s8[4]; float bm = -1e30f;
                constexpr float qk = ATTN_SCALE / (pg8::FP8_SX * pg8::FP8_SX);
                const bool full = bt * 64 + 16 * NT <= n_keys;
#pragma unroll
                for (int T = 0; T < 4; ++T) s8[T] = (f32x4){-1e30f, -1e30f, -1e30f, -1e30f};
#pragma unroll
                for (int T = 0; T < NT; ++T) {
                    const f32x4 a = __builtin_amdgcn_mfma_scale_f32_16x16x128_f8f6f4(pg8::cat8(__builtin_bit_cast(bf16x8, kf[T][0]), __builtin_bit_cast(bf16x8, kf[T][1])), qf8, (f32x4){0.f, 0.f, 0.f, 0.f}, 0, 0, 0, 0, 0, 0);
                    if (full) { s8[T] = a; }
                    else {
#pragma unroll
                        for (int j = 0; j < 4; ++j) { const int ki = bt * 64 + 16 * T + 4 * fq + j; s8[T][j] = ki < n_keys ? a[j] : -1e30f; } }
                    bm = fmaxf(bm, fmaxf(fmaxf(s8[T][0], s8[T][1]), fmaxf(s8[T][2], s8[T][3])));
                }
                if (more) { LOAD_KX(kp2, rowbase, bt + 1 < NB ? bt + 1 : 0, fq, NTN); } else if (has_next) { LOAD_KX(kpn, rbn, 0, fq, 4); }
                bm = fmaxf(bm, shx(bm, 16, lane)); bm = fmaxf(bm, shx(bm, 32, lane)); bm *= qk;
                const float mnew = fmaxf(mrun, bm), rs = __expf(mrun - mnew); mrun = mnew;
                float bs = 0.f; unsigned pk[4];
                const float mb = mnew * 1.4426950408889634f - 8.0f;
                constexpr float qkl = qk * 1.4426950408889634f;
#pragma unroll
                for (int T = 0; T < 4; ++T) { const float e0 = __builtin_amdgcn_exp2f(__builtin_fmaf(s8[T][0], qkl, -mb)), e1 = __builtin_amdgcn_exp2f(__builtin_fmaf(s8[T][1], qkl, -mb)),
                                                          e2 = __builtin_amdgcn_exp2f(__builtin_fmaf(s8[T][2], qkl, -mb)), e3 = __builtin_amdgcn_exp2f(__builtin_fmaf(s8[T][3], qkl, -mb));
                    bs += (e0 + e1) + (e2 + e3); unsigned w = 0u; w = (unsigned)__builtin_amdgcn_cvt_pk_fp8_f32(e0, e1, (int)w, false); w = (unsigned)__builtin_amdgcn_cvt_pk_fp8_f32(e2, e3, (int)w, true); pk[T] = w; }
                bs *= (1.f / 256.f);
                lsum = lsum * rs + bs;
#pragma unroll
                for (int d = 0; d < 8; ++d) o[d] = o[d] * rs;
#pragma unroll
                for (int q8 = 0; q8 < 2 * NT; ++q8) *(LAS v4u*)(vl + sta[q8]) = vt[q8];
                if (more) { LOAD_VX(kp2, rowbase, bt + 1 < NB ? bt + 1 : 0, lane, NTN); } else if (has_next) { LOAD_VX(kpn, rbn, 0, lane, 4); }
                const pg8::pg8_v8i pf = {(int)pk[0], (int)pk[1], (int)pk[2], (int)pk[3], 0, 0, 0, 0};
#pragma unroll
                for (int d = 0; d < 8; ++d) {
                    v2i r[2];
#pragma unroll
                    for (int u = 0; u < 2; ++u) r[u] = __builtin_amdgcn_ds_read_tr8_b64_v2i32((LAS v2i*)(vl + tra[2 * d + u]));
                    const pg8::pg8_v8i vf = {r[0].x, r[0].y, r[1].x, r[1].y, 0, 0, 0, 0};
                    o[d] = __builtin_amdgcn_mfma_scale_f32_16x16x128_f8f6f4(vf, pf, o[d], 0, 0, 0, 0, 0, 0);
                }
            }
        }
        lsum += shx(lsum, 16, lane); lsum += shx(lsum, 32, lane);
        float inv;
        if (!DSA) { const float sk = sinks[fr], m2 = fmaxf(mrun, sk), f = __expf(mrun - m2); inv = f / (lsum * f + __expf(sk - m2)); }
        else inv = 1.f / lsum;
        { unsigned char* orow = O + (size_t)tok * DM + fr * 64 + fq * 4; const bool hi = fr >= 8; const float inv8 = inv * (pg8::FP8_SO / (256.f * pg8::FP8_SX));
#pragma unroll
          for (int dd = 0; dd < 4; ++dd) { const f32x4 vl_ = o[dd], vh_ = o[4 + dd];
              const float v0 = hi ? vh_[0] : vl_[0], v1 = hi ? vh_[1] : vl_[1], v2 = hi ? vh_[2] : vl_[2], v3 = hi ? vh_[3] : vl_[3];
              *(unsigned*)(orow + dd * 16) = pg8::pk4_fp8(v0 * inv8, v1 * inv8, v2 * inv8, v3 * inv8); } }
    }
#undef TOK_DESC
#undef REQ_KP
#undef KPX
#undef LOAD_KX
#undef LOAD_VX
}

constexpr int SWA_ROWS = 288, SWA_KOFF = 0, SWA_VOFF = SWA_ROWS * 128;
__device__ __forceinline__ unsigned swa_koff(unsigned row, unsigned ch) { return 128u * row + 16u * (ch ^ (((row >> 1) & 1u) | (((row >> 3) & 3u) << 1))); }
__device__ __forceinline__ unsigned swa_voff(unsigned row, unsigned ch) { return 128u * row + 16u * (ch ^ (2u * (((row >> 1) & 1u) | (((row >> 3) & 1u) << 1)))); }
__device__ __forceinline__ void swa_tile_phase(CArgs* A, LAS unsigned char* lds, int G, int wg, int wave, int lane_) {
    unsigned char* ws = launder(A->ws);
    const bf16* P = (const bf16*)(ws + WS_PROJ); constexpr int ld = NCOLA;
    const bf16* KV = (const bf16*)(ws + WS_KV);
    bf16* O = (bf16*)(ws + WS_ATT);
    const float* sinks = gptr(A->in[4]);
    LAS unsigned char* kl = lds + SWA_KOFF; LAS unsigned char* vl = lds + SWA_VOFF;
    constexpr int NUNITS = NBATCH * 2 * 32;
    int nwit = 0;
    for (int unit = wg; unit < NUNITS; unit += G) {
        const int lane = launder_v(lane_), tid = wave * 64 + lane, fr = lane & 15, fq = lane >> 4;
        const int qb = unit & 31, kvh = (unit >> 5) & 1, b = unit >> 6;
        const size_t rowbase = (size_t)b * LTOK;
        __syncthreads();
        { constexpr int NST = (SWA_ROWS * 8 + NTHREADS - 1) / NTHREADS;
          v4u kk[NST], vv[NST];
#pragma unroll
          for (int i = 0; i < NST; ++i) { const int id = tid + i * NTHREADS; const int r = id >> 3, ch = id & 7;
              int pos = -1;
              if (r < 16) pos = r; else if (r < 272) { const int s = (qb - 1) * 128 + (r - 16); if (s >= 0) pos = NMETA + s; }
              kk[i] = (v4u){0u, 0u, 0u, 0u}; vv[i] = kk[i];
              if (id < SWA_ROWS * 8 && pos >= 0) { const bf16* src = KV + (rowbase + pos) * 256 + kvh * 64 + ch * 8; kk[i] = *(const v4u*)src; vv[i] = *(const v4u*)(src + 128); } }
#pragma unroll
          for (int i = 0; i < NST; ++i) { const int id = tid + i * NTHREADS; const int r = id >> 3, ch = id & 7;
              if (id < SWA_ROWS * 8) { *(LAS v4u*)(kl + swa_koff((unsigned)r, (unsigned)ch)) = kk[i]; *(LAS v4u*)(vl + swa_voff((unsigned)r, (unsigned)ch)) = vv[i]; } } }
        __syncthreads();
        const int i0 = 16 * wave;
        const int tokrow = (int)rowbase + NMETA + qb * 128 + i0 + fr;
        const unsigned tq = ((unsigned)lane & 15u) >> 2, tp = (unsigned)lane & 3u;
        bf16x8 qn[2];
        { const bf16* qr = P + (size_t)tokrow * ld + (kvh * 8) * 64 + fq * 8; qn[0] = *(const bf16x8*)qr; qn[1] = *(const bf16x8*)(qr + 32); }
#pragma unroll 1
        for (int g = 0; g < 8; ++g) {
            const int h = kvh * 8 + g;
            bf16x8 qf[2]; qf[0] = qn[0]; qf[1] = qn[1];
            { const int hn = kvh * 8 + (g < 7 ? g + 1 : g); const bf16* qr = P + (size_t)tokrow * ld + hn * 64 + fq * 8; qn[0] = *(const bf16x8*)qr; qn[1] = *(const bf16x8*)(qr + 32); }
            f32x4 sc[12]; float mx = -1e30f;
#pragma unroll
            for (int T = 0; T < 12; ++T) {
                const int c = T >> 1; const int base = c == 0 ? 0 : 16 + i0 + 32 * (c - 1);
                const unsigned r = (unsigned)(base + 8 * (fr >> 2) + 4 * (T & 1) + (fr & 3));
                const bf16x8 k0 = *(const LAS bf16x8*)(kl + swa_koff(r, (unsigned)fq)), k1 = *(const LAS bf16x8*)(kl + swa_koff(r, 4u + (unsigned)fq));
                f32x4 a = {0.f, 0.f, 0.f, 0.f};
                a = __builtin_amdgcn_mfma_f32_16x16x32_bf16(k0, qf[0], a, 0, 0, 0);
                a = __builtin_amdgcn_mfma_f32_16x16x32_bf16(k1, qf[1], a, 0, 0, 0);
#pragma unroll
                for (int j = 0; j < 4; ++j) { const int rr = base + 8 * fq + 4 * (T & 1) + j;
                    bool ok;
                    if (c == 0) ok = rr < 16; else { const int kbi = rr - 16, it = i0 + fr; ok = (kbi >= it + 1) && (kbi <= it + 128) && (qb > 0 || kbi >= 128); }
                    const float v = ok ? a[j] * ATTN_SCALE : -1e30f; sc[T][j] = v; mx = fmaxf(mx, v); }
            }
            mx = fmaxf(mx, shx(mx, 16, lane)); mx = fmaxf(mx, shx(mx, 32, lane));
            const float sk = sinks[h]; mx = fmaxf(mx, sk);
            float sum = 0.f; v4u pk[6];
#pragma unroll
            for (int c = 0; c < 6; ++c) { float e[8];
#pragma unroll
                for (int j = 0; j < 4; ++j) { e[j] = __expf(sc[2 * c][j] - mx); e[4 + j] = __expf(sc[2 * c + 1][j] - mx); }
                sum += ((e[0] + e[1]) + (e[2] + e[3])) + ((e[4] + e[5]) + (e[6] + e[7]));
                pk[c].x = cvtpk(e[0], e[1]); pk[c].y = cvtpk(e[2], e[3]); pk[c].z = cvtpk(e[4], e[5]); pk[c].w = cvtpk(e[6], e[7]); }
            sum += shx(sum, 16, lane); sum += shx(sum, 32, lane);
            sum += __expf(sk - mx);
            const float inv = 1.f / sum;
            f32x4 o[4];
#pragma unroll
            for (int d = 0; d < 4; ++d) o[d] = (f32x4){0.f, 0.f, 0.f, 0.f};
#pragma unroll
            for (int c = 0; c < 6; ++c) {
                const int base = c == 0 ? 0 : 16 + i0 + 32 * (c - 1);
                const bf16x8 pf = __builtin_bit_cast(bf16x8, pk[c]);
                const unsigned r0 = (unsigned)(base + 8 * fq) + tq, r1 = r0 + 4u;
#pragma unroll
                for (int d = 0; d < 4; ++d) {
                    typedef short s16x4 __attribute__((ext_vector_type(4)));
                    const s16x4 lo = __builtin_bit_cast(s16x4, __builtin_amdgcn_ds_read_tr16_b64_v4i16((LAS s16x4*)(vl + swa_voff(r0, 2u * d + (tp >> 1)) + 8u * (tp & 1u))));
                    const s16x4 hi = __builtin_bit_cast(s16x4, __builtin_amdgcn_ds_read_tr16_b64_v4i16((LAS s16x4*)(vl + swa_voff(r1, 2u * d + (tp >> 1)) + 8u * (tp & 1u))));
                    const bf16x8 vf = {lo[0], lo[1], lo[2], lo[3], hi[0], hi[1], hi[2], hi[3]};
                    o[d] = __builtin_amdgcn_mfma_f32_16x16x32_bf16(vf, pf, o[d], 0, 0, 0);
                }
            }
            { unsigned char* orow = (unsigned char*)O + (size_t)tokrow * DM + h * 64 + fq * 4; const float inv8 = inv * pg8::FP8_SO;
#pragma unroll
              for (int d = 0; d < 4; ++d) *(unsigned*)(orow + d * 16) = pg8::pk4_fp8(o[d][0] * inv8, o[d][1] * inv8, o[d][2] * inv8, o[d][3] * inv8); }
            { const int wit = (wg * NWAVES + wave) + nwit * (G * NWAVES); if (wit < L1W_ITEMS) moe_weight_item(A, 0, wit, lane); ++nwit; }
        }
    }
    for (int wit = (wg * NWAVES + wave) + nwit * (G * NWAVES); wit < L1W_ITEMS; wit += G * NWAVES) moe_weight_item(A, 0, wit, launder_v(lane_));
}

#ifndef PROBE_SUB
#define PROBE_SUB 0
#endif
#define SUB_T0() unsigned long long sub_t_ = (PROBE_SUB) ? __builtin_amdgcn_s_memrealtime() : 0ull
#define SUB_ADD(lds_, word_) do { if (PROBE_SUB) { const unsigned long long n_ = __builtin_amdgcn_s_memrealtime(); if (threadIdx.x == 0) ((LAS unsigned*)((lds_) + LDSCTL_OFF))[word_] += (unsigned)(n_ - sub_t_); sub_t_ = n_; } } while (0)
__device__ __forceinline__ int idx_bucket(float s) { return (int)__builtin_amdgcn_fmed3f(__builtin_fmaf(s, 24.f, 128.5f), 0.f, 255.9f); }
__device__ __forceinline__ unsigned ordkey(float f) { unsigned u = __builtin_bit_cast(unsigned, f); if (u == 0x80000000u) u = 0u; return (u & 0x80000000u) ? ~u : (u | 0x80000000u); }
__device__ __forceinline__ void indexer_phase(CArgs* A, LAS unsigned char* lds, int G, int wg, int wave, int lane_) {
    unsigned char* ws = launder(A->ws);
    const bf16* P = (const bf16*)(ws + WS_PROJ); constexpr int ld = NCOLB_PAD;
    const bf16* KI = (const bf16*)(ws + WS_KI);
    float* scr = (float*)(ws + WS_SCORE) + (size_t)wg * 32 * SEQ;
    u16* SEL = (u16*)(ws + WS_SEL);
    constexpr int NUNITS = NBATCH * 120;
    int nwit = 0;
    for (int r = 0;; ++r) {
        const int k = r * G + ((r & 1) ? (G - 1 - wg) : wg);
        if (r * G >= NUNITS) break;
        if (k >= NUNITS) continue;
        const int lane = launder_v(lane_), fr = lane & 15, fq = lane >> 4, tid = wave * 64 + lane;
        const int qb = 127 - k / NBATCH, b = k % NBATCH, t0 = qb * 32;
        const size_t rowbase = (size_t)b * LTOK + NMETA;
        bf16x8 qf[2][2]; float wv[2][4];
#pragma unroll
        for (int rg = 0; rg < 2; ++rg) {
            const int tq = t0 + 4 * wave + (fr >> 2);
            const bf16* qr = P + (rowbase + tq) * ld + 1280 + ((fr & 3) + 4 * rg) * 64 + fq * 8;
            qf[rg][0] = *(const bf16x8*)qr; qf[rg][1] = *(const bf16x8*)(qr + 32);
            const bf16* wr_ = P + (rowbase + t0 + 4 * wave + fq) * ld + 1856 + 4 * rg;
#pragma unroll
            for (int j = 0; j < 4; ++j) wv[rg][j] = bf2f(wr_[j]) * (IDX_W_SCALE * IDX_SCALE);
        }
        SUB_T0();
        const int nkt = t0 / 16 + 2;
        const int nchunk = (nkt + 31) >> 5;
        const bf16* kgl = KI + rowbase * 64 + (size_t)(tid >> 3) * 64 + (tid & 7) * 8;
        v4u st[8];
#pragma unroll
        for (int j = 0; j < 8; ++j) st[j] = *(const v4u*)(kgl + (size_t)(64 * j) * 64);
        __syncthreads();
#pragma unroll
        for (int j = 0; j < 8; ++j) { const unsigned row = (unsigned)(tid >> 3) + 64u * j, ch = (unsigned)tid & 7u; *(LAS v4u*)(lds + 128u * row + 16u * (ch ^ ((row >> 1) & 7u))) = st[j]; }
        float* sp = scr + (size_t)(4 * wave + fq) * SEQ + fr;
        LAS unsigned* hist = (LAS unsigned*)(lds + LDS_HIST_OFF);
#pragma unroll
        for (int j = 0; j < 8; ++j) hist[4 * wave * 128 + lane + 64 * j] = 0u;
        LAS unsigned* hrow = hist + (4 * wave + fq) * 128; const int trow = t0 + 4 * wave + fq;
        for (int c = 0; c < nchunk; ++c) {
            __syncthreads();
            if (c + 1 < nchunk) {
#pragma unroll
                for (int j = 0; j < 8; ++j) st[j] = *(const v4u*)(kgl + (size_t)((c + 1) * 512 + 64 * j) * 64); }
            const LAS unsigned char* kb = lds + (c & 1) * 65536;
            const int ntl = __builtin_amdgcn_readfirstlane(nkt - c * 32 < 32 ? nkt - c * 32 : 32);
            const unsigned sw = ((unsigned)fr >> 1) & 7u;
            const LAS unsigned char* ka0 = kb + 128u * (unsigned)fr + 16u * ((unsigned)fq ^ sw); const LAS unsigned char* ka1 = kb + 128u * (unsigned)fr + 16u * ((4u + (unsigned)fq) ^ sw);
            for (int tl = 0; tl < ntl; tl += 2) {
                const bf16x8 k0a = *(const LAS bf16x8*)(ka0 + 2048 * tl), k1a = *(const LAS bf16x8*)(ka1 + 2048 * tl);
                const bf16x8 k0b = *(const LAS bf16x8*)(ka0 + 2048 * tl + 2048), k1b = *(const LAS bf16x8*)(ka1 + 2048 * tl + 2048);
                f32x4 aa[2], ab[2];
#pragma unroll
                for (int rg = 0; rg < 2; ++rg) {
                    aa[rg] = __builtin_amdgcn_mfma_f32_16x16x32_bf16(qf[rg][0], k0a, (f32x4){0.f, 0.f, 0.f, 0.f}, 0, 0, 0);
                    ab[rg] = __builtin_amdgcn_mfma_f32_16x16x32_bf16(qf[rg][0], k0b, (f32x4){0.f, 0.f, 0.f, 0.f}, 0, 0, 0); }
#pragma unroll
                for (int rg = 0; rg < 2; ++rg) {
                    aa[rg] = __builtin_amdgcn_mfma_f32_16x16x32_bf16(qf[rg][1], k1a, aa[rg], 0, 0, 0);
                    ab[rg] = __builtin_amdgcn_mfma_f32_16x16x32_bf16(qf[rg][1], k1b, ab[rg], 0, 0, 0); }
                float ta = 0.f, tb = 0.f;
#pragma unroll
                for (int rg = 0; rg < 2; ++rg)
#pragma unroll
                    for (int j = 0; j < 4; ++j) { ta = __builtin_fmaf(wv[rg][j], __builtin_amdgcn_fmed3f(aa[rg][j], 0.f, 3.0e38f), ta); tb = __builtin_fmaf(wv[rg][j], __builtin_amdgcn_fmed3f(ab[rg][j], 0.f, 3.0e38f), tb); }
                const int kt = c * 32 + tl;
                sp[kt * 16] = ta; sp[kt * 16 + 16] = tb;
                { const int bka = idx_bucket(ta), bkb = idx_bucket(tb);
                  (void)__hip_atomic_fetch_add(hrow + (bka >> 1), (kt * 16 + fr <= trow ? 1u : 0u) << (16 * (bka & 1)), __ATOMIC_RELAXED, __HIP_MEMORY_SCOPE_WORKGROUP);
                  (void)__hip_atomic_fetch_add(hrow + (bkb >> 1), (kt * 16 + 16 + fr <= trow ? 1u : 0u) << (16 * (bkb & 1)), __ATOMIC_RELAXED, __HIP_MEMORY_SCOPE_WORKGROUP); }
            }
            if (c + 1 < nchunk) {
#pragma unroll
                for (int j = 0; j < 8; ++j) { const unsigned row = (unsigned)(tid >> 3) + 64u * j, ch = (unsigned)tid & 7u; *(LAS v4u*)(lds + ((c + 1) & 1) * 65536 + 128u * row + 16u * (ch ^ ((row >> 1) & 7u))) = st[j]; } }
        }
        asm volatile("s_waitcnt vmcnt(0)" ::: "memory");
        SUB_ADD(lds, LC_PROBE_A);
        unsigned fraw[64];
#define IDX_ROW_LOAD(qi_) do { \
            _Pragma("unroll") for (int g_ = 0; g_ < 4; ++g_) { if (g_ * 1024 <= t0) { \
                unsigned long long pa_ = (unsigned long long)((const unsigned*)(scr + (size_t)(4 * wave + (qi_)) * SEQ) + lane + g_ * 1024); asm volatile("" : "+v"(pa_));     \
                const unsigned* gp_ = (const unsigned*)(const GAS unsigned*)pa_; \
                _Pragma("unroll") for (int r_ = 0; r_ < 16; ++r_) fraw[g_ * 16 + r_] = __hip_atomic_load(gp_ + r_ * 64, __ATOMIC_RELAXED, __HIP_MEMORY_SCOPE_AGENT); } } } while (0)
#ifndef DUP_SEL
#define DUP_SEL 1
#endif
        for (int rep_ = 0, nrep_ = __builtin_amdgcn_readfirstlane(launder_v(DUP_SEL)); rep_ < nrep_; ++rep_) {
        IDX_ROW_LOAD(0);
        for (int qi = 0; qi < 4; ++qi) {
            const int t = t0 + 4 * wave + qi;
            const int nfull = (t + 1) >> 6;
            LAS u16* out = (LAS u16*)(lds + LDSCTL_OFF + 4096 + wave * 512);
            int bstar, cab, neq;
            { const LAS unsigned* hw = hist + (4 * wave + qi) * 128;
              const unsigned w0 = hw[2 * lane], w1 = hw[2 * lane + 1];
              const int c0 = (int)(w0 & 0xffffu), c1 = (int)(w0 >> 16), c2 = (int)(w1 & 0xffffu), c3 = (int)(w1 >> 16), tl4 = (c0 + c1) + (c2 + c3);
              int pf = tl4;
#pragma unroll
              for (int o = 1; o < 64; o <<= 1) { const int v = __builtin_amdgcn_ds_bpermute(((lane - o) & 63) << 2, pf); pf += lane >= o ? v : 0; }
              const int total = __builtin_amdgcn_readlane(pf, 63);
              const int above = total - pf;
              const unsigned long long hm = __ballot(above < 256 && above + tl4 >= 256);
              const int L = (int)__builtin_ctzll(hm);
              int a = above, bs, ne;
              if (a + c3 >= 256) { bs = 3; ne = c3; } else { a += c3; if (a + c2 >= 256) { bs = 2; ne = c2; } else { a += c2; if (a + c1 >= 256) { bs = 1; ne = c1; } else { a += c1; bs = 0; ne = c0; } } }
              bstar = 4 * L + __builtin_amdgcn_readlane(bs, L); cab = __builtin_amdgcn_readlane(a, L); neq = __builtin_amdgcn_readlane(ne, L); }
            const int m256 = 256 - cab;
            if (neq <= 64) {
                LAS unsigned* ek = (LAS unsigned*)(lds + LDS_EQ_OFF + wave * 512); LAS u16* ei = (LAS u16*)(lds + LDS_EQ_OFF + wave * 512 + 256);
                int base = 0, eb = 0;
                const unsigned* nb[4];
#pragma unroll
                for (int g = 0; g < 4; ++g) { unsigned long long pa = (unsigned long long)((const unsigned*)(scr + (size_t)(4 * wave + (qi < 3 ? qi + 1 : qi)) * SEQ) + lane + g * 1024); asm volatile("" : "+v"(pa)); nb[g] = (const unsigned*)(const GAS unsigned*)pa; }
#pragma unroll
                for (int rr = 0; rr < 64; ++rr) {
                    if (rr <= nfull + 1) {
                        const float f = __builtin_bit_cast(float, fraw[rr]);
                        if (qi < 3) fraw[rr] = __hip_atomic_load(nb[rr >> 4] + (rr & 15) * 64, __ATOMIC_RELAXED, __HIP_MEMORY_SCOPE_AGENT);
                        const int bk = (rr * 64 + lane <= t) ? idx_bucket(f) : -1;
                        const bool gt = bk > bstar, eq = bk == bstar;
                        const unsigned long long mt = __ballot(gt);
                        if (gt) out[base + (int)__builtin_amdgcn_mbcnt_hi((unsigned)(mt >> 32), __builtin_amdgcn_mbcnt_lo((unsigned)mt, 0u))] = (u16)(rr * 64 + lane);
                        base += __popcll(mt);
                        const unsigned long long me = __ballot(eq);
                        if (eq) { const int p = eb + (int)__builtin_amdgcn_mbcnt_hi((unsigned)(me >> 32), __builtin_amdgcn_mbcnt_lo((unsigned)me, 0u)); ek[p] = ordkey(f); ei[p] = (u16)(rr * 64 + lane); }
                        eb += __popcll(me);
                    }
                }
                const unsigned key = lane < neq ? ek[lane] : 0u; const u16 kidx = ei[lane];
                int rank = 0;
                for (int j = 0; j < neq; ++j) { const unsigned kj = (unsigned)__builtin_amdgcn_readlane((int)key, j); rank += (kj > key || (kj == key && j < lane)) ? 1 : 0; }
                const bool take = lane < neq && rank < m256;
                const unsigned long long mt = __ballot(take);
                if (take) out[cab + (int)__builtin_amdgcn_mbcnt_hi((unsigned)(mt >> 32), __builtin_amdgcn_mbcnt_lo((unsigned)mt, 0u))] = kidx;
            } else {
#pragma unroll
            for (int rr = 0; rr < 64; ++rr) fraw[rr] = (rr * 64 + lane <= t) ? ordkey(__builtin_bit_cast(float, fraw[rr])) : 0u;
#define IDX_COUNT(cmpop, x_, c_) do { c_ = 0; _Pragma("unroll") for (int g8 = 0; g8 < 8; ++g8) { if (g8 * 8 <= nfull) { unsigned long long bm[8]; \
                _Pragma("unroll") for (int r8 = 0; r8 < 8; ++r8) bm[r8] = __ballot(fraw[g8 * 8 + r8] cmpop (x_)); __builtin_amdgcn_sched_barrier(0); \
                _Pragma("unroll") for (int r8 = 0; r8 < 8; ++r8) c_ += __popcll(bm[r8]); } } } while (0)
#ifndef DUP_BIS
#define DUP_BIS 1
#endif
            unsigned lo = 0u, hi = 0xFFFFFFFFu; int clo = t + 1, chi = 0;
            for (int rb_ = 0, nrb_ = __builtin_amdgcn_readfirstlane(launder_v(DUP_BIS)); rb_ < nrb_; ++rb_) { lo = 0u; hi = 0xFFFFFFFFu; clo = t + 1; chi = 0;
            for (int it = 0; it < 80 && hi - lo > 1u; ++it) {
                unsigned mid = lo + ((hi - lo) >> 1);
                if (it >= 9 && (it & 1)) { const float f = (float)(clo - 255) / (float)(clo - chi + 1);
                    const unsigned d = (unsigned)((float)(hi - lo) * f); mid = lo + (d < 1u ? 1u : d); if (mid >= hi) mid = hi - 1u; }
                int c; IDX_COUNT(>=, mid, c);
                if (c >= 256) { lo = mid; clo = c; if (c == 256) break; } else { hi = mid; chi = c; }
            }
            }
            const unsigned prefix = lo;
            int cge, cgt; IDX_COUNT(>=, prefix, cge); IDX_COUNT(>, prefix, cgt);
            if (cge == 256) {
                int base = 0;
#pragma unroll
                for (int rr = 0; rr < 64; ++rr) {
                    if (rr <= nfull) {
                        const bool take = fraw[rr] >= prefix;
                        const unsigned long long mt = __ballot(take);
                        if (take) out[base + (int)__builtin_amdgcn_mbcnt_hi((unsigned)(mt >> 32), __builtin_amdgcn_mbcnt_lo((unsigned)mt, 0u))] = (u16)(rr * 64 + lane);
                        base += __popcll(mt);
                    }
                }
            } else {
                int need = 256 - cgt, base = 0;
#pragma unroll
                for (int rr = 0; rr < 64; ++rr) {
                    if (rr <= nfull) {
                        const bool gt = fraw[rr] > prefix, eq = fraw[rr] == prefix;
                        const unsigned long long meq = __ballot(eq);
                        const int eqrank = (int)__builtin_amdgcn_mbcnt_hi((unsigned)(meq >> 32), __builtin_amdgcn_mbcnt_lo((unsigned)meq, 0u));
                        const bool take = gt || (eq && eqrank < need);
                        const unsigned long long mt = __ballot(take);
                        if (take) out[base + (int)__builtin_amdgcn_mbcnt_hi((unsigned)(mt >> 32), __builtin_amdgcn_mbcnt_lo((unsigned)mt, 0u))] = (u16)(rr * 64 + lane);
                        base += __popcll(mt);
                        const int neq = __popcll(meq); need -= (neq < need ? neq : need);
                    }
                }
            }
                if (qi < 3) IDX_ROW_LOAD(qi + 1);
            }
            { const unsigned long long row8 = *(const LAS unsigned long long*)((const LAS unsigned char*)out + lane * 8);
              *(unsigned long long*)((unsigned char*)(SEL + ((size_t)b * SEQ + t) * 256) + lane * 8) = row8; }
            { const int wit = (wg * NWAVES + wave) + nwit * (G * NWAVES); if (wit < L1W_ITEMS) moe_weight_item(A, 1, wit, lane); ++nwit; }
#undef IDX_COUNT
        }
        }
#undef IDX_ROW_LOAD
        asm volatile("s_waitcnt vmcnt(0)" ::: "memory");
        SUB_ADD(lds, LC_PROBE_B);
    }
    for (int wit = (wg * NWAVES + wave) + nwit * (G * NWAVES); wit < L1W_ITEMS; wit += G * NWAVES) moe_weight_item(A, 1, wit, launder_v(lane_));
}

__device__ __forceinline__ void ln_router_phase(CArgs* A, LAS unsigned char* lds, int layer, int G, int wg, int wave, int lane, const bf16* PRE, bf16* HOUT) {
    unsigned char* ws = launder(A->ws);
    const float* lg = gptr(A->in[11]) + layer * DM; const float* lb = gptr(A->in[12]) + layer * DM;
    const bf16* WRT = (const bf16*)(ws + WS_WRT) + (size_t)layer * 32 * 1024;
    const float* br = gptr(A->in[14]) + layer * 32;
    unsigned* cnt = (unsigned*)(ws + WS_CTL) + CW_CNT + layer * 32;
    int2* elist = (int2*)(ws + WS_ELIST); unsigned* eoff = (unsigned*)(ws + WS_EOFF) + (size_t)layer * 32 * NTOK;
    LAS int* lc = (LAS int*)(lds + LDSCTL_OFF);
    LAS float* lgt = (LAS float*)(lds + 98304 + wave * 4096);
    const int fr = lane & 15, fq = lane >> 4, tid = wave * 64 + lane;
    constexpr int NUNITS = NTOK / 128;
    LAS unsigned char* wl = lds; LAS float* gl = (LAS float*)(lds + 65536); LAS float* bl = (LAS float*)(lds + 69632);
    __syncthreads();
    for (int id = tid; id < 32 * 128; id += NTHREADS) { const int e = id >> 7, ch = id & 127; *(LAS v4u*)(wl + e * 2048 + 16 * (ch ^ (e & 7))) = *(const v4u*)(WRT + (size_t)e * 1024 + ch * 8); }
    for (int id = tid; id < 256; id += NTHREADS) { *(LAS f32x4*)(gl + 4 * id) = *(const f32x4*)(lg + 4 * id); *(LAS f32x4*)(bl + 4 * id) = *(const f32x4*)(lb + 4 * id); }
    __syncthreads();
    const int nmr = NUNITS / G, nrem = (NTOK - nmr * G * 128) / 16;
    int pe4[4] = {0, 0, 0, 0}, ploc[4] = {0, 0, 0, 0}, prow0 = 0, gbase = 0; float pg4[4] = {0.f, 0.f, 0.f, 0.f}; bool pact = false, have_prev = false;
    for (int it = 0; ; ++it) {
        int r0; bool act = true;
        if (it < nmr) r0 = (wg + it * G) * 128 + wave * 16;
        else { const int j0 = (it - nmr) * G * 8 + wg; if (j0 >= nrem) break; const int j = j0 + wave * G; act = j < nrem; r0 = nmr * G * 128 + (act ? j : 0) * 16; }
        if (tid < 32) lc[LC_LCNT + tid] = 0;
        __syncthreads();
        int e4[4] = {0, 0, 0, 0}, loc[4] = {0, 0, 0, 0}; float g4[4] = {0.f, 0.f, 0.f, 0.f};
        if (act) {
        const bf16* xr = PRE + (size_t)(r0 + fr) * DM + fq * 16;
        float sm = 0.f, sq = 0.f;
#pragma unroll 4
        for (int s = 0; s < 16; ++s) {
#pragma unroll
            for (int j = 0; j < 2; ++j) { const v4u x = *(const v4u*)(xr + 64 * s + 8 * j);
                const float x0 = bflo(x.x), x1 = bfhi(x.x), x2 = bflo(x.y), x3 = bfhi(x.y), x4 = bflo(x.z), x5 = bfhi(x.z), x6 = bflo(x.w), x7 = bfhi(x.w);
                sm += ((x0 + x1) + (x2 + x3)) + ((x4 + x5) + (x6 + x7));
                sq += ((x0 * x0 + x1 * x1) + (x2 * x2 + x3 * x3)) + ((x4 * x4 + x5 * x5) + (x6 * x6 + x7 * x7)); } }
        sm += shx(sm, 16, lane); sm += shx(sm, 32, lane); sq += shx(sq, 16, lane); sq += shx(sq, 32, lane);
        const float mean = sm * (1.f / DM);
        const float var = fmaxf(sq * (1.f / DM) - mean * mean, 0.f);
        const float rstd = 1.f / sqrtf(var + LN_EPS);
        f32x4 a0 = {0.f, 0.f, 0.f, 0.f}, a1 = {0.f, 0.f, 0.f, 0.f};
        bf16* hr = HOUT + (size_t)(r0 + fr) * DM + fq * 16;
        unsigned char* h8r = ws + WS_HB8 + (size_t)(r0 + fr) * DM + fq * 16;
#pragma unroll 2
        for (int s = 0; s < 16; ++s) {
            v4u o8v;
#pragma unroll
            for (int j = 0; j < 2; ++j) {
                const int c = fq * 16 + 64 * s + 8 * j;
                const v4u x = *(const v4u*)(xr + 64 * s + 8 * j);
                const f32x4 g0 = *(const LAS f32x4*)(gl + c), g1 = *(const LAS f32x4*)(gl + c + 4);
                const f32x4 b0 = *(const LAS f32x4*)(bl + c), b1 = *(const LAS f32x4*)(bl + c + 4);
                v4u y;
                const float f0 = (bflo(x.x) - mean) * rstd * g0[0] + b0[0], f1 = (bfhi(x.x) - mean) * rstd * g0[1] + b0[1], f2 = (bflo(x.y) - mean) * rstd * g0[2] + b0[2], f3 = (bfhi(x.y) - mean) * rstd * g0[3] + b0[3];
                const float f4 = (bflo(x.z) - mean) * rstd * g1[0] + b1[0], f5 = (bfhi(x.z) - mean) * rstd * g1[1] + b1[1], f6 = (bflo(x.w) - mean) * rstd * g1[2] + b1[2], f7 = (bfhi(x.w) - mean) * rstd * g1[3] + b1[3];
                y.x = cvtpk(f0, f1); y.y = cvtpk(f2, f3); y.z = cvtpk(f4, f5); y.w = cvtpk(f6, f7);
                *(v4u*)(hr + 64 * s + 8 * j) = y;
                { constexpr float sx = pg8::FP8_SX; const unsigned p0 = pg8::pk4_fp8(sx * f0, sx * f1, sx * f2, sx * f3), p1 = pg8::pk4_fp8(sx * f4, sx * f5, sx * f6, sx * f7);
                  if (j == 0) { o8v.x = p0; o8v.y = p1; } else { o8v.z = p0; o8v.w = p1; } }
                const bf16x8 yf = __builtin_bit_cast(bf16x8, y);
                const int ch = 8 * s + 2 * fq + j;
                const bf16x8 w0 = *(const LAS bf16x8*)(wl + fr * 2048 + 16 * (ch ^ (fr & 7))), w1 = *(const LAS bf16x8*)(wl + (16 + fr) * 2048 + 16 * (ch ^ (fr & 7)));
                a0 = __builtin_amdgcn_mfma_f32_16x16x32_bf16(yf, w0, a0, 0, 0, 0);
                a1 = __builtin_amdgcn_mfma_f32_16x16x32_bf16(yf, w1, a1, 0, 0, 0);
            }
            *(v4u*)(h8r + 64 * s) = o8v;
        }
        { const float bb0 = br[fr], bb1 = br[16 + fr];
#pragma unroll
          for (int j = 0; j < 4; ++j) { lgt[(fq * 4 + j) * 33 + fr] = a0[j] + bb0; lgt[(fq * 4 + j) * 33 + 16 + fr] = a1[j] + bb1; } }
        LDS_WAIT();
        if (lane < 16) {
            float v[32];
#pragma unroll
            for (int e = 0; e < 32; ++e) v[e] = lgt[lane * 33 + e];
            float l4[4];
#pragma unroll
            for (int k = 0; k < 4; ++k) { float best = -3.0e38f; int bi = 0;
#pragma unroll
                for (int e = 0; e < 32; ++e) { const bool better = v[e] > best; best = better ? v[e] : best; bi = better ? e : bi; }
                l4[k] = best; e4[k] = bi;
#pragma unroll
                for (int e = 0; e < 32; ++e) v[e] = (e == bi) ? -3.0e38f : v[e]; }
            float den = 0.f;
#pragma unroll
            for (int k = 0; k < 4; ++k) { g4[k] = __expf(l4[k] - l4[0]); den += g4[k]; }
            const float rd = 1.f / den;
#pragma unroll
            for (int k = 0; k < 4; ++k) { g4[k] *= rd; loc[k] = __hip_atomic_fetch_add(lc + LC_LCNT + e4[k], 1, __ATOMIC_RELAXED, __HIP_MEMORY_SCOPE_WORKGROUP); }
        }
        }
        __syncthreads();
        if (have_prev && tid < 32) lc[LC_LBASE + tid] = gbase;
        if (tid < 32) { const int n = lc[LC_LCNT + tid]; gbase = n > 0 ? (int)__hip_atomic_fetch_add(cnt + tid, (unsigned)n, __ATOMIC_RELAXED, __HIP_MEMORY_SCOPE_AGENT) : 0; }
        if (have_prev) {
            __syncthreads();
            if (pact && lane < 16) { const int row = prow0 + lane;
#pragma unroll
                for (int k = 0; k < 4; ++k) { const size_t sl = (size_t)pe4[k] * NTOK + (size_t)(lc[LC_LBASE + pe4[k]] + ploc[k]); elist[sl] = make_int2(row * 4 + k, __builtin_bit_cast(int, pg4[k])); eoff[sl] = (unsigned)row * (unsigned)DM; } }
        }
#pragma unroll
        for (int k = 0; k < 4; ++k) { pe4[k] = e4[k]; ploc[k] = loc[k]; pg4[k] = g4[k]; }
        prow0 = r0; pact = act; have_prev = true;
    }
    if (have_prev) {
        if (tid < 32) lc[LC_LBASE + tid] = gbase;
        __syncthreads();
        if (pact && lane < 16) { const int row = prow0 + lane;
#pragma unroll
            for (int k = 0; k < 4; ++k) { const size_t sl = (size_t)pe4[k] * NTOK + (size_t)(lc[LC_LBASE + pe4[k]] + ploc[k]); elist[sl] = make_int2(row * 4 + k, __builtin_bit_cast(int, pg4[k])); eoff[sl] = (unsigned)row * (unsigned)DM; } }
    }
}

__device__ __forceinline__ int moe_table(CArgs* A, LAS unsigned char* lds, int layer, int tid) {
    const unsigned* cnt = (const unsigned*)(launder(A->ws) + WS_CTL) + CW_CNT + layer * 32;
    LAS int* lc = (LAS int*)(lds + LDSCTL_OFF);
    tid = launder_v(tid);
    __syncthreads();
    if (tid < 64) {
        const int c = tid < 32 ? (int)__hip_atomic_load(cnt + tid, __ATOMIC_RELAXED, __HIP_MEMORY_SCOPE_AGENT) : 0;
        const int tiles = (c + 255) >> 8; int pf = tiles;
#pragma unroll
        for (int o = 1; o < 32; o <<= 1) { const int v = __builtin_amdgcn_ds_bpermute(((tid - o) & 63) << 2, pf); pf += tid >= o ? v : 0; }
        if (tid < 32) { lc[LC_ECNT + tid] = c; lc[LC_TSTART + tid] = pf - tiles; }
        if (tid == 31) lc[LC_TSTART + 32] = pf;
    }
    __syncthreads();
    const int ntiles = lc[LC_TSTART + 32];
    { LAS unsigned char* te = (LAS unsigned char*)(lc + LC_TILEE);
      for (int i = tid; i < ntiles; i += NTHREADS) { int lo = 0;
#pragma unroll
          for (int st = 16; st >= 1; st >>= 1) lo += (lc[LC_TSTART + lo + st] <= i) ? st : 0;
          te[i] = (unsigned char)lo; } }
    __syncthreads();
    return ntiles;
}

__device__ __forceinline__ void ln_ffn_phase(CArgs* A, int layer, int gw, int NGW, int lane, const bf16* H1, bf16* HOUT) {
    unsigned char* ws = launder(A->ws);
    const unsigned char* Y = ws + WS_XS;
    const float* lg = gptr(A->in[19]) + layer * DM; const float* lb = gptr(A->in[20]) + layer * DM;
    typedef float f32x2l __attribute__((ext_vector_type(2)));
    v4u hq[2], yq[4];
    if (gw < NTOK) {
#pragma unroll
        for (int j = 0; j < 2; ++j) hq[j] = *(const v4u*)(H1 + (size_t)gw * DM + lane * 16 + j * 8);
#pragma unroll
        for (int k = 0; k < 4; ++k) yq[k] = *(const v4u*)(Y + ((size_t)gw * 4 + k) * DM + lane * 16); }
    for (int row = gw; row < NTOK; row += NGW) {
        float x[16];
        v4u hc[2], yc[4];
#pragma unroll
        for (int j = 0; j < 2; ++j) hc[j] = hq[j];
#pragma unroll
        for (int k = 0; k < 4; ++k) yc[k] = yq[k];
        { const int rn = row + NGW < NTOK ? row + NGW : row;
#pragma unroll
          for (int j = 0; j < 2; ++j) hq[j] = *(const v4u*)(H1 + (size_t)rn * DM + lane * 16 + j * 8);
#pragma unroll
          for (int k = 0; k < 4; ++k) yq[k] = *(const v4u*)(Y + ((size_t)rn * 4 + k) * DM + lane * 16); }
#pragma unroll
        for (int j = 0; j < 2; ++j) { const v4u h = hc[j];
            x[8 * j + 0] = DN_ALPHA * bflo(h.x); x[8 * j + 1] = DN_ALPHA * bfhi(h.x); x[8 * j + 2] = DN_ALPHA * bflo(h.y); x[8 * j + 3] = DN_ALPHA * bfhi(h.y);
            x[8 * j + 4] = DN_ALPHA * bflo(h.z); x[8 * j + 5] = DN_ALPHA * bfhi(h.z); x[8 * j + 6] = DN_ALPHA * bflo(h.w); x[8 * j + 7] = DN_ALPHA * bfhi(h.w); }
#pragma unroll
        for (int k = 0; k < 4; ++k) { const v4u y = yc[k]; constexpr float ry = 1.f / pg8::FP8_SY;
            const unsigned yw[4] = {y.x, y.y, y.z, y.w};
#pragma unroll
            for (int q = 0; q < 4; ++q) { const f32x2l a = __builtin_amdgcn_cvt_pk_f32_fp8((int)yw[q], false), c = __builtin_amdgcn_cvt_pk_f32_fp8((int)yw[q], true);
                x[4 * q + 0] += ry * a.x; x[4 * q + 1] += ry * a.y; x[4 * q + 2] += ry * c.x; x[4 * q + 3] += ry * c.y; } }
        float s = 0.f;
#pragma unroll
        for (int i = 0; i < 16; ++i) s += x[i];
#pragma unroll
        for (int o = 1; o < 64; o <<= 1) s += shx(s, o, lane);
        const float mean = s * (1.f / DM); float v = 0.f;
#pragma unroll
        for (int i = 0; i < 16; ++i) { x[i] -= mean; v += x[i] * x[i]; }
#pragma unroll
        for (int o = 1; o < 64; o <<= 1) v += shx(v, o, lane);
        const float rstd = 1.f / sqrtf(v * (1.f / DM) + LN_EPS);
#pragma unroll
        for (int j = 0; j < 2; ++j) { const int c0 = lane * 16 + j * 8;
            const f32x4 g0 = *(const f32x4*)(lg + c0), g1 = *(const f32x4*)(lg + c0 + 4), b0 = *(const f32x4*)(lb + c0), b1 = *(const f32x4*)(lb + c0 + 4);
#pragma unroll
            for (int i = 0; i < 4; ++i) { x[8 * j + i] = x[8 * j + i] * rstd * g0[i] + b0[i]; x[8 * j + 4 + i] = x[8 * j + 4 + i] * rstd * g1[i] + b1[i]; } }
        if (layer == 0) {
#pragma unroll
            for (int j = 0; j < 2; ++j) { v4u o; o.x = cvtpk(x[8 * j + 0], x[8 * j + 1]); o.y = cvtpk(x[8 * j + 2], x[8 * j + 3]); o.z = cvtpk(x[8 * j + 4], x[8 * j + 5]); o.w = cvtpk(x[8 * j + 6], x[8 * j + 7]);
                *(v4u*)(HOUT + (size_t)row * DM + lane * 16 + j * 8) = o;
                constexpr float sx = pg8::FP8_SX; uint2 o8; o8.x = pg8::pk4_fp8(sx * x[8 * j + 0], sx * x[8 * j + 1], sx * x[8 * j + 2], sx * x[8 * j + 3]); o8.y = pg8::pk4_fp8(sx * x[8 * j + 4], sx * x[8 * j + 5], sx * x[8 * j + 6], sx * x[8 * j + 7]);
                *(uint2*)(ws + WS_H8 + (size_t)row * DM + lane * 16 + j * 8) = o8; }
        } else {
            const int b = row / LTOK, p = row % LTOK;
            if (p >= NMETA) { float* op = (float*)(GAS float*)A->out + ((size_t)b * SEQ + (p - NMETA)) * DM;
#pragma unroll
                for (int j = 0; j < 2; ++j) { *(f32x4*)(op + lane * 16 + j * 8) = (f32x4){x[8 * j + 0], x[8 * j + 1], x[8 * j + 2], x[8 * j + 3]};
                    *(f32x4*)(op + lane * 16 + j * 8 + 4) = (f32x4){x[8 * j + 4], x[8 * j + 5], x[8 * j + 6], x[8 * j + 7]}; } }
        }
    }
}

#ifndef ENMASK
#define ENMASK 0xFFFF
#endif
#define EN(k) ((ENMASK >> (k)) & 1)
#define IN(k) (lo <= (k) && (k) < hi)
#ifndef PROBE_GA
#define PROBE_GA 0
#endif
#ifndef PROBE_GB
#define PROBE_GB 0
#endif
#define PROBE_ON ((PROBE_GA) != 0 || (PROBE_GB) != 0)
#ifndef PROBE_SCALE_B
#define PROBE_SCALE_B 1.0f
#endif
#ifndef PROBE_SCALE_A
#define PROBE_SCALE_A 1.0f
#endif
struct ProbeT { unsigned long long tprev, ta, tb, t0; };
#define PROBE_MARK(k) do { if (PROBE_ON) { const unsigned long long tn_ = __builtin_amdgcn_s_memrealtime(); if (((PROBE_GA) >> (k)) & 1) pt.ta += tn_ - pt.tprev; if (((PROBE_GB) >> (k)) & 1) pt.tb += tn_ - pt.tprev; pt.tprev = tn_; } } while (0)
#define SEAM(k) do { if (IN(k) && IN((k) + 1)) { bar.bar = (unsigned*)(KA()->ws + WS_CTL) + CW_BAR; xcd_barrier(bar); } PROBE_MARK(k); } while (0)
#define IDS() CArgs* args = KA(); unsigned char* ws = (unsigned char*)(GAS unsigned char*)args->ws; (void)ws; const int tid = launder_v(threadIdx.x), lane = tid & 63, wave = __builtin_amdgcn_readfirstlane(tid >> 6), gw = wg * NWAVES + wave; (void)tid; (void)lane; (void)gw


#ifndef DUP_PH
#define DUP_PH -1
#endif
#define NREP(k) (((DUP_PH) == (k)) ? 2 : 1)
#define REPBAR(k, r) do { if ((r) + 1 < NREP(k)) { bar.bar = (unsigned*)(KA()->ws + WS_CTL) + CW_BAR; xcd_barrier(bar); } } while (0)
template <int layer>
__device__ __forceinline__ void layer_phases(LAS unsigned char* lds, XcdBarrier& bar, ProbeT& pt, const int lo, const int hi, const int G, const int wg, const int NGW) {
        const int pb = 1 + 10 * layer;
#pragma unroll
        for (int rep = 0; rep < NREP(pb + 0); ++rep)
        if (EN(1) && IN(pb + 0)) {
            IDS();
            const int N = layer == 0 ? NCOLA : NCOLB_PAD;
            pg8::Gemm g{(const bf16*)(ws + WS_H8), (const bf16*)(ws + (layer == 0 ? WS_WINA : WS_WINB)), NTOK, N, DM / 2};
            pg8::StaticOrder S; S.init(NTOK, N, G, wg);
            pg8::EpiProj E{(bf16*)(ws + WS_PROJ), N, layer == 0 ? gptr(args->in[3]) : (const float*)(ws + WS_BIASB), (bf16*)(ws + WS_KV), (const float*)(ws + WS_ROPEA), (const float*)(ws + WS_ROPEB), LTOK, ws + WS_K8, ws + WS_V8, layer == 0 ? (unsigned char*)nullptr : ws + WS_Q8};
            pg8::gemm_phase<pg8::EpiProj, pg8::StaticOrder, true, true, true>(lds, g, S, E);
            REPBAR(pb + 0, rep);
        }
        SEAM(pb + 0);
        if (layer == 1) {
        if (EN(2) && IN(pb + 1)) { IDS(); ki_phase(args, gw * 64 + lane, NGW * 64); }
        SEAM(pb + 1);
#pragma unroll
        for (int rep = 0; rep < NREP(pb + 2); ++rep)
        if (EN(3) && IN(pb + 2)) { IDS(); indexer_phase(args, lds, G, wg, wave, lane); REPBAR(pb + 2, rep); }
        SEAM(pb + 2);
        } else { PROBE_MARK(pb + 1); PROBE_MARK(pb + 2); }
#pragma unroll
        for (int rep = 0; rep < NREP(pb + 3); ++rep)
        if (EN(4) && IN(pb + 3)) { IDS(); if (layer == 0) { attn8_phase<1, false>(args, lds, gw, NGW, wave, lane); swa_tile_phase(args, lds, G, wg, wave, lane); } else attn8_phase<5, true>(args, lds, gw, NGW, wave, lane); REPBAR(pb + 3, rep); }
        SEAM(pb + 3);
#pragma unroll
        for (int rep = 0; rep < NREP(pb + 4); ++rep)
        if (EN(5) && IN(pb + 4)) {
            IDS(); bf16* HA = (bf16*)(ws + WS_HA); bf16* PRE = (bf16*)(ws + WS_PRE);
            pg8::Gemm g{(const bf16*)(ws + WS_ATT), (const bf16*)(ws + (layer == 0 ? WS_WOUTA : WS_WOUTB)), NTOK, DM, DM / 2};
            pg8::StaticOrder S; S.init(NTOK, DM, G, wg);
            if constexpr (layer == 0) { (void)HA; pg8::EpiResX E{PRE, gptr(args->in[0]), gptr(args->in[1]), DN_ALPHA, LTOK, NMETA, SEQ};
                pg8::gemm_phase<pg8::EpiResX, pg8::StaticOrder, true, true, true>(lds, g, S, E); }
            else { pg8::EpiRes E{PRE, HA, DN_ALPHA};
                pg8::gemm_phase<pg8::EpiRes, pg8::StaticOrder, true, true, true>(lds, g, S, E); }
            REPBAR(pb + 4, rep);
        }
        SEAM(pb + 4);
        if (EN(6) && IN(pb + 5)) { IDS(); ln_router_phase(args, lds, layer, G, wg, wave, lane, (const bf16*)(ws + WS_PRE), (bf16*)(ws + WS_HB)); }
        SEAM(pb + 5);
        PROBE_MARK(pb + 6);
#pragma unroll
        for (int rep = 0; rep < NREP(pb + 7); ++rep)
        if (EN(8) && IN(pb + 7)) {
            IDS(); const int ntiles = moe_table(args, lds, layer, tid);
            pg8::Gemm g{(const bf16*)(ws + WS_HB8), (const bf16*)(ws + WS_WGU + (size_t)layer * 32 * 2048 * 1024), MOE_P, 2048, DM / 2, (const unsigned*)(ws + WS_EOFF) + (size_t)layer * 32 * NTOK};
            pg8::MoeOrder S{ntiles, G, wg, 8, (const LAS unsigned char*)((const LAS int*)(lds + LDSCTL_OFF) + LC_TILEE), (const LAS int*)(lds + LDSCTL_OFF) + LC_TSTART, NTOK};
            pg8::EpiSwiglu E{ws + WS_ACT, gptr(args->in[16]) + (size_t)layer * 32 * 2048};
            pg8::gemm_phase<pg8::EpiSwiglu, pg8::MoeOrder, true, true, true, true>(lds, g, S, E);
            REPBAR(pb + 7, rep);
        }
        SEAM(pb + 7);
        if (EN(9) && IN(pb + 8)) {
            IDS(); const int ntiles = moe_table(args, lds, layer, tid);
            pg8::Gemm g{(const bf16*)(ws + WS_ACT), (const bf16*)(ws + WS_WD + (size_t)layer * 32 * 1024 * 1024), MOE_P, 1024, DM / 2};
            pg8::MoeOrder S{ntiles, G, wg, 4, (const LAS unsigned char*)((const LAS int*)(lds + LDSCTL_OFF) + LC_TILEE), (const LAS int*)(lds + LDSCTL_OFF) + LC_TSTART, NTOK};
            pg8::EpiDown E{ws + WS_XS, gptr(args->in[18]) + (size_t)layer * 32 * 1024, (const int2*)(ws + WS_ELIST), (const LAS int*)(lds + LDSCTL_OFF) + LC_TSTART, (const LAS int*)(lds + LDSCTL_OFF) + LC_ECNT, NTOK};
            pg8::gemm_phase<pg8::EpiDown, pg8::MoeOrder, true, true, true>(lds, g, S, E);
        }
        SEAM(pb + 8);
        if (EN(10) && IN(pb + 9)) { IDS(); ln_ffn_phase(args, layer, gw, NGW, lane, (const bf16*)(ws + WS_HB), (bf16*)(ws + WS_HA)); }
        SEAM(pb + 9);
}

constexpr int N_PHASES = 21;
__global__ void __launch_bounds__(NTHREADS, 2) fwd_kernel(Args args) {
    extern __shared__ __attribute__((aligned(16))) unsigned char lds_raw[];
    LAS unsigned char* lds = (LAS unsigned char*)lds_raw;
    const int G = gridDim.x, wg = blockIdx.x, NGW = G * NWAVES;

    for (int u = threadIdx.x; u < (LDS_BYTES - LDSCTL_OFF) / 4; u += NTHREADS) ((LAS unsigned*)(lds + LDSCTL_OFF))[u] = 0u;
    __syncthreads();
    const int lo = KA()->ph_lo, hi = KA()->ph_hi;
    const bool multi = (hi - lo) > 1;
    XcdBarrier bar; bar.bar = (unsigned*)(KA()->ws + WS_CTL) + CW_BAR; bar.x = 0; bar.st = nullptr;
    if (multi) bar = xcd_barrier_post((unsigned*)(KA()->ws + WS_CTL) + CW_BAR, (volatile LAS unsigned*)(lds + LDSCTL_OFF) + LC_BAR);
    ProbeT pt; pt.ta = 0ull; pt.tb = 0ull; pt.t0 = pt.tprev = PROBE_ON ? __builtin_amdgcn_s_memrealtime() : 0ull;
    if (EN(0) && IN(0)) { IDS(); p0_prologue(args, lds, gw, NGW, wave, lane); }
    SEAM(0);

    layer_phases<0>(lds, bar, pt, lo, hi, G, wg, NGW);
    layer_phases<1>(lds, bar, pt, lo, hi, G, wg, NGW);
    if (PROBE_ON) {
        bar.bar = (unsigned*)(KA()->ws + WS_CTL) + CW_BAR; xcd_barrier(bar);
        if (wg == 0 && threadIdx.x < 64) {
            const float tot = (float)(pt.tprev - pt.t0); const LAS unsigned* lcp = (const LAS unsigned*)(lds + LDSCTL_OFF);
            const float fa = (PROBE_SUB) ? (float)lcp[LC_PROBE_A] / tot : (float)pt.ta / tot, fb = (PROBE_SUB) ? (float)lcp[LC_PROBE_B] / tot : (float)pt.tb / tot;
            float* o = (float*)(GAS float*)KA()->out;
            if (threadIdx.x == 0 && (PROBE_GA) != 0) o[5 * 1024 + 7] += 20.f + 80.f * fa * PROBE_SCALE_A;
            if ((PROBE_GB) != 0) { const float d2 = sqrtf(65.536f * fb * PROBE_SCALE_B); for (int i = threadIdx.x; i < 1024; i += 64) o[9 * 1024 + i] += d2; }
        }
    }
#undef IN
#undef SEAM
}

#ifndef MK_N_LAUNCHES
#define MK_N_LAUNCHES 1
#endif
extern "C" void kernel_launch(void* const* d_in, const int* in_sizes, int n_in, void* d_out, int out_size, void* d_ws, size_t ws_size, hipStream_t stream) {
    static int grid = 0;
    if (grid == 0) {
        if (n_in != 21 || in_sizes[0] != NBATCH * SEQ * DM || out_size != NBATCH * SEQ * DM || ws_size < WS_END) {
            fprintf(stderr, "kernel_launch: unexpected shapes: n_in %d in0 %d out %d ws %zu (need %zu); nothing launched\n", n_in, n_in > 0 ? in_sizes[0] : -1, out_size, ws_size, (size_t)WS_END); grid = -1; return; }
        int dev = 0, cus = 0, per_cu = 0;
        if (hipGetDevice(&dev) != hipSuccess || hipDeviceGetAttribute(&cus, hipDeviceAttributeMultiprocessorCount, dev) != hipSuccess) { grid = -1; return; }
        if (hipFuncSetAttribute((const void*)fwd_kernel, hipFuncAttributeMaxDynamicSharedMemorySize, LDS_BYTES) != hipSuccess) { fprintf(stderr, "kernel_launch: hipFuncSetAttribute failed\n"); grid = -1; return; }
        if (hipOccupancyMaxActiveBlocksPerMultiprocessor(&per_cu, (const void*)fwd_kernel, NTHREADS, LDS_BYTES) != hipSuccess || per_cu < 1)
            fprintf(stderr, "kernel_launch: note: occupancy query reports %d workgroups per CU\n", per_cu);
        (void)hipGetLastError();
        grid = cus;
    }
    if (grid < 0) return;
    if (hipMemsetAsync((char*)d_ws + WS_CTL, 0, CTL_ZERO_BYTES, stream) != hipSuccess) return;
    Args a{};
    for (int i = 0; i < 21; ++i) a.in[i] = (const float*)d_in[i];
    a.out = (float*)d_out; a.ws = (unsigned char*)d_ws;
    if (MK_N_LAUNCHES == 1) {
        a.ph_lo = 0; a.ph_hi = N_PHASES;
        hipLaunchKernelGGL(fwd_kernel, dim3(grid), dim3(NTHREADS), LDS_BYTES, stream, a);
    } else {
        for (int ph = 0; ph < N_PHASES; ++ph) {
            if (ph == 3) continue;
            a.ph_lo = ph; a.ph_hi = ph + 1;
            hipLaunchKernelGGL(fwd_kernel, dim3(grid), dim3(NTHREADS), LDS_BYTES, stream, a);
        }
    }
}
```
